# Optimizing an MI355X kernel written in HIP

```python
import math
import jax
import jax.numpy as jnp
from jax import lax
import numpy as np

D_MODEL = 1024
BATCH = 8
SEQ = 4096
DEPTH = 2

CTX_LEN = 256
GRID_W = 64
N_MOD = 6
EPS = 1e-6
DA_WIDTH = D_MODEL // 2
DA_HEAD_DIM = 64
DA_V_DIM = 2 * DA_HEAD_DIM
DA_HEADS = DA_WIDTH // DA_V_DIM
DA_COLS = 3 * DA_WIDTH
Q_BLOCK = 128
ROPE_BASE = 10000.0
ROPE_NFREQ = DA_HEAD_DIM // 4
RW_WIDTH = D_MODEL - DA_WIDTH
RW_HEAD_DIM = 64
RW_HEADS = RW_WIDTH // RW_HEAD_DIM
RW_DECAY_LORA = 64
RW_AAA_LORA = 64
RW_GATE_LORA = 128
RW_COLS = 3 * RW_WIDTH + 2 * RW_DECAY_LORA + 2 * RW_AAA_LORA + RW_GATE_LORA
RW_SPLITS = (RW_WIDTH, 2 * RW_WIDTH, 3 * RW_WIDTH, 3 * RW_WIDTH + RW_DECAY_LORA, 3 * RW_WIDTH + 2 * RW_DECAY_LORA, 3 * RW_WIDTH + 2 * RW_DECAY_LORA + RW_AAA_LORA, 3 * RW_WIDTH + 2 * RW_DECAY_LORA + 2 * RW_AAA_LORA)
RW_GN_EPS = 64e-5
EVEN_IN_COLS = DA_COLS + RW_COLS
M_INNER = 2 * D_MODEL
M_HEAD_DIM = 64
M_HEADS = M_INNER // M_HEAD_DIM
M_GROUPS = 4
M_STATE = 128
M_BC = M_GROUPS * M_STATE
M_CONV = 3
M_CONV_DIM = M_INNER + 2 * M_BC
M_CHUNK = 128
ODD_IN_COLS = M_INNER + M_CONV_DIM + 2 * M_HEADS
PEER_HEADS = 8
PEER_NKEYS = 128
PEER_EXPERTS = PEER_NKEYS * PEER_NKEYS
PEER_HALF = 128
PEER_QDIM = 2 * PEER_HALF
PEER_TOPK = 16
PEER_BLOCK = 128

kernel_name = 'hybrid_diffattn_rwkv7_ssd_peer'

F32 = jnp.float32


def rmsnorm(x, g):
    xf = x.astype(F32)
    y = xf * lax.rsqrt(jnp.mean(xf * xf, axis=-1, keepdims=True) + EPS)
    return (y * g.astype(F32)).astype(x.dtype)


def modulate(h, shift, scale):
    return h * (1.0 + scale) + shift


def ada_mod(cvec, w, b):
    m = jax.nn.silu(cvec) @ w + b
    return [t[:, None, :] for t in jnp.split(m, N_MOD, axis=-1)]


def centred_shift(u):
    up = jnp.pad(u, ((0, 0), (1, 1), (0, 0)))
    return 0.5 * (up[:, :-2] + up[:, 2:])


def dwconv_centred(u, w, b):
    pad = w.shape[0] // 2
    out = lax.conv_general_dilated(u, w[:, None, :].astype(u.dtype), window_strides=(1,), padding=((pad, pad),), dimension_numbers=('NWC', 'WIO', 'NWC'), feature_group_count=u.shape[-1])
    return out + b


def axial_rope_tables(rows):
    n = rows * GRID_W
    row = jnp.repeat(jnp.arange(rows, dtype=F32), GRID_W)
    col = (jnp.arange(n) % GRID_W).astype(F32)
    inv = ROPE_BASE ** (-jnp.arange(ROPE_NFREQ, dtype=F32) / ROPE_NFREQ)
    ang = jnp.stack([row[:, None] * inv, col[:, None] * inv], axis=1)
    return jnp.cos(ang), jnp.sin(ang)


def apply_axial_rope(t, cos, sin):
    shp = t.shape
    tt = t.reshape(shp[:-1] + (2, 2, ROPE_NFREQ)).astype(F32)
    t1, t2 = tt[..., 0, :], tt[..., 1, :]
    cb = cos[None, :, None, None]
    sb = sin[None, :, None, None]
    out = jnp.stack([t1 * cb - t2 * sb, t2 * cb + t1 * sb], axis=-2)
    return out.reshape(shp).astype(t.dtype)


def diff_attention(q, k, v, lam):
    s = jnp.einsum('bqhmd,bkhmd->bhmqk', q, k).astype(F32) * (DA_HEAD_DIM ** -0.5)
    p = jax.nn.softmax(s, axis=-1)
    a = p[:, :, 0] - lam * p[:, :, 1]
    return jnp.einsum('bhqk,bkhe->bqhe', a.astype(v.dtype), v)


def split_attn(p):
    bsz, L = p.shape[:2]
    q = p[..., :DA_WIDTH].reshape(bsz, L, DA_HEADS, 2, DA_HEAD_DIM)
    k = p[..., DA_WIDTH:2 * DA_WIDTH].reshape(bsz, L, DA_HEADS, 2, DA_HEAD_DIM)
    v = p[..., 2 * DA_WIDTH:DA_COLS].reshape(bsz, L, DA_HEADS, DA_V_DIM)
    return q, k, v


def rwkv7_scan(r, decay, k, v, a, b, s0, reverse):
    xs = tuple(jnp.moveaxis(t, 1, 0) for t in (r, decay, k, v, a, b))

    def step(S, inp):
        rt, wt, kt, vt, at, bt = inp
        sa = jnp.einsum('bhvk,bhk->bhv', S, at)
        S = S * wt[:, :, None, :] + sa[..., None] * bt[:, :, None, :] + vt[..., None] * kt[:, :, None, :]
        return S, jnp.einsum('bhvk,bhk->bhv', S, rt)

    s_final, ys = lax.scan(step, s0, xs, reverse=reverse)
    return jnp.moveaxis(ys, 0, 1), s_final


def rwkv_prepare(u, mu, w0, w2, a0, a2, g2, k_k, k_a):
    bsz, L, _ = u.shape
    u = u + mu * (centred_shift(u) - u)
    r, k, v, w_f, w_b, a_f, a_b, g_in = jnp.split(u, RW_SPLITS, axis=-1)
    heads = lambda t: t.reshape(bsz, L, RW_HEADS, RW_HEAD_DIM)
    g = jax.nn.sigmoid(g_in) @ g2
    kk = heads(k * k_k).astype(F32)
    kk = kk / jnp.maximum(jnp.linalg.norm(kk, axis=-1, keepdims=True), 1e-12)
    per_dir = []
    for d, (w_in, a_in) in enumerate(((w_f, a_f), (w_b, a_b))):
        w_log = -jax.nn.softplus(-(w0[d] + jnp.tanh(w_in) @ w2[d])) - 0.5
        decay = jnp.exp(-jnp.exp(w_log.astype(F32)))
        a = jax.nn.sigmoid(a0[d] + a_in @ a2[d])
        k_d = k * (1.0 + (a - 1.0) * k_a)
        per_dir.append((heads(decay), heads(k_d), kk * heads(a).astype(F32)))
    return heads(r), heads(v), g, kk, per_dir


def rwkv_mix(r, v, g, kk, per_dir, init_states, r_k, lnx_w, lnx_b):
    bsz, L = r.shape[:2]
    ys = []
    finals = []
    for d in range(2):
        decay, k_d, b_vec = per_dir[d]
        y, s_t = rwkv7_scan(r, decay, k_d, v, -kk, b_vec, init_states[d], reverse=(d == 1))
        ys.append(y)
        finals.append(s_t)
    y = ys[0] + ys[1]
    mean = jnp.mean(y, axis=-1, keepdims=True)
    var = jnp.mean(jnp.square(y - mean), axis=-1, keepdims=True)
    y = (y - mean) * lax.rsqrt(var + RW_GN_EPS) * lnx_w.reshape(RW_HEADS, RW_HEAD_DIM) + lnx_b.reshape(RW_HEADS, RW_HEAD_DIM)
    bonus = (jnp.sum(r * per_dir[0][1] * r_k, axis=-1, keepdims=True) + jnp.sum(r * per_dir[1][1] * r_k, axis=-1, keepdims=True)) * v
    out = (y + bonus).reshape(bsz, L, RW_WIDTH) * g
    return out.astype(g.dtype), finals


def even_mixer(p_lat, p_ctx, da_lambda, da_subln, rw_mu, rw_w0, rw_w2, rw_a0, rw_a2, rw_g2, rw_kk, rw_ka, rw_rk, rw_lnx_w, rw_lnx_b, lam_init, rope):
    bsz, L = p_lat.shape[:2]
    lamp = da_lambda.astype(F32)
    lam = jnp.exp(jnp.sum(lamp[0] * lamp[1])) - jnp.exp(jnp.sum(lamp[2] * lamp[3])) + lam_init
    q_l, k_l, v_l = split_attn(p_lat)
    q_c, k_c, v_c = split_attn(p_ctx)
    o_c = diff_attention(q_c, k_c, v_c, lam)
    cos, sin = rope
    q_l = apply_axial_rope(q_l, cos, sin)
    k_l = apply_axial_rope(k_l, cos, sin)
    k_all = jnp.concatenate([k_c, k_l], axis=1)
    v_all = jnp.concatenate([v_c, v_l], axis=1)
    nb = L // Q_BLOCK
    q_blocks = jnp.moveaxis(q_l.reshape(bsz, nb, Q_BLOCK, DA_HEADS, 2, DA_HEAD_DIM), 1, 0)
    o_l = lax.map(lambda qb: diff_attention(qb, k_all, v_all, lam), q_blocks)
    o_l = jnp.moveaxis(o_l, 0, 1).reshape(bsz, L, DA_HEADS, DA_V_DIM)
    post = lambda o: (rmsnorm(o, da_subln) * (1.0 - lam_init)).reshape(o.shape[0], o.shape[1], DA_WIDTH)
    rw_args = (rw_mu, rw_w0, rw_w2, rw_a0, rw_a2, rw_g2, rw_kk, rw_ka)
    zero = jnp.zeros((bsz, RW_HEADS, RW_HEAD_DIM, RW_HEAD_DIM), F32)
    r_c, vv_c, g_c, kk_c, dir_c = rwkv_prepare(p_ctx[..., DA_COLS:], *rw_args)
    or_c, ctx_states = rwkv_mix(r_c, vv_c, g_c, kk_c, dir_c, [zero, zero], rw_rk, rw_lnx_w, rw_lnx_b)
    r_l, vv_l, g_l, kk_l, dir_l = rwkv_prepare(p_lat[..., DA_COLS:], *rw_args)
    or_l, _ = rwkv_mix(r_l, vv_l, g_l, kk_l, dir_l, ctx_states, rw_rk, rw_lnx_w, rw_lnx_b)
    o_lat = jnp.concatenate([post(o_l), or_l], axis=-1)
    o_ctx = jnp.concatenate([post(o_c), or_c], axis=-1)
    return o_lat, o_ctx


def peer(h, wq, keys, U, V):
    bsz, L, D = h.shape
    q = (h @ wq).reshape(bsz, L, PEER_HEADS, 2, PEER_HALF)
    s = jnp.einsum('blhpd,hpkd->blhpk', q, keys).astype(F32)
    v1, i1 = lax.top_k(s[..., 0, :], PEER_TOPK)
    v2, i2 = lax.top_k(s[..., 1, :], PEER_TOPK)
    cand = (v1[..., :, None] + v2[..., None, :]).reshape(bsz, L, PEER_HEADS, PEER_TOPK * PEER_TOPK)
    cidx = (i1[..., :, None] * PEER_NKEYS + i2[..., None, :]).reshape(bsz, L, PEER_HEADS, PEER_TOPK * PEER_TOPK)
    top_s, pos = lax.top_k(cand, PEER_TOPK)
    idx = jnp.take_along_axis(cidx, pos, axis=-1)
    gates = jax.nn.softmax(top_s, axis=-1)
    T = bsz * L
    nblk = T // PEER_BLOCK
    hb = h.reshape(nblk, PEER_BLOCK, D)
    ib = idx.reshape(nblk, PEER_BLOCK, PEER_HEADS * PEER_TOPK)
    gb = gates.reshape(nblk, PEER_BLOCK, PEER_HEADS * PEER_TOPK).astype(h.dtype)

    def block(args):
        hx, ix, gx = args
        act = jax.nn.gelu(jnp.einsum('td,ted->te', hx, U[ix]), approximate=False)
        return jnp.einsum('te,ted->td', gx * act, V[ix])

    out = lax.map(block, (hb, ib, gb))
    return out.reshape(bsz, L, D)


def even_layer(x_lat, x_ctx, c, c_ctx, ada_w, ada_b, norm1, norm2, win, da_lambda, da_subln, rw_mu, rw_w0, rw_w2, rw_a0, rw_a2, rw_g2, rw_kk, rw_ka, rw_rk, rw_lnx_w, rw_lnx_b, wout, peer_q, peer_keys, peer_u, peer_v, lam_init, rope, last):
    ml = ada_mod(c, ada_w, ada_b)
    mc = ada_mod(c_ctx[None, :], ada_w, ada_b)
    p_lat = modulate(rmsnorm(x_lat, norm1), ml[0], ml[1]) @ win
    p_ctx = modulate(rmsnorm(x_ctx, norm1), mc[0], mc[1]) @ win
    o_lat, o_ctx = even_mixer(p_lat, p_ctx, da_lambda, da_subln, rw_mu, rw_w0, rw_w2, rw_a0, rw_a2, rw_g2, rw_kk, rw_ka, rw_rk, rw_lnx_w, rw_lnx_b, lam_init, rope)
    x_lat = x_lat + ml[2] * (o_lat @ wout)
    x_lat = x_lat + ml[5] * peer(modulate(rmsnorm(x_lat, norm2), ml[3], ml[4]), peer_q, peer_keys, peer_u, peer_v)
    if last:
        return x_lat, None
    x_ctx = x_ctx + mc[2] * (o_ctx @ wout)
    x_ctx = x_ctx + mc[5] * peer(modulate(rmsnorm(x_ctx, norm2), mc[3], mc[4]), peer_q, peer_keys, peer_u, peer_v)
    return x_lat, x_ctx


def mamba_pre(p, conv_w, conv_b, dt_bias):
    bsz, L, _ = p.shape
    xbc = jax.nn.silu(dwconv_centred(p[..., :M_CONV_DIM], conv_w, conv_b))
    xs = xbc[..., :M_INNER].reshape(bsz, L, M_HEADS, M_HEAD_DIM)
    Bm = xbc[..., M_INNER:M_INNER + M_BC].reshape(bsz, L, M_GROUPS, M_STATE)
    Cm = xbc[..., M_INNER + M_BC:].reshape(bsz, L, M_GROUPS, M_STATE)
    dt = jax.nn.softplus(p[..., M_CONV_DIM:].reshape(bsz, L, 2, M_HEADS).astype(F32) + dt_bias)
    return xs, Bm, Cm, dt


def ssd_chunked(xs, dt, A, Bm, Cm, h0, with_output):
    bsz, L, H, P = xs.shape
    G, N = Bm.shape[2], Bm.shape[3]
    hg = H // G
    nc = L // M_CHUNK
    dtf = dt.astype(F32)
    xdt = (xs * dtf[..., None]).reshape(bsz, nc, M_CHUNK, G, hg, P)
    a_cs = jnp.cumsum(dtf.reshape(bsz, nc, M_CHUNK, G, hg) * A.reshape(G, hg), axis=2)
    Bc = Bm.reshape(bsz, nc, M_CHUNK, G, N)
    a_last = a_cs[:, :, -1]
    states = jnp.einsum('bclgn,bclgh,bclghp->bcghpn', Bc, jnp.exp(a_last[:, :, None] - a_cs), xdt)

    def carry_step(h, inp):
        al, st = inp
        return h * jnp.exp(al)[..., None, None] + st, h

    h_final, h_prev = lax.scan(carry_step, h0, (jnp.moveaxis(a_last, 1, 0), jnp.moveaxis(states, 1, 0)))
    if not with_output:
        return None, h_final
    Cc = Cm.reshape(bsz, nc, M_CHUNK, G, N)
    h_prev = jnp.moveaxis(h_prev, 0, 1)
    seg = a_cs[:, :, :, None] - a_cs[:, :, None, :]
    lower = jnp.tril(jnp.ones((M_CHUNK, M_CHUNK), dtype=bool))
    lmat = jnp.exp(jnp.where(lower[:, :, None, None], seg, -jnp.inf))
    cb = jnp.einsum('bclgn,bcsgn->bclsg', Cc, Bc)
    y_diag = jnp.einsum('bclsg,bclsgh,bcsghp->bclghp', cb, lmat, xdt)
    y_off = jnp.einsum('bclgn,bcghpn,bclgh->bclghp', Cc, h_prev, jnp.exp(a_cs))
    return (y_diag + y_off).reshape(bsz, L, H, P), h_final


def ssd_bidir(xs, Bm, Cm, dt, A, h0_f, h0_b, with_output):
    flip = lambda t: jnp.flip(t, axis=1)
    y_f, h_f = ssd_chunked(xs, dt[:, :, 0], A[0], Bm, Cm, h0_f, with_output)
    y_b, h_b = ssd_chunked(flip(xs), flip(dt[:, :, 1]), A[1], flip(Bm), flip(Cm), h0_b, with_output)
    y = y_f + flip(y_b) if with_output else None
    return y, h_f, h_b


def mamba_out(y, xs, z, d_skip, gnorm, wout):
    bsz, L = z.shape[:2]
    y = y + d_skip.astype(F32)[:, None] * xs.astype(F32)
    y = y.reshape(bsz, L, M_INNER) * jax.nn.silu(z.astype(F32))
    yg = y.reshape(bsz, L, M_GROUPS, M_INNER // M_GROUPS)
    yg = yg * lax.rsqrt(jnp.mean(yg * yg, axis=-1, keepdims=True) + EPS)
    y = yg.reshape(bsz, L, M_INNER) * gnorm
    return y.astype(z.dtype) @ wout


def odd_layer(x_lat, x_ctx, c, c_ctx, ada_w, ada_b, norm1, norm2, win, conv_w, conv_b, dt_bias, a_log, d_skip, gnorm, wout, peer_q, peer_keys, peer_u, peer_v, last):
    bsz = x_lat.shape[0]
    ml = ada_mod(c, ada_w, ada_b)
    mc = ada_mod(c_ctx[None, :], ada_w, ada_b)
    A = -jnp.exp(a_log.astype(F32))
    p_lat = modulate(rmsnorm(x_lat, norm1), ml[0], ml[1]) @ win
    h_ctx = modulate(rmsnorm(x_ctx, norm1), mc[0], mc[1])
    p_ctx = h_ctx @ (win[:, M_INNER:] if last else win)
    rest_ctx = p_ctx if last else p_ctx[..., M_INNER:]
    xs_c, Bm_c, Cm_c, dt_c = mamba_pre(rest_ctx, conv_w, conv_b, dt_bias)
    h0 = jnp.zeros((bsz, M_GROUPS, M_HEADS // M_GROUPS, M_HEAD_DIM, M_STATE), F32)
    y_c, h_f, h_b = ssd_bidir(xs_c, Bm_c, Cm_c, dt_c, A, h0, h0, not last)
    xs_l, Bm_l, Cm_l, dt_l = mamba_pre(p_lat[..., M_INNER:], conv_w, conv_b, dt_bias)
    y_l, _, _ = ssd_bidir(xs_l, Bm_l, Cm_l, dt_l, A, h_f, h_b, True)
    x_lat = x_lat + ml[2] * mamba_out(y_l, xs_l, p_lat[..., :M_INNER], d_skip, gnorm, wout)
    x_lat = x_lat + ml[5] * peer(modulate(rmsnorm(x_lat, norm2), ml[3], ml[4]), peer_q, peer_keys, peer_u, peer_v)
    if last:
        return x_lat, None
    x_ctx = x_ctx + mc[2] * mamba_out(y_c, xs_c, p_ctx[..., :M_INNER], d_skip, gnorm, wout)
    x_ctx = x_ctx + mc[5] * peer(modulate(rmsnorm(x_ctx, norm2), mc[3], mc[4]), peer_q, peer_keys, peer_u, peer_v)
    return x_lat, x_ctx


def setup_inputs(seed: int = 0) -> dict:
    key = jax.random.key(seed)
    keys = list(jax.random.split(key, 80))

    def nk():
        return keys.pop()

    def nrm(shape, scale):
        return scale * jax.random.normal(nk(), shape, F32)

    def gain(n):
        return 1.0 + 0.02 * jax.random.normal(nk(), (n,), F32)

    D = D_MODEL
    inp = {}
    inp['x'] = nrm((BATCH, SEQ, D), 1.0)
    inp['c'] = nrm((BATCH, D), 1.0)
    inp['ctx'] = nrm((BATCH, CTX_LEN, D), 1.0)
    inp['c_ctx'] = nrm((D,), 1.0)
    inp['ada_w_0'] = nrm((D, N_MOD * D), 0.5 * D ** -0.5)
    inp['ada_b_0'] = nrm((N_MOD * D,), 0.02)
    inp['norm1_0'] = gain(D)
    inp['norm2_0'] = gain(D)
    inp['win_0'] = nrm((D, EVEN_IN_COLS), D ** -0.5)
    inp['da_lambda_0'] = nrm((4, DA_HEAD_DIM), 0.1)
    inp['da_subln_0'] = gain(DA_V_DIM)
    inp['rw_mu_0'] = jax.random.uniform(nk(), (RW_COLS,), F32)
    inp['rw_w0_0'] = jax.random.uniform(nk(), (2, RW_WIDTH), F32, -6.0, -1.0)
    inp['rw_w2_0'] = nrm((2, RW_DECAY_LORA, RW_WIDTH), 0.1)
    inp['rw_a0_0'] = nrm((2, RW_WIDTH), 0.1)
    inp['rw_a2_0'] = nrm((2, RW_AAA_LORA, RW_WIDTH), 0.1)
    inp['rw_g2_0'] = nrm((RW_GATE_LORA, RW_WIDTH), RW_GATE_LORA ** -0.5)
    inp['rw_kk_0'] = 0.85 + nrm((RW_WIDTH,), 0.02)
    inp['rw_ka_0'] = gain(RW_WIDTH)
    inp['rw_rk_0'] = nrm((RW_HEADS, RW_HEAD_DIM), 0.1)
    inp['rw_lnx_w_0'] = gain(RW_WIDTH)
    inp['rw_lnx_b_0'] = nrm((RW_WIDTH,), 0.02)
    inp['wout_0'] = nrm((D, D), D ** -0.5)
    inp['peer_q_0'] = nrm((D, PEER_HEADS * PEER_QDIM), D ** -0.5)
    inp['peer_keys_0'] = nrm((PEER_HEADS, 2, PEER_NKEYS, PEER_HALF), PEER_HALF ** -0.5)
    inp['peer_u_0'] = nrm((PEER_EXPERTS, D), D ** -0.5)
    inp['peer_v_0'] = nrm((PEER_EXPERTS, D), 0.5)
    inp['ada_w_1'] = nrm((D, N_MOD * D), 0.5 * D ** -0.5)
    inp['ada_b_1'] = nrm((N_MOD * D,), 0.02)
    inp['norm1_1'] = gain(D)
    inp['norm2_1'] = gain(D)
    inp['win_1'] = nrm((D, ODD_IN_COLS), D ** -0.5)
    inp['conv_w_1'] = nrm((M_CONV, M_CONV_DIM), M_CONV ** -0.5)
    inp['conv_b_1'] = nrm((M_CONV_DIM,), 0.02)
    u = jax.random.uniform(nk(), (2, M_HEADS), F32)
    dt0 = jnp.exp(u * (math.log(0.1) - math.log(1e-3)) + math.log(1e-3))
    inp['dt_bias_1'] = dt0 + jnp.log(-jnp.expm1(-dt0))
    inp['a_log_1'] = jnp.log(jax.random.uniform(nk(), (2, M_HEADS), F32, 1.0, 16.0))
    inp['d_skip_1'] = gain(M_HEADS)
    inp['gnorm_1'] = gain(M_INNER)
    inp['wout_1'] = nrm((M_INNER, D), M_INNER ** -0.5)
    inp['peer_q_1'] = nrm((D, PEER_HEADS * PEER_QDIM), D ** -0.5)
    inp['peer_keys_1'] = nrm((PEER_HEADS, 2, PEER_NKEYS, PEER_HALF), PEER_HALF ** -0.5)
    inp['peer_u_1'] = nrm((PEER_EXPERTS, D), D ** -0.5)
    inp['peer_v_1'] = nrm((PEER_EXPERTS, D), 0.5)
    inp['norm_f'] = gain(D)
    return inp


def reference(x, c, ctx, c_ctx, ada_w_0, ada_b_0, norm1_0, norm2_0, win_0, da_lambda_0, da_subln_0, rw_mu_0, rw_w0_0, rw_w2_0, rw_a0_0, rw_a2_0, rw_g2_0, rw_kk_0, rw_ka_0, rw_rk_0, rw_lnx_w_0, rw_lnx_b_0, wout_0, peer_q_0, peer_keys_0, peer_u_0, peer_v_0, ada_w_1, ada_b_1, norm1_1, norm2_1, win_1, conv_w_1, conv_b_1, dt_bias_1, a_log_1, d_skip_1, gnorm_1, wout_1, peer_q_1, peer_keys_1, peer_u_1, peer_v_1, norm_f):
    rows = x.shape[1] // GRID_W
    rope = axial_rope_tables(rows)
    layer_params = (
        (ada_w_0, ada_b_0, norm1_0, norm2_0, win_0, da_lambda_0, da_subln_0, rw_mu_0, rw_w0_0, rw_w2_0, rw_a0_0, rw_a2_0, rw_g2_0, rw_kk_0, rw_ka_0, rw_rk_0, rw_lnx_w_0, rw_lnx_b_0, wout_0, peer_q_0, peer_keys_0, peer_u_0, peer_v_0),
        (ada_w_1, ada_b_1, norm1_1, norm2_1, win_1, conv_w_1, conv_b_1, dt_bias_1, a_log_1, d_skip_1, gnorm_1, wout_1, peer_q_1, peer_keys_1, peer_u_1, peer_v_1),
    )
    h_lat, h_ctx = x, ctx
    for layer in range(DEPTH):
        last = layer == DEPTH - 1
        if layer % 2 == 0:
            lam_init = 0.8 - 0.6 * math.exp(-0.3 * layer)
            h_lat, h_ctx = even_layer(h_lat, h_ctx, c, c_ctx, *layer_params[layer], lam_init=lam_init, rope=rope, last=last)
        else:
            h_lat, h_ctx = odd_layer(h_lat, h_ctx, c, c_ctx, *layer_params[layer], last=last)
    return rmsnorm(h_lat, norm_f)
```

```cpp
#include <hip/hip_runtime.h>
#include <stdint.h>
#include <stdio.h>

#ifndef N_LAUNCH_MODE
#define N_LAUNCH_MODE 0
#endif

#define DI __device__ __forceinline__
typedef unsigned short bf16_t;
typedef __attribute__((ext_vector_type(8))) short bf16x8;
typedef __attribute__((ext_vector_type(16))) float f32x16;
typedef __attribute__((ext_vector_type(2))) __bf16 bf2_t;

constexpr int D = 1024, NB = 8, SEQ = 4096, CTXL = 256, TPB = SEQ + CTXL, R = NB * TPB;
constexpr int NTHR = 512;
constexpr int LDS_BYTES = 147456;
constexpr int P0LD = 3456;
constexpr int P1LD = 5184;
constexpr int P1NPAD = 5248;

enum { I_X = 0, I_C, I_CTX, I_CCTX,
       I_ADAW0, I_ADAB0, I_N1_0, I_N2_0, I_WIN0, I_DALAM, I_DASUB, I_RWMU, I_RWW0, I_RWW2, I_RWA0, I_RWA2, I_RWG2, I_RWKK, I_RWKA, I_RWRK, I_LNXW, I_LNXB, I_WOUT0, I_PQ0, I_PK0, I_PU0, I_PV0,
       I_ADAW1, I_ADAB1, I_N1_1, I_N2_1, I_WIN1, I_CONVW, I_CONVB, I_DTB, I_ALOG, I_DSKIP, I_GNORM, I_WOUT1, I_PQ1, I_PK1, I_PU1, I_PV1, I_NF, N_IN };

constexpr size_t MiB = 1048576;
constexpr size_t WS_CTL = 0;
constexpr size_t WS_SCAL = 65536;
constexpr size_t WS_MODS = 131072;
constexpr size_t WS_ROPE = 1 * MiB;
constexpr size_t WS_RWT = 2 * MiB;
constexpr size_t WS_WIN0T = 3 * MiB;
constexpr size_t WS_WOUT0T = 10 * MiB;
constexpr size_t WS_PQ0T = 12 * MiB;
constexpr size_t WS_KEYS0 = 16 * MiB;
constexpr size_t WS_KEYS1 = 16 * MiB + 524288;
constexpr size_t WS_WIN1T = 17 * MiB;
constexpr size_t WS_WOUT1T = 28 * MiB;
constexpr size_t WS_PQ1T = 32 * MiB;
constexpr size_t WS_PB = 36 * MiB;
constexpr size_t WS_XC = 381 * MiB;
constexpr size_t WS_HB = 389 * MiB;
constexpr size_t WS_END = 457 * MiB;
constexpr size_t WS_YF = WS_XC;
constexpr size_t PB_P = 0;
constexpr size_t PB_O0 = 230 * MiB;
constexpr size_t PB_G = 298 * MiB;
constexpr size_t PB_GA = 332 * MiB;
constexpr size_t PB_BONUS = 341 * MiB;
constexpr size_t PB_H2 = 0;
constexpr size_t PB_Q = 68 * MiB;
constexpr size_t PB_IDX = 204 * MiB;
constexpr size_t PB_GATE = 221 * MiB;
constexpr size_t HB_YF = 0, HB_YB = 34 * MiB;
constexpr size_t HB_U = 0, HB_V = 32 * MiB;

struct P {
  const float* in[N_IN];
  float* out;
  unsigned char* ws;
  int ph_lo, ph_hi;
};

DI unsigned pack_bf2(float a, float b) { bf2_t v; v[0] = (__bf16)a; v[1] = (__bf16)b; return __builtin_bit_cast(unsigned, v); }
DI bf16_t f2bf(float a) { return __builtin_bit_cast(unsigned short, (__bf16)a); }
DI float bf2f(bf16_t v) { return __uint_as_float((unsigned)v << 16); }
DI float bflo(unsigned u) { return __uint_as_float(u << 16); }
DI float bfhi(unsigned u) { return __uint_as_float(u & 0xffff0000u); }
template <int CTRL> DI float dpp_f(float x) { return __int_as_float(__builtin_amdgcn_update_dpp(0, __float_as_int(x), CTRL, 0xF, 0xF, true)); }
DI float red4(float x) { x += dpp_f<0xB1>(x); x += dpp_f<0x4E>(x); return x; }
DI float red8(float x) { x += dpp_f<0x141>(x); return red4(x); }
DI float red16(float x) { x += dpp_f<0x140>(x); return red8(x); }
DI float red64(float x) { x = red16(x); x += __shfl_xor(x, 16); x += __shfl_xor(x, 32); return x; }
DI float sigmoidf_(float x) { return 1.f / (1.f + __expf(-x)); }
DI float siluf_(float x) { return x / (1.f + __expf(-x)); }
DI float softplusf_(float x) { return x > 20.f ? x : log1pf(__expf(x)); }
DI float geluf_(float x) { return 0.5f * x * (1.f + erff(x * 0.70710678118654752f)); }
DI void unpack8(const uint4& u, float (&f)[8]) { f[0] = bflo(u.x); f[1] = bfhi(u.x); f[2] = bflo(u.y); f[3] = bfhi(u.y); f[4] = bflo(u.z); f[5] = bfhi(u.z); f[6] = bflo(u.w); f[7] = bfhi(u.w); }
DI uint4 pack8(const float (&f)[8]) { uint4 u; u.x = pack_bf2(f[0], f[1]); u.y = pack_bf2(f[2], f[3]); u.z = pack_bf2(f[4], f[5]); u.w = pack_bf2(f[6], f[7]); return u; }
#define ACC_ROW(reg, lane) (((reg) & 3) + 8 * ((reg) >> 2) + 4 * ((lane) >> 5))
#define MFMA32(a, b, c) __builtin_amdgcn_mfma_f32_32x32x16_bf16((a), (b), (c), 0, 0, 0)

#define XB_TMO      128
#define XB_XCNT(j)  (256  + 64 * (j))
#define XB_XSUB(j)  (1280 + 64 * (j))
#define XB_XGEN(j)  (2304 + 64 * (j))
#define XB_TOP      3328
#define XB_TOPGEN   3392
#define XCD_BAR_WORDS 3456
#define XB_SPIN_CAP (1u << 22)
#define LAS __attribute__((address_space(3)))
DI unsigned xb_ld(unsigned* p) { return __hip_atomic_load(p, __ATOMIC_RELAXED, __HIP_MEMORY_SCOPE_AGENT); }
DI unsigned xb_add(unsigned* p, unsigned v) { return __hip_atomic_fetch_add(p, v, __ATOMIC_RELAXED, __HIP_MEMORY_SCOPE_AGENT); }
DI unsigned xb_xcc_id() { return (unsigned)__builtin_amdgcn_s_getreg((3 << 11) | 20) & 0xFu; }
#define XB_SPIN(cond, bar) do { unsigned _sp = 0; while (cond) { __builtin_amdgcn_s_sleep(1); \
    if ((++_sp & 255u) == 0u) { if (xb_ld(&(bar)[XB_TMO])) break; if (_sp > XB_SPIN_CAP) { atomicAdd(&(bar)[XB_TMO], 1u); break; } } } } while (0)
struct XcdBarrier { unsigned* bar; unsigned x; volatile LAS unsigned* st; };
DI XcdBarrier xcd_barrier_post(unsigned* bar, volatile LAS unsigned* st) {
  XcdBarrier b; b.bar = bar; b.x = xb_xcc_id(); b.st = st;
  if (threadIdx.x == 0) (void)xb_add(&bar[XB_XCNT(b.x)], 1u);
  return b;
}
DI void xcd_barrier_complete(unsigned* bar, unsigned x, unsigned& nloc, unsigned& nx) {
  const unsigned G = gridDim.x * gridDim.y * gridDim.z;
  unsigned sum, cnt, mine, sp = 0u;
  for (;;) {
    sum = 0u; cnt = 0u; mine = 0u;
#pragma unroll
    for (unsigned j = 0; j < 16; ++j) { const unsigned c = xb_ld(&bar[XB_XCNT(j)]); sum += c; cnt += (c > 0u) ? 1u : 0u; mine = (j == x) ? c : mine; }
    if (sum == G) break;
    __builtin_amdgcn_s_sleep(1);
    if ((++sp & 255u) == 0u) { if (xb_ld(&bar[XB_TMO])) break; if (sp > XB_SPIN_CAP) { atomicAdd(&bar[XB_TMO], 1u); break; } }
  }
  nloc = mine > 0u ? mine : 1u; nx = cnt > 0u ? cnt : 1u;
}
DI void xcd_barrier(const XcdBarrier& b) {
  asm volatile("s_waitcnt vmcnt(0)" ::: "memory");
  __syncthreads();
  if (threadIdx.x == 0) {
    unsigned* bar = b.bar;
    __builtin_amdgcn_s_waitcnt(0);
    unsigned nloc = b.st[0], nx = b.st[1];
    if (nloc == 0u) { xcd_barrier_complete(bar, b.x, nloc, nx); b.st[0] = nloc; b.st[1] = nx; }
    const unsigned old = xb_add(&bar[XB_XSUB(b.x)], 1u);
    const unsigned gen = old / nloc;
    if (old + 1u == (gen + 1u) * nloc) {
      __builtin_amdgcn_fence(__ATOMIC_RELEASE, "agent");
      asm volatile("s_waitcnt vmcnt(0)" ::: "memory");
      const unsigned og = xb_add(&bar[XB_TOP], 1u);
      const unsigned tg = og / nx;
      if (og + 1u == (tg + 1u) * nx) xb_add(&bar[XB_TOPGEN], 1u);
      else XB_SPIN(xb_ld(&bar[XB_TOPGEN]) == tg, bar);
      __builtin_amdgcn_fence(__ATOMIC_ACQUIRE, "agent");
      xb_add(&bar[XB_XGEN(b.x)], 1u);
      asm volatile("s_waitcnt vmcnt(0)" ::: "memory");
    } else {
      XB_SPIN(xb_ld(&bar[XB_XGEN(b.x)]) == gen, bar);
      __builtin_amdgcn_fence(__ATOMIC_ACQUIRE, "agent");
      asm volatile("s_waitcnt vmcnt(0)" ::: "memory");
    }
  }
  __syncthreads();
}

DI void gemm_tile(char* lds, const bf16_t* __restrict__ A, int lda, const bf16_t* __restrict__ Bt, int ldb, int K, f32x16 (&acc)[2][2]) {
  const int tid = threadIdx.x, lane = tid & 63, wave = tid >> 6, wm = wave >> 1, wn = wave & 1;
#pragma unroll
  for (int i = 0; i < 2; ++i)
#pragma unroll
    for (int j = 0; j < 2; ++j)
#pragma unroll
      for (int r = 0; r < 16; ++r) acc[i][j][r] = 0.f;
  const int arow0 = tid >> 3, ac = tid & 7;
  const bf16_t* ap = A + (size_t)arow0 * lda + ac * 8;
  const bf16_t* bp = Bt + (size_t)arow0 * ldb + ac * 8;
  const int sw = ((ac ^ (arow0 >> 1)) & 7) << 4;
  const int st_off = arow0 * 128 + sw;
  uint4 ra[4], rb[2];
#pragma unroll
  for (int i = 0; i < 4; ++i) ra[i] = *(const uint4*)(ap + (size_t)i * 64 * lda);
#pragma unroll
  for (int i = 0; i < 2; ++i) rb[i] = *(const uint4*)(bp + (size_t)i * 64 * ldb);
#pragma unroll
  for (int i = 0; i < 4; ++i) *(uint4*)(lds + st_off + i * 8192) = ra[i];
#pragma unroll
  for (int i = 0; i < 2; ++i) *(uint4*)(lds + 65536 + st_off + i * 8192) = rb[i];
  __syncthreads();
  const int nk = K >> 6;
  const int r31 = lane & 31, hh = lane >> 5;
  for (int kt = 0; kt < nk; ++kt) {
    const int cur = kt & 1;
    if (kt + 1 < nk) {
#pragma unroll
      for (int i = 0; i < 4; ++i) ra[i] = *(const uint4*)(ap + (size_t)i * 64 * lda + (kt + 1) * 64);
#pragma unroll
      for (int i = 0; i < 2; ++i) rb[i] = *(const uint4*)(bp + (size_t)i * 64 * ldb + (kt + 1) * 64);
    }
    const char* la = lds + cur * 32768;
    const char* lb = lds + 65536 + cur * 16384;
#pragma unroll
    for (int kk = 0; kk < 4; ++kk) {
      const int c = kk * 2 + hh;
      bf16x8 a[2], b[2];
#pragma unroll
      for (int mi = 0; mi < 2; ++mi) { const int row = wm * 64 + mi * 32 + r31; a[mi] = *(const bf16x8*)(la + row * 128 + (((c ^ (row >> 1)) & 7) << 4)); }
#pragma unroll
      for (int ni = 0; ni < 2; ++ni) { const int row = wn * 64 + ni * 32 + r31; b[ni] = *(const bf16x8*)(lb + row * 128 + (((c ^ (row >> 1)) & 7) << 4)); }
#pragma unroll
      for (int mi = 0; mi < 2; ++mi)
#pragma unroll
        for (int ni = 0; ni < 2; ++ni) acc[mi][ni] = MFMA32(a[mi], b[ni], acc[mi][ni]);
    }
    if (kt + 1 < nk) {
      char* wa = lds + (cur ^ 1) * 32768;
      char* wb = lds + 65536 + (cur ^ 1) * 16384;
#pragma unroll
      for (int i = 0; i < 4; ++i) *(uint4*)(wa + st_off + i * 8192) = ra[i];
#pragma unroll
      for (int i = 0; i < 2; ++i) *(uint4*)(wb + st_off + i * 8192) = rb[i];
    }
    __syncthreads();
  }
}

DI void gemm_store_phase(char* lds, const bf16_t* A, int lda, const bf16_t* Bt, int ldb, int M, int Npad, int K, bf16_t* C, int ldc, int nvalid) {
  const int ntn = Npad / 128, ntm = M / 256;
  const int lane = threadIdx.x & 63, wave = threadIdx.x >> 6, wm = wave >> 1, wn = wave & 1;
  for (int tile = blockIdx.x; tile < ntm * ntn; tile += gridDim.x) {
    const int mt = tile / ntn, nt = tile - mt * ntn;
    f32x16 acc[2][2];
    gemm_tile(lds, A + (size_t)mt * 256 * lda, lda, Bt + (size_t)nt * 128 * ldb, ldb, K, acc);
#pragma unroll
    for (int mi = 0; mi < 2; ++mi)
#pragma unroll
      for (int ni = 0; ni < 2; ++ni) {
        const int col = nt * 128 + wn * 64 + ni * 32 + (lane & 31);
        if (col < nvalid) {
#pragma unroll
          for (int r = 0; r < 16; ++r) {
            const int row = mt * 256 + wm * 64 + mi * 32 + ACC_ROW(r, lane);
            C[(size_t)row * ldc + col] = f2bf(acc[mi][ni][r]);
          }
        }
      }
  }
}

DI void gemm_resid_phase(const P& p, char* lds, int layer, const bf16_t* A, int lda, const bf16_t* Bt, int K) {
  const int ntn = 8, ntm = R / 256;
  const int lane = threadIdx.x & 63, wave = threadIdx.x >> 6, wm = wave >> 1, wn = wave & 1;
  const float* mods = (const float*)(p.ws + WS_MODS) + (size_t)layer * 9 * 6144;
  float* xc = (float*)(p.ws + WS_XC);
  for (int tile = blockIdx.x; tile < ntm * ntn; tile += gridDim.x) {
    const int mt = tile / ntn, nt = tile - mt * ntn;
    if (layer == 1 && (mt % 17) == 0) continue;
    f32x16 acc[2][2];
    gemm_tile(lds, A + (size_t)mt * 256 * lda, lda, Bt + (size_t)nt * 128 * K, K, K, acc);
    const int b = mt / 17;
    const bool isctx = (mt % 17) == 0;
    const float* gate = mods + (isctx ? 8 : b) * 6144 + 2 * 1024;
#pragma unroll
    for (int mi = 0; mi < 2; ++mi)
#pragma unroll
      for (int ni = 0; ni < 2; ++ni) {
        const int col = nt * 128 + wn * 64 + ni * 32 + (lane & 31);
        const float gt = gate[col];
#pragma unroll
        for (int r = 0; r < 16; ++r) {
          const int row = mt * 256 + wm * 64 + mi * 32 + ACC_ROW(r, lane);
          const int t = row - b * TPB;
          if (isctx) {
            const size_t o = ((size_t)(b * CTXL + t)) * D + col;
            xc[o] = p.in[I_CTX][o] + gt * acc[mi][ni][r];
          } else {
            const size_t o = ((size_t)(b * SEQ + t - CTXL)) * D + col;
            const float xin = (layer == 0) ? p.in[I_X][o] : p.out[o];
            p.out[o] = xin + gt * acc[mi][ni][r];
          }
        }
      }
  }
}

DI void transpose_tile(char* lds, const float* __restrict__ src, int K, int N, bf16_t* __restrict__ dst, int tile) {
  float* T = (float*)lds;
  const int ntk = K / 64;
  const int tn = tile / ntk, tk = tile - tn * ntk;
  const int tid = threadIdx.x;
  __syncthreads();
  for (int e = tid; e < 4096; e += NTHR) {
    const int kk = e >> 6, nn = e & 63;
    const int n = tn * 64 + nn;
    T[kk * 65 + nn] = (n < N) ? src[(size_t)(tk * 64 + kk) * N + n] : 0.f;
  }
  __syncthreads();
  for (int e = tid; e < 4096; e += NTHR) {
    const int nn = e >> 6, kk = e & 63;
    dst[(size_t)(tn * 64 + nn) * K + tk * 64 + kk] = f2bf(T[kk * 65 + nn]);
  }
}

DI void phase_prep(const P& p, char* lds) {
  const int tid = threadIdx.x;
  unsigned char* ws = p.ws;
  struct TD { int idx; int K, N, Npad; size_t dst; size_t srcoff; };
  int base = 0;
  const int G = gridDim.x;
#define TRANSPOSE_TASK(SRC, KK, NN, NPAD, DST) { const int nt_ = ((NPAD) / 64) * ((KK) / 64); \
    for (int w = blockIdx.x; w < nt_; w += G) transpose_tile(lds, (SRC), (KK), (NN), (bf16_t*)(DST), w); }
  TRANSPOSE_TASK(p.in[I_WIN0], 1024, 3456, 3456, ws + WS_WIN0T)
  TRANSPOSE_TASK(p.in[I_WOUT0], 1024, 1024, 1024, ws + WS_WOUT0T)
  TRANSPOSE_TASK(p.in[I_PQ0], 1024, 2048, 2048, ws + WS_PQ0T)
  TRANSPOSE_TASK(p.in[I_WIN1], 1024, 5184, P1NPAD, ws + WS_WIN1T)
  TRANSPOSE_TASK(p.in[I_WOUT1], 2048, 1024, 1024, ws + WS_WOUT1T)
  TRANSPOSE_TASK(p.in[I_PQ1], 1024, 2048, 2048, ws + WS_PQ1T)
  TRANSPOSE_TASK(p.in[I_RWW2], 64, 512, 512, ws + WS_RWT)
  TRANSPOSE_TASK(p.in[I_RWW2] + 64 * 512, 64, 512, 512, ws + WS_RWT + 65536)
  TRANSPOSE_TASK(p.in[I_RWA2], 64, 512, 512, ws + WS_RWT + 131072)
  TRANSPOSE_TASK(p.in[I_RWA2] + 64 * 512, 64, 512, 512, ws + WS_RWT + 196608)
  TRANSPOSE_TASK(p.in[I_RWG2], 128, 512, 512, ws + WS_RWT + 262144)
  (void)base;
  {
    const int gt = blockIdx.x * NTHR + tid, gs = G * NTHR;
    bf16_t* k0 = (bf16_t*)(ws + WS_KEYS0); bf16_t* k1 = (bf16_t*)(ws + WS_KEYS1);
    for (int i = gt; i < 262144; i += gs) { k0[i] = f2bf(p.in[I_PK0][i]); k1[i] = f2bf(p.in[I_PK1][i]); }
    float2* rope = (float2*)(ws + WS_ROPE);
    for (int i = gt; i < 4096 * 32; i += gs) {
      const int l = i >> 5, a = (i >> 4) & 1, f = i & 15;
      const float inv = powf(10000.f, -(float)f / 16.f);
      const float pos = (float)(a == 0 ? (l >> 6) : (l & 63));
      float s, c; sincosf(pos * inv, &s, &c);
      rope[i] = make_float2(c, s);
    }
    if (gt == 0) {
      const float* lp = p.in[I_DALAM];
      float s01 = 0.f, s23 = 0.f;
      for (int i = 0; i < 64; ++i) { s01 += lp[i] * lp[64 + i]; s23 += lp[128 + i] * lp[192 + i]; }
      ((float*)(ws + WS_SCAL))[0] = expf(s01) - expf(s23) + 0.2f;
    }
  }
  {
    float* sc = (float*)lds;
    float* red = (float*)(lds + 36864);
    __syncthreads();
    for (int e = tid; e < 9 * 1024; e += NTHR) { const int r = e >> 10, k = e & 1023; const float v = (r < 8) ? p.in[I_C][r * 1024 + k] : p.in[I_CCTX][k]; sc[e] = siluf_(v); }
    __syncthreads();
    float* mods = (float*)(ws + WS_MODS);
    for (int w = blockIdx.x; w < 192; w += G) {
      const int l = w / 96, j0 = (w % 96) * 64;
      const float* aw = p.in[l == 0 ? I_ADAW0 : I_ADAW1];
      const float* ab = p.in[l == 0 ? I_ADAB0 : I_ADAB1];
      const int col = tid & 63, kg = tid >> 6;
      float a[9];
#pragma unroll
      for (int r = 0; r < 9; ++r) a[r] = 0.f;
      for (int k = kg * 128; k < kg * 128 + 128; ++k) {
        const float wv = aw[(size_t)k * 6144 + j0 + col];
#pragma unroll
        for (int r = 0; r < 9; ++r) a[r] += sc[r * 1024 + k] * wv;
      }
      __syncthreads();
#pragma unroll
      for (int r = 0; r < 9; ++r) red[(kg * 64 + col) * 9 + r] = a[r];
      __syncthreads();
      for (int e = tid; e < 64 * 9; e += NTHR) {
        const int c2 = e / 9, r = e - c2 * 9;
        float s = ab[j0 + c2];
        for (int g = 0; g < 8; ++g) s += red[(g * 64 + c2) * 9 + r];
        mods[((size_t)l * 9 + r) * 6144 + j0 + c2] = s;
      }
    }
  }
}

DI void convert_tables(const P& p, int layer) {
  const float4* u = (const float4*)p.in[layer == 0 ? I_PU0 : I_PU1];
  const float4* v = (const float4*)p.in[layer == 0 ? I_PV0 : I_PV1];
  uint2* du = (uint2*)(p.ws + WS_HB + HB_U);
  uint2* dv = (uint2*)(p.ws + WS_HB + HB_V);
  const size_t n4 = (size_t)16384 * 1024 / 4;
  for (size_t i = (size_t)blockIdx.x * NTHR + threadIdx.x; i < n4; i += (size_t)gridDim.x * NTHR) {
    const float4 a = u[i]; du[i] = make_uint2(pack_bf2(a.x, a.y), pack_bf2(a.z, a.w));
    const float4 b = v[i]; dv[i] = make_uint2(pack_bf2(b.x, b.y), pack_bf2(b.z, b.w));
  }
}

DI void phase_normmod(const P& p, int layer, int which, bool from_inputs, bool lat_only, bf16_t* dst) {
  const int lane = threadIdx.x & 63, gw = blockIdx.x * 8 + (threadIdx.x >> 6), nw = gridDim.x * 8;
  const float* g = p.in[layer == 0 ? (which == 0 ? I_N1_0 : I_N2_0) : (which == 0 ? I_N1_1 : I_N2_1)];
  const float* mods = (const float*)(p.ws + WS_MODS) + (size_t)layer * 9 * 6144;
  const float* xc = (const float*)(p.ws + WS_XC);
  for (int row = gw; row < R; row += nw) {
    const int b = row / TPB, t = row - b * TPB;
    const bool isctx = t < CTXL;
    if (isctx && lat_only) continue;
    const float* src = isctx ? ((from_inputs ? p.in[I_CTX] : xc) + ((size_t)(b * CTXL + t)) * D)
                             : ((from_inputs ? p.in[I_X] : p.out) + ((size_t)(b * SEQ + t - CTXL)) * D);
    const float* mrow = mods + (isctx ? 8 : b) * 6144 + (which == 0 ? 0 : 3 * 1024);
    float v[16];
#pragma unroll
    for (int i = 0; i < 4; ++i) { const float4 f = *(const float4*)(src + lane * 16 + i * 4); v[i * 4] = f.x; v[i * 4 + 1] = f.y; v[i * 4 + 2] = f.z; v[i * 4 + 3] = f.w; }
    float ss = 0.f;
#pragma unroll
    for (int i = 0; i < 16; ++i) ss += v[i] * v[i];
    ss = red64(ss);
    const float rs = rsqrtf(ss * (1.f / 1024.f) + 1e-6f);
    float o[16];
#pragma unroll
    for (int i = 0; i < 16; ++i) { const int c = lane * 16 + i; o[i] = v[i] * rs * g[c] * (1.f + mrow[1024 + c]) + mrow[c]; }
    uint4 w0, w1;
    w0.x = pack_bf2(o[0], o[1]); w0.y = pack_bf2(o[2], o[3]); w0.z = pack_bf2(o[4], o[5]); w0.w = pack_bf2(o[6], o[7]);
    w1.x = pack_bf2(o[8], o[9]); w1.y = pack_bf2(o[10], o[11]); w1.z = pack_bf2(o[12], o[13]); w1.w = pack_bf2(o[14], o[15]);
    *(uint4*)(dst + (size_t)row * D + lane * 16) = w0;
    *(uint4*)(dst + (size_t)row * D + lane * 16 + 8) = w1;
  }
}

DI void phase_final_norm(const P& p) {
  const int lane = threadIdx.x & 63, gw = blockIdx.x * 8 + (threadIdx.x >> 6), nw = gridDim.x * 8;
  const float* g = p.in[I_NF];
  for (int row = gw; row < NB * SEQ; row += nw) {
    float* src = p.out + (size_t)row * D;
    float v[16];
#pragma unroll
    for (int i = 0; i < 4; ++i) { const float4 f = *(const float4*)(src + lane * 16 + i * 4); v[i * 4] = f.x; v[i * 4 + 1] = f.y; v[i * 4 + 2] = f.z; v[i * 4 + 3] = f.w; }
    float ss = 0.f;
#pragma unroll
    for (int i = 0; i < 16; ++i) ss += v[i] * v[i];
    ss = red64(ss);
    const float rs = rsqrtf(ss * (1.f / 1024.f) + 1e-6f);
#pragma unroll
    for (int i = 0; i < 4; ++i) {
      const int c = lane * 16 + i * 4;
      float4 f; f.x = v[i * 4] * rs * g[c]; f.y = v[i * 4 + 1] * rs * g[c + 1]; f.z = v[i * 4 + 2] * rs * g[c + 2]; f.w = v[i * 4 + 3] * rs * g[c + 3];
      *(float4*)(src + c) = f;
    }
  }
}

DI void attn_naive_unit(const P& p, char* lds, int unit) {
  const int tid = threadIdx.x;
  const bool isctx = unit >= 2048;
  int b, h, qb;
  if (!isctx) { b = unit >> 8; h = (unit >> 6) & 3; qb = unit & 63; } else { const int u = unit - 2048; b = u >> 4; h = (u >> 2) & 3; qb = u & 3; }
  const int nkeys = isctx ? CTXL : TPB;
  const bf16_t* p0 = (const bf16_t*)(p.ws + WS_PB + PB_P);
  const float2* rope = (const float2*)(p.ws + WS_ROPE);
  const float lam = ((const float*)(p.ws + WS_SCAL))[0];
  const int q = tid & 63, m = (tid >> 6) & 1, qt = tid >> 7;
  const int ql = qb * 64 + q;
  const size_t qrow = (size_t)b * TPB + (isctx ? ql : CTXL + ql);
  float* Ks = (float*)lds;
  float* Vs = (float*)(lds + 16384);
  float* Ex = (float*)(lds + 32768);
  float* SS = (float*)(lds + 65536);
  float qv[64];
  {
    const bf16_t* qp = p0 + qrow * P0LD + h * 128 + m * 64;
#pragma unroll
    for (int i = 0; i < 8; ++i) { const uint4 u = *(const uint4*)(qp + i * 8); float f[8]; unpack8(u, f);
#pragma unroll
      for (int j = 0; j < 8; ++j) qv[i * 8 + j] = f[j]; }
    if (!isctx) {
#pragma unroll
      for (int a = 0; a < 2; ++a)
#pragma unroll
        for (int f = 0; f < 16; ++f) {
          const float2 cs = rope[ql * 32 + a * 16 + f];
          const float t1 = qv[a * 32 + f], t2 = qv[a * 32 + 16 + f];
          qv[a * 32 + f] = t1 * cs.x - t2 * cs.y;
          qv[a * 32 + 16 + f] = t2 * cs.x + t1 * cs.y;
        }
    }
#pragma unroll
    for (int i = 0; i < 64; ++i) qv[i] *= 0.125f;
  }
  float O[32];
#pragma unroll
  for (int i = 0; i < 32; ++i) O[i] = 0.f;
  float mx = -1e30f, lsum = 0.f;
  for (int kt = 0; kt < nkeys / 32; ++kt) {
    __syncthreads();
#pragma unroll 1
    for (int i = 0; i < 4; ++i) {
      const int id = tid + i * NTHR;
      const int j = id >> 6, rem = id & 63, m2 = rem >> 5, a = (rem >> 4) & 1, f = rem & 15;
      const int tk = kt * 32 + j;
      const bf16_t* kp = p0 + ((size_t)b * TPB + tk) * P0LD + 512 + h * 128 + m2 * 64 + a * 32 + f;
      float k1 = bf2f(kp[0]), k2 = bf2f(kp[16]);
      if (tk >= CTXL) { const float2 cs = rope[(tk - CTXL) * 32 + a * 16 + f]; const float t1 = k1, t2 = k2; k1 = t1 * cs.x - t2 * cs.y; k2 = t2 * cs.x + t1 * cs.y; }
      Ks[j * 128 + m2 * 64 + a * 32 + f] = k1;
      Ks[j * 128 + m2 * 64 + a * 32 + 16 + f] = k2;
    }
    {
      const int j = tid >> 4, c8 = (tid & 15) * 8;
      const uint4 u = *(const uint4*)(p0 + ((size_t)b * TPB + kt * 32 + j) * P0LD + 1024 + h * 128 + c8);
      float f[8]; unpack8(u, f);
#pragma unroll
      for (int i = 0; i < 8; ++i) Vs[j * 128 + c8 + i] = f[i];
    }
    __syncthreads();
#pragma unroll 1
    for (int j0 = 0; j0 < 32; j0 += 8) {
      float s[8];
#pragma unroll
      for (int j = 0; j < 8; ++j) {
        const float4* kr = (const float4*)(Ks + (j0 + j) * 128 + m * 64);
        float acc = 0.f;
#pragma unroll
        for (int d4 = 0; d4 < 16; ++d4) { const float4 kk = kr[d4]; acc += qv[d4 * 4] * kk.x + qv[d4 * 4 + 1] * kk.y + qv[d4 * 4 + 2] * kk.z + qv[d4 * 4 + 3] * kk.w; }
        s[j] = acc;
      }
      float mn = mx;
#pragma unroll
      for (int j = 0; j < 8; ++j) mn = fmaxf(mn, s[j]);
      const float corr = __expf(mx - mn);
      mx = mn; lsum *= corr;
#pragma unroll
      for (int i = 0; i < 32; ++i) O[i] *= corr;
#pragma unroll
      for (int j = 0; j < 8; ++j) {
        const float pj = __expf(s[j] - mn);
        lsum += pj;
        const float4* vr = (const float4*)(Vs + (j0 + j) * 128 + qt * 32);
#pragma unroll
        for (int d4 = 0; d4 < 8; ++d4) { const float4 vv = vr[d4]; O[d4 * 4] += pj * vv.x; O[d4 * 4 + 1] += pj * vv.y; O[d4 * 4 + 2] += pj * vv.z; O[d4 * 4 + 3] += pj * vv.w; }
      }
    }
  }
  const float inv = 1.f / lsum;
#pragma unroll
  for (int i = 0; i < 32; ++i) O[i] *= inv;
  __syncthreads();
  if (m == 1) {
#pragma unroll
    for (int i = 0; i < 32; ++i) Ex[q * 128 + qt * 32 + i] = O[i];
  }
  __syncthreads();
  if (m == 0) {
    float ss = 0.f;
#pragma unroll
    for (int i = 0; i < 32; ++i) { O[i] -= lam * Ex[q * 128 + qt * 32 + i]; ss += O[i] * O[i]; }
    SS[q * 4 + qt] = ss;
  }
  __syncthreads();
  if (m == 0) {
    const float tot = SS[q * 4] + SS[q * 4 + 1] + SS[q * 4 + 2] + SS[q * 4 + 3];
    const float rs = rsqrtf(tot * (1.f / 128.f) + 1e-6f) * 0.8f;
    const float* sub = p.in[I_DASUB] + qt * 32;
    bf16_t* op = (bf16_t*)(p.ws + WS_PB + PB_O0) + qrow * 1024 + h * 128 + qt * 32;
#pragma unroll
    for (int i = 0; i < 4; ++i) {
      float f[8];
#pragma unroll
      for (int j = 0; j < 8; ++j) f[j] = O[i * 8 + j] * rs * sub[i * 8 + j];
      *(uint4*)(op + i * 8) = pack8(f);
    }
  }
}

DI void phase_ga(const P& p) {
  const bf16_t* p0 = (const bf16_t*)(p.ws + WS_PB + PB_P);
  bf16_t* ga = (bf16_t*)(p.ws + WS_PB + PB_GA);
  const float* mu = p.in[I_RWMU] + 1792;
  for (int i = blockIdx.x * NTHR + threadIdx.x; i < R * 16; i += gridDim.x * NTHR) {
    const int row = i >> 4, c8 = (i & 15) * 8;
    const int t = row % TPB;
    const bool first = (t == 0) || (t == CTXL), last = (t == CTXL - 1) || (t == TPB - 1);
    const bf16_t* sp = p0 + (size_t)row * P0LD + 1536 + 1792 + c8;
    float u[8], um[8], up[8];
    unpack8(*(const uint4*)sp, u);
    if (!first) unpack8(*(const uint4*)(sp - P0LD), um); else { for (int j = 0; j < 8; ++j) um[j] = 0.f; }
    if (!last) unpack8(*(const uint4*)(sp + P0LD), up); else { for (int j = 0; j < 8; ++j) up[j] = 0.f; }
    float o[8];
#pragma unroll
    for (int j = 0; j < 8; ++j) { const float mix = u[j] + mu[c8 + j] * (0.5f * (um[j] + up[j]) - u[j]); o[j] = sigmoidf_(mix); }
    *(uint4*)(ga + (size_t)row * 128 + c8) = pack8(o);
  }
}

DI int scan_token(int d, int s) { return d == 0 ? s : (s < CTXL ? (CTXL - 1 - s) : (TPB + CTXL - 1 - s)); }

DI void rwkv_scan_unit(const P& p, char* lds, int unit) {
  const int tid = threadIdx.x, lane = tid & 63, wave = tid >> 6;
  const int half = unit & 1, d = (unit >> 1) & 1, h = (unit >> 2) & 7, b = unit >> 5;
  float* Lr = (float*)lds;
  float* Lk = (float*)(lds + 16384);
  float* Lv = (float*)(lds + 32768);
  float* La = (float*)(lds + 49152);
  float* Lb = (float*)(lds + 65536);
  float* Lw = (float*)(lds + 81920);
  float* Las = (float*)(lds + 98304);
  bf16_t* Aw = (bf16_t*)(lds + 114688);
  bf16_t* Aa = (bf16_t*)(lds + 122880);
  float* Linv = (float*)(lds + 131072);
  float* Ly = (float*)(lds + 131072 + 1024);
  const bf16_t* p0 = (const bf16_t*)(p.ws + WS_PB + PB_P);
  const float* mu = p.in[I_RWMU];
  const int gid = wave >> 2, tmi = (wave >> 1) & 1, tni = wave & 1;
  bf16x8 bfrag[4];
  {
    const bf16_t* wt = (const bf16_t*)(p.ws + WS_RWT + (gid == 0 ? 0 : 131072) + (size_t)d * 65536);
    const int n = h * 64 + tni * 32 + (lane & 31);
#pragma unroll
    for (int kk = 0; kk < 4; ++kk) bfrag[kk] = *(const bf16x8*)(wt + n * 64 + kk * 16 + 8 * (lane >> 5));
  }
  const float bias0 = (gid == 0 ? p.in[I_RWW0] : p.in[I_RWA0])[d * 512 + h * 64 + tni * 32 + (lane & 31)];
  const int ss_ = tid >> 3, cg8 = (tid & 7) * 8;
  float kkc[8], kac[8], rkc[8];
#pragma unroll
  for (int j = 0; j < 8; ++j) { kkc[j] = p.in[I_RWKK][h * 64 + cg8 + j]; kac[j] = p.in[I_RWKA][h * 64 + cg8 + j]; rkc[j] = p.in[I_RWRK][h * 64 + cg8 + j]; }
  const int rl = tid >> 4, c4 = (tid & 15) * 4;
  const int row = half * 32 + rl;
  float S0 = 0.f, S1 = 0.f, S2 = 0.f, S3 = 0.f;
  bf16_t* yout = (bf16_t*)(p.ws + WS_HB + (d == 0 ? HB_YF : HB_YB));
  float* bonus = (float*)(p.ws + WS_PB + PB_BONUS) + (size_t)d * R * 8;
  for (int ch = 0; ch < TPB / 64; ++ch) {
    {
      const int s = ch * 64 + ss_;
      const int t = scan_token(d, s);
      const bool first = (t == 0) || (t == CTXL), last = (t == CTXL - 1) || (t == TPB - 1);
      const bf16_t* rowp = p0 + ((size_t)b * TPB + t) * P0LD + 1536;
      const int cols[5] = {h * 64 + cg8, 512 + h * 64 + cg8, 1024 + h * 64 + cg8, 1536 + d * 64 + cg8, 1664 + d * 64 + cg8};
      float mixed[5][8];
#pragma unroll
      for (int g = 0; g < 5; ++g) {
        float u[8], um[8], up[8];
        unpack8(*(const uint4*)(rowp + cols[g]), u);
        if (!first) unpack8(*(const uint4*)(rowp - P0LD + cols[g]), um); else {
#pragma unroll
          for (int j = 0; j < 8; ++j) um[j] = 0.f; }
        if (!last) unpack8(*(const uint4*)(rowp + P0LD + cols[g]), up); else {
#pragma unroll
          for (int j = 0; j < 8; ++j) up[j] = 0.f; }
#pragma unroll
        for (int j = 0; j < 8; ++j) mixed[g][j] = u[j] + mu[cols[g] + j] * (0.5f * (um[j] + up[j]) - u[j]);
      }
      float nrm = 0.f;
#pragma unroll
      for (int j = 0; j < 8; ++j) {
        Lr[ss_ * 64 + cg8 + j] = mixed[0][j];
        Lk[ss_ * 64 + cg8 + j] = mixed[1][j];
        Lv[ss_ * 64 + cg8 + j] = mixed[2][j];
        const float kq = mixed[1][j] * kkc[j];
        nrm += kq * kq;
      }
      float tw[8];
#pragma unroll
      for (int j = 0; j < 8; ++j) tw[j] = tanhf(mixed[3][j]);
      *(uint4*)(Aw + ss_ * 64 + cg8) = pack8(tw);
      *(uint4*)(Aa + ss_ * 64 + cg8) = pack8(mixed[4]);
      nrm = red8(nrm);
      if ((tid & 7) == 0) Linv[ss_] = 1.f / fmaxf(sqrtf(nrm), 1e-12f);
    }
    __syncthreads();
    {
      f32x16 acc;
#pragma unroll
      for (int r = 0; r < 16; ++r) acc[r] = 0.f;
      const bf16_t* Asrc = gid == 0 ? Aw : Aa;
#pragma unroll
      for (int kk = 0; kk < 4; ++kk) {
        const bf16x8 a = *(const bf16x8*)(Asrc + (tmi * 32 + (lane & 31)) * 64 + kk * 16 + 8 * (lane >> 5));
        acc = MFMA32(a, bfrag[kk], acc);
      }
      const int n = tni * 32 + (lane & 31);
#pragma unroll
      for (int r = 0; r < 16; ++r) {
        const int s = tmi * 32 + ACC_ROW(r, lane);
        const float x = acc[r] + bias0;
        if (gid == 0) { const float wl = -softplusf_(-x) - 0.5f; Lw[s * 64 + n] = __expf(-__expf(wl)); }
        else Las[s * 64 + n] = sigmoidf_(x);
      }
    }
    __syncthreads();
    {
      const float iv = Linv[ss_];
      float bsum = 0.f;
#pragma unroll
      for (int j = 0; j < 8; ++j) {
        const int o = ss_ * 64 + cg8 + j;
        const float k = Lk[o], as = Las[o];
        const float kkv = k * kkc[j] * iv;
        La[o] = -kkv; Lb[o] = kkv * as;
        const float kd = k * (1.f + (as - 1.f) * kac[j]);
        Lk[o] = kd;
        bsum += Lr[o] * kd * rkc[j];
      }
      bsum = red8(bsum);
      if (half == 0 && (tid & 7) == 0) {
        const int t = scan_token(d, ch * 64 + ss_);
        bonus[((size_t)b * TPB + t) * 8 + h] = bsum;
      }
    }
    __syncthreads();
#pragma unroll 2
    for (int s = 0; s < 64; ++s) {
      const float4 a4 = *(const float4*)(La + s * 64 + c4);
      const float4 b4 = *(const float4*)(Lb + s * 64 + c4);
      const float4 k4 = *(const float4*)(Lk + s * 64 + c4);
      const float4 w4 = *(const float4*)(Lw + s * 64 + c4);
      const float4 r4 = *(const float4*)(Lr + s * 64 + c4);
      const float vv = Lv[s * 64 + row];
      float sa = S0 * a4.x + S1 * a4.y + S2 * a4.z + S3 * a4.w;
      sa = red16(sa);
      S0 = S0 * w4.x + (sa * b4.x + vv * k4.x);
      S1 = S1 * w4.y + (sa * b4.y + vv * k4.y);
      S2 = S2 * w4.z + (sa * b4.z + vv * k4.z);
      S3 = S3 * w4.w + (sa * b4.w + vv * k4.w);
      float y = S0 * r4.x + S1 * r4.y + S2 * r4.z + S3 * r4.w;
      y = red16(y);
      if ((tid & 15) == 0) Ly[s * 32 + rl] = y;
    }
    __syncthreads();
    {
      const int s = tid >> 3, r4i = (tid & 7) * 4;
      const int t = scan_token(d, ch * 64 + s);
      const float4 yv = *(const float4*)(Ly + s * 32 + r4i);
      uint2 w; w.x = pack_bf2(yv.x, yv.y); w.y = pack_bf2(yv.z, yv.w);
      *(uint2*)(yout + ((size_t)b * TPB + t) * 512 + h * 64 + half * 32 + r4i) = w;
    }
  }
}

DI void phase_rwkv_post(const P& p) {
  const bf16_t* p0 = (const bf16_t*)(p.ws + WS_PB + PB_P);
  const bf16_t* yf = (const bf16_t*)(p.ws + WS_HB + HB_YF);
  const bf16_t* yb = (const bf16_t*)(p.ws + WS_HB + HB_YB);
  const bf16_t* G = (const bf16_t*)(p.ws + WS_PB + PB_G);
  const float* bonus = (const float*)(p.ws + WS_PB + PB_BONUS);
  bf16_t* o0 = (bf16_t*)(p.ws + WS_PB + PB_O0);
  const float* mu = p.in[I_RWMU] + 1024;
  for (int i = blockIdx.x * NTHR + threadIdx.x; i < R * 8; i += gridDim.x * NTHR) {
    const int row = i >> 3, h = i & 7;
    const int t = row % TPB;
    const bool first = (t == 0) || (t == CTXL), last = (t == CTXL - 1) || (t == TPB - 1);
    float y[64];
    float mean = 0.f;
#pragma unroll
    for (int c = 0; c < 8; ++c) {
      float a[8], bb[8];
      unpack8(*(const uint4*)(yf + (size_t)row * 512 + h * 64 + c * 8), a);
      unpack8(*(const uint4*)(yb + (size_t)row * 512 + h * 64 + c * 8), bb);
#pragma unroll
      for (int j = 0; j < 8; ++j) { y[c * 8 + j] = a[j] + bb[j]; mean += y[c * 8 + j]; }
    }
    mean *= (1.f / 64.f);
    float var = 0.f;
#pragma unroll
    for (int j = 0; j < 64; ++j) { const float dlt = y[j] - mean; var += dlt * dlt; }
    var *= (1.f / 64.f);
    const float rs = rsqrtf(var + 64e-5f);
    const float bn = bonus[(size_t)row * 8 + h] + bonus[(size_t)R * 8 + (size_t)row * 8 + h];
    const bf16_t* vp = p0 + (size_t)row * P0LD + 1536 + 1024 + h * 64;
#pragma unroll
    for (int c = 0; c < 8; ++c) {
      float u[8], um[8], up[8], g[8], o[8];
      unpack8(*(const uint4*)(vp + c * 8), u);
      if (!first) unpack8(*(const uint4*)(vp - P0LD + c * 8), um); else {
#pragma unroll
        for (int j = 0; j < 8; ++j) um[j] = 0.f; }
      if (!last) unpack8(*(const uint4*)(vp + P0LD + c * 8), up); else {
#pragma unroll
        for (int j = 0; j < 8; ++j) up[j] = 0.f; }
      unpack8(*(const uint4*)(G + (size_t)row * 512 + h * 64 + c * 8), g);
#pragma unroll
      for (int j = 0; j < 8; ++j) {
        const int cc = h * 64 + c * 8 + j;
        const float v = u[j] + mu[cc] * (0.5f * (um[j] + up[j]) - u[j]);
        const float yn = (y[c * 8 + j] - mean) * rs * p.in[I_LNXW][cc] + p.in[I_LNXB][cc];
        o[j] = (yn + bn * v) * g[j];
      }
      *(uint4*)(o0 + (size_t)row * 1024 + 512 + h * 64 + c * 8) = pack8(o);
    }
  }
}

DI unsigned f2ord(float f) { const unsigned u = __float_as_uint(f); return u ^ ((u >> 31) ? 0xFFFFFFFFu : 0x80000000u); }
DI float ord2f(unsigned u) { u ^= ((u >> 31) ? 0x80000000u : 0xFFFFFFFFu); return __uint_as_float(u); }

struct CandPairs { int ia[25], ja[25], ib[25], jb[25]; };
constexpr CandPairs make_pairs() {
  CandPairs c{};
  int n = 0;
  for (int i = 0; i < 16; ++i) for (int j = 0; j < 16; ++j) if ((i + 1) * (j + 1) <= 16) {
    if ((n & 1) == 0) { c.ia[n >> 1] = i; c.ja[n >> 1] = j; } else { c.ib[n >> 1] = i; c.jb[n >> 1] = j; }
    ++n;
  }
  return c;
}
constexpr CandPairs CP = make_pairs();

DI void peer_topk_unit(const P& p, char* lds, int layer, int unit) {
  const int tid = threadIdx.x, lane = tid & 63, wave = tid >> 6;
  const int mt = unit >> 3, h = unit & 7;
  const bf16_t* q = (const bf16_t*)(p.ws + WS_PB + PB_Q);
  const bf16_t* keys = (const bf16_t*)(p.ws + (layer == 0 ? WS_KEYS0 : WS_KEYS1)) + (size_t)h * 2 * 128 * 128;
  int* idxo = (int*)(p.ws + WS_PB + PB_IDX);
  float* gateo = (float*)(p.ws + WS_PB + PB_GATE);
  __syncthreads();
  for (int e = tid; e < 2 * 128 * 16; e += NTHR) {
    const int pp = e >> 11, row = (e >> 4) & 127, c = e & 15;
    *(uint4*)(lds + pp * 32768 + row * 256 + ((c ^ (row & 15)) << 4)) = *(const uint4*)(keys + (size_t)pp * 16384 + row * 128 + c * 8);
  }
  __syncthreads();
  const int r31 = lane & 31, hh = lane >> 5;
  const size_t trow = (size_t)mt * 256 + wave * 32 + r31;
  unsigned vk[2][16];
#pragma unroll
  for (int pp = 0; pp < 2; ++pp) {
    f32x16 acc[4];
#pragma unroll
    for (int m = 0; m < 4; ++m)
#pragma unroll
      for (int r = 0; r < 16; ++r) acc[m][r] = 0.f;
    const bf16_t* qp = q + trow * 2048 + (h * 2 + pp) * 128;
#pragma unroll
    for (int kk = 0; kk < 8; ++kk) {
      const bf16x8 bq = *(const bf16x8*)(qp + kk * 16 + 8 * hh);
      const int c = kk * 2 + hh;
#pragma unroll
      for (int m = 0; m < 4; ++m) {
        const int row = m * 32 + r31;
        const bf16x8 ak = *(const bf16x8*)(lds + pp * 32768 + row * 256 + ((c ^ (row & 15)) << 4));
        acc[m] = MFMA32(ak, bq, acc[m]);
      }
    }
    unsigned v[16];
#pragma unroll
    for (int i = 0; i < 16; ++i) v[i] = 0u;
#pragma unroll
    for (int m = 0; m < 4; ++m)
#pragma unroll
      for (int r = 0; r < 16; ++r) {
        const int kidx = m * 32 + ACC_ROW(r, lane);
        unsigned x = (f2ord(acc[m][r]) & ~127u) | (unsigned)(127 - kidx);
#pragma unroll
        for (int i = 0; i < 16; ++i) { const unsigned hi = max(v[i], x); x = min(v[i], x); v[i] = hi; }
      }
    unsigned c16[16];
#pragma unroll
    for (int i = 0; i < 16; ++i) { const unsigned o = (unsigned)__shfl_xor((int)v[15 - i], 32); c16[i] = max(v[i], o); }
#pragma unroll
    for (int st = 8; st >= 1; st >>= 1)
#pragma unroll
      for (int i = 0; i < 16; ++i) if ((i & st) == 0) { const unsigned hi = max(c16[i], c16[i + st]), lo = min(c16[i], c16[i + st]); c16[i] = hi; c16[i + st] = lo; }
#pragma unroll
    for (int i = 0; i < 16; ++i) vk[pp][i] = c16[i];
  }
  float val1[16], val2[16]; int id1[16], id2[16];
#pragma unroll
  for (int i = 0; i < 16; ++i) {
    val1[i] = ord2f(vk[0][i] & ~127u); id1[i] = 127 - (int)(vk[0][i] & 127u);
    val2[i] = ord2f(vk[1][i] & ~127u); id2[i] = 127 - (int)(vk[1][i] & 127u);
  }
  float tv[16]; int tp[16];
#pragma unroll
  for (int i = 0; i < 16; ++i) { tv[i] = -3.0e38f; tp[i] = 0; }
#pragma unroll
  for (int t = 0; t < 25; ++t) {
    const float va = val1[CP.ia[t]] + val2[CP.ja[t]];
    const float vb = val1[CP.ib[t]] + val2[CP.jb[t]];
    const int pa = id1[CP.ia[t]] * 128 + id2[CP.ja[t]];
    const int pb = id1[CP.ib[t]] * 128 + id2[CP.jb[t]];
    float val = hh ? vb : va; int pay = hh ? pb : pa;
#pragma unroll
    for (int i = 0; i < 16; ++i) {
      const bool gt = val > tv[i];
      const float nv = gt ? val : tv[i]; const int np = gt ? pay : tp[i];
      val = gt ? tv[i] : val; pay = gt ? tp[i] : pay;
      tv[i] = nv; tp[i] = np;
    }
  }
  float cv[16]; int cp[16];
  float mx = -3.0e38f;
#pragma unroll
  for (int i = 0; i < 16; ++i) {
    const float ov = __shfl_xor(tv[15 - i], 32); const int op = __shfl_xor(tp[15 - i], 32);
    const bool own = tv[i] >= ov;
    cv[i] = own ? tv[i] : ov; cp[i] = own ? tp[i] : op;
    mx = fmaxf(mx, cv[i]);
  }
  float sum = 0.f;
#pragma unroll
  for (int i = 0; i < 16; ++i) { cv[i] = __expf(cv[i] - mx); sum += cv[i]; }
  const float inv = 1.f / sum;
  if (hh == 0) {
    int* ip = idxo + trow * 128 + h * 16;
    float* gp = gateo + trow * 128 + h * 16;
#pragma unroll
    for (int i = 0; i < 4; ++i) {
      *(int4*)(ip + i * 4) = make_int4(cp[i * 4], cp[i * 4 + 1], cp[i * 4 + 2], cp[i * 4 + 3]);
      *(float4*)(gp + i * 4) = make_float4(cv[i * 4] * inv, cv[i * 4 + 1] * inv, cv[i * 4 + 2] * inv, cv[i * 4 + 3] * inv);
    }
  }
}

DI void phase_peer_gather(const P& p, int layer) {
  const int lane = threadIdx.x & 63, gw = blockIdx.x * 8 + (threadIdx.x >> 6), nw = gridDim.x * 8;
  const bf16_t* h2 = (const bf16_t*)(p.ws + WS_PB + PB_H2);
  const int* idx = (const int*)(p.ws + WS_PB + PB_IDX);
  const float* gate = (const float*)(p.ws + WS_PB + PB_GATE);
  const bf16_t* U = (const bf16_t*)(p.ws + WS_HB + HB_U);
  const bf16_t* V = (const bf16_t*)(p.ws + WS_HB + HB_V);
  const float* mods = (const float*)(p.ws + WS_MODS) + (size_t)layer * 9 * 6144;
  float* xc = (float*)(p.ws + WS_XC);
  for (int row = gw; row < R; row += nw) {
    const int b = row / TPB, t = row - b * TPB;
    const bool isctx = t < CTXL;
    if (isctx && layer == 1) continue;
    float hv[16];
    {
      float f[8];
      unpack8(*(const uint4*)(h2 + (size_t)row * D + lane * 16), f);
#pragma unroll
      for (int j = 0; j < 8; ++j) hv[j] = f[j];
      unpack8(*(const uint4*)(h2 + (size_t)row * D + lane * 16 + 8), f);
#pragma unroll
      for (int j = 0; j < 8; ++j) hv[8 + j] = f[j];
    }
    float acc[16];
#pragma unroll
    for (int j = 0; j < 16; ++j) acc[j] = 0.f;
    const int my_i0 = idx[(size_t)row * 128 + lane], my_i1 = idx[(size_t)row * 128 + 64 + lane];
    const float my_g0 = gate[(size_t)row * 128 + lane], my_g1 = gate[(size_t)row * 128 + 64 + lane];
    for (int e0 = 0; e0 < 128; e0 += 4) {
      uint4 ur[4][2], vr[4][2];
      float gg[4];
#pragma unroll
      for (int k = 0; k < 4; ++k) {
        const int e = e0 + k;
        const int ei = (e < 64) ? __builtin_amdgcn_readlane(my_i0, e & 63) : __builtin_amdgcn_readlane(my_i1, e & 63);
        gg[k] = __int_as_float((e < 64) ? __builtin_amdgcn_readlane(__float_as_int(my_g0), e & 63) : __builtin_amdgcn_readlane(__float_as_int(my_g1), e & 63));
        const bf16_t* up = U + (size_t)ei * D + lane * 16;
        const bf16_t* vp = V + (size_t)ei * D + lane * 16;
        ur[k][0] = *(const uint4*)up; ur[k][1] = *(const uint4*)(up + 8);
        vr[k][0] = *(const uint4*)vp; vr[k][1] = *(const uint4*)(vp + 8);
      }
#pragma unroll
      for (int k = 0; k < 4; ++k) {
        float f[8]; float dot = 0.f;
        unpack8(ur[k][0], f);
#pragma unroll
        for (int j = 0; j < 8; ++j) dot += hv[j] * f[j];
        unpack8(ur[k][1], f);
#pragma unroll
        for (int j = 0; j < 8; ++j) dot += hv[8 + j] * f[j];
        dot = red64(dot);
        const float w = gg[k] * geluf_(dot);
        unpack8(vr[k][0], f);
#pragma unroll
        for (int j = 0; j < 8; ++j) acc[j] += w * f[j];
        unpack8(vr[k][1], f);
#pragma unroll
        for (int j = 0; j < 8; ++j) acc[8 + j] += w * f[j];
      }
    }
    const float* g5 = mods + (isctx ? 8 : b) * 6144 + 5 * 1024 + lane * 16;
    float* xp = isctx ? (xc + ((size_t)(b * CTXL + t)) * D + lane * 16) : (p.out + ((size_t)(b * SEQ + t - CTXL)) * D + lane * 16);
#pragma unroll
    for (int i = 0; i < 4; ++i) {
      float4 x = *(float4*)(xp + i * 4);
      x.x += g5[i * 4] * acc[i * 4]; x.y += g5[i * 4 + 1] * acc[i * 4 + 1]; x.z += g5[i * 4 + 2] * acc[i * 4 + 2]; x.w += g5[i * 4 + 3] * acc[i * 4 + 3];
      *(float4*)(xp + i * 4) = x;
    }
  }
}

DI void ssd_naive_unit(const P& p, char* lds, int unit) {
  const int tid = threadIdx.x;
  const int b = unit >> 5, head = unit & 31, grp = head >> 3;
  float* Lx = (float*)lds;
  float* LB = (float*)(lds + 16384);
  float* LC = (float*)(lds + 49152);
  float* Lda = (float*)(lds + 81920);
  float* Ldt = (float*)(lds + 81920 + 256);
  float* Ly = (float*)(lds + 82944);
  bf16_t* p1 = (bf16_t*)(p.ws + WS_PB + PB_P);
  bf16_t* yftmp = (bf16_t*)(p.ws + WS_YF);
  const float* cw = p.in[I_CONVW]; const float* cb = p.in[I_CONVB];
  const int ss_ = tid >> 3, j8 = tid & 7;
  const int pp = tid >> 3, ng = tid & 7;
  const float dsk = p.in[I_DSKIP][head];
  for (int d = 0; d < 2; ++d) {
    const float Aneg = -__expf(p.in[I_ALOG][d * 32 + head]);
    const float dtb = p.in[I_DTB][d * 32 + head];
    float hst[16];
#pragma unroll
    for (int n = 0; n < 16; ++n) hst[n] = 0.f;
    for (int ch = 0; ch < TPB / 64; ++ch) {
      __syncthreads();
      {
        const int t = scan_token(d, ch * 64 + ss_);
        const bool first = (t == 0) || (t == CTXL), last = (t == CTXL - 1) || (t == TPB - 1);
        const bf16_t* rowp = p1 + ((size_t)b * TPB + t) * P1LD + 2048;
        const int cc[5] = {head * 64 + j8 * 8, 2048 + grp * 128 + j8 * 16, 2048 + grp * 128 + j8 * 16 + 8, 2560 + grp * 128 + j8 * 16, 2560 + grp * 128 + j8 * 16 + 8};
#pragma unroll
        for (int g = 0; g < 5; ++g) {
          float u[8], um[8], up[8];
          unpack8(*(const uint4*)(rowp + cc[g]), u);
          if (!first) unpack8(*(const uint4*)(rowp - P1LD + cc[g]), um); else {
#pragma unroll
            for (int j = 0; j < 8; ++j) um[j] = 0.f; }
          if (!last) unpack8(*(const uint4*)(rowp + P1LD + cc[g]), up); else {
#pragma unroll
            for (int j = 0; j < 8; ++j) up[j] = 0.f; }
#pragma unroll
          for (int j = 0; j < 8; ++j) {
            const int c = cc[g] + j;
            const float v = siluf_(cw[c] * um[j] + cw[3072 + c] * u[j] + cw[6144 + c] * up[j] + cb[c]);
            if (g == 0) Lx[ss_ * 64 + j8 * 8 + j] = v;
            else if (g == 1) LB[ss_ * 128 + j8 * 16 + j] = v;
            else if (g == 2) LB[ss_ * 128 + j8 * 16 + 8 + j] = v;
            else if (g == 3) LC[ss_ * 128 + j8 * 16 + j] = v;
            else LC[ss_ * 128 + j8 * 16 + 8 + j] = v;
          }
        }
        if (j8 == 0) {
          const float raw = bf2f(p1[((size_t)b * TPB + t) * P1LD + 5120 + d * 32 + head]);
          const float dtv = softplusf_(raw + dtb);
          Ldt[ss_] = dtv; Lda[ss_] = __expf(dtv * Aneg);
        }
      }
      __syncthreads();
      for (int s = 0; s < 64; ++s) {
        const float da = Lda[s];
        const float xdt = Lx[s * 64 + pp] * Ldt[s];
        float y = 0.f;
#pragma unroll
        for (int n4 = 0; n4 < 4; ++n4) {
          const float4 bv = *(const float4*)(LB + s * 128 + ng * 16 + n4 * 4);
          const float4 cv = *(const float4*)(LC + s * 128 + ng * 16 + n4 * 4);
          hst[n4 * 4] = hst[n4 * 4] * da + xdt * bv.x; y += cv.x * hst[n4 * 4];
          hst[n4 * 4 + 1] = hst[n4 * 4 + 1] * da + xdt * bv.y; y += cv.y * hst[n4 * 4 + 1];
          hst[n4 * 4 + 2] = hst[n4 * 4 + 2] * da + xdt * bv.z; y += cv.z * hst[n4 * 4 + 2];
          hst[n4 * 4 + 3] = hst[n4 * 4 + 3] * da + xdt * bv.w; y += cv.w * hst[n4 * 4 + 3];
        }
        y = red8(y);
        if (ng == 0) Ly[s * 64 + pp] = y;
      }
      __syncthreads();
      if (ch >= CTXL / 64) {
        const int t = scan_token(d, ch * 64 + ss_);
        const size_t lrow = (size_t)b * SEQ + (t - CTXL);
        bf16_t* yfp = yftmp + lrow * 2048 + head * 64 + j8 * 8;
        float yv[8];
#pragma unroll
        for (int j = 0; j < 8; ++j) yv[j] = Ly[ss_ * 64 + j8 * 8 + j];
        if (d == 0) {
          *(uint4*)yfp = pack8(yv);
        } else {
          float yf[8], z[8], o[8];
          unpack8(*(const uint4*)yfp, yf);
          bf16_t* zp = p1 + ((size_t)b * TPB + t) * P1LD + head * 64 + j8 * 8;
          unpack8(*(const uint4*)zp, z);
#pragma unroll
          for (int j = 0; j < 8; ++j) o[j] = (yf[j] + yv[j] + dsk * Lx[ss_ * 64 + j8 * 8 + j]) * siluf_(z[j]);
          *(uint4*)zp = pack8(o);
        }
      }
    }
  }
}

DI void phase_groupnorm(const P& p) {
  const int lane = threadIdx.x & 63, gw = blockIdx.x * 8 + (threadIdx.x >> 6), nw = gridDim.x * 8;
  bf16_t* p1 = (bf16_t*)(p.ws + WS_PB + PB_P);
  const float* gn = p.in[I_GNORM];
  for (int lr = gw; lr < NB * SEQ; lr += nw) {
    const int b = lr >> 12, l = lr & 4095;
    bf16_t* rp = p1 + ((size_t)b * TPB + CTXL + l) * P1LD + lane * 32;
    float v[32];
#pragma unroll
    for (int i = 0; i < 4; ++i) { float f[8]; unpack8(*(const uint4*)(rp + i * 8), f);
#pragma unroll
      for (int j = 0; j < 8; ++j) v[i * 8 + j] = f[j]; }
    float ss = 0.f;
#pragma unroll
    for (int i = 0; i < 32; ++i) ss += v[i] * v[i];
    ss = red16(ss);
    const float rs = rsqrtf(ss * (1.f / 512.f) + 1e-6f);
#pragma unroll
    for (int i = 0; i < 4; ++i) {
      float o[8];
#pragma unroll
      for (int j = 0; j < 8; ++j) o[j] = v[i * 8 + j] * rs * gn[lane * 32 + i * 8 + j];
      *(uint4*)(rp + i * 8) = pack8(o);
    }
  }
}

constexpr int N_PHASES = 21;

__global__ void __launch_bounds__(NTHR) fwd_kernel(P p) {
  extern __shared__ __attribute__((aligned(16))) char lds[];
  const int lo = p.ph_lo, hi = p.ph_hi;
  unsigned char* ws = p.ws;
  XcdBarrier bar; bar.bar = (unsigned*)(ws + WS_CTL); bar.x = 0; bar.st = nullptr;
  volatile LAS unsigned* stw = (volatile LAS unsigned*)(lds + LDS_BYTES - 16);
  if (hi - lo > 1) {
    if (threadIdx.x == 0) { stw[0] = 0u; stw[1] = 0u; }
    __syncthreads();
    bar = xcd_barrier_post((unsigned*)(ws + WS_CTL), stw);
  }
#define IN(k) (lo <= (k) && (k) < hi)
#define SEAM(k) do { if (IN(k) && IN((k) + 1)) xcd_barrier(bar); } while (0)
  const int G = gridDim.x;
  bf16_t* HBp = (bf16_t*)(ws + WS_HB);
  bf16_t* PBp = (bf16_t*)(ws + WS_PB + PB_P);

  if (IN(0)) { phase_prep(p, lds); } SEAM(0);
  if (IN(1)) { phase_normmod(p, 0, 0, true, false, HBp); } SEAM(1);
  if (IN(2)) { gemm_store_phase(lds, HBp, D, (const bf16_t*)(ws + WS_WIN0T), D, R, 3456, D, PBp, P0LD, 3456); } SEAM(2);
  if (IN(3)) {
    for (int u = blockIdx.x; u < 2048 + 128; u += G) attn_naive_unit(p, lds, u);
    phase_ga(p);
  } SEAM(3);
  if (IN(4)) {
    for (int u = blockIdx.x; u < 256; u += G) rwkv_scan_unit(p, lds, u);
    __syncthreads();
    gemm_store_phase(lds, (const bf16_t*)(ws + WS_PB + PB_GA), 128, (const bf16_t*)(ws + WS_RWT + 262144), 128, R, 512, 128, (bf16_t*)(ws + WS_PB + PB_G), 512, 512);
  } SEAM(4);
  if (IN(5)) { phase_rwkv_post(p); } SEAM(5);
  if (IN(6)) { gemm_resid_phase(p, lds, 0, (const bf16_t*)(ws + WS_PB + PB_O0), D, (const bf16_t*)(ws + WS_WOUT0T), D); } SEAM(6);
  if (IN(7)) { phase_normmod(p, 0, 1, false, false, (bf16_t*)(ws + WS_PB + PB_H2)); convert_tables(p, 0); } SEAM(7);
  if (IN(8)) { gemm_store_phase(lds, (const bf16_t*)(ws + WS_PB + PB_H2), D, (const bf16_t*)(ws + WS_PQ0T), D, R, 2048, D, (bf16_t*)(ws + WS_PB + PB_Q), 2048, 2048); } SEAM(8);
  if (IN(9)) { for (int u = blockIdx.x; u < (R / 256) * 8; u += G) peer_topk_unit(p, lds, 0, u); } SEAM(9);
  if (IN(10)) { phase_peer_gather(p, 0); } SEAM(10);
  if (IN(11)) { phase_normmod(p, 1, 0, false, false, HBp); } SEAM(11);
  if (IN(12)) { gemm_store_phase(lds, HBp, D, (const bf16_t*)(ws + WS_WIN1T), D, R, P1NPAD, D, PBp, P1LD, P1LD); } SEAM(12);
  if (IN(13)) { for (int u = blockIdx.x; u < 256; u += G) ssd_naive_unit(p, lds, u); } SEAM(13);
  if (IN(14)) { phase_groupnorm(p); } SEAM(14);
  if (IN(15)) { gemm_resid_phase(p, lds, 1, PBp, P1LD, (const bf16_t*)(ws + WS_WOUT1T), 2048); } SEAM(15);
  if (IN(16)) { phase_normmod(p, 1, 1, false, true, (bf16_t*)(ws + WS_PB + PB_H2)); convert_tables(p, 1); } SEAM(16);
  if (IN(17)) { gemm_store_phase(lds, (const bf16_t*)(ws + WS_PB + PB_H2), D, (const bf16_t*)(ws + WS_PQ1T), D, R, 2048, D, (bf16_t*)(ws + WS_PB + PB_Q), 2048, 2048); } SEAM(17);
  if (IN(18)) { for (int u = blockIdx.x; u < (R / 256) * 8; u += G) peer_topk_unit(p, lds, 1, u); } SEAM(18);
  if (IN(19)) { phase_peer_gather(p, 1); } SEAM(19);
  if (IN(20)) { phase_final_norm(p); }
}

extern "C" void kernel_launch(void* const* d_in, const int* in_sizes, int n_in, void* d_out, int out_size, void* d_ws, size_t ws_size, hipStream_t stream) {
  static int inited = 0;
  if (!inited) {
    if (n_in != N_IN || ws_size < WS_XC + 128 * MiB) { fprintf(stderr, "kernel_launch: unexpected n_in %d / ws_size %zu\n", n_in, ws_size); inited = -1; return; }
    if (hipFuncSetAttribute((const void*)fwd_kernel, hipFuncAttributeMaxDynamicSharedMemorySize, LDS_BYTES) != hipSuccess) { fprintf(stderr, "kernel_launch: hipFuncSetAttribute failed\n"); inited = -1; return; }
    inited = 1;
  }
  if (inited < 0) return;
  P p{};
  for (int i = 0; i < N_IN; ++i) p.in[i] = (const float*)d_in[i];
  p.out = (float*)d_out; p.ws = (unsigned char*)d_ws;
  (void)hipMemsetAsync((char*)d_ws + WS_CTL, 0, 65536, stream);
#if N_LAUNCH_MODE == 1
  p.ph_lo = 0; p.ph_hi = N_PHASES;
  hipLaunchKernelGGL(fwd_kernel, dim3(256), dim3(NTHR), LDS_BYTES, stream, p);
#else
  for (int ph = 0; ph < N_PHASES; ++ph) {
    p.ph_lo = ph; p.ph_hi = ph + 1;
    hipLaunchKernelGGL(fwd_kernel, dim3(256), dim3(NTHR), LDS_BYTES, stream, p);
  }
#endif
}
```

```cpp
#include <hip/hip_runtime.h>
#include <stdint.h>
#include <stdio.h>

#ifndef N_LAUNCH_MODE
#define N_LAUNCH_MODE 1
#endif

#define DI __device__ __forceinline__
typedef unsigned short bf16_t;
typedef __attribute__((ext_vector_type(8))) short bf16x8;
typedef __attribute__((ext_vector_type(16))) float f32x16;
typedef __attribute__((ext_vector_type(2))) __bf16 bf2_t;

constexpr int D = 1024, NB = 8, SEQ = 4096, CTXL = 256, TPB = SEQ + CTXL, R = NB * TPB;
constexpr int NTHR = 512;
constexpr int LDS_BYTES = 147456;
constexpr int P0LD = 3456;
constexpr int P1LD = 5184;
constexpr int P1NPAD = 5248;

enum { I_X = 0, I_C, I_CTX, I_CCTX,
       I_ADAW0, I_ADAB0, I_N1_0, I_N2_0, I_WIN0, I_DALAM, I_DASUB, I_RWMU, I_RWW0, I_RWW2, I_RWA0, I_RWA2, I_RWG2, I_RWKK, I_RWKA, I_RWRK, I_LNXW, I_LNXB, I_WOUT0, I_PQ0, I_PK0, I_PU0, I_PV0,
       I_ADAW1, I_ADAB1, I_N1_1, I_N2_1, I_WIN1, I_CONVW, I_CONVB, I_DTB, I_ALOG, I_DSKIP, I_GNORM, I_WOUT1, I_PQ1, I_PK1, I_PU1, I_PV1, I_NF, N_IN };

constexpr size_t MiB = 1048576;
constexpr size_t WS_CTL = 0;
constexpr size_t WS_SCAL = 65536;
constexpr size_t WS_MODS = 131072;
constexpr size_t WS_ROPE = 1 * MiB;
constexpr size_t WS_RWT = 2 * MiB;
constexpr size_t WS_WIN0T = 3 * MiB;
constexpr size_t WS_WOUT0T = 10 * MiB;
constexpr size_t WS_PQ0T = 12 * MiB;
constexpr size_t WS_KEYS0 = 16 * MiB;
constexpr size_t WS_KEYS1 = 16 * MiB + 524288;
constexpr size_t WS_WIN1T = 17 * MiB;
constexpr size_t WS_WOUT1T = 28 * MiB;
constexpr size_t WS_PQ1T = 32 * MiB;
constexpr size_t WS_PB = 36 * MiB;
constexpr size_t WS_XC = 381 * MiB;
constexpr size_t WS_HB = 389 * MiB;
constexpr size_t WS_END = 457 * MiB;
constexpr size_t WS_YF = WS_XC;
constexpr size_t PB_P = 0;
constexpr size_t PB_O0 = 230 * MiB;
constexpr size_t PB_G = 298 * MiB;
constexpr size_t PB_GA = 332 * MiB;
constexpr size_t PB_BONUS = 341 * MiB;
constexpr size_t PB_H2 = 0;
constexpr size_t PB_Q = 68 * MiB;
constexpr size_t PB_IDX = 204 * MiB;
constexpr size_t PB_GATE = 221 * MiB;
constexpr size_t HB_YF = 0, HB_YB = 34 * MiB;
constexpr size_t HB_U = 0, HB_V = 32 * MiB;

struct P {
  const float* in[N_IN];
  float* out;
  unsigned char* ws;
  int ph_lo, ph_hi;
};

DI unsigned pack_bf2(float a, float b) { bf2_t v; v[0] = (__bf16)a; v[1] = (__bf16)b; return __builtin_bit_cast(unsigned, v); }
DI bf16_t f2bf(float a) { return __builtin_bit_cast(unsigned short, (__bf16)a); }
DI float bf2f(bf16_t v) { return __uint_as_float((unsigned)v << 16); }
DI float bflo(unsigned u) { return __uint_as_float(u << 16); }
DI float bfhi(unsigned u) { return __uint_as_float(u & 0xffff0000u); }
template <int CTRL> DI float dpp_f(float x) { return __int_as_float(__builtin_amdgcn_update_dpp(0, __float_as_int(x), CTRL, 0xF, 0xF, true)); }
DI float red4(float x) { x += dpp_f<0xB1>(x); x += dpp_f<0x4E>(x); return x; }
DI float red8(float x) { x += dpp_f<0x141>(x); return red4(x); }
DI float red16(float x) { x += dpp_f<0x140>(x); return red8(x); }
DI float red64(float x) { x = red16(x); x += __shfl_xor(x, 16); x += __shfl_xor(x, 32); return x; }
DI float sigmoidf_(float x) { return 1.f / (1.f + __expf(-x)); }
DI float siluf_(float x) { return x / (1.f + __expf(-x)); }
DI float softplusf_(float x) { return x > 20.f ? x : log1pf(__expf(x)); }
DI float geluf_(float x) { return 0.5f * x * (1.f + erff(x * 0.70710678118654752f)); }
DI void unpack8(const uint4& u, float (&f)[8]) { f[0] = bflo(u.x); f[1] = bfhi(u.x); f[2] = bflo(u.y); f[3] = bfhi(u.y); f[4] = bflo(u.z); f[5] = bfhi(u.z); f[6] = bflo(u.w); f[7] = bfhi(u.w); }
DI uint4 pack8(const float (&f)[8]) { uint4 u; u.x = pack_bf2(f[0], f[1]); u.y = pack_bf2(f[2], f[3]); u.z = pack_bf2(f[4], f[5]); u.w = pack_bf2(f[6], f[7]); return u; }
#define ACC_ROW(reg, lane) (((reg) & 3) + 8 * ((reg) >> 2) + 4 * ((lane) >> 5))
#define MFMA32(a, b, c) __builtin_amdgcn_mfma_f32_32x32x16_bf16((a), (b), (c), 0, 0, 0)

#define XB_TMO      128
#define XB_XCNT(j)  (256  + 64 * (j))
#define XB_XSUB(j)  (1280 + 64 * (j))
#define XB_XGEN(j)  (2304 + 64 * (j))
#define XB_TOP      3328
#define XB_TOPGEN   3392
#define XCD_BAR_WORDS 3456
#define XB_SPIN_CAP (1u << 22)
#define LAS __attribute__((address_space(3)))
DI unsigned xb_ld(unsigned* p) { return __hip_atomic_load(p, __ATOMIC_RELAXED, __HIP_MEMORY_SCOPE_AGENT); }
DI unsigned xb_add(unsigned* p, unsigned v) { return __hip_atomic_fetch_add(p, v, __ATOMIC_RELAXED, __HIP_MEMORY_SCOPE_AGENT); }
DI unsigned xb_xcc_id() { return (unsigned)__builtin_amdgcn_s_getreg((3 << 11) | 20) & 0xFu; }
#define XB_SPIN(cond, bar) do { unsigned _sp = 0; while (cond) { __builtin_amdgcn_s_sleep(1); \
    if ((++_sp & 255u) == 0u) { if (xb_ld(&(bar)[XB_TMO])) break; if (_sp > XB_SPIN_CAP) { atomicAdd(&(bar)[XB_TMO], 1u); break; } } } } while (0)
struct XcdBarrier { unsigned* bar; unsigned x; volatile LAS unsigned* st; };
DI XcdBarrier xcd_barrier_post(unsigned* bar, volatile LAS unsigned* st) {
  XcdBarrier b; b.bar = bar; b.x = xb_xcc_id(); b.st = st;
  if (threadIdx.x == 0) (void)xb_add(&bar[XB_XCNT(b.x)], 1u);
  return b;
}
DI void xcd_barrier_complete(unsigned* bar, unsigned x, unsigned& nloc, unsigned& nx) {
  const unsigned G = gridDim.x * gridDim.y * gridDim.z;
  unsigned sum, cnt, mine, sp = 0u;
  for (;;) {
    sum = 0u; cnt = 0u; mine = 0u;
#pragma unroll
    for (unsigned j = 0; j < 16; ++j) { const unsigned c = xb_ld(&bar[XB_XCNT(j)]); sum += c; cnt += (c > 0u) ? 1u : 0u; mine = (j == x) ? c : mine; }
    if (sum == G) break;
    __builtin_amdgcn_s_sleep(1);
    if ((++sp & 255u) == 0u) { if (xb_ld(&bar[XB_TMO])) break; if (sp > XB_SPIN_CAP) { atomicAdd(&bar[XB_TMO], 1u); break; } }
  }
  nloc = mine > 0u ? mine : 1u; nx = cnt > 0u ? cnt : 1u;
}
DI void xcd_barrier(const XcdBarrier& b) {
  asm volatile("s_waitcnt vmcnt(0)" ::: "memory");
  __syncthreads();
  if (threadIdx.x == 0) {
    unsigned* bar = b.bar;
    __builtin_amdgcn_s_waitcnt(0);
    unsigned nloc = b.st[0], nx = b.st[1];
    if (nloc == 0u) { xcd_barrier_complete(bar, b.x, nloc, nx); b.st[0] = nloc; b.st[1] = nx; }
    const unsigned old = xb_add(&bar[XB_XSUB(b.x)], 1u);
    const unsigned gen = old / nloc;
    if (old + 1u == (gen + 1u) * nloc) {
      __builtin_amdgcn_fence(__ATOMIC_RELEASE, "agent");
      asm volatile("s_waitcnt vmcnt(0)" ::: "memory");
      const unsigned og = xb_add(&bar[XB_TOP], 1u);
      const unsigned tg = og / nx;
      if (og + 1u == (tg + 1u) * nx) xb_add(&bar[XB_TOPGEN], 1u);
      else XB_SPIN(xb_ld(&bar[XB_TOPGEN]) == tg, bar);
      __builtin_amdgcn_fence(__ATOMIC_ACQUIRE, "agent");
      xb_add(&bar[XB_XGEN(b.x)], 1u);
      asm volatile("s_waitcnt vmcnt(0)" ::: "memory");
    } else {
      XB_SPIN(xb_ld(&bar[XB_XGEN(b.x)]) == gen, bar);
      __builtin_amdgcn_fence(__ATOMIC_ACQUIRE, "agent");
      asm volatile("s_waitcnt vmcnt(0)" ::: "memory");
    }
  }
  __syncthreads();
}

DI void gemm_tile(char* lds, const bf16_t* __restrict__ A, int lda, const bf16_t* __restrict__ Bt, int ldb, int K, f32x16 (&acc)[2][2]) {
  const int tid = threadIdx.x, lane = tid & 63, wave = tid >> 6, wm = wave >> 1, wn = wave & 1;
#pragma unroll
  for (int i = 0; i < 2; ++i)
#pragma unroll
    for (int j = 0; j < 2; ++j)
#pragma unroll
      for (int r = 0; r < 16; ++r) acc[i][j][r] = 0.f;
  const int arow0 = tid >> 3, ac = tid & 7;
  const bf16_t* ap = A + (size_t)arow0 * lda + ac * 8;
  const bf16_t* bp = Bt + (size_t)arow0 * ldb + ac * 8;
  const int sw = ((ac ^ (arow0 >> 1)) & 7) << 4;
  const int st_off = arow0 * 128 + sw;
  uint4 ra[4], rb[2];
#pragma unroll
  for (int i = 0; i < 4; ++i) ra[i] = *(const uint4*)(ap + (size_t)i * 64 * lda);
#pragma unroll
  for (int i = 0; i < 2; ++i) rb[i] = *(const uint4*)(bp + (size_t)i * 64 * ldb);
#pragma unroll
  for (int i = 0; i < 4; ++i) *(uint4*)(lds + st_off + i * 8192) = ra[i];
#pragma unroll
  for (int i = 0; i < 2; ++i) *(uint4*)(lds + 65536 + st_off + i * 8192) = rb[i];
  __syncthreads();
  const int nk = K >> 6;
  const int r31 = lane & 31, hh = lane >> 5;
  for (int kt = 0; kt < nk; ++kt) {
    const int cur = kt & 1;
    if (kt + 1 < nk) {
#pragma unroll
      for (int i = 0; i < 4; ++i) ra[i] = *(const uint4*)(ap + (size_t)i * 64 * lda + (kt + 1) * 64);
#pragma unroll
      for (int i = 0; i < 2; ++i) rb[i] = *(const uint4*)(bp + (size_t)i * 64 * ldb + (kt + 1) * 64);
    }
    const char* la = lds + cur * 32768;
    const char* lb = lds + 65536 + cur * 16384;
#pragma unroll
    for (int kk = 0; kk < 4; ++kk) {
      const int c = kk * 2 + hh;
      bf16x8 a[2], b[2];
#pragma unroll
      for (int mi = 0; mi < 2; ++mi) { const int row = wm * 64 + mi * 32 + r31; a[mi] = *(const bf16x8*)(la + row * 128 + (((c ^ (row >> 1)) & 7) << 4)); }
#pragma unroll
      for (int ni = 0; ni < 2; ++ni) { const int row = wn * 64 + ni * 32 + r31; b[ni] = *(const bf16x8*)(lb + row * 128 + (((c ^ (row >> 1)) & 7) << 4)); }
#pragma unroll
      for (int mi = 0; mi < 2; ++mi)
#pragma unroll
        for (int ni = 0; ni < 2; ++ni) acc[mi][ni] = MFMA32(a[mi], b[ni], acc[mi][ni]);
    }
    if (kt + 1 < nk) {
      char* wa = lds + (cur ^ 1) * 32768;
      char* wb = lds + 65536 + (cur ^ 1) * 16384;
#pragma unroll
      for (int i = 0; i < 4; ++i) *(uint4*)(wa + st_off + i * 8192) = ra[i];
#pragma unroll
      for (int i = 0; i < 2; ++i) *(uint4*)(wb + st_off + i * 8192) = rb[i];
    }
    __syncthreads();
  }
}

DI void gemm_store_phase(char* lds, const bf16_t* A, int lda, const bf16_t* Bt, int ldb, int M, int Npad, int K, bf16_t* C, int ldc, int nvalid) {
  const int ntn = Npad / 128, ntm = M / 256;
  const int lane = threadIdx.x & 63, wave = threadIdx.x >> 6, wm = wave >> 1, wn = wave & 1;
  for (int tile = blockIdx.x; tile < ntm * ntn; tile += gridDim.x) {
    const int mt = tile / ntn, nt = tile - mt * ntn;
    f32x16 acc[2][2];
    gemm_tile(lds, A + (size_t)mt * 256 * lda, lda, Bt + (size_t)nt * 128 * ldb, ldb, K, acc);
#pragma unroll
    for (int mi = 0; mi < 2; ++mi)
#pragma unroll
      for (int ni = 0; ni < 2; ++ni) {
        const int col = nt * 128 + wn * 64 + ni * 32 + (lane & 31);
        if (col < nvalid) {
#pragma unroll
          for (int r = 0; r < 16; ++r) {
            const int row = mt * 256 + wm * 64 + mi * 32 + ACC_ROW(r, lane);
            C[(size_t)row * ldc + col] = f2bf(acc[mi][ni][r]);
          }
        }
      }
  }
}

DI void gemm_resid_phase(const P& p, char* lds, int layer, const bf16_t* A, int lda, const bf16_t* Bt, int K) {
  const int ntn = 8, ntm = R / 256;
  const int lane = threadIdx.x & 63, wave = threadIdx.x >> 6, wm = wave >> 1, wn = wave & 1;
  const float* mods = (const float*)(p.ws + WS_MODS) + (size_t)layer * 9 * 6144;
  float* xc = (float*)(p.ws + WS_XC);
  for (int tile = blockIdx.x; tile < ntm * ntn; tile += gridDim.x) {
    const int mt = tile / ntn, nt = tile - mt * ntn;
    if (layer == 1 && (mt % 17) == 0) continue;
    f32x16 acc[2][2];
    gemm_tile(lds, A + (size_t)mt * 256 * lda, lda, Bt + (size_t)nt * 128 * K, K, K, acc);
    const int b = mt / 17;
    const bool isctx = (mt % 17) == 0;
    const float* gate = mods + (isctx ? 8 : b) * 6144 + 2 * 1024;
#pragma unroll
    for (int mi = 0; mi < 2; ++mi)
#pragma unroll
      for (int ni = 0; ni < 2; ++ni) {
        const int col = nt * 128 + wn * 64 + ni * 32 + (lane & 31);
        const float gt = gate[col];
#pragma unroll
        for (int r = 0; r < 16; ++r) {
          const int row = mt * 256 + wm * 64 + mi * 32 + ACC_ROW(r, lane);
          const int t = row - b * TPB;
          if (isctx) {
            const size_t o = ((size_t)(b * CTXL + t)) * D + col;
            xc[o] = p.in[I_CTX][o] + gt * acc[mi][ni][r];
          } else {
            const size_t o = ((size_t)(b * SEQ + t - CTXL)) * D + col;
            const float xin = (layer == 0) ? p.in[I_X][o] : p.out[o];
            p.out[o] = xin + gt * acc[mi][ni][r];
          }
        }
      }
  }
}

DI void transpose_tile(char* lds, const float* __restrict__ src, int K, int N, bf16_t* __restrict__ dst, int tile) {
  float* T = (float*)lds;
  const int ntk = K / 64;
  const int tn = tile / ntk, tk = tile - tn * ntk;
  const int tid = threadIdx.x;
  __syncthreads();
  for (int e = tid; e < 4096; e += NTHR) {
    const int kk = e >> 6, nn = e & 63;
    const int n = tn * 64 + nn;
    T[kk * 65 + nn] = (n < N) ? src[(size_t)(tk * 64 + kk) * N + n] : 0.f;
  }
  __syncthreads();
  for (int e = tid; e < 4096; e += NTHR) {
    const int nn = e >> 6, kk = e & 63;
    dst[(size_t)(tn * 64 + nn) * K + tk * 64 + kk] = f2bf(T[kk * 65 + nn]);
  }
}

DI void phase_prep(const P& p, char* lds) {
  const int tid = threadIdx.x;
  unsigned char* ws = p.ws;
  struct TD { int idx; int K, N, Npad; size_t dst; size_t srcoff; };
  int base = 0;
  const int G = gridDim.x;
#define TRANSPOSE_TASK(SRC, KK, NN, NPAD, DST) { const int nt_ = ((NPAD) / 64) * ((KK) / 64); \
    for (int w = blockIdx.x; w < nt_; w += G) transpose_tile(lds, (SRC), (KK), (NN), (bf16_t*)(DST), w); }
  TRANSPOSE_TASK(p.in[I_WIN0], 1024, 3456, 3456, ws + WS_WIN0T)
  TRANSPOSE_TASK(p.in[I_WOUT0], 1024, 1024, 1024, ws + WS_WOUT0T)
  TRANSPOSE_TASK(p.in[I_PQ0], 1024, 2048, 2048, ws + WS_PQ0T)
  TRANSPOSE_TASK(p.in[I_WIN1], 1024, 5184, P1NPAD, ws + WS_WIN1T)
  TRANSPOSE_TASK(p.in[I_WOUT1], 2048, 1024, 1024, ws + WS_WOUT1T)
  TRANSPOSE_TASK(p.in[I_PQ1], 1024, 2048, 2048, ws + WS_PQ1T)
  TRANSPOSE_TASK(p.in[I_RWW2], 64, 512, 512, ws + WS_RWT)
  TRANSPOSE_TASK(p.in[I_RWW2] + 64 * 512, 64, 512, 512, ws + WS_RWT + 65536)
  TRANSPOSE_TASK(p.in[I_RWA2], 64, 512, 512, ws + WS_RWT + 131072)
  TRANSPOSE_TASK(p.in[I_RWA2] + 64 * 512, 64, 512, 512, ws + WS_RWT + 196608)
  TRANSPOSE_TASK(p.in[I_RWG2], 128, 512, 512, ws + WS_RWT + 262144)
  (void)base;
  {
    const int gt = blockIdx.x * NTHR + tid, gs = G * NTHR;
    bf16_t* k0 = (bf16_t*)(ws + WS_KEYS0); bf16_t* k1 = (bf16_t*)(ws + WS_KEYS1);
    for (int i = gt; i < 262144; i += gs) { k0[i] = f2bf(p.in[I_PK0][i]); k1[i] = f2bf(p.in[I_PK1][i]); }
    float2* rope = (float2*)(ws + WS_ROPE);
    for (int i = gt; i < 4096 * 32; i += gs) {
      const int l = i >> 5, a = (i >> 4) & 1, f = i & 15;
      const float inv = powf(10000.f, -(float)f / 16.f);
      const float pos = (float)(a == 0 ? (l >> 6) : (l & 63));
      float s, c; sincosf(pos * inv, &s, &c);
      rope[i] = make_float2(c, s);
    }
    if (gt == 0) {
      const float* lp = p.in[I_DALAM];
      float s01 = 0.f, s23 = 0.f;
      for (int i = 0; i < 64; ++i) { s01 += lp[i] * lp[64 + i]; s23 += lp[128 + i] * lp[192 + i]; }
      ((float*)(ws + WS_SCAL))[0] = expf(s01) - expf(s23) + 0.2f;
    }
  }
  {
    float* sc = (float*)lds;
    float* red = (float*)(lds + 36864);
    __syncthreads();
    for (int e = tid; e < 9 * 1024; e += NTHR) { const int r = e >> 10, k = e & 1023; const float v = (r < 8) ? p.in[I_C][r * 1024 + k] : p.in[I_CCTX][k]; sc[e] = siluf_(v); }
    __syncthreads();
    float* mods = (float*)(ws + WS_MODS);
    for (int w = blockIdx.x; w < 192; w += G) {
      const int l = w / 96, j0 = (w % 96) * 64;
      const float* aw = p.in[l == 0 ? I_ADAW0 : I_ADAW1];
      const float* ab = p.in[l == 0 ? I_ADAB0 : I_ADAB1];
      const int col = tid & 63, kg = tid >> 6;
      float a[9];
#pragma unroll
      for (int r = 0; r < 9; ++r) a[r] = 0.f;
      for (int k = kg * 128; k < kg * 128 + 128; ++k) {
        const float wv = aw[(size_t)k * 6144 + j0 + col];
#pragma unroll
        for (int r = 0; r < 9; ++r) a[r] += sc[r * 1024 + k] * wv;
      }
      __syncthreads();
#pragma unroll
      for (int r = 0; r < 9; ++r) red[(kg * 64 + col) * 9 + r] = a[r];
      __syncthreads();
      for (int e = tid; e < 64 * 9; e += NTHR) {
        const int c2 = e / 9, r = e - c2 * 9;
        float s = ab[j0 + c2];
        for (int g = 0; g < 8; ++g) s += red[(g * 64 + c2) * 9 + r];
        mods[((size_t)l * 9 + r) * 6144 + j0 + c2] = s;
      }
    }
  }
}

DI void convert_tables(const P& p, int layer) {
  const float4* u = (const float4*)p.in[layer == 0 ? I_PU0 : I_PU1];
  const float4* v = (const float4*)p.in[layer == 0 ? I_PV0 : I_PV1];
  uint2* du = (uint2*)(p.ws + WS_HB + HB_U);
  uint2* dv = (uint2*)(p.ws + WS_HB + HB_V);
  const size_t n4 = (size_t)16384 * 1024 / 4;
  for (size_t i = (size_t)blockIdx.x * NTHR + threadIdx.x; i < n4; i += (size_t)gridDim.x * NTHR) {
    const float4 a = u[i]; du[i] = make_uint2(pack_bf2(a.x, a.y), pack_bf2(a.z, a.w));
    const float4 b = v[i]; dv[i] = make_uint2(pack_bf2(b.x, b.y), pack_bf2(b.z, b.w));
  }
}

DI void phase_normmod(const P& p, int layer, int which, bool from_inputs, bool lat_only, bf16_t* dst) {
  const int lane = threadIdx.x & 63, gw = blockIdx.x * 8 + (threadIdx.x >> 6), nw = gridDim.x * 8;
  const float* g = p.in[layer == 0 ? (which == 0 ? I_N1_0 : I_N2_0) : (which == 0 ? I_N1_1 : I_N2_1)];
  const float* mods = (const float*)(p.ws + WS_MODS) + (size_t)layer * 9 * 6144;
  const float* xc = (const float*)(p.ws + WS_XC);
  for (int row = gw; row < R; row += nw) {
    const int b = row / TPB, t = row - b * TPB;
    const bool isctx = t < CTXL;
    if (isctx && lat_only) continue;
    const float* src = isctx ? ((from_inputs ? p.in[I_CTX] : xc) + ((size_t)(b * CTXL + t)) * D)
                             : ((from_inputs ? p.in[I_X] : p.out) + ((size_t)(b * SEQ + t - CTXL)) * D);
    const float* mrow = mods + (isctx ? 8 : b) * 6144 + (which == 0 ? 0 : 3 * 1024);
    float v[16];
#pragma unroll
    for (int i = 0; i < 4; ++i) { const float4 f = *(const float4*)(src + lane * 16 + i * 4); v[i * 4] = f.x; v[i * 4 + 1] = f.y; v[i * 4 + 2] = f.z; v[i * 4 + 3] = f.w; }
    float ss = 0.f;
#pragma unroll
    for (int i = 0; i < 16; ++i) ss += v[i] * v[i];
    ss = red64(ss);
    const float rs = rsqrtf(ss * (1.f / 1024.f) + 1e-6f);
    float o[16];
#pragma unroll
    for (int i = 0; i < 16; ++i) { const int c = lane * 16 + i; o[i] = v[i] * rs * g[c] * (1.f + mrow[1024 + c]) + mrow[c]; }
    uint4 w0, w1;
    w0.x = pack_bf2(o[0], o[1]); w0.y = pack_bf2(o[2], o[3]); w0.z = pack_bf2(o[4], o[5]); w0.w = pack_bf2(o[6], o[7]);
    w1.x = pack_bf2(o[8], o[9]); w1.y = pack_bf2(o[10], o[11]); w1.z = pack_bf2(o[12], o[13]); w1.w = pack_bf2(o[14], o[15]);
    *(uint4*)(dst + (size_t)row * D + lane * 16) = w0;
    *(uint4*)(dst + (size_t)row * D + lane * 16 + 8) = w1;
  }
}

DI void phase_final_norm(const P& p) {
  const int lane = threadIdx.x & 63, gw = blockIdx.x * 8 + (threadIdx.x >> 6), nw = gridDim.x * 8;
  const float* g = p.in[I_NF];
  for (int row = gw; row < NB * SEQ; row += nw) {
    float* src = p.out + (size_t)row * D;
    float v[16];
#pragma unroll
    for (int i = 0; i < 4; ++i) { const float4 f = *(const float4*)(src + lane * 16 + i * 4); v[i * 4] = f.x; v[i * 4 + 1] = f.y; v[i * 4 + 2] = f.z; v[i * 4 + 3] = f.w; }
    float ss = 0.f;
#pragma unroll
    for (int i = 0; i < 16; ++i) ss += v[i] * v[i];
    ss = red64(ss);
    const float rs = rsqrtf(ss * (1.f / 1024.f) + 1e-6f);
#pragma unroll
    for (int i = 0; i < 4; ++i) {
      const int c = lane * 16 + i * 4;
      float4 f; f.x = v[i * 4] * rs * g[c]; f.y = v[i * 4 + 1] * rs * g[c + 1]; f.z = v[i * 4 + 2] * rs * g[c + 2]; f.w = v[i * 4 + 3] * rs * g[c + 3];
      *(float4*)(src + c) = f;
    }
  }
}

DI void attn_naive_unit(const P& p, char* lds, int unit) {
  const int tid = threadIdx.x;
  const bool isctx = unit >= 2048;
  int b, h, qb;
  if (!isctx) { b = unit >> 8; h = (unit >> 6) & 3; qb = unit & 63; } else { const int u = unit - 2048; b = u >> 4; h = (u >> 2) & 3; qb = u & 3; }
  const int nkeys = isctx ? CTXL : TPB;
  const bf16_t* p0 = (const bf16_t*)(p.ws + WS_PB + PB_P);
  const float2* rope = (const float2*)(p.ws + WS_ROPE);
  const float lam = ((const float*)(p.ws + WS_SCAL))[0];
  const int q = tid & 63, m = (tid >> 6) & 1, qt = tid >> 7;
  const int ql = qb * 64 + q;
  const size_t qrow = (size_t)b * TPB + (isctx ? ql : CTXL + ql);
  float* Ks = (float*)lds;
  float* Vs = (float*)(lds + 16384);
  float* Ex = (float*)(lds + 32768);
  float* SS = (float*)(lds + 65536);
  float qv[64];
  {
    const bf16_t* qp = p0 + qrow * P0LD + h * 128 + m * 64;
#pragma unroll
    for (int i = 0; i < 8; ++i) { const uint4 u = *(const uint4*)(qp + i * 8); float f[8]; unpack8(u, f);
#pragma unroll
      for (int j = 0; j < 8; ++j) qv[i * 8 + j] = f[j]; }
    if (!isctx) {
#pragma unroll
      for (int a = 0; a < 2; ++a)
#pragma unroll
        for (int f = 0; f < 16; ++f) {
          const float2 cs = rope[ql * 32 + a * 16 + f];
          const float t1 = qv[a * 32 + f], t2 = qv[a * 32 + 16 + f];
          qv[a * 32 + f] = t1 * cs.x - t2 * cs.y;
          qv[a * 32 + 16 + f] = t2 * cs.x + t1 * cs.y;
        }
    }
#pragma unroll
    for (int i = 0; i < 64; ++i) qv[i] *= 0.125f;
  }
  float O[32];
#pragma unroll
  for (int i = 0; i < 32; ++i) O[i] = 0.f;
  float mx = -1e30f, lsum = 0.f;
  for (int kt = 0; kt < nkeys / 32; ++kt) {
    __syncthreads();
#pragma unroll 1
    for (int i = 0; i < 4; ++i) {
      const int id = tid + i * NTHR;
      const int j = id >> 6, rem = id & 63, m2 = rem >> 5, a = (rem >> 4) & 1, f = rem & 15;
      const int tk = kt * 32 + j;
      const bf16_t* kp = p0 + ((size_t)b * TPB + tk) * P0LD + 512 + h * 128 + m2 * 64 + a * 32 + f;
      float k1 = bf2f(kp[0]), k2 = bf2f(kp[16]);
      if (tk >= CTXL) { const float2 cs = rope[(tk - CTXL) * 32 + a * 16 + f]; const float t1 = k1, t2 = k2; k1 = t1 * cs.x - t2 * cs.y; k2 = t2 * cs.x + t1 * cs.y; }
      Ks[j * 128 + m2 * 64 + a * 32 + f] = k1;
      Ks[j * 128 + m2 * 64 + a * 32 + 16 + f] = k2;
    }
    {
      const int j = tid >> 4, c8 = (tid & 15) * 8;
      const uint4 u = *(const uint4*)(p0 + ((size_t)b * TPB + kt * 32 + j) * P0LD + 1024 + h * 128 + c8);
      float f[8]; unpack8(u, f);
#pragma unroll
      for (int i = 0; i < 8; ++i) Vs[j * 128 + c8 + i] = f[i];
    }
    __syncthreads();
#pragma unroll 1
    for (int j0 = 0; j0 < 32; j0 += 8) {
      float s[8];
#pragma unroll
      for (int j = 0; j < 8; ++j) {
        const float4* kr = (const float4*)(Ks + (j0 + j) * 128 + m * 64);
        float acc = 0.f;
#pragma unroll
        for (int d4 = 0; d4 < 16; ++d4) { const float4 kk = kr[d4]; acc += qv[d4 * 4] * kk.x + qv[d4 * 4 + 1] * kk.y + qv[d4 * 4 + 2] * kk.z + qv[d4 * 4 + 3] * kk.w; }
        s[j] = acc;
      }
      float mn = mx;
#pragma unroll
      for (int j = 0; j < 8; ++j) mn = fmaxf(mn, s[j]);
      const float corr = __expf(mx - mn);
      mx = mn; lsum *= corr;
#pragma unroll
      for (int i = 0; i < 32; ++i) O[i] *= corr;
#pragma unroll
      for (int j = 0; j < 8; ++j) {
        const float pj = __expf(s[j] - mn);
        lsum += pj;
        const float4* vr = (const float4*)(Vs + (j0 + j) * 128 + qt * 32);
#pragma unroll
        for (int d4 = 0; d4 < 8; ++d4) { const float4 vv = vr[d4]; O[d4 * 4] += pj * vv.x; O[d4 * 4 + 1] += pj * vv.y; O[d4 * 4 + 2] += pj * vv.z; O[d4 * 4 + 3] += pj * vv.w; }
      }
    }
  }
  const float inv = 1.f / lsum;
#pragma unroll
  for (int i = 0; i < 32; ++i) O[i] *= inv;
  __syncthreads();
  if (m == 1) {
#pragma unroll
    for (int i = 0; i < 32; ++i) Ex[q * 128 + qt * 32 + i] = O[i];
  }
  __syncthreads();
  if (m == 0) {
    float ss = 0.f;
#pragma unroll
    for (int i = 0; i < 32; ++i) { O[i] -= lam * Ex[q * 128 + qt * 32 + i]; ss += O[i] * O[i]; }
    SS[q * 4 + qt] = ss;
  }
  __syncthreads();
  if (m == 0) {
    const float tot = SS[q * 4] + SS[q * 4 + 1] + SS[q * 4 + 2] + SS[q * 4 + 3];
    const float rs = rsqrtf(tot * (1.f / 128.f) + 1e-6f) * 0.8f;
    const float* sub = p.in[I_DASUB] + qt * 32;
    bf16_t* op = (bf16_t*)(p.ws + WS_PB + PB_O0) + qrow * 1024 + h * 128 + qt * 32;
#pragma unroll
    for (int i = 0; i < 4; ++i) {
      float f[8];
#pragma unroll
      for (int j = 0; j < 8; ++j) f[j] = O[i * 8 + j] * rs * sub[i * 8 + j];
      *(uint4*)(op + i * 8) = pack8(f);
    }
  }
}

DI void phase_ga(const P& p) {
  const bf16_t* p0 = (const bf16_t*)(p.ws + WS_PB + PB_P);
  bf16_t* ga = (bf16_t*)(p.ws + WS_PB + PB_GA);
  const float* mu = p.in[I_RWMU] + 1792;
  for (int i = blockIdx.x * NTHR + threadIdx.x; i < R * 16; i += gridDim.x * NTHR) {
    const int row = i >> 4, c8 = (i & 15) * 8;
    const int t = row % TPB;
    const bool first = (t == 0) || (t == CTXL), last = (t == CTXL - 1) || (t == TPB - 1);
    const bf16_t* sp = p0 + (size_t)row * P0LD + 1536 + 1792 + c8;
    float u[8], um[8], up[8];
    unpack8(*(const uint4*)sp, u);
    if (!first) unpack8(*(const uint4*)(sp - P0LD), um); else { for (int j = 0; j < 8; ++j) um[j] = 0.f; }
    if (!last) unpack8(*(const uint4*)(sp + P0LD), up); else { for (int j = 0; j < 8; ++j) up[j] = 0.f; }
    float o[8];
#pragma unroll
    for (int j = 0; j < 8; ++j) { const float mix = u[j] + mu[c8 + j] * (0.5f * (um[j] + up[j]) - u[j]); o[j] = sigmoidf_(mix); }
    *(uint4*)(ga + (size_t)row * 128 + c8) = pack8(o);
  }
}

DI int scan_token(int d, int s) { return d == 0 ? s : (s < CTXL ? (CTXL - 1 - s) : (TPB + CTXL - 1 - s)); }

DI void rwkv_scan_unit(const P& p, char* lds, int unit) {
  const int tid = threadIdx.x, lane = tid & 63, wave = tid >> 6;
  const int half = unit & 1, d = (unit >> 1) & 1, h = (unit >> 2) & 7, b = unit >> 5;
  float* Lr = (float*)lds;
  float* Lk = (float*)(lds + 16384);
  float* Lv = (float*)(lds + 32768);
  float* La = (float*)(lds + 49152);
  float* Lb = (float*)(lds + 65536);
  float* Lw = (float*)(lds + 81920);
  float* Las = (float*)(lds + 98304);
  bf16_t* Aw = (bf16_t*)(lds + 114688);
  bf16_t* Aa = (bf16_t*)(lds + 122880);
  float* Linv = (float*)(lds + 131072);
  float* Ly = (float*)(lds + 131072 + 1024);
  const bf16_t* p0 = (const bf16_t*)(p.ws + WS_PB + PB_P);
  const float* mu = p.in[I_RWMU];
  const int gid = wave >> 2, tmi = (wave >> 1) & 1, tni = wave & 1;
  bf16x8 bfrag[4];
  {
    const bf16_t* wt = (const bf16_t*)(p.ws + WS_RWT + (gid == 0 ? 0 : 131072) + (size_t)d * 65536);
    const int n = h * 64 + tni * 32 + (lane & 31);
#pragma unroll
    for (int kk = 0; kk < 4; ++kk) bfrag[kk] = *(const bf16x8*)(wt + n * 64 + kk * 16 + 8 * (lane >> 5));
  }
  const float bias0 = (gid == 0 ? p.in[I_RWW0] : p.in[I_RWA0])[d * 512 + h * 64 + tni * 32 + (lane & 31)];
  const int ss_ = tid >> 3, cg8 = (tid & 7) * 8;
  float kkc[8], kac[8], rkc[8];
#pragma unroll
  for (int j = 0; j < 8; ++j) { kkc[j] = p.in[I_RWKK][h * 64 + cg8 + j]; kac[j] = p.in[I_RWKA][h * 64 + cg8 + j]; rkc[j] = p.in[I_RWRK][h * 64 + cg8 + j]; }
  const int rl = tid >> 4, c4 = (tid & 15) * 4;
  const int row = half * 32 + rl;
  float S0 = 0.f, S1 = 0.f, S2 = 0.f, S3 = 0.f;
  bf16_t* yout = (bf16_t*)(p.ws + WS_HB + (d == 0 ? HB_YF : HB_YB));
  float* bonus = (float*)(p.ws + WS_PB + PB_BONUS) + (size_t)d * R * 8;
  for (int ch = 0; ch < TPB / 64; ++ch) {
    {
      const int s = ch * 64 + ss_;
      const int t = scan_token(d, s);
      const bool first = (t == 0) || (t == CTXL), last = (t == CTXL - 1) || (t == TPB - 1);
      const bf16_t* rowp = p0 + ((size_t)b * TPB + t) * P0LD + 1536;
      const int cols[5] = {h * 64 + cg8, 512 + h * 64 + cg8, 1024 + h * 64 + cg8, 1536 + d * 64 + cg8, 1664 + d * 64 + cg8};
      float mixed[5][8];
#pragma unroll
      for (int g = 0; g < 5; ++g) {
        float u[8], um[8], up[8];
        unpack8(*(const uint4*)(rowp + cols[g]), u);
        if (!first) unpack8(*(const uint4*)(rowp - P0LD + cols[g]), um); else {
#pragma unroll
          for (int j = 0; j < 8; ++j) um[j] = 0.f; }
        if (!last) unpack8(*(const uint4*)(rowp + P0LD + cols[g]), up); else {
#pragma unroll
          for (int j = 0; j < 8; ++j) up[j] = 0.f; }
#pragma unroll
        for (int j = 0; j < 8; ++j) mixed[g][j] = u[j] + mu[cols[g] + j] * (0.5f * (um[j] + up[j]) - u[j]);
      }
      float nrm = 0.f;
#pragma unroll
      for (int j = 0; j < 8; ++j) {
        Lr[ss_ * 64 + cg8 + j] = mixed[0][j];
        Lk[ss_ * 64 + cg8 + j] = mixed[1][j];
        Lv[ss_ * 64 + cg8 + j] = mixed[2][j];
        const float kq = mixed[1][j] * kkc[j];
        nrm += kq * kq;
      }
      float tw[8];
#pragma unroll
      for (int j = 0; j < 8; ++j) tw[j] = tanhf(mixed[3][j]);
      *(uint4*)(Aw + ss_ * 64 + cg8) = pack8(tw);
      *(uint4*)(Aa + ss_ * 64 + cg8) = pack8(mixed[4]);
      nrm = red8(nrm);
      if ((tid & 7) == 0) Linv[ss_] = 1.f / fmaxf(sqrtf(nrm), 1e-12f);
    }
    __syncthreads();
    {
      f32x16 acc;
#pragma unroll
      for (int r = 0; r < 16; ++r) acc[r] = 0.f;
      const bf16_t* Asrc = gid == 0 ? Aw : Aa;
#pragma unroll
      for (int kk = 0; kk < 4; ++kk) {
        const bf16x8 a = *(const bf16x8*)(Asrc + (tmi * 32 + (lane & 31)) * 64 + kk * 16 + 8 * (lane >> 5));
        acc = MFMA32(a, bfrag[kk], acc);
      }
      const int n = tni * 32 + (lane & 31);
#pragma unroll
      for (int r = 0; r < 16; ++r) {
        const int s = tmi * 32 + ACC_ROW(r, lane);
        const float x = acc[r] + bias0;
        if (gid == 0) { const float wl = -softplusf_(-x) - 0.5f; Lw[s * 64 + n] = __expf(-__expf(wl)); }
        else Las[s * 64 + n] = sigmoidf_(x);
      }
    }
    __syncthreads();
    {
      const float iv = Linv[ss_];
      float bsum = 0.f;
#pragma unroll
      for (int j = 0; j < 8; ++j) {
        const int o = ss_ * 64 + cg8 + j;
        const float k = Lk[o], as = Las[o];
        const float kkv = k * kkc[j] * iv;
        La[o] = -kkv; Lb[o] = kkv * as;
        const float kd = k * (1.f + (as - 1.f) * kac[j]);
        Lk[o] = kd;
        bsum += Lr[o] * kd * rkc[j];
      }
      bsum = red8(bsum);
      if (half == 0 && (tid & 7) == 0) {
        const int t = scan_token(d, ch * 64 + ss_);
        bonus[((size_t)b * TPB + t) * 8 + h] = bsum;
      }
    }
    __syncthreads();
#pragma unroll 2
    for (int s = 0; s < 64; ++s) {
      const float4 a4 = *(const float4*)(La + s * 64 + c4);
      const float4 b4 = *(const float4*)(Lb + s * 64 + c4);
      const float4 k4 = *(const float4*)(Lk + s * 64 + c4);
      const float4 w4 = *(const float4*)(Lw + s * 64 + c4);
      const float4 r4 = *(const float4*)(Lr + s * 64 + c4);
      const float vv = Lv[s * 64 + row];
      float sa = S0 * a4.x + S1 * a4.y + S2 * a4.z + S3 * a4.w;
      sa = red16(sa);
      S0 = S0 * w4.x + (sa * b4.x + vv * k4.x);
      S1 = S1 * w4.y + (sa * b4.y + vv * k4.y);
      S2 = S2 * w4.z + (sa * b4.z + vv * k4.z);
      S3 = S3 * w4.w + (sa * b4.w + vv * k4.w);
      float y = S0 * r4.x + S1 * r4.y + S2 * r4.z + S3 * r4.w;
      y = red16(y);
      if ((tid & 15) == 0) Ly[s * 32 + rl] = y;
    }
    __syncthreads();
    {
      const int s = tid >> 3, r4i = (tid & 7) * 4;
      const int t = scan_token(d, ch * 64 + s);
      const float4 yv = *(const float4*)(Ly + s * 32 + r4i);
      uint2 w; w.x = pack_bf2(yv.x, yv.y); w.y = pack_bf2(yv.z, yv.w);
      *(uint2*)(yout + ((size_t)b * TPB + t) * 512 + h * 64 + half * 32 + r4i) = w;
    }
  }
}

DI void phase_rwkv_post(const P& p) {
  const bf16_t* p0 = (const bf16_t*)(p.ws + WS_PB + PB_P);
  const bf16_t* yf = (const bf16_t*)(p.ws + WS_HB + HB_YF);
  const bf16_t* yb = (const bf16_t*)(p.ws + WS_HB + HB_YB);
  const bf16_t* G = (const bf16_t*)(p.ws + WS_PB + PB_G);
  const float* bonus = (const float*)(p.ws + WS_PB + PB_BONUS);
  bf16_t* o0 = (bf16_t*)(p.ws + WS_PB + PB_O0);
  const float* mu = p.in[I_RWMU] + 1024;
  for (int i = blockIdx.x * NTHR + threadIdx.x; i < R * 8; i += gridDim.x * NTHR) {
    const int row = i >> 3, h = i & 7;
    const int t = row % TPB;
    const bool first = (t == 0) || (t == CTXL), last = (t == CTXL - 1) || (t == TPB - 1);
    float y[64];
    float mean = 0.f;
#pragma unroll
    for (int c = 0; c < 8; ++c) {
      float a[8], bb[8];
      unpack8(*(const uint4*)(yf + (size_t)row * 512 + h * 64 + c * 8), a);
      unpack8(*(const uint4*)(yb + (size_t)row * 512 + h * 64 + c * 8), bb);
#pragma unroll
      for (int j = 0; j < 8; ++j) { y[c * 8 + j] = a[j] + bb[j]; mean += y[c * 8 + j]; }
    }
    mean *= (1.f / 64.f);
    float var = 0.f;
#pragma unroll
    for (int j = 0; j < 64; ++j) { const float dlt = y[j] - mean; var += dlt * dlt; }
    var *= (1.f / 64.f);
    const float rs = rsqrtf(var + 64e-5f);
    const float bn = bonus[(size_t)row * 8 + h] + bonus[(size_t)R * 8 + (size_t)row * 8 + h];
    const bf16_t* vp = p0 + (size_t)row * P0LD + 1536 + 1024 + h * 64;
#pragma unroll
    for (int c = 0; c < 8; ++c) {
      float u[8], um[8], up[8], g[8], o[8];
      unpack8(*(const uint4*)(vp + c * 8), u);
      if (!first) unpack8(*(const uint4*)(vp - P0LD + c * 8), um); else {
#pragma unroll
        for (int j = 0; j < 8; ++j) um[j] = 0.f; }
      if (!last) unpack8(*(const uint4*)(vp + P0LD + c * 8), up); else {
#pragma unroll
        for (int j = 0; j < 8; ++j) up[j] = 0.f; }
      unpack8(*(const uint4*)(G + (size_t)row * 512 + h * 64 + c * 8), g);
#pragma unroll
      for (int j = 0; j < 8; ++j) {
        const int cc = h * 64 + c * 8 + j;
        const float v = u[j] + mu[cc] * (0.5f * (um[j] + up[j]) - u[j]);
        const float yn = (y[c * 8 + j] - mean) * rs * p.in[I_LNXW][cc] + p.in[I_LNXB][cc];
        o[j] = (yn + bn * v) * g[j];
      }
      *(uint4*)(o0 + (size_t)row * 1024 + 512 + h * 64 + c * 8) = pack8(o);
    }
  }
}

DI unsigned f2ord(float f) { const unsigned u = __float_as_uint(f); return u ^ ((u >> 31) ? 0xFFFFFFFFu : 0x80000000u); }
DI float ord2f(unsigned u) { u ^= ((u >> 31) ? 0x80000000u : 0xFFFFFFFFu); return __uint_as_float(u); }

struct CandPairs { int ia[25], ja[25], ib[25], jb[25]; };
constexpr CandPairs make_pairs() {
  CandPairs c{};
  int n = 0;
  for (int i = 0; i < 16; ++i) for (int j = 0; j < 16; ++j) if ((i + 1) * (j + 1) <= 16) {
    if ((n & 1) == 0) { c.ia[n >> 1] = i; c.ja[n >> 1] = j; } else { c.ib[n >> 1] = i; c.jb[n >> 1] = j; }
    ++n;
  }
  return c;
}
constexpr CandPairs CP = make_pairs();

DI void peer_topk_unit(const P& p, char* lds, int layer, int unit) {
  const int tid = threadIdx.x, lane = tid & 63, wave = tid >> 6;
  const int mt = unit >> 3, h = unit & 7;
  const bf16_t* q = (const bf16_t*)(p.ws + WS_PB + PB_Q);
  const bf16_t* keys = (const bf16_t*)(p.ws + (layer == 0 ? WS_KEYS0 : WS_KEYS1)) + (size_t)h * 2 * 128 * 128;
  int* idxo = (int*)(p.ws + WS_PB + PB_IDX);
  float* gateo = (float*)(p.ws + WS_PB + PB_GATE);
  __syncthreads();
  for (int e = tid; e < 2 * 128 * 16; e += NTHR) {
    const int pp = e >> 11, row = (e >> 4) & 127, c = e & 15;
    *(uint4*)(lds + pp * 32768 + row * 256 + ((c ^ (row & 15)) << 4)) = *(const uint4*)(keys + (size_t)pp * 16384 + row * 128 + c * 8);
  }
  __syncthreads();
  const int r31 = lane & 31, hh = lane >> 5;
  const size_t trow = (size_t)mt * 256 + wave * 32 + r31;
  unsigned vk[2][16];
#pragma unroll
  for (int pp = 0; pp < 2; ++pp) {
    f32x16 acc[4];
#pragma unroll
    for (int m = 0; m < 4; ++m)
#pragma unroll
      for (int r = 0; r < 16; ++r) acc[m][r] = 0.f;
    const bf16_t* qp = q + trow * 2048 + (h * 2 + pp) * 128;
#pragma unroll
    for (int kk = 0; kk < 8; ++kk) {
      const bf16x8 bq = *(const bf16x8*)(qp + kk * 16 + 8 * hh);
      const int c = kk * 2 + hh;
#pragma unroll
      for (int m = 0; m < 4; ++m) {
        const int row = m * 32 + r31;
        const bf16x8 ak = *(const bf16x8*)(lds + pp * 32768 + row * 256 + ((c ^ (row & 15)) << 4));
        acc[m] = MFMA32(ak, bq, acc[m]);
      }
    }
    unsigned v[16];
#pragma unroll
    for (int i = 0; i < 16; ++i) v[i] = 0u;
#pragma unroll
    for (int m = 0; m < 4; ++m)
#pragma unroll
      for (int r = 0; r < 16; ++r) {
        const int kidx = m * 32 + ACC_ROW(r, lane);
        unsigned x = (f2ord(acc[m][r]) & ~127u) | (unsigned)(127 - kidx);
#pragma unroll
        for (int i = 0; i < 16; ++i) { const unsigned hi = max(v[i], x); x = min(v[i], x); v[i] = hi; }
      }
    unsigned c16[16];
#pragma unroll
    for (int i = 0; i < 16; ++i) { const unsigned o = (unsigned)__shfl_xor((int)v[15 - i], 32); c16[i] = max(v[i], o); }
#pragma unroll
    for (int st = 8; st >= 1; st >>= 1)
#pragma unroll
      for (int i = 0; i < 16; ++i) if ((i & st) == 0) { const unsigned hi = max(c16[i], c16[i + st]), lo = min(c16[i], c16[i + st]); c16[i] = hi; c16[i + st] = lo; }
#pragma unroll
    for (int i = 0; i < 16; ++i) vk[pp][i] = c16[i];
  }
  float val1[16], val2[16]; int id1[16], id2[16];
#pragma unroll
  for (int i = 0; i < 16; ++i) {
    val1[i] = ord2f(vk[0][i] & ~127u); id1[i] = 127 - (int)(vk[0][i] & 127u);
    val2[i] = ord2f(vk[1][i] & ~127u); id2[i] = 127 - (int)(vk[1][i] & 127u);
  }
  float tv[16]; int tp[16];
#pragma unroll
  for (int i = 0; i < 16; ++i) { tv[i] = -3.0e38f; tp[i] = 0; }
#pragma unroll
  for (int t = 0; t < 25; ++t) {
    const float va = val1[CP.ia[t]] + val2[CP.ja[t]];
    const float vb = val1[CP.ib[t]] + val2[CP.jb[t]];
    const int pa = id1[CP.ia[t]] * 128 + id2[CP.ja[t]];
    const int pb = id1[CP.ib[t]] * 128 + id2[CP.jb[t]];
    float val = hh ? vb : va; int pay = hh ? pb : pa;
#pragma unroll
    for (int i = 0; i < 16; ++i) {
      const bool gt = val > tv[i];
      const float nv = gt ? val : tv[i]; const int np = gt ? pay : tp[i];
      val = gt ? tv[i] : val; pay = gt ? tp[i] : pay;
      tv[i] = nv; tp[i] = np;
    }
  }
  float cv[16]; int cp[16];
  float mx = -3.0e38f;
#pragma unroll
  for (int i = 0; i < 16; ++i) {
    const float ov = __shfl_xor(tv[15 - i], 32); const int op = __shfl_xor(tp[15 - i], 32);
    const bool own = tv[i] >= ov;
    cv[i] = own ? tv[i] : ov; cp[i] = own ? tp[i] : op;
    mx = fmaxf(mx, cv[i]);
  }
  float sum = 0.f;
#pragma unroll
  for (int i = 0; i < 16; ++i) { cv[i] = __expf(cv[i] - mx); sum += cv[i]; }
  const float inv = 1.f / sum;
  if (hh == 0) {
    int* ip = idxo + trow * 128 + h * 16;
    float* gp = gateo + trow * 128 + h * 16;
#pragma unroll
    for (int i = 0; i < 4; ++i) {
      *(int4*)(ip + i * 4) = make_int4(cp[i * 4], cp[i * 4 + 1], cp[i * 4 + 2], cp[i * 4 + 3]);
      *(float4*)(gp + i * 4) = make_float4(cv[i * 4] * inv, cv[i * 4 + 1] * inv, cv[i * 4 + 2] * inv, cv[i * 4 + 3] * inv);
    }
  }
}

DI void phase_peer_gather(const P& p, int layer) {
  const int lane = threadIdx.x & 63, gw = blockIdx.x * 8 + (threadIdx.x >> 6), nw = gridDim.x * 8;
  const bf16_t* h2 = (const bf16_t*)(p.ws + WS_PB + PB_H2);
  const int* idx = (const int*)(p.ws + WS_PB + PB_IDX);
  const float* gate = (const float*)(p.ws + WS_PB + PB_GATE);
  const bf16_t* U = (const bf16_t*)(p.ws + WS_HB + HB_U);
  const bf16_t* V = (const bf16_t*)(p.ws + WS_HB + HB_V);
  const float* mods = (const float*)(p.ws + WS_MODS) + (size_t)layer * 9 * 6144;
  float* xc = (float*)(p.ws + WS_XC);
  for (int row = gw; row < R; row += nw) {
    const int b = row / TPB, t = row - b * TPB;
    const bool isctx = t < CTXL;
    if (isctx && layer == 1) continue;
    float hv[16];
    {
      float f[8];
      unpack8(*(const uint4*)(h2 + (size_t)row * D + lane * 16), f);
#pragma unroll
      for (int j = 0; j < 8; ++j) hv[j] = f[j];
      unpack8(*(const uint4*)(h2 + (size_t)row * D + lane * 16 + 8), f);
#pragma unroll
      for (int j = 0; j < 8; ++j) hv[8 + j] = f[j];
    }
    float acc[16];
#pragma unroll
    for (int j = 0; j < 16; ++j) acc[j] = 0.f;
    const int my_i0 = idx[(size_t)row * 128 + lane], my_i1 = idx[(size_t)row * 128 + 64 + lane];
    const float my_g0 = gate[(size_t)row * 128 + lane], my_g1 = gate[(size_t)row * 128 + 64 + lane];
    for (int e0 = 0; e0 < 128; e0 += 4) {
      uint4 ur[4][2], vr[4][2];
      float gg[4];
#pragma unroll
      for (int k = 0; k < 4; ++k) {
        const int e = e0 + k;
        const int ei = (e < 64) ? __builtin_amdgcn_readlane(my_i0, e & 63) : __builtin_amdgcn_readlane(my_i1, e & 63);
        gg[k] = __int_as_float((e < 64) ? __builtin_amdgcn_readlane(__float_as_int(my_g0), e & 63) : __builtin_amdgcn_readlane(__float_as_int(my_g1), e & 63));
        const bf16_t* up = U + (size_t)ei * D + lane * 16;
        const bf16_t* vp = V + (size_t)ei * D + lane * 16;
        ur[k][0] = *(const uint4*)up; ur[k][1] = *(const uint4*)(up + 8);
        vr[k][0] = *(const uint4*)vp; vr[k][1] = *(const uint4*)(vp + 8);
      }
#pragma unroll
      for (int k = 0; k < 4; ++k) {
        float f[8]; float dot = 0.f;
        unpack8(ur[k][0], f);
#pragma unroll
        for (int j = 0; j < 8; ++j) dot += hv[j] * f[j];
        unpack8(ur[k][1], f);
#pragma unroll
        for (int j = 0; j < 8; ++j) dot += hv[8 + j] * f[j];
        dot = red64(dot);
        const float w = gg[k] * geluf_(dot);
        unpack8(vr[k][0], f);
#pragma unroll
        for (int j = 0; j < 8; ++j) acc[j] += w * f[j];
        unpack8(vr[k][1], f);
#pragma unroll
        for (int j = 0; j < 8; ++j) acc[8 + j] += w * f[j];
      }
    }
    const float* g5 = mods + (isctx ? 8 : b) * 6144 + 5 * 1024 + lane * 16;
    float* xp = isctx ? (xc + ((size_t)(b * CTXL + t)) * D + lane * 16) : (p.out + ((size_t)(b * SEQ + t - CTXL)) * D + lane * 16);
#pragma unroll
    for (int i = 0; i < 4; ++i) {
      float4 x = *(float4*)(xp + i * 4);
      x.x += g5[i * 4] * acc[i * 4]; x.y += g5[i * 4 + 1] * acc[i * 4 + 1]; x.z += g5[i * 4 + 2] * acc[i * 4 + 2]; x.w += g5[i * 4 + 3] * acc[i * 4 + 3];
      *(float4*)(xp + i * 4) = x;
    }
  }
}

DI void ssd_naive_unit(const P& p, char* lds, int unit) {
  const int tid = threadIdx.x;
  const int b = unit >> 5, head = unit & 31, grp = head >> 3;
  float* Lx = (float*)lds;
  float* LB = (float*)(lds + 16384);
  float* LC = (float*)(lds + 49152);
  float* Lda = (float*)(lds + 81920);
  float* Ldt = (float*)(lds + 81920 + 256);
  float* Ly = (float*)(lds + 82944);
  bf16_t* p1 = (bf16_t*)(p.ws + WS_PB + PB_P);
  bf16_t* yftmp = (bf16_t*)(p.ws + WS_YF);
  const float* cw = p.in[I_CONVW]; const float* cb = p.in[I_CONVB];
  const int ss_ = tid >> 3, j8 = tid & 7;
  const int pp = tid >> 3, ng = tid & 7;
  const float dsk = p.in[I_DSKIP][head];
  for (int d = 0; d < 2; ++d) {
    const float Aneg = -__expf(p.in[I_ALOG][d * 32 + head]);
    const float dtb = p.in[I_DTB][d * 32 + head];
    float hst[16];
#pragma unroll
    for (int n = 0; n < 16; ++n) hst[n] = 0.f;
    for (int ch = 0; ch < TPB / 64; ++ch) {
      __syncthreads();
      {
        const int t = scan_token(d, ch * 64 + ss_);
        const bool first = (t == 0) || (t == CTXL), last = (t == CTXL - 1) || (t == TPB - 1);
        const bf16_t* rowp = p1 + ((size_t)b * TPB + t) * P1LD + 2048;
        const int cc[5] = {head * 64 + j8 * 8, 2048 + grp * 128 + j8 * 16, 2048 + grp * 128 + j8 * 16 + 8, 2560 + grp * 128 + j8 * 16, 2560 + grp * 128 + j8 * 16 + 8};
#pragma unroll
        for (int g = 0; g < 5; ++g) {
          float u[8], um[8], up[8];
          unpack8(*(const uint4*)(rowp + cc[g]), u);
          if (!first) unpack8(*(const uint4*)(rowp - P1LD + cc[g]), um); else {
#pragma unroll
            for (int j = 0; j < 8; ++j) um[j] = 0.f; }
          if (!last) unpack8(*(const uint4*)(rowp + P1LD + cc[g]), up); else {
#pragma unroll
            for (int j = 0; j < 8; ++j) up[j] = 0.f; }
#pragma unroll
          for (int j = 0; j < 8; ++j) {
            const int c = cc[g] + j;
            const float v = siluf_(cw[c] * um[j] + cw[3072 + c] * u[j] + cw[6144 + c] * up[j] + cb[c]);
            if (g == 0) Lx[ss_ * 64 + j8 * 8 + j] = v;
            else if (g == 1) LB[ss_ * 128 + j8 * 16 + j] = v;
            else if (g == 2) LB[ss_ * 128 + j8 * 16 + 8 + j] = v;
            else if (g == 3) LC[ss_ * 128 + j8 * 16 + j] = v;
            else LC[ss_ * 128 + j8 * 16 + 8 + j] = v;
          }
        }
        if (j8 == 0) {
          const float raw = bf2f(p1[((size_t)b * TPB + t) * P1LD + 5120 + d * 32 + head]);
          const float dtv = softplusf_(raw + dtb);
          Ldt[ss_] = dtv; Lda[ss_] = __expf(dtv * Aneg);
        }
      }
      __syncthreads();
      for (int s = 0; s < 64; ++s) {
        const float da = Lda[s];
        const float xdt = Lx[s * 64 + pp] * Ldt[s];
        float y = 0.f;
#pragma unroll
        for (int n4 = 0; n4 < 4; ++n4) {
          const float4 bv = *(const float4*)(LB + s * 128 + ng * 16 + n4 * 4);
          const float4 cv = *(const float4*)(LC + s * 128 + ng * 16 + n4 * 4);
          hst[n4 * 4] = hst[n4 * 4] * da + xdt * bv.x; y += cv.x * hst[n4 * 4];
          hst[n4 * 4 + 1] = hst[n4 * 4 + 1] * da + xdt * bv.y; y += cv.y * hst[n4 * 4 + 1];
          hst[n4 * 4 + 2] = hst[n4 * 4 + 2] * da + xdt * bv.z; y += cv.z * hst[n4 * 4 + 2];
          hst[n4 * 4 + 3] = hst[n4 * 4 + 3] * da + xdt * bv.w; y += cv.w * hst[n4 * 4 + 3];
        }
        y = red8(y);
        if (ng == 0) Ly[s * 64 + pp] = y;
      }
      __syncthreads();
      if (ch >= CTXL / 64) {
        const int t = scan_token(d, ch * 64 + ss_);
        const size_t lrow = (size_t)b * SEQ + (t - CTXL);
        bf16_t* yfp = yftmp + lrow * 2048 + head * 64 + j8 * 8;
        float yv[8];
#pragma unroll
        for (int j = 0; j < 8; ++j) yv[j] = Ly[ss_ * 64 + j8 * 8 + j];
        if (d == 0) {
          *(uint4*)yfp = pack8(yv);
        } else {
          float yf[8], z[8], o[8];
          unpack8(*(const uint4*)yfp, yf);
          bf16_t* zp = p1 + ((size_t)b * TPB + t) * P1LD + head * 64 + j8 * 8;
          unpack8(*(const uint4*)zp, z);
#pragma unroll
          for (int j = 0; j < 8; ++j) o[j] = (yf[j] + yv[j] + dsk * Lx[ss_ * 64 + j8 * 8 + j]) * siluf_(z[j]);
          *(uint4*)zp = pack8(o);
        }
      }
    }
  }
}

DI void phase_groupnorm(const P& p) {
  const int lane = threadIdx.x & 63, gw = blockIdx.x * 8 + (threadIdx.x >> 6), nw = gridDim.x * 8;
  bf16_t* p1 = (bf16_t*)(p.ws + WS_PB + PB_P);
  const float* gn = p.in[I_GNORM];
  for (int lr = gw; lr < NB * SEQ; lr += nw) {
    const int b = lr >> 12, l = lr & 4095;
    bf16_t* rp = p1 + ((size_t)b * TPB + CTXL + l) * P1LD + lane * 32;
    float v[32];
#pragma unroll
    for (int i = 0; i < 4; ++i) { float f[8]; unpack8(*(const uint4*)(rp + i * 8), f);
#pragma unroll
      for (int j = 0; j < 8; ++j) v[i * 8 + j] = f[j]; }
    float ss = 0.f;
#pragma unroll
    for (int i = 0; i < 32; ++i) ss += v[i] * v[i];
    ss = red16(ss);
    const float rs = rsqrtf(ss * (1.f / 512.f) + 1e-6f);
#pragma unroll
    for (int i = 0; i < 4; ++i) {
      float o[8];
#pragma unroll
      for (int j = 0; j < 8; ++j) o[j] = v[i * 8 + j] * rs * gn[lane * 32 + i * 8 + j];
      *(uint4*)(rp + i * 8) = pack8(o);
    }
  }
}

constexpr int N_PHASES = 21;

__global__ void __launch_bounds__(NTHR) fwd_kernel(P p) {
  extern __shared__ __attribute__((aligned(16))) char lds[];
  const int lo = p.ph_lo, hi = p.ph_hi;
  unsigned char* ws = p.ws;
  XcdBarrier bar; bar.bar = (unsigned*)(ws + WS_CTL); bar.x = 0; bar.st = nullptr;
  volatile LAS unsigned* stw = (volatile LAS unsigned*)(lds + LDS_BYTES - 16);
  if (hi - lo > 1) {
    if (threadIdx.x == 0) { stw[0] = 0u; stw[1] = 0u; }
    __syncthreads();
    bar = xcd_barrier_post((unsigned*)(ws + WS_CTL), stw);
  }
#define IN(k) (lo <= (k) && (k) < hi)
#define SEAM(k) do { if (IN(k) && IN((k) + 1)) xcd_barrier(bar); } while (0)
  const int G = gridDim.x;
  bf16_t* HBp = (bf16_t*)(ws + WS_HB);
  bf16_t* PBp = (bf16_t*)(ws + WS_PB + PB_P);

  if (IN(0)) { phase_prep(p, lds); } SEAM(0);
  if (IN(1)) { phase_normmod(p, 0, 0, true, false, HBp); } SEAM(1);
  if (IN(2)) { gemm_store_phase(lds, HBp, D, (const bf16_t*)(ws + WS_WIN0T), D, R, 3456, D, PBp, P0LD, 3456); } SEAM(2);
  if (IN(3)) {
    for (int u = blockIdx.x; u < 2048 + 128; u += G) attn_naive_unit(p, lds, u);
    phase_ga(p);
  } SEAM(3);
  if (IN(4)) {
    for (int u = blockIdx.x; u < 256; u += G) rwkv_scan_unit(p, lds, u);
    __syncthreads();
    gemm_store_phase(lds, (const bf16_t*)(ws + WS_PB + PB_GA), 128, (const bf16_t*)(ws + WS_RWT + 262144), 128, R, 512, 128, (bf16_t*)(ws + WS_PB + PB_G), 512, 512);
  } SEAM(4);
  if (IN(5)) { phase_rwkv_post(p); } SEAM(5);
  if (IN(6)) { gemm_resid_phase(p, lds, 0, (const bf16_t*)(ws + WS_PB + PB_O0), D, (const bf16_t*)(ws + WS_WOUT0T), D); } SEAM(6);
  if (IN(7)) { phase_normmod(p, 0, 1, false, false, (bf16_t*)(ws + WS_PB + PB_H2)); convert_tables(p, 0); } SEAM(7);
  if (IN(8)) { gemm_store_phase(lds, (const bf16_t*)(ws + WS_PB + PB_H2), D, (const bf16_t*)(ws + WS_PQ0T), D, R, 2048, D, (bf16_t*)(ws + WS_PB + PB_Q), 2048, 2048); } SEAM(8);
  if (IN(9)) { for (int u = blockIdx.x; u < (R / 256) * 8; u += G) peer_topk_unit(p, lds, 0, u); } SEAM(9);
  if (IN(10)) { phase_peer_gather(p, 0); } SEAM(10);
  if (IN(11)) { phase_normmod(p, 1, 0, false, false, HBp); } SEAM(11);
  if (IN(12)) { gemm_store_phase(lds, HBp, D, (const bf16_t*)(ws + WS_WIN1T), D, R, P1NPAD, D, PBp, P1LD, P1LD); } SEAM(12);
  if (IN(13)) { for (int u = blockIdx.x; u < 256; u += G) ssd_naive_unit(p, lds, u); } SEAM(13);
  if (IN(14)) { phase_groupnorm(p); } SEAM(14);
  if (IN(15)) { gemm_resid_phase(p, lds, 1, PBp, P1LD, (const bf16_t*)(ws + WS_WOUT1T), 2048); } SEAM(15);
  if (IN(16)) { phase_normmod(p, 1, 1, false, true, (bf16_t*)(ws + WS_PB + PB_H2)); convert_tables(p, 1); } SEAM(16);
  if (IN(17)) { gemm_store_phase(lds, (const bf16_t*)(ws + WS_PB + PB_H2), D, (const bf16_t*)(ws + WS_PQ1T), D, R, 2048, D, (bf16_t*)(ws + WS_PB + PB_Q), 2048, 2048); } SEAM(17);
  if (IN(18)) { for (int u = blockIdx.x; u < (R / 256) * 8; u += G) peer_topk_unit(p, lds, 1, u); } SEAM(18);
  if (IN(19)) { phase_peer_gather(p, 1); } SEAM(19);
  if (IN(20)) { phase_final_norm(p); }
}

extern "C" void kernel_launch(void* const* d_in, const int* in_sizes, int n_in, void* d_out, int out_size, void* d_ws, size_t ws_size, hipStream_t stream) {
  static int inited = 0;
  if (!inited) {
    if (n_in != N_IN || ws_size < WS_XC + 128 * MiB) { fprintf(stderr, "kernel_launch: unexpected n_in %d / ws_size %zu\n", n_in, ws_size); inited = -1; return; }
    if (hipFuncSetAttribute((const void*)fwd_kernel, hipFuncAttributeMaxDynamicSharedMemorySize, LDS_BYTES) != hipSuccess) { fprintf(stderr, "kernel_launch: hipFuncSetAttribute failed\n"); inited = -1; return; }
    inited = 1;
  }
  if (inited < 0) return;
  P p{};
  for (int i = 0; i < N_IN; ++i) p.in[i] = (const float*)d_in[i];
  p.out = (float*)d_out; p.ws = (unsigned char*)d_ws;
  (void)hipMemsetAsync((char*)d_ws + WS_CTL, 0, 65536, stream);
#if N_LAUNCH_MODE == 1
  p.ph_lo = 0; p.ph_hi = N_PHASES;
  hipLaunchKernelGGL(fwd_kernel, dim3(256), dim3(NTHR), LDS_BYTES, stream, p);
#else
  for (int ph = 0; ph < N_PHASES; ++ph) {
    p.ph_lo = ph; p.ph_hi = ph + 1;
    hipLaunchKernelGGL(fwd_kernel, dim3(256), dim3(NTHR), LDS_BYTES, stream, p);
  }
#endif
}
```

```cpp
#include <hip/hip_runtime.h>
#include <stdint.h>
#include <stdio.h>

#ifndef N_LAUNCH_MODE
#define N_LAUNCH_MODE 1
#endif

#define DI __device__ __forceinline__
typedef unsigned short bf16_t;
typedef __attribute__((ext_vector_type(8))) short bf16x8;
typedef __attribute__((ext_vector_type(16))) float f32x16;
typedef __attribute__((ext_vector_type(2))) __bf16 bf2_t;

constexpr int D = 1024, NB = 8, SEQ = 4096, CTXL = 256, TPB = SEQ + CTXL, R = NB * TPB;
constexpr int NTHR = 512;
constexpr int LDS_BYTES = 147456;
constexpr int P0LD = 3456;
constexpr int P1LD = 5184;
constexpr int P1NPAD = 5248;

enum { I_X = 0, I_C, I_CTX, I_CCTX,
       I_ADAW0, I_ADAB0, I_N1_0, I_N2_0, I_WIN0, I_DALAM, I_DASUB, I_RWMU, I_RWW0, I_RWW2, I_RWA0, I_RWA2, I_RWG2, I_RWKK, I_RWKA, I_RWRK, I_LNXW, I_LNXB, I_WOUT0, I_PQ0, I_PK0, I_PU0, I_PV0,
       I_ADAW1, I_ADAB1, I_N1_1, I_N2_1, I_WIN1, I_CONVW, I_CONVB, I_DTB, I_ALOG, I_DSKIP, I_GNORM, I_WOUT1, I_PQ1, I_PK1, I_PU1, I_PV1, I_NF, N_IN };

constexpr size_t MiB = 1048576;
constexpr size_t WS_CTL = 0;
constexpr size_t WS_SCAL = 65536;
constexpr size_t WS_MODS = 131072;
constexpr size_t WS_ROPE = 1 * MiB;
constexpr size_t WS_RWT = 2 * MiB;
constexpr size_t WS_WIN0T = 3 * MiB;
constexpr size_t WS_WOUT0T = 10 * MiB;
constexpr size_t WS_PQ0T = 12 * MiB;
constexpr size_t WS_KEYS0 = 16 * MiB;
constexpr size_t WS_KEYS1 = 16 * MiB + 524288;
constexpr size_t WS_WIN1T = 17 * MiB;
constexpr size_t WS_WOUT1T = 28 * MiB;
constexpr size_t WS_PQ1T = 32 * MiB;
constexpr size_t WS_PB = 36 * MiB;
constexpr size_t WS_XC = 381 * MiB;
constexpr size_t WS_HB = 389 * MiB;
constexpr size_t WS_END = 457 * MiB;
constexpr size_t WS_YF = WS_XC;
constexpr size_t PB_P = 0;
constexpr size_t PB_O0 = 230 * MiB;
constexpr size_t PB_G = 298 * MiB;
constexpr size_t PB_GA = 332 * MiB;
constexpr size_t PB_BONUS = 341 * MiB;
constexpr size_t PB_H2 = 0;
constexpr size_t PB_Q = 68 * MiB;
constexpr size_t PB_IDX = 204 * MiB;
constexpr size_t PB_GATE = 221 * MiB;
constexpr size_t HB_YF = 0, HB_YB = 34 * MiB;
constexpr size_t HB_U = 0, HB_V = 32 * MiB;

struct P {
  const float* in[N_IN];
  float* out;
  unsigned char* ws;
  int ph_lo, ph_hi;
};

DI unsigned pack_bf2(float a, float b) { bf2_t v; v[0] = (__bf16)a; v[1] = (__bf16)b; return __builtin_bit_cast(unsigned, v); }
DI bf16_t f2bf(float a) { return __builtin_bit_cast(unsigned short, (__bf16)a); }
DI float bf2f(bf16_t v) { return __uint_as_float((unsigned)v << 16); }
DI float bflo(unsigned u) { return __uint_as_float(u << 16); }
DI float bfhi(unsigned u) { return __uint_as_float(u & 0xffff0000u); }
template <int CTRL> DI float dpp_f(float x) { return __int_as_float(__builtin_amdgcn_update_dpp(0, __float_as_int(x), CTRL, 0xF, 0xF, true)); }
DI float red4(float x) { x += dpp_f<0xB1>(x); x += dpp_f<0x4E>(x); return x; }
DI float red8(float x) { x += dpp_f<0x141>(x); return red4(x); }
DI float red16(float x) { x += dpp_f<0x140>(x); return red8(x); }
DI float red64(float x) { x = red16(x); x += __shfl_xor(x, 16); x += __shfl_xor(x, 32); return x; }
DI float sigmoidf_(float x) { return 1.f / (1.f + __expf(-x)); }
DI float siluf_(float x) { return x / (1.f + __expf(-x)); }
DI float softplusf_(float x) { return x > 20.f ? x : log1pf(__expf(x)); }
DI float geluf_(float x) { return 0.5f * x * (1.f + erff(x * 0.70710678118654752f)); }
DI void unpack8(const uint4& u, float (&f)[8]) { f[0] = bflo(u.x); f[1] = bfhi(u.x); f[2] = bflo(u.y); f[3] = bfhi(u.y); f[4] = bflo(u.z); f[5] = bfhi(u.z); f[6] = bflo(u.w); f[7] = bfhi(u.w); }
DI uint4 pack8(const float (&f)[8]) { uint4 u; u.x = pack_bf2(f[0], f[1]); u.y = pack_bf2(f[2], f[3]); u.z = pack_bf2(f[4], f[5]); u.w = pack_bf2(f[6], f[7]); return u; }
#define ACC_ROW(reg, lane) (((reg) & 3) + 8 * ((reg) >> 2) + 4 * ((lane) >> 5))
#define MFMA32(a, b, c) __builtin_amdgcn_mfma_f32_32x32x16_bf16((a), (b), (c), 0, 0, 0)

#define XB_TMO      128
#define XB_XCNT(j)  (256  + 64 * (j))
#define XB_XSUB(j)  (1280 + 64 * (j))
#define XB_XGEN(j)  (2304 + 64 * (j))
#define XB_TOP      3328
#define XB_TOPGEN   3392
#define XCD_BAR_WORDS 3456
#define XB_SPIN_CAP (1u << 22)
#define LAS __attribute__((address_space(3)))
DI unsigned xb_ld(unsigned* p) { return __hip_atomic_load(p, __ATOMIC_RELAXED, __HIP_MEMORY_SCOPE_AGENT); }
DI unsigned xb_add(unsigned* p, unsigned v) { return __hip_atomic_fetch_add(p, v, __ATOMIC_RELAXED, __HIP_MEMORY_SCOPE_AGENT); }
DI unsigned xb_xcc_id() { return (unsigned)__builtin_amdgcn_s_getreg((3 << 11) | 20) & 0xFu; }
#define XB_SPIN(cond, bar) do { unsigned _sp = 0; while (cond) { __builtin_amdgcn_s_sleep(1); \
    if ((++_sp & 255u) == 0u) { if (xb_ld(&(bar)[XB_TMO])) break; if (_sp > XB_SPIN_CAP) { atomicAdd(&(bar)[XB_TMO], 1u); break; } } } } while (0)
struct XcdBarrier { unsigned* bar; unsigned x; volatile LAS unsigned* st; };
DI XcdBarrier xcd_barrier_post(unsigned* bar, volatile LAS unsigned* st) {
  XcdBarrier b; b.bar = bar; b.x = xb_xcc_id(); b.st = st;
  if (threadIdx.x == 0) (void)xb_add(&bar[XB_XCNT(b.x)], 1u);
  return b;
}
DI void xcd_barrier_complete(unsigned* bar, unsigned x, unsigned& nloc, unsigned& nx) {
  const unsigned G = gridDim.x * gridDim.y * gridDim.z;
  unsigned sum, cnt, mine, sp = 0u;
  for (;;) {
    sum = 0u; cnt = 0u; mine = 0u;
#pragma unroll
    for (unsigned j = 0; j < 16; ++j) { const unsigned c = xb_ld(&bar[XB_XCNT(j)]); sum += c; cnt += (c > 0u) ? 1u : 0u; mine = (j == x) ? c : mine; }
    if (sum == G) break;
    __builtin_amdgcn_s_sleep(1);
    if ((++sp & 255u) == 0u) { if (xb_ld(&bar[XB_TMO])) break; if (sp > XB_SPIN_CAP) { atomicAdd(&bar[XB_TMO], 1u); break; } }
  }
  nloc = mine > 0u ? mine : 1u; nx = cnt > 0u ? cnt : 1u;
}
DI void xcd_barrier(const XcdBarrier& b) {
  asm volatile("s_waitcnt vmcnt(0)" ::: "memory");
  __syncthreads();
  if (threadIdx.x == 0) {
    unsigned* bar = b.bar;
    __builtin_amdgcn_s_waitcnt(0);
    unsigned nloc = b.st[0], nx = b.st[1];
    if (nloc == 0u) { xcd_barrier_complete(bar, b.x, nloc, nx); b.st[0] = nloc; b.st[1] = nx; }
    const unsigned old = xb_add(&bar[XB_XSUB(b.x)], 1u);
    const unsigned gen = old / nloc;
    if (old + 1u == (gen + 1u) * nloc) {
      __builtin_amdgcn_fence(__ATOMIC_RELEASE, "agent");
      asm volatile("s_waitcnt vmcnt(0)" ::: "memory");
      const unsigned og = xb_add(&bar[XB_TOP], 1u);
      const unsigned tg = og / nx;
      if (og + 1u == (tg + 1u) * nx) xb_add(&bar[XB_TOPGEN], 1u);
      else XB_SPIN(xb_ld(&bar[XB_TOPGEN]) == tg, bar);
      __builtin_amdgcn_fence(__ATOMIC_ACQUIRE, "agent");
      xb_add(&bar[XB_XGEN(b.x)], 1u);
      asm volatile("s_waitcnt vmcnt(0)" ::: "memory");
    } else {
      XB_SPIN(xb_ld(&bar[XB_XGEN(b.x)]) == gen, bar);
      __builtin_amdgcn_fence(__ATOMIC_ACQUIRE, "agent");
      asm volatile("s_waitcnt vmcnt(0)" ::: "memory");
    }
  }
  __syncthreads();
}

DI void gemm_tile(char* lds, const bf16_t* __restrict__ A, int lda, const bf16_t* __restrict__ Bt, int ldb, int K, f32x16 (&acc)[2][2]) {
  const int tid = threadIdx.x, lane = tid & 63, wave = tid >> 6, wm = wave >> 1, wn = wave & 1;
#pragma unroll
  for (int i = 0; i < 2; ++i)
#pragma unroll
    for (int j = 0; j < 2; ++j)
#pragma unroll
      for (int r = 0; r < 16; ++r) acc[i][j][r] = 0.f;
  const int arow0 = tid >> 3, ac = tid & 7;
  const bf16_t* ap = A + (size_t)arow0 * lda + ac * 8;
  const bf16_t* bp = Bt + (size_t)arow0 * ldb + ac * 8;
  const int sw = ((ac ^ (arow0 >> 1)) & 7) << 4;
  const int st_off = arow0 * 128 + sw;
  uint4 ra[4], rb[2];
#pragma unroll
  for (int i = 0; i < 4; ++i) ra[i] = *(const uint4*)(ap + (size_t)i * 64 * lda);
#pragma unroll
  for (int i = 0; i < 2; ++i) rb[i] = *(const uint4*)(bp + (size_t)i * 64 * ldb);
#pragma unroll
  for (int i = 0; i < 4; ++i) *(uint4*)(lds + st_off + i * 8192) = ra[i];
#pragma unroll
  for (int i = 0; i < 2; ++i) *(uint4*)(lds + 65536 + st_off + i * 8192) = rb[i];
  __syncthreads();
  const int nk = K >> 6;
  const int r31 = lane & 31, hh = lane >> 5;
  for (int kt = 0; kt < nk; ++kt) {
    const int cur = kt & 1;
    if (kt + 1 < nk) {
#pragma unroll
      for (int i = 0; i < 4; ++i) ra[i] = *(const uint4*)(ap + (size_t)i * 64 * lda + (kt + 1) * 64);
#pragma unroll
      for (int i = 0; i < 2; ++i) rb[i] = *(const uint4*)(bp + (size_t)i * 64 * ldb + (kt + 1) * 64);
    }
    const char* la = lds + cur * 32768;
    const char* lb = lds + 65536 + cur * 16384;
#pragma unroll
    for (int kk = 0; kk < 4; ++kk) {
      const int c = kk * 2 + hh;
      bf16x8 a[2], b[2];
#pragma unroll
      for (int mi = 0; mi < 2; ++mi) { const int row = wm * 64 + mi * 32 + r31; a[mi] = *(const bf16x8*)(la + row * 128 + (((c ^ (row >> 1)) & 7) << 4)); }
#pragma unroll
      for (int ni = 0; ni < 2; ++ni) { const int row = wn * 64 + ni * 32 + r31; b[ni] = *(const bf16x8*)(lb + row * 128 + (((c ^ (row >> 1)) & 7) << 4)); }
#pragma unroll
      for (int mi = 0; mi < 2; ++mi)
#pragma unroll
        for (int ni = 0; ni < 2; ++ni) acc[mi][ni] = MFMA32(a[mi], b[ni], acc[mi][ni]);
    }
    if (kt + 1 < nk) {
      char* wa = lds + (cur ^ 1) * 32768;
      char* wb = lds + 65536 + (cur ^ 1) * 16384;
#pragma unroll
      for (int i = 0; i < 4; ++i) *(uint4*)(wa + st_off + i * 8192) = ra[i];
#pragma unroll
      for (int i = 0; i < 2; ++i) *(uint4*)(wb + st_off + i * 8192) = rb[i];
    }
    __syncthreads();
  }
}

DI void gemm_store_phase(char* lds, const bf16_t* A, int lda, const bf16_t* Bt, int ldb, int M, int Npad, int K, bf16_t* C, int ldc, int nvalid) {
  const int ntn = Npad / 128, ntm = M / 256;
  const int lane = threadIdx.x & 63, wave = threadIdx.x >> 6, wm = wave >> 1, wn = wave & 1;
  for (int tile = blockIdx.x; tile < ntm * ntn; tile += gridDim.x) {
    const int mt = tile / ntn, nt = tile - mt * ntn;
    f32x16 acc[2][2];
    gemm_tile(lds, A + (size_t)mt * 256 * lda, lda, Bt + (size_t)nt * 128 * ldb, ldb, K, acc);
#pragma unroll
    for (int mi = 0; mi < 2; ++mi)
#pragma unroll
      for (int ni = 0; ni < 2; ++ni) {
        const int col = nt * 128 + wn * 64 + ni * 32 + (lane & 31);
        if (col < nvalid) {
#pragma unroll
          for (int r = 0; r < 16; ++r) {
            const int row = mt * 256 + wm * 64 + mi * 32 + ACC_ROW(r, lane);
            C[(size_t)row * ldc + col] = f2bf(acc[mi][ni][r]);
          }
        }
      }
  }
}

DI void gemm_p0_phase(const P& p, char* lds, const bf16_t* A, const bf16_t* Bt, bf16_t* C) {
  const int ntn = P0LD / 128, ntm = R / 256;
  const int lane = threadIdx.x & 63, wave = threadIdx.x >> 6, wm = wave >> 1, wn = wave & 1;
  const float2* rope = (const float2*)(p.ws + WS_ROPE);
  for (int tile = blockIdx.x; tile < ntm * ntn; tile += gridDim.x) {
    const int mt = tile / ntn, nt = tile - mt * ntn;
    f32x16 acc[2][2];
    gemm_tile(lds, A + (size_t)mt * 256 * D, D, Bt + (size_t)nt * 128 * D, D, D, acc);
    const bool isctx = (mt % 17) == 0;
    const int b = mt / 17;
#pragma unroll
    for (int mi = 0; mi < 2; ++mi)
#pragma unroll
      for (int ni = 0; ni < 2; ++ni) {
        const int col = nt * 128 + wn * 64 + ni * 32 + (lane & 31);
        if (nt < 8) {
          const int a = (col >> 5) & 1, half = (col >> 4) & 1, f = col & 15;
          const float qs = (nt < 4) ? 0.125f * 1.4426950408889634f : 1.f;
#pragma unroll
          for (int r = 0; r < 16; ++r) {
            const int row = mt * 256 + wm * 64 + mi * 32 + ACC_ROW(r, lane);
            float v = acc[mi][ni][r];
            const float pv = __shfl_xor(v, 16);
            if (!isctx) {
              const int l = row - b * TPB - CTXL;
              const float2 cs = rope[l * 32 + a * 16 + f];
              v = half ? (v * cs.x + pv * cs.y) : (v * cs.x - pv * cs.y);
            }
            C[(size_t)row * P0LD + col] = f2bf(v * qs);
          }
        } else {
#pragma unroll
          for (int r = 0; r < 16; ++r) {
            const int row = mt * 256 + wm * 64 + mi * 32 + ACC_ROW(r, lane);
            C[(size_t)row * P0LD + col] = f2bf(acc[mi][ni][r]);
          }
        }
      }
  }
}

DI void gemm_resid_phase(const P& p, char* lds, int layer, const bf16_t* A, int lda, const bf16_t* Bt, int K) {
  const int ntn = 8, ntm = R / 256;
  const int lane = threadIdx.x & 63, wave = threadIdx.x >> 6, wm = wave >> 1, wn = wave & 1;
  const float* mods = (const float*)(p.ws + WS_MODS) + (size_t)layer * 9 * 6144;
  float* xc = (float*)(p.ws + WS_XC);
  for (int tile = blockIdx.x; tile < ntm * ntn; tile += gridDim.x) {
    const int mt = tile / ntn, nt = tile - mt * ntn;
    if (layer == 1 && (mt % 17) == 0) continue;
    f32x16 acc[2][2];
    gemm_tile(lds, A + (size_t)mt * 256 * lda, lda, Bt + (size_t)nt * 128 * K, K, K, acc);
    const int b = mt / 17;
    const bool isctx = (mt % 17) == 0;
    const float* gate = mods + (isctx ? 8 : b) * 6144 + 2 * 1024;
#pragma unroll
    for (int mi = 0; mi < 2; ++mi)
#pragma unroll
      for (int ni = 0; ni < 2; ++ni) {
        const int col = nt * 128 + wn * 64 + ni * 32 + (lane & 31);
        const float gt = gate[col];
#pragma unroll
        for (int r = 0; r < 16; ++r) {
          const int row = mt * 256 + wm * 64 + mi * 32 + ACC_ROW(r, lane);
          const int t = row - b * TPB;
          if (isctx) {
            const size_t o = ((size_t)(b * CTXL + t)) * D + col;
            xc[o] = p.in[I_CTX][o] + gt * acc[mi][ni][r];
          } else {
            const size_t o = ((size_t)(b * SEQ + t - CTXL)) * D + col;
            const float xin = (layer == 0) ? p.in[I_X][o] : p.out[o];
            p.out[o] = xin + gt * acc[mi][ni][r];
          }
        }
      }
  }
}

DI void transpose_tile(char* lds, const float* __restrict__ src, int K, int N, bf16_t* __restrict__ dst, int tile) {
  float* T = (float*)lds;
  const int ntk = K / 64;
  const int tn = tile / ntk, tk = tile - tn * ntk;
  const int tid = threadIdx.x;
  __syncthreads();
  for (int e = tid; e < 4096; e += NTHR) {
    const int kk = e >> 6, nn = e & 63;
    const int n = tn * 64 + nn;
    T[kk * 65 + nn] = (n < N) ? src[(size_t)(tk * 64 + kk) * N + n] : 0.f;
  }
  __syncthreads();
  for (int e = tid; e < 4096; e += NTHR) {
    const int nn = e >> 6, kk = e & 63;
    dst[(size_t)(tn * 64 + nn) * K + tk * 64 + kk] = f2bf(T[kk * 65 + nn]);
  }
}

DI void phase_prep(const P& p, char* lds) {
  const int tid = threadIdx.x;
  unsigned char* ws = p.ws;
  struct TD { int idx; int K, N, Npad; size_t dst; size_t srcoff; };
  int base = 0;
  const int G = gridDim.x;
#define TRANSPOSE_TASK(SRC, KK, NN, NPAD, DST) { const int nt_ = ((NPAD) / 64) * ((KK) / 64); \
    for (int w = blockIdx.x; w < nt_; w += G) transpose_tile(lds, (SRC), (KK), (NN), (bf16_t*)(DST), w); }
  TRANSPOSE_TASK(p.in[I_WIN0], 1024, 3456, 3456, ws + WS_WIN0T)
  TRANSPOSE_TASK(p.in[I_WOUT0], 1024, 1024, 1024, ws + WS_WOUT0T)
  TRANSPOSE_TASK(p.in[I_PQ0], 1024, 2048, 2048, ws + WS_PQ0T)
  TRANSPOSE_TASK(p.in[I_WIN1], 1024, 5184, P1NPAD, ws + WS_WIN1T)
  TRANSPOSE_TASK(p.in[I_WOUT1], 2048, 1024, 1024, ws + WS_WOUT1T)
  TRANSPOSE_TASK(p.in[I_PQ1], 1024, 2048, 2048, ws + WS_PQ1T)
  TRANSPOSE_TASK(p.in[I_RWW2], 64, 512, 512, ws + WS_RWT)
  TRANSPOSE_TASK(p.in[I_RWW2] + 64 * 512, 64, 512, 512, ws + WS_RWT + 65536)
  TRANSPOSE_TASK(p.in[I_RWA2], 64, 512, 512, ws + WS_RWT + 131072)
  TRANSPOSE_TASK(p.in[I_RWA2] + 64 * 512, 64, 512, 512, ws + WS_RWT + 196608)
  TRANSPOSE_TASK(p.in[I_RWG2], 128, 512, 512, ws + WS_RWT + 262144)
  (void)base;
  {
    const int gt = blockIdx.x * NTHR + tid, gs = G * NTHR;
    bf16_t* k0 = (bf16_t*)(ws + WS_KEYS0); bf16_t* k1 = (bf16_t*)(ws + WS_KEYS1);
    for (int i = gt; i < 262144; i += gs) { k0[i] = f2bf(p.in[I_PK0][i]); k1[i] = f2bf(p.in[I_PK1][i]); }
    float2* rope = (float2*)(ws + WS_ROPE);
    for (int i = gt; i < 4096 * 32; i += gs) {
      const int l = i >> 5, a = (i >> 4) & 1, f = i & 15;
      const float inv = powf(10000.f, -(float)f / 16.f);
      const float pos = (float)(a == 0 ? (l >> 6) : (l & 63));
      float s, c; sincosf(pos * inv, &s, &c);
      rope[i] = make_float2(c, s);
    }
    if (gt == 0) {
      const float* lp = p.in[I_DALAM];
      float s01 = 0.f, s23 = 0.f;
      for (int i = 0; i < 64; ++i) { s01 += lp[i] * lp[64 + i]; s23 += lp[128 + i] * lp[192 + i]; }
      ((float*)(ws + WS_SCAL))[0] = expf(s01) - expf(s23) + 0.2f;
    }
  }
  {
    float* sc = (float*)lds;
    float* red = (float*)(lds + 36864);
    __syncthreads();
    for (int e = tid; e < 9 * 1024; e += NTHR) { const int r = e >> 10, k = e & 1023; const float v = (r < 8) ? p.in[I_C][r * 1024 + k] : p.in[I_CCTX][k]; sc[e] = siluf_(v); }
    __syncthreads();
    float* mods = (float*)(ws + WS_MODS);
    for (int w = blockIdx.x; w < 192; w += G) {
      const int l = w / 96, j0 = (w % 96) * 64;
      const float* aw = p.in[l == 0 ? I_ADAW0 : I_ADAW1];
      const float* ab = p.in[l == 0 ? I_ADAB0 : I_ADAB1];
      const int col = tid & 63, kg = tid >> 6;
      float a[9];
#pragma unroll
      for (int r = 0; r < 9; ++r) a[r] = 0.f;
      for (int k = kg * 128; k < kg * 128 + 128; ++k) {
        const float wv = aw[(size_t)k * 6144 + j0 + col];
#pragma unroll
        for (int r = 0; r < 9; ++r) a[r] += sc[r * 1024 + k] * wv;
      }
      __syncthreads();
#pragma unroll
      for (int r = 0; r < 9; ++r) red[(kg * 64 + col) * 9 + r] = a[r];
      __syncthreads();
      for (int e = tid; e < 64 * 9; e += NTHR) {
        const int c2 = e / 9, r = e - c2 * 9;
        float s = ab[j0 + c2];
        for (int g = 0; g < 8; ++g) s += red[(g * 64 + c2) * 9 + r];
        mods[((size_t)l * 9 + r) * 6144 + j0 + c2] = s;
      }
    }
  }
}

DI void convert_tables(const P& p, int layer) {
  const float4* u = (const float4*)p.in[layer == 0 ? I_PU0 : I_PU1];
  const float4* v = (const float4*)p.in[layer == 0 ? I_PV0 : I_PV1];
  uint2* du = (uint2*)(p.ws + WS_HB + HB_U);
  uint2* dv = (uint2*)(p.ws + WS_HB + HB_V);
  const size_t n4 = (size_t)16384 * 1024 / 4;
  for (size_t i = (size_t)blockIdx.x * NTHR + threadIdx.x; i < n4; i += (size_t)gridDim.x * NTHR) {
    const float4 a = u[i]; du[i] = make_uint2(pack_bf2(a.x, a.y), pack_bf2(a.z, a.w));
    const float4 b = v[i]; dv[i] = make_uint2(pack_bf2(b.x, b.y), pack_bf2(b.z, b.w));
  }
}

DI void phase_normmod(const P& p, int layer, int which, bool from_inputs, bool lat_only, bf16_t* dst) {
  const int lane = threadIdx.x & 63, gw = blockIdx.x * 8 + (threadIdx.x >> 6), nw = gridDim.x * 8;
  const float* g = p.in[layer == 0 ? (which == 0 ? I_N1_0 : I_N2_0) : (which == 0 ? I_N1_1 : I_N2_1)];
  const float* mods = (const float*)(p.ws + WS_MODS) + (size_t)layer * 9 * 6144;
  const float* xc = (const float*)(p.ws + WS_XC);
  for (int row = gw; row < R; row += nw) {
    const int b = row / TPB, t = row - b * TPB;
    const bool isctx = t < CTXL;
    if (isctx && lat_only) continue;
    const float* src = isctx ? ((from_inputs ? p.in[I_CTX] : xc) + ((size_t)(b * CTXL + t)) * D)
                             : ((from_inputs ? p.in[I_X] : p.out) + ((size_t)(b * SEQ + t - CTXL)) * D);
    const float* mrow = mods + (isctx ? 8 : b) * 6144 + (which == 0 ? 0 : 3 * 1024);
    float v[16];
#pragma unroll
    for (int i = 0; i < 4; ++i) { const float4 f = *(const float4*)(src + lane * 16 + i * 4); v[i * 4] = f.x; v[i * 4 + 1] = f.y; v[i * 4 + 2] = f.z; v[i * 4 + 3] = f.w; }
    float ss = 0.f;
#pragma unroll
    for (int i = 0; i < 16; ++i) ss += v[i] * v[i];
    ss = red64(ss);
    const float rs = rsqrtf(ss * (1.f / 1024.f) + 1e-6f);
    float o[16];
#pragma unroll
    for (int i = 0; i < 16; ++i) { const int c = lane * 16 + i; o[i] = v[i] * rs * g[c] * (1.f + mrow[1024 + c]) + mrow[c]; }
    uint4 w0, w1;
    w0.x = pack_bf2(o[0], o[1]); w0.y = pack_bf2(o[2], o[3]); w0.z = pack_bf2(o[4], o[5]); w0.w = pack_bf2(o[6], o[7]);
    w1.x = pack_bf2(o[8], o[9]); w1.y = pack_bf2(o[10], o[11]); w1.z = pack_bf2(o[12], o[13]); w1.w = pack_bf2(o[14], o[15]);
    *(uint4*)(dst + (size_t)row * D + lane * 16) = w0;
    *(uint4*)(dst + (size_t)row * D + lane * 16 + 8) = w1;
  }
}

DI void phase_final_norm(const P& p) {
  const int lane = threadIdx.x & 63, gw = blockIdx.x * 8 + (threadIdx.x >> 6), nw = gridDim.x * 8;
  const float* g = p.in[I_NF];
  for (int row = gw; row < NB * SEQ; row += nw) {
    float* src = p.out + (size_t)row * D;
    float v[16];
#pragma unroll
    for (int i = 0; i < 4; ++i) { const float4 f = *(const float4*)(src + lane * 16 + i * 4); v[i * 4] = f.x; v[i * 4 + 1] = f.y; v[i * 4 + 2] = f.z; v[i * 4 + 3] = f.w; }
    float ss = 0.f;
#pragma unroll
    for (int i = 0; i < 16; ++i) ss += v[i] * v[i];
    ss = red64(ss);
    const float rs = rsqrtf(ss * (1.f / 1024.f) + 1e-6f);
#pragma unroll
    for (int i = 0; i < 4; ++i) {
      const int c = lane * 16 + i * 4;
      float4 f; f.x = v[i * 4] * rs * g[c]; f.y = v[i * 4 + 1] * rs * g[c + 1]; f.z = v[i * 4 + 2] * rs * g[c + 2]; f.w = v[i * 4 + 3] * rs * g[c + 3];
      *(float4*)(src + c) = f;
    }
  }
}

typedef __attribute__((ext_vector_type(4))) short s16x4;
DI s16x4 tr_read(const char* p) { return __builtin_amdgcn_ds_read_tr16_b64_v4i16((__attribute__((address_space(3))) s16x4*)(p)); }

DI void attn_flash_unit(const P& p, char* lds, int unit) {
  const int tid = threadIdx.x, lane = tid & 63, wave = tid >> 6;
  const bool isctx = unit >= 1024;
  int b, h, qb;
  if (!isctx) { b = unit >> 7; h = (unit >> 5) & 3; qb = unit & 31; } else { const int u = unit - 1024; b = u >> 3; h = (u >> 1) & 3; qb = u & 1; }
  const int nkt = isctx ? CTXL / 64 : TPB / 64;
  const bf16_t* p0 = (const bf16_t*)(p.ws + WS_PB + PB_P);
  const float lam = ((const float*)(p.ws + WS_SCAL))[0];
  const int qg = wave >> 1, m = wave & 1;
  const int r31 = lane & 31, hh = lane >> 5;
  const int ql = qb * 128 + qg * 32 + r31;
  const size_t qrow = (size_t)b * TPB + (isctx ? ql : CTXL + ql);
  bf16x8 qf[4];
#pragma unroll
  for (int kk = 0; kk < 4; ++kk) qf[kk] = *(const bf16x8*)(p0 + qrow * P0LD + h * 128 + m * 64 + kk * 16 + 8 * hh);
  const int skey = tid >> 4, scc = tid & 15;
  const bf16_t* kg = p0 + ((size_t)b * TPB + skey) * P0LD + 512 + h * 128 + scc * 8;
  const bf16_t* vg = kg + 512;
  const int koff = (scc >> 3) * 8192 + skey * 128 + ((((scc & 7) ^ (skey >> 1)) & 7) << 4);
  const int voff = 16384 + skey * 320 + scc * 16;
  constexpr int BUFSZ = 36864;
  uint4 rk[2], rv[2];
  __syncthreads();
#pragma unroll
  for (int i = 0; i < 2; ++i) { rk[i] = *(const uint4*)(kg + (size_t)i * 32 * P0LD); rv[i] = *(const uint4*)(vg + (size_t)i * 32 * P0LD); }
#pragma unroll
  for (int i = 0; i < 2; ++i) { *(uint4*)(lds + koff + i * 4096) = rk[i]; *(uint4*)(lds + voff + i * 10240) = rv[i]; }
  __syncthreads();
  f32x16 o[4];
#pragma unroll
  for (int v = 0; v < 4; ++v)
#pragma unroll
    for (int r = 0; r < 16; ++r) o[v][r] = 0.f;
  float mrun = -1e30f, lsum = 0.f;
  const int q4 = (lane & 15) >> 2;
  const int vboff = ((lane >> 4) & 1) * 32 + 8 * (lane & 3);
  for (int kt = 0; kt < nkt; ++kt) {
    const int cur = kt & 1;
    if (kt + 1 < nkt) {
#pragma unroll
      for (int i = 0; i < 2; ++i) { rk[i] = *(const uint4*)(kg + (size_t)((kt + 1) * 64 + i * 32) * P0LD); rv[i] = *(const uint4*)(vg + (size_t)((kt + 1) * 64 + i * 32) * P0LD); }
    }
    const char* kb = lds + cur * BUFSZ + m * 8192;
    const char* vb = lds + cur * BUFSZ + 16384;
    f32x16 s[2];
#pragma unroll
    for (int t = 0; t < 2; ++t)
#pragma unroll
      for (int r = 0; r < 16; ++r) s[t][r] = 0.f;
#pragma unroll
    for (int kk = 0; kk < 4; ++kk)
#pragma unroll
      for (int t = 0; t < 2; ++t) {
        const int row = t * 32 + r31;
        const bf16x8 a = *(const bf16x8*)(kb + row * 128 + ((((kk * 2 + hh) ^ (row >> 1)) & 7) << 4));
        s[t] = MFMA32(a, qf[kk], s[t]);
      }
    float mx = s[0][0];
#pragma unroll
    for (int t = 0; t < 2; ++t)
#pragma unroll
      for (int r = 0; r < 16; ++r) mx = fmaxf(mx, s[t][r]);
    mx = fmaxf(mx, __shfl_xor(mx, 32));
    const float mnew = fmaxf(mrun, mx);
    const float corr = __builtin_amdgcn_exp2f(mrun - mnew);
    mrun = mnew;
    lsum *= corr;
#pragma unroll
    for (int v = 0; v < 4; ++v)
#pragma unroll
      for (int r = 0; r < 16; ++r) o[v][r] *= corr;
#pragma unroll
    for (int t = 0; t < 2; ++t)
#pragma unroll
      for (int r = 0; r < 16; ++r) { const float e = __builtin_amdgcn_exp2f(s[t][r] - mnew); s[t][r] = e; lsum += e; }
#pragma unroll
    for (int t = 0; t < 2; ++t)
#pragma unroll
      for (int st = 0; st < 2; ++st) {
        unsigned pk[4];
#pragma unroll
        for (int j = 0; j < 4; ++j) pk[j] = pack_bf2(s[t][8 * st + 2 * j], s[t][8 * st + 2 * j + 1]);
        bf16x8 bp;
        { typedef __attribute__((ext_vector_type(4))) unsigned u32x4; u32x4 u = {pk[0], pk[1], pk[2], pk[3]}; bp = __builtin_bit_cast(bf16x8, u); }
        const int key0 = t * 32 + 16 * st + 4 * hh + q4;
#pragma unroll
        for (int v = 0; v < 4; ++v) {
          const s16x4 lo = tr_read(vb + key0 * 320 + v * 64 + vboff);
          const s16x4 hi = tr_read(vb + (key0 + 8) * 320 + v * 64 + vboff);
          const bf16x8 av = __builtin_shufflevector(lo, hi, 0, 1, 2, 3, 4, 5, 6, 7);
          o[v] = MFMA32(av, bp, o[v]);
        }
      }
    if (kt + 1 < nkt) {
      char* nb = lds + (cur ^ 1) * BUFSZ;
#pragma unroll
      for (int i = 0; i < 2; ++i) { *(uint4*)(nb + koff + i * 4096) = rk[i]; *(uint4*)(nb + voff + i * 10240) = rv[i]; }
    }
    __syncthreads();
  }
  lsum += __shfl_xor(lsum, 32);
  const float inv = 1.f / lsum;
  float* Ex = (float*)lds;
  if (m == 1) {
#pragma unroll
    for (int v = 0; v < 4; ++v)
#pragma unroll
      for (int r = 0; r < 16; ++r) Ex[(qg * 128 + v * 32 + ACC_ROW(r, lane)) * 32 + r31] = o[v][r] * inv;
  }
  __syncthreads();
  if (m == 0) {
    float ss = 0.f;
#pragma unroll
    for (int v = 0; v < 4; ++v)
#pragma unroll
      for (int r = 0; r < 16; ++r) { const float dv = o[v][r] * inv - lam * Ex[(qg * 128 + v * 32 + ACC_ROW(r, lane)) * 32 + r31]; o[v][r] = dv; ss += dv * dv; }
    ss += __shfl_xor(ss, 32);
    const float rs = rsqrtf(ss * (1.f / 128.f) + 1e-6f) * 0.8f;
    const float* sub = p.in[I_DASUB];
    bf16_t* op = (bf16_t*)(p.ws + WS_PB + PB_O0) + qrow * 1024 + h * 128;
#pragma unroll
    for (int v = 0; v < 4; ++v)
#pragma unroll
      for (int g4 = 0; g4 < 4; ++g4) {
        const int vd = v * 32 + 8 * g4 + 4 * hh;
        uint2 w;
        w.x = pack_bf2(o[v][g4 * 4] * rs * sub[vd], o[v][g4 * 4 + 1] * rs * sub[vd + 1]);
        w.y = pack_bf2(o[v][g4 * 4 + 2] * rs * sub[vd + 2], o[v][g4 * 4 + 3] * rs * sub[vd + 3]);
        *(uint2*)(op + vd) = w;
      }
  }
  __syncthreads();
}

DI void phase_ga(const P& p) {
  const bf16_t* p0 = (const bf16_t*)(p.ws + WS_PB + PB_P);
  bf16_t* ga = (bf16_t*)(p.ws + WS_PB + PB_GA);
  const float* mu = p.in[I_RWMU] + 1792;
  for (int i = blockIdx.x * NTHR + threadIdx.x; i < R * 16; i += gridDim.x * NTHR) {
    const int row = i >> 4, c8 = (i & 15) * 8;
    const int t = row % TPB;
    const bool first = (t == 0) || (t == CTXL), last = (t == CTXL - 1) || (t == TPB - 1);
    const bf16_t* sp = p0 + (size_t)row * P0LD + 1536 + 1792 + c8;
    float u[8], um[8], up[8];
    unpack8(*(const uint4*)sp, u);
    if (!first) unpack8(*(const uint4*)(sp - P0LD), um); else { for (int j = 0; j < 8; ++j) um[j] = 0.f; }
    if (!last) unpack8(*(const uint4*)(sp + P0LD), up); else { for (int j = 0; j < 8; ++j) up[j] = 0.f; }
    float o[8];
#pragma unroll
    for (int j = 0; j < 8; ++j) { const float mix = u[j] + mu[c8 + j] * (0.5f * (um[j] + up[j]) - u[j]); o[j] = sigmoidf_(mix); }
    *(uint4*)(ga + (size_t)row * 128 + c8) = pack8(o);
  }
}

DI int scan_token(int d, int s) { return d == 0 ? s : (s < CTXL ? (CTXL - 1 - s) : (TPB + CTXL - 1 - s)); }

DI void rwkv_scan_unit(const P& p, char* lds, int unit) {
  const int tid = threadIdx.x, lane = tid & 63, wave = tid >> 6;
  const int half = unit & 1, d = (unit >> 1) & 1, h = (unit >> 2) & 7, b = unit >> 5;
  float* Lr = (float*)lds;
  float* Lk = (float*)(lds + 16384);
  float* Lv = (float*)(lds + 32768);
  float* La = (float*)(lds + 49152);
  float* Lb = (float*)(lds + 65536);
  float* Lw = (float*)(lds + 81920);
  float* Las = (float*)(lds + 98304);
  bf16_t* Aw = (bf16_t*)(lds + 114688);
  bf16_t* Aa = (bf16_t*)(lds + 122880);
  float* Linv = (float*)(lds + 131072);
  float* Ly = (float*)(lds + 131072 + 1024);
  const bf16_t* p0 = (const bf16_t*)(p.ws + WS_PB + PB_P);
  const float* mu = p.in[I_RWMU];
  const int gid = wave >> 2, tmi = (wave >> 1) & 1, tni = wave & 1;
  bf16x8 bfrag[4];
  {
    const bf16_t* wt = (const bf16_t*)(p.ws + WS_RWT + (gid == 0 ? 0 : 131072) + (size_t)d * 65536);
    const int n = h * 64 + tni * 32 + (lane & 31);
#pragma unroll
    for (int kk = 0; kk < 4; ++kk) bfrag[kk] = *(const bf16x8*)(wt + n * 64 + kk * 16 + 8 * (lane >> 5));
  }
  const float bias0 = (gid == 0 ? p.in[I_RWW0] : p.in[I_RWA0])[d * 512 + h * 64 + tni * 32 + (lane & 31)];
  const int ss_ = tid >> 3, cg8 = (tid & 7) * 8;
  float kkc[8], kac[8], rkc[8];
#pragma unroll
  for (int j = 0; j < 8; ++j) { kkc[j] = p.in[I_RWKK][h * 64 + cg8 + j]; kac[j] = p.in[I_RWKA][h * 64 + cg8 + j]; rkc[j] = p.in[I_RWRK][h * 64 + cg8 + j]; }
  const int rl = tid >> 4, c4 = (tid & 15) * 4;
  const int row = half * 32 + rl;
  float S0 = 0.f, S1 = 0.f, S2 = 0.f, S3 = 0.f;
  bf16_t* yout = (bf16_t*)(p.ws + WS_HB + (d == 0 ? HB_YF : HB_YB));
  float* bonus = (float*)(p.ws + WS_PB + PB_BONUS) + (size_t)d * R * 8;
  for (int ch = 0; ch < TPB / 64; ++ch) {
    {
      const int s = ch * 64 + ss_;
      const int t = scan_token(d, s);
      const bool first = (t == 0) || (t == CTXL), last = (t == CTXL - 1) || (t == TPB - 1);
      const bf16_t* rowp = p0 + ((size_t)b * TPB + t) * P0LD + 1536;
      const int cols[5] = {h * 64 + cg8, 512 + h * 64 + cg8, 1024 + h * 64 + cg8, 1536 + d * 64 + cg8, 1664 + d * 64 + cg8};
      float mixed[5][8];
#pragma unroll
      for (int g = 0; g < 5; ++g) {
        float u[8], um[8], up[8];
        unpack8(*(const uint4*)(rowp + cols[g]), u);
        if (!first) unpack8(*(const uint4*)(rowp - P0LD + cols[g]), um); else {
#pragma unroll
          for (int j = 0; j < 8; ++j) um[j] = 0.f; }
        if (!last) unpack8(*(const uint4*)(rowp + P0LD + cols[g]), up); else {
#pragma unroll
          for (int j = 0; j < 8; ++j) up[j] = 0.f; }
#pragma unroll
        for (int j = 0; j < 8; ++j) mixed[g][j] = u[j] + mu[cols[g] + j] * (0.5f * (um[j] + up[j]) - u[j]);
      }
      float nrm = 0.f;
#pragma unroll
      for (int j = 0; j < 8; ++j) {
        Lr[ss_ * 64 + cg8 + j] = mixed[0][j];
        Lk[ss_ * 64 + cg8 + j] = mixed[1][j];
        Lv[ss_ * 64 + cg8 + j] = mixed[2][j];
        const float kq = mixed[1][j] * kkc[j];
        nrm += kq * kq;
      }
      float tw[8];
#pragma unroll
      for (int j = 0; j < 8; ++j) tw[j] = tanhf(mixed[3][j]);
      *(uint4*)(Aw + ss_ * 64 + cg8) = pack8(tw);
      *(uint4*)(Aa + ss_ * 64 + cg8) = pack8(mixed[4]);
      nrm = red8(nrm);
      if ((tid & 7) == 0) Linv[ss_] = 1.f / fmaxf(sqrtf(nrm), 1e-12f);
    }
    __syncthreads();
    {
      f32x16 acc;
#pragma unroll
      for (int r = 0; r < 16; ++r) acc[r] = 0.f;
      const bf16_t* Asrc = gid == 0 ? Aw : Aa;
#pragma unroll
      for (int kk = 0; kk < 4; ++kk) {
        const bf16x8 a = *(const bf16x8*)(Asrc + (tmi * 32 + (lane & 31)) * 64 + kk * 16 + 8 * (lane >> 5));
        acc = MFMA32(a, bfrag[kk], acc);
      }
      const int n = tni * 32 + (lane & 31);
#pragma unroll
      for (int r = 0; r < 16; ++r) {
        const int s = tmi * 32 + ACC_ROW(r, lane);
        const float x = acc[r] + bias0;
        if (gid == 0) { const float wl = -softplusf_(-x) - 0.5f; Lw[s * 64 + n] = __expf(-__expf(wl)); }
        else Las[s * 64 + n] = sigmoidf_(x);
      }
    }
    __syncthreads();
    {
      const float iv = Linv[ss_];
      float bsum = 0.f;
#pragma unroll
      for (int j = 0; j < 8; ++j) {
        const int o = ss_ * 64 + cg8 + j;
        const float k = Lk[o], as = Las[o];
        const float kkv = k * kkc[j] * iv;
        La[o] = -kkv; Lb[o] = kkv * as;
        const float kd = k * (1.f + (as - 1.f) * kac[j]);
        Lk[o] = kd;
        bsum += Lr[o] * kd * rkc[j];
      }
      bsum = red8(bsum);
      if (half == 0 && (tid & 7) == 0) {
        const int t = scan_token(d, ch * 64 + ss_);
        bonus[((size_t)b * TPB + t) * 8 + h] = bsum;
      }
    }
    __syncthreads();
#pragma unroll 2
    for (int s = 0; s < 64; ++s) {
      const float4 a4 = *(const float4*)(La + s * 64 + c4);
      const float4 b4 = *(const float4*)(Lb + s * 64 + c4);
      const float4 k4 = *(const float4*)(Lk + s * 64 + c4);
      const float4 w4 = *(const float4*)(Lw + s * 64 + c4);
      const float4 r4 = *(const float4*)(Lr + s * 64 + c4);
      const float vv = Lv[s * 64 + row];
      float sa = S0 * a4.x + S1 * a4.y + S2 * a4.z + S3 * a4.w;
      sa = red16(sa);
      S0 = S0 * w4.x + (sa * b4.x + vv * k4.x);
      S1 = S1 * w4.y + (sa * b4.y + vv * k4.y);
      S2 = S2 * w4.z + (sa * b4.z + vv * k4.z);
      S3 = S3 * w4.w + (sa * b4.w + vv * k4.w);
      float y = S0 * r4.x + S1 * r4.y + S2 * r4.z + S3 * r4.w;
      y = red16(y);
      if ((tid & 15) == 0) Ly[s * 32 + rl] = y;
    }
    __syncthreads();
    {
      const int s = tid >> 3, r4i = (tid & 7) * 4;
      const int t = scan_token(d, ch * 64 + s);
      const float4 yv = *(const float4*)(Ly + s * 32 + r4i);
      uint2 w; w.x = pack_bf2(yv.x, yv.y); w.y = pack_bf2(yv.z, yv.w);
      *(uint2*)(yout + ((size_t)b * TPB + t) * 512 + h * 64 + half * 32 + r4i) = w;
    }
  }
}

DI void phase_rwkv_post(const P& p) {
  const bf16_t* p0 = (const bf16_t*)(p.ws + WS_PB + PB_P);
  const bf16_t* yf = (const bf16_t*)(p.ws + WS_HB + HB_YF);
  const bf16_t* yb = (const bf16_t*)(p.ws + WS_HB + HB_YB);
  const bf16_t* G = (const bf16_t*)(p.ws + WS_PB + PB_G);
  const float* bonus = (const float*)(p.ws + WS_PB + PB_BONUS);
  bf16_t* o0 = (bf16_t*)(p.ws + WS_PB + PB_O0);
  const float* mu = p.in[I_RWMU] + 1024;
  for (int i = blockIdx.x * NTHR + threadIdx.x; i < R * 8; i += gridDim.x * NTHR) {
    const int row = i >> 3, h = i & 7;
    const int t = row % TPB;
    const bool first = (t == 0) || (t == CTXL), last = (t == CTXL - 1) || (t == TPB - 1);
    float y[64];
    float mean = 0.f;
#pragma unroll
    for (int c = 0; c < 8; ++c) {
      float a[8], bb[8];
      unpack8(*(const uint4*)(yf + (size_t)row * 512 + h * 64 + c * 8), a);
      unpack8(*(const uint4*)(yb + (size_t)row * 512 + h * 64 + c * 8), bb);
#pragma unroll
      for (int j = 0; j < 8; ++j) { y[c * 8 + j] = a[j] + bb[j]; mean += y[c * 8 + j]; }
    }
    mean *= (1.f / 64.f);
    float var = 0.f;
#pragma unroll
    for (int j = 0; j < 64; ++j) { const float dlt = y[j] - mean; var += dlt * dlt; }
    var *= (1.f / 64.f);
    const float rs = rsqrtf(var + 64e-5f);
    const float bn = bonus[(size_t)row * 8 + h] + bonus[(size_t)R * 8 + (size_t)row * 8 + h];
    const bf16_t* vp = p0 + (size_t)row * P0LD + 1536 + 1024 + h * 64;
#pragma unroll
    for (int c = 0; c < 8; ++c) {
      float u[8], um[8], up[8], g[8], o[8];
      unpack8(*(const uint4*)(vp + c * 8), u);
      if (!first) unpack8(*(const uint4*)(vp - P0LD + c * 8), um); else {
#pragma unroll
        for (int j = 0; j < 8; ++j) um[j] = 0.f; }
      if (!last) unpack8(*(const uint4*)(vp + P0LD + c * 8), up); else {
#pragma unroll
        for (int j = 0; j < 8; ++j) up[j] = 0.f; }
      unpack8(*(const uint4*)(G + (size_t)row * 512 + h * 64 + c * 8), g);
#pragma unroll
      for (int j = 0; j < 8; ++j) {
        const int cc = h * 64 + c * 8 + j;
        const float v = u[j] + mu[cc] * (0.5f * (um[j] + up[j]) - u[j]);
        const float yn = (y[c * 8 + j] - mean) * rs * p.in[I_LNXW][cc] + p.in[I_LNXB][cc];
        o[j] = (yn + bn * v) * g[j];
      }
      *(uint4*)(o0 + (size_t)row * 1024 + 512 + h * 64 + c * 8) = pack8(o);
    }
  }
}

DI unsigned f2ord(float f) { const unsigned u = __float_as_uint(f); return u ^ ((u >> 31) ? 0xFFFFFFFFu : 0x80000000u); }
DI float ord2f(unsigned u) { u ^= ((u >> 31) ? 0x80000000u : 0xFFFFFFFFu); return __uint_as_float(u); }

struct CandPairs { int ia[25], ja[25], ib[25], jb[25]; };
constexpr CandPairs make_pairs() {
  CandPairs c{};
  int n = 0;
  for (int i = 0; i < 16; ++i) for (int j = 0; j < 16; ++j) if ((i + 1) * (j + 1) <= 16) {
    if ((n & 1) == 0) { c.ia[n >> 1] = i; c.ja[n >> 1] = j; } else { c.ib[n >> 1] = i; c.jb[n >> 1] = j; }
    ++n;
  }
  return c;
}
constexpr CandPairs CP = make_pairs();

DI void peer_topk_unit(const P& p, char* lds, int layer, int unit) {
  const int tid = threadIdx.x, lane = tid & 63, wave = tid >> 6;
  const int mt = unit >> 3, h = unit & 7;
  const bf16_t* q = (const bf16_t*)(p.ws + WS_PB + PB_Q);
  const bf16_t* keys = (const bf16_t*)(p.ws + (layer == 0 ? WS_KEYS0 : WS_KEYS1)) + (size_t)h * 2 * 128 * 128;
  int* idxo = (int*)(p.ws + WS_PB + PB_IDX);
  float* gateo = (float*)(p.ws + WS_PB + PB_GATE);
  __syncthreads();
  for (int e = tid; e < 2 * 128 * 16; e += NTHR) {
    const int pp = e >> 11, row = (e >> 4) & 127, c = e & 15;
    *(uint4*)(lds + pp * 32768 + row * 256 + ((c ^ (row & 15)) << 4)) = *(const uint4*)(keys + (size_t)pp * 16384 + row * 128 + c * 8);
  }
  __syncthreads();
  const int r31 = lane & 31, hh = lane >> 5;
  const size_t trow = (size_t)mt * 256 + wave * 32 + r31;
  unsigned vk[2][16];
#pragma unroll
  for (int pp = 0; pp < 2; ++pp) {
    f32x16 acc[4];
#pragma unroll
    for (int m = 0; m < 4; ++m)
#pragma unroll
      for (int r = 0; r < 16; ++r) acc[m][r] = 0.f;
    const bf16_t* qp = q + trow * 2048 + (h * 2 + pp) * 128;
#pragma unroll
    for (int kk = 0; kk < 8; ++kk) {
      const bf16x8 bq = *(const bf16x8*)(qp + kk * 16 + 8 * hh);
      const int c = kk * 2 + hh;
#pragma unroll
      for (int m = 0; m < 4; ++m) {
        const int row = m * 32 + r31;
        const bf16x8 ak = *(const bf16x8*)(lds + pp * 32768 + row * 256 + ((c ^ (row & 15)) << 4));
        acc[m] = MFMA32(ak, bq, acc[m]);
      }
    }
    unsigned v[16];
#pragma unroll
    for (int i = 0; i < 16; ++i) v[i] = 0u;
#pragma unroll
    for (int m = 0; m < 4; ++m)
#pragma unroll
      for (int r = 0; r < 16; ++r) {
        const int kidx = m * 32 + ACC_ROW(r, lane);
        unsigned x = (f2ord(acc[m][r]) & ~127u) | (unsigned)(127 - kidx);
#pragma unroll
        for (int i = 0; i < 16; ++i) { const unsigned hi = max(v[i], x); x = min(v[i], x); v[i] = hi; }
      }
    unsigned c16[16];
#pragma unroll
    for (int i = 0; i < 16; ++i) { const unsigned o = (unsigned)__shfl_xor((int)v[15 - i], 32); c16[i] = max(v[i], o); }
#pragma unroll
    for (int st = 8; st >= 1; st >>= 1)
#pragma unroll
      for (int i = 0; i < 16; ++i) if ((i & st) == 0) { const unsigned hi = max(c16[i], c16[i + st]), lo = min(c16[i], c16[i + st]); c16[i] = hi; c16[i + st] = lo; }
#pragma unroll
    for (int i = 0; i < 16; ++i) vk[pp][i] = c16[i];
  }
  float val1[16], val2[16]; int id1[16], id2[16];
#pragma unroll
  for (int i = 0; i < 16; ++i) {
    val1[i] = ord2f(vk[0][i] & ~127u); id1[i] = 127 - (int)(vk[0][i] & 127u);
    val2[i] = ord2f(vk[1][i] & ~127u); id2[i] = 127 - (int)(vk[1][i] & 127u);
  }
  float tv[16]; int tp[16];
#pragma unroll
  for (int i = 0; i < 16; ++i) { tv[i] = -3.0e38f; tp[i] = 0; }
#pragma unroll
  for (int t = 0; t < 25; ++t) {
    const float va = val1[CP.ia[t]] + val2[CP.ja[t]];
    const float vb = val1[CP.ib[t]] + val2[CP.jb[t]];
    const int pa = id1[CP.ia[t]] * 128 + id2[CP.ja[t]];
    const int pb = id1[CP.ib[t]] * 128 + id2[CP.jb[t]];
    float val = hh ? vb : va; int pay = hh ? pb : pa;
#pragma unroll
    for (int i = 0; i < 16; ++i) {
      const bool gt = val > tv[i];
      const float nv = gt ? val : tv[i]; const int np = gt ? pay : tp[i];
      val = gt ? tv[i] : val; pay = gt ? tp[i] : pay;
      tv[i] = nv; tp[i] = np;
    }
  }
  float cv[16]; int cp[16];
  float mx = -3.0e38f;
#pragma unroll
  for (int i = 0; i < 16; ++i) {
    const float ov = __shfl_xor(tv[15 - i], 32); const int op = __shfl_xor(tp[15 - i], 32);
    const bool own = tv[i] >= ov;
    cv[i] = own ? tv[i] : ov; cp[i] = own ? tp[i] : op;
    mx = fmaxf(mx, cv[i]);
  }
  float sum = 0.f;
#pragma unroll
  for (int i = 0; i < 16; ++i) { cv[i] = __expf(cv[i] - mx); sum += cv[i]; }
  const float inv = 1.f / sum;
  if (hh == 0) {
    int* ip = idxo + trow * 128 + h * 16;
    float* gp = gateo + trow * 128 + h * 16;
#pragma unroll
    for (int i = 0; i < 4; ++i) {
      *(int4*)(ip + i * 4) = make_int4(cp[i * 4], cp[i * 4 + 1], cp[i * 4 + 2], cp[i * 4 + 3]);
      *(float4*)(gp + i * 4) = make_float4(cv[i * 4] * inv, cv[i * 4 + 1] * inv, cv[i * 4 + 2] * inv, cv[i * 4 + 3] * inv);
    }
  }
}

DI void phase_peer_gather(const P& p, int layer) {
  const int lane = threadIdx.x & 63, gw = blockIdx.x * 8 + (threadIdx.x >> 6), nw = gridDim.x * 8;
  const bf16_t* h2 = (const bf16_t*)(p.ws + WS_PB + PB_H2);
  const int* idx = (const int*)(p.ws + WS_PB + PB_IDX);
  const float* gate = (const float*)(p.ws + WS_PB + PB_GATE);
  const bf16_t* U = (const bf16_t*)(p.ws + WS_HB + HB_U);
  const bf16_t* V = (const bf16_t*)(p.ws + WS_HB + HB_V);
  const float* mods = (const float*)(p.ws + WS_MODS) + (size_t)layer * 9 * 6144;
  float* xc = (float*)(p.ws + WS_XC);
  for (int row = gw; row < R; row += nw) {
    const int b = row / TPB, t = row - b * TPB;
    const bool isctx = t < CTXL;
    if (isctx && layer == 1) continue;
    float hv[16];
    {
      float f[8];
      unpack8(*(const uint4*)(h2 + (size_t)row * D + lane * 16), f);
#pragma unroll
      for (int j = 0; j < 8; ++j) hv[j] = f[j];
      unpack8(*(const uint4*)(h2 + (size_t)row * D + lane * 16 + 8), f);
#pragma unroll
      for (int j = 0; j < 8; ++j) hv[8 + j] = f[j];
    }
    float acc[16];
#pragma unroll
    for (int j = 0; j < 16; ++j) acc[j] = 0.f;
    const int my_i0 = idx[(size_t)row * 128 + lane], my_i1 = idx[(size_t)row * 128 + 64 + lane];
    const float my_g0 = gate[(size_t)row * 128 + lane], my_g1 = gate[(size_t)row * 128 + 64 + lane];
    for (int e0 = 0; e0 < 128; e0 += 4) {
      uint4 ur[4][2], vr[4][2];
      float gg[4];
#pragma unroll
      for (int k = 0; k < 4; ++k) {
        const int e = e0 + k;
        const int ei = (e < 64) ? __builtin_amdgcn_readlane(my_i0, e & 63) : __builtin_amdgcn_readlane(my_i1, e & 63);
        gg[k] = __int_as_float((e < 64) ? __builtin_amdgcn_readlane(__float_as_int(my_g0), e & 63) : __builtin_amdgcn_readlane(__float_as_int(my_g1), e & 63));
        const bf16_t* up = U + (size_t)ei * D + lane * 16;
        const bf16_t* vp = V + (size_t)ei * D + lane * 16;
        ur[k][0] = *(const uint4*)up; ur[k][1] = *(const uint4*)(up + 8);
        vr[k][0] = *(const uint4*)vp; vr[k][1] = *(const uint4*)(vp + 8);
      }
#pragma unroll
      for (int k = 0; k < 4; ++k) {
        float f[8]; float dot = 0.f;
        unpack8(ur[k][0], f);
#pragma unroll
        for (int j = 0; j < 8; ++j) dot += hv[j] * f[j];
        unpack8(ur[k][1], f);
#pragma unroll
        for (int j = 0; j < 8; ++j) dot += hv[8 + j] * f[j];
        dot = red64(dot);
        const float w = gg[k] * geluf_(dot);
        unpack8(vr[k][0], f);
#pragma unroll
        for (int j = 0; j < 8; ++j) acc[j] += w * f[j];
        unpack8(vr[k][1], f);
#pragma unroll
        for (int j = 0; j < 8; ++j) acc[8 + j] += w * f[j];
      }
    }
    const float* g5 = mods + (isctx ? 8 : b) * 6144 + 5 * 1024 + lane * 16;
    float* xp = isctx ? (xc + ((size_t)(b * CTXL + t)) * D + lane * 16) : (p.out + ((size_t)(b * SEQ + t - CTXL)) * D + lane * 16);
#pragma unroll
    for (int i = 0; i < 4; ++i) {
      float4 x = *(float4*)(xp + i * 4);
      x.x += g5[i * 4] * acc[i * 4]; x.y += g5[i * 4 + 1] * acc[i * 4 + 1]; x.z += g5[i * 4 + 2] * acc[i * 4 + 2]; x.w += g5[i * 4 + 3] * acc[i * 4 + 3];
      *(float4*)(xp + i * 4) = x;
    }
  }
}

DI void ssd_naive_unit(const P& p, char* lds, int unit) {
  const int tid = threadIdx.x;
  const int b = unit >> 5, head = unit & 31, grp = head >> 3;
  float* Lx = (float*)lds;
  float* LB = (float*)(lds + 16384);
  float* LC = (float*)(lds + 49152);
  float* Lda = (float*)(lds + 81920);
  float* Ldt = (float*)(lds + 81920 + 256);
  float* Ly = (float*)(lds + 82944);
  bf16_t* p1 = (bf16_t*)(p.ws + WS_PB + PB_P);
  bf16_t* yftmp = (bf16_t*)(p.ws + WS_YF);
  const float* cw = p.in[I_CONVW]; const float* cb = p.in[I_CONVB];
  const int ss_ = tid >> 3, j8 = tid & 7;
  const int pp = tid >> 3, ng = tid & 7;
  const float dsk = p.in[I_DSKIP][head];
  for (int d = 0; d < 2; ++d) {
    const float Aneg = -__expf(p.in[I_ALOG][d * 32 + head]);
    const float dtb = p.in[I_DTB][d * 32 + head];
    float hst[16];
#pragma unroll
    for (int n = 0; n < 16; ++n) hst[n] = 0.f;
    for (int ch = 0; ch < TPB / 64; ++ch) {
      __syncthreads();
      {
        const int t = scan_token(d, ch * 64 + ss_);
        const bool first = (t == 0) || (t == CTXL), last = (t == CTXL - 1) || (t == TPB - 1);
        const bf16_t* rowp = p1 + ((size_t)b * TPB + t) * P1LD + 2048;
        const int cc[5] = {head * 64 + j8 * 8, 2048 + grp * 128 + j8 * 16, 2048 + grp * 128 + j8 * 16 + 8, 2560 + grp * 128 + j8 * 16, 2560 + grp * 128 + j8 * 16 + 8};
#pragma unroll
        for (int g = 0; g < 5; ++g) {
          float u[8], um[8], up[8];
          unpack8(*(const uint4*)(rowp + cc[g]), u);
          if (!first) unpack8(*(const uint4*)(rowp - P1LD + cc[g]), um); else {
#pragma unroll
            for (int j = 0; j < 8; ++j) um[j] = 0.f; }
          if (!last) unpack8(*(const uint4*)(rowp + P1LD + cc[g]), up); else {
#pragma unroll
            for (int j = 0; j < 8; ++j) up[j] = 0.f; }
#pragma unroll
          for (int j = 0; j < 8; ++j) {
            const int c = cc[g] + j;
            const float v = siluf_(cw[c] * um[j] + cw[3072 + c] * u[j] + cw[6144 + c] * up[j] + cb[c]);
            if (g == 0) Lx[ss_ * 64 + j8 * 8 + j] = v;
            else if (g == 1) LB[ss_ * 128 + j8 * 16 + j] = v;
            else if (g == 2) LB[ss_ * 128 + j8 * 16 + 8 + j] = v;
            else if (g == 3) LC[ss_ * 128 + j8 * 16 + j] = v;
            else LC[ss_ * 128 + j8 * 16 + 8 + j] = v;
          }
        }
        if (j8 == 0) {
          const float raw = bf2f(p1[((size_t)b * TPB + t) * P1LD + 5120 + d * 32 + head]);
          const float dtv = softplusf_(raw + dtb);
          Ldt[ss_] = dtv; Lda[ss_] = __expf(dtv * Aneg);
        }
      }
      __syncthreads();
      for (int s = 0; s < 64; ++s) {
        const float da = Lda[s];
        const float xdt = Lx[s * 64 + pp] * Ldt[s];
        float y = 0.f;
#pragma unroll
        for (int n4 = 0; n4 < 4; ++n4) {
          const float4 bv = *(const float4*)(LB + s * 128 + ng * 16 + n4 * 4);
          const float4 cv = *(const float4*)(LC + s * 128 + ng * 16 + n4 * 4);
          hst[n4 * 4] = hst[n4 * 4] * da + xdt * bv.x; y += cv.x * hst[n4 * 4];
          hst[n4 * 4 + 1] = hst[n4 * 4 + 1] * da + xdt * bv.y; y += cv.y * hst[n4 * 4 + 1];
          hst[n4 * 4 + 2] = hst[n4 * 4 + 2] * da + xdt * bv.z; y += cv.z * hst[n4 * 4 + 2];
          hst[n4 * 4 + 3] = hst[n4 * 4 + 3] * da + xdt * bv.w; y += cv.w * hst[n4 * 4 + 3];
        }
        y = red8(y);
        if (ng == 0) Ly[s * 64 + pp] = y;
      }
      __syncthreads();
      if (ch >= CTXL / 64) {
        const int t = scan_token(d, ch * 64 + ss_);
        const size_t lrow = (size_t)b * SEQ + (t - CTXL);
        bf16_t* yfp = yftmp + lrow * 2048 + head * 64 + j8 * 8;
        float yv[8];
#pragma unroll
        for (int j = 0; j < 8; ++j) yv[j] = Ly[ss_ * 64 + j8 * 8 + j];
        if (d == 0) {
          *(uint4*)yfp = pack8(yv);
        } else {
          float yf[8], z[8], o[8];
          unpack8(*(const uint4*)yfp, yf);
          bf16_t* zp = p1 + ((size_t)b * TPB + t) * P1LD + head * 64 + j8 * 8;
          unpack8(*(const uint4*)zp, z);
#pragma unroll
          for (int j = 0; j < 8; ++j) o[j] = (yf[j] + yv[j] + dsk * Lx[ss_ * 64 + j8 * 8 + j]) * siluf_(z[j]);
          *(uint4*)zp = pack8(o);
        }
      }
    }
  }
}

DI void phase_groupnorm(const P& p) {
  const int lane = threadIdx.x & 63, gw = blockIdx.x * 8 + (threadIdx.x >> 6), nw = gridDim.x * 8;
  bf16_t* p1 = (bf16_t*)(p.ws + WS_PB + PB_P);
  const float* gn = p.in[I_GNORM];
  for (int lr = gw; lr < NB * SEQ; lr += nw) {
    const int b = lr >> 12, l = lr & 4095;
    bf16_t* rp = p1 + ((size_t)b * TPB + CTXL + l) * P1LD + lane * 32;
    float v[32];
#pragma unroll
    for (int i = 0; i < 4; ++i) { float f[8]; unpack8(*(const uint4*)(rp + i * 8), f);
#pragma unroll
      for (int j = 0; j < 8; ++j) v[i * 8 + j] = f[j]; }
    float ss = 0.f;
#pragma unroll
    for (int i = 0; i < 32; ++i) ss += v[i] * v[i];
    ss = red16(ss);
    const float rs = rsqrtf(ss * (1.f / 512.f) + 1e-6f);
#pragma unroll
    for (int i = 0; i < 4; ++i) {
      float o[8];
#pragma unroll
      for (int j = 0; j < 8; ++j) o[j] = v[i * 8 + j] * rs * gn[lane * 32 + i * 8 + j];
      *(uint4*)(rp + i * 8) = pack8(o);
    }
  }
}

constexpr int N_PHASES = 21;

__global__ void __launch_bounds__(NTHR) fwd_kernel(P p) {
  extern __shared__ __attribute__((aligned(16))) char lds[];
  const int lo = p.ph_lo, hi = p.ph_hi;
  unsigned char* ws = p.ws;
  XcdBarrier bar; bar.bar = (unsigned*)(ws + WS_CTL); bar.x = 0; bar.st = nullptr;
  volatile LAS unsigned* stw = (volatile LAS unsigned*)(lds + LDS_BYTES - 16);
  if (hi - lo > 1) {
    if (threadIdx.x == 0) { stw[0] = 0u; stw[1] = 0u; }
    __syncthreads();
    bar = xcd_barrier_post((unsigned*)(ws + WS_CTL), stw);
  }
#define IN(k) (lo <= (k) && (k) < hi)
#define SEAM(k) do { if (IN(k) && IN((k) + 1)) xcd_barrier(bar); } while (0)
  const int G = gridDim.x;
  bf16_t* HBp = (bf16_t*)(ws + WS_HB);
  bf16_t* PBp = (bf16_t*)(ws + WS_PB + PB_P);

  if (IN(0)) { phase_prep(p, lds); } SEAM(0);
  if (IN(1)) { phase_normmod(p, 0, 0, true, false, HBp); } SEAM(1);
  if (IN(2)) { gemm_p0_phase(p, lds, HBp, (const bf16_t*)(ws + WS_WIN0T), PBp); } SEAM(2);
  if (IN(3)) {
    for (int u = blockIdx.x; u < 1024 + 64; u += G) attn_flash_unit(p, lds, u);
    phase_ga(p);
  } SEAM(3);
  if (IN(4)) {
    for (int u = blockIdx.x; u < 256; u += G) rwkv_scan_unit(p, lds, u);
    __syncthreads();
    gemm_store_phase(lds, (const bf16_t*)(ws + WS_PB + PB_GA), 128, (const bf16_t*)(ws + WS_RWT + 262144), 128, R, 512, 128, (bf16_t*)(ws + WS_PB + PB_G), 512, 512);
  } SEAM(4);
  if (IN(5)) { phase_rwkv_post(p); } SEAM(5);
  if (IN(6)) { gemm_resid_phase(p, lds, 0, (const bf16_t*)(ws + WS_PB + PB_O0), D, (const bf16_t*)(ws + WS_WOUT0T), D); } SEAM(6);
  if (IN(7)) { phase_normmod(p, 0, 1, false, false, (bf16_t*)(ws + WS_PB + PB_H2)); convert_tables(p, 0); } SEAM(7);
  if (IN(8)) { gemm_store_phase(lds, (const bf16_t*)(ws + WS_PB + PB_H2), D, (const bf16_t*)(ws + WS_PQ0T), D, R, 2048, D, (bf16_t*)(ws + WS_PB + PB_Q), 2048, 2048); } SEAM(8);
  if (IN(9)) { for (int u = blockIdx.x; u < (R / 256) * 8; u += G) peer_topk_unit(p, lds, 0, u); } SEAM(9);
  if (IN(10)) { phase_peer_gather(p, 0); } SEAM(10);
  if (IN(11)) { phase_normmod(p, 1, 0, false, false, HBp); } SEAM(11);
  if (IN(12)) { gemm_store_phase(lds, HBp, D, (const bf16_t*)(ws + WS_WIN1T), D, R, P1NPAD, D, PBp, P1LD, P1LD); } SEAM(12);
  if (IN(13)) { for (int u = blockIdx.x; u < 256; u += G) ssd_naive_unit(p, lds, u); } SEAM(13);
  if (IN(14)) { phase_groupnorm(p); } SEAM(14);
  if (IN(15)) { gemm_resid_phase(p, lds, 1, PBp, P1LD, (const bf16_t*)(ws + WS_WOUT1T), 2048); } SEAM(15);
  if (IN(16)) { phase_normmod(p, 1, 1, false, true, (bf16_t*)(ws + WS_PB + PB_H2)); convert_tables(p, 1); } SEAM(16);
  if (IN(17)) { gemm_store_phase(lds, (const bf16_t*)(ws + WS_PB + PB_H2), D, (const bf16_t*)(ws + WS_PQ1T), D, R, 2048, D, (bf16_t*)(ws + WS_PB + PB_Q), 2048, 2048); } SEAM(17);
  if (IN(18)) { for (int u = blockIdx.x; u < (R / 256) * 8; u += G) peer_topk_unit(p, lds, 1, u); } SEAM(18);
  if (IN(19)) { phase_peer_gather(p, 1); } SEAM(19);
  if (IN(20)) { phase_final_norm(p); }
}

extern "C" void kernel_launch(void* const* d_in, const int* in_sizes, int n_in, void* d_out, int out_size, void* d_ws, size_t ws_size, hipStream_t stream) {
  static int inited = 0;
  if (!inited) {
    if (n_in != N_IN || ws_size < WS_XC + 128 * MiB) { fprintf(stderr, "kernel_launch: unexpected n_in %d / ws_size %zu\n", n_in, ws_size); inited = -1; return; }
    if (hipFuncSetAttribute((const void*)fwd_kernel, hipFuncAttributeMaxDynamicSharedMemorySize, LDS_BYTES) != hipSuccess) { fprintf(stderr, "kernel_launch: hipFuncSetAttribute failed\n"); inited = -1; return; }
    inited = 1;
  }
  if (inited < 0) return;
  P p{};
  for (int i = 0; i < N_IN; ++i) p.in[i] = (const float*)d_in[i];
  p.out = (float*)d_out; p.ws = (unsigned char*)d_ws;
  (void)hipMemsetAsync((char*)d_ws + WS_CTL, 0, 65536, stream);
#if N_LAUNCH_MODE == 1
  p.ph_lo = 0; p.ph_hi = N_PHASES;
  hipLaunchKernelGGL(fwd_kernel, dim3(256), dim3(NTHR), LDS_BYTES, stream, p);
#else
  for (int ph = 0; ph < N_PHASES; ++ph) {
    p.ph_lo = ph; p.ph_hi = ph + 1;
    hipLaunchKernelGGL(fwd_kernel, dim3(256), dim3(NTHR), LDS_BYTES, stream, p);
  }
#endif
}
```

```cpp
#include <hip/hip_runtime.h>
#include <stdint.h>
#include <stdio.h>

#ifndef N_LAUNCH_MODE
#define N_LAUNCH_MODE 1
#endif

#define DI __device__ __forceinline__
typedef unsigned short bf16_t;
typedef __attribute__((ext_vector_type(8))) short bf16x8;
typedef __attribute__((ext_vector_type(16))) float f32x16;
typedef __attribute__((ext_vector_type(2))) __bf16 bf2_t;

constexpr int D = 1024, NB = 8, SEQ = 4096, CTXL = 256, TPB = SEQ + CTXL, R = NB * TPB;
constexpr int NTHR = 512;
constexpr int LDS_BYTES = 163840;
constexpr int P0LD = 3456;
constexpr int P1LD = 5184;
constexpr int P1NPAD = 5248;

enum { I_X = 0, I_C, I_CTX, I_CCTX,
       I_ADAW0, I_ADAB0, I_N1_0, I_N2_0, I_WIN0, I_DALAM, I_DASUB, I_RWMU, I_RWW0, I_RWW2, I_RWA0, I_RWA2, I_RWG2, I_RWKK, I_RWKA, I_RWRK, I_LNXW, I_LNXB, I_WOUT0, I_PQ0, I_PK0, I_PU0, I_PV0,
       I_ADAW1, I_ADAB1, I_N1_1, I_N2_1, I_WIN1, I_CONVW, I_CONVB, I_DTB, I_ALOG, I_DSKIP, I_GNORM, I_WOUT1, I_PQ1, I_PK1, I_PU1, I_PV1, I_NF, N_IN };

constexpr size_t MiB = 1048576;
constexpr size_t WS_CTL = 0;
constexpr size_t WS_SCAL = 65536;
constexpr size_t WS_MODS = 131072;
constexpr size_t WS_ROPE = 1 * MiB;
constexpr size_t WS_RWT = 2 * MiB;
constexpr size_t WS_WIN0T = 3 * MiB;
constexpr size_t WS_WOUT0T = 10 * MiB;
constexpr size_t WS_PQ0T = 12 * MiB;
constexpr size_t WS_KEYS0 = 16 * MiB;
constexpr size_t WS_KEYS1 = 16 * MiB + 524288;
constexpr size_t WS_WIN1T = 17 * MiB;
constexpr size_t WS_WOUT1T = 28 * MiB;
constexpr size_t WS_PQ1T = 32 * MiB;
constexpr size_t WS_PB = 36 * MiB;
constexpr size_t WS_XC = 381 * MiB;
constexpr size_t WS_HB = 389 * MiB;
constexpr size_t WS_END = 457 * MiB;
constexpr size_t WS_YF = WS_XC;
constexpr size_t PB_P = 0;
constexpr size_t PB_O0 = 230 * MiB;
constexpr size_t PB_G = 298 * MiB;
constexpr size_t PB_GA = 332 * MiB;
constexpr size_t PB_BONUS = 341 * MiB;
constexpr size_t L1_ZH = 0;
constexpr size_t L1_XH = 136 * MiB;
constexpr size_t L1_BG = 272 * MiB;
constexpr size_t L1_CG = 306 * MiB;
constexpr size_t L1_DT = 340 * MiB;
constexpr size_t PB_H2 = 0;
constexpr size_t PB_Q = 68 * MiB;
constexpr size_t PB_IDX = 204 * MiB;
constexpr size_t PB_GATE = 221 * MiB;
constexpr size_t WS_HNEXT = WS_HB + 33 * MiB;
constexpr size_t HB_YF = 0, HB_YB = 34 * MiB;
constexpr size_t HB_U = 0, HB_V = 8 * MiB;
constexpr size_t HB_SU = 32 * MiB, HB_SV = 32 * MiB + 65536;

struct P {
  const float* in[N_IN];
  float* out;
  unsigned char* ws;
  int ph_lo, ph_hi;
};

constexpr int N_PHASES = 21;
#ifndef PROBE_GRP
#define PROBE_GRP 0
#endif
#define SEG_DECL_() unsigned long long seg_last_ = 0ull, seg_acc_[4] = {0ull, 0ull, 0ull, 0ull}
#define SEG_INIT_() do { seg_last_ = __builtin_amdgcn_s_memrealtime(); } while (0)
#define SEG_ADD_(j) do { const unsigned long long t__ = __builtin_amdgcn_s_memrealtime(); seg_acc_[j] += t__ - seg_last_; seg_last_ = t__; } while (0)
#define SEG_FLUSH_(base) do { if (blockIdx.x == 0 && threadIdx.x == 0) { for (int j__ = 0; j__ < 4; ++j__) ((unsigned long long*)(p.ws + WS_SCAL + 1024))[22 + (base) + j__] += seg_acc_[j__]; } } while (0)
#if defined(PROBE_A) && PROBE_GRP == 1
#define SEGR_DECL() SEG_DECL_()
#define SEGR_INIT() SEG_INIT_()
#define SEGR_ADD(j) SEG_ADD_(j)
#define SEGR_FLUSH(b) SEG_FLUSH_(b)
#else
#define SEGR_DECL() do {} while (0)
#define SEGR_INIT() do {} while (0)
#define SEGR_ADD(j) do {} while (0)
#define SEGR_FLUSH(b) do {} while (0)
#endif
#if defined(PROBE_A) && PROBE_GRP == 2
#define SEGS_DECL() SEG_DECL_()
#define SEGS_INIT() SEG_INIT_()
#define SEGS_ADD(j) SEG_ADD_(j)
#define SEGS_FLUSH(b) SEG_FLUSH_(b)
#else
#define SEGS_DECL() do {} while (0)
#define SEGS_INIT() do {} while (0)
#define SEGS_ADD(j) do {} while (0)
#define SEGS_FLUSH(b) do {} while (0)
#endif

DI unsigned pack_bf2(float a, float b) { bf2_t v; v[0] = (__bf16)a; v[1] = (__bf16)b; return __builtin_bit_cast(unsigned, v); }
DI bf16_t f2bf(float a) { return __builtin_bit_cast(unsigned short, (__bf16)a); }
DI float bf2f(bf16_t v) { return __uint_as_float((unsigned)v << 16); }
DI float bflo(unsigned u) { return __uint_as_float(u << 16); }
DI float bfhi(unsigned u) { return __uint_as_float(u & 0xffff0000u); }
template <int CTRL> DI float dpp_f(float x) { return __int_as_float(__builtin_amdgcn_update_dpp(0, __float_as_int(x), CTRL, 0xF, 0xF, true)); }
DI float red4(float x) { x += dpp_f<0xB1>(x); x += dpp_f<0x4E>(x); return x; }
DI float red8(float x) { x += dpp_f<0x141>(x); return red4(x); }
DI float red16(float x) { x += dpp_f<0x140>(x); return red8(x); }
DI float red64(float x) { x = red16(x); x += __shfl_xor(x, 16); x += __shfl_xor(x, 32); return x; }
DI float frcp_(float x) { return __builtin_amdgcn_rcpf(x); }
DI float sigmoidf_(float x) { return frcp_(1.f + __expf(-x)); }
DI float siluf_(float x) { return x * frcp_(1.f + __expf(-x)); }
DI float softplusf_(float x) { return x > 20.f ? x : log1pf(__expf(x)); }
DI float geluf_(float x) { return 0.5f * x * (1.f + erff(x * 0.70710678118654752f)); }
DI void unpack8(const uint4& u, float (&f)[8]) { f[0] = bflo(u.x); f[1] = bfhi(u.x); f[2] = bflo(u.y); f[3] = bfhi(u.y); f[4] = bflo(u.z); f[5] = bfhi(u.z); f[6] = bflo(u.w); f[7] = bfhi(u.w); }
DI uint4 pack8(const float (&f)[8]) { uint4 u; u.x = pack_bf2(f[0], f[1]); u.y = pack_bf2(f[2], f[3]); u.z = pack_bf2(f[4], f[5]); u.w = pack_bf2(f[6], f[7]); return u; }
#define ACC_ROW(reg, lane) (((reg) & 3) + 8 * ((reg) >> 2) + 4 * ((lane) >> 5))
#define MFMA32(a, b, c) __builtin_amdgcn_mfma_f32_32x32x16_bf16((a), (b), (c), 0, 0, 0)

#define XB_TMO      128
#define XB_XCNT(j)  (256  + 64 * (j))
#define XB_XSUB(j)  (1280 + 64 * (j))
#define XB_XGEN(j)  (2304 + 64 * (j))
#define XB_TOP      3328
#define XB_TOPGEN   3392
#define XCD_BAR_WORDS 3456
#define XB_SPIN_CAP (1u << 22)
#define LAS __attribute__((address_space(3)))
DI unsigned xb_ld(unsigned* p) { return __hip_atomic_load(p, __ATOMIC_RELAXED, __HIP_MEMORY_SCOPE_AGENT); }
DI unsigned xb_add(unsigned* p, unsigned v) { return __hip_atomic_fetch_add(p, v, __ATOMIC_RELAXED, __HIP_MEMORY_SCOPE_AGENT); }
DI unsigned xb_xcc_id() { return (unsigned)__builtin_amdgcn_s_getreg((3 << 11) | 20) & 0xFu; }
#define XB_SPIN(cond, bar) do { unsigned _sp = 0; while (cond) { __builtin_amdgcn_s_sleep(1); \
    if ((++_sp & 255u) == 0u) { if (xb_ld(&(bar)[XB_TMO])) break; if (_sp > XB_SPIN_CAP) { atomicAdd(&(bar)[XB_TMO], 1u); break; } } } } while (0)
struct XcdBarrier { unsigned* bar; unsigned x; volatile LAS unsigned* st; };
DI XcdBarrier xcd_barrier_post(unsigned* bar, volatile LAS unsigned* st) {
  XcdBarrier b; b.bar = bar; b.x = xb_xcc_id(); b.st = st;
  if (threadIdx.x == 0) (void)xb_add(&bar[XB_XCNT(b.x)], 1u);
  return b;
}
DI void xcd_barrier_complete(unsigned* bar, unsigned x, unsigned& nloc, unsigned& nx) {
  const unsigned G = gridDim.x * gridDim.y * gridDim.z;
  unsigned sum, cnt, mine, sp = 0u;
  for (;;) {
    sum = 0u; cnt = 0u; mine = 0u;
#pragma unroll
    for (unsigned j = 0; j < 16; ++j) { const unsigned c = xb_ld(&bar[XB_XCNT(j)]); sum += c; cnt += (c > 0u) ? 1u : 0u; mine = (j == x) ? c : mine; }
    if (sum == G) break;
    __builtin_amdgcn_s_sleep(1);
    if ((++sp & 255u) == 0u) { if (xb_ld(&bar[XB_TMO])) break; if (sp > XB_SPIN_CAP) { atomicAdd(&bar[XB_TMO], 1u); break; } }
  }
  nloc = mine > 0u ? mine : 1u; nx = cnt > 0u ? cnt : 1u;
}
DI void xcd_barrier(const XcdBarrier& b) {
  asm volatile("s_waitcnt vmcnt(0)" ::: "memory");
  __syncthreads();
  if (threadIdx.x == 0) {
    unsigned* bar = b.bar;
    __builtin_amdgcn_s_waitcnt(0);
    unsigned nloc = b.st[0], nx = b.st[1];
    if (nloc == 0u) { xcd_barrier_complete(bar, b.x, nloc, nx); b.st[0] = nloc; b.st[1] = nx; }
    const unsigned old = xb_add(&bar[XB_XSUB(b.x)], 1u);
    const unsigned gen = old / nloc;
    if (old + 1u == (gen + 1u) * nloc) {
      __builtin_amdgcn_fence(__ATOMIC_RELEASE, "agent");
      asm volatile("s_waitcnt vmcnt(0)" ::: "memory");
      const unsigned og = xb_add(&bar[XB_TOP], 1u);
      const unsigned tg = og / nx;
      if (og + 1u == (tg + 1u) * nx) xb_add(&bar[XB_TOPGEN], 1u);
      else XB_SPIN(xb_ld(&bar[XB_TOPGEN]) == tg, bar);
      __builtin_amdgcn_fence(__ATOMIC_ACQUIRE, "agent");
      xb_add(&bar[XB_XGEN(b.x)], 1u);
      asm volatile("s_waitcnt vmcnt(0)" ::: "memory");
    } else {
      XB_SPIN(xb_ld(&bar[XB_XGEN(b.x)]) == gen, bar);
      __builtin_amdgcn_fence(__ATOMIC_ACQUIRE, "agent");
      asm volatile("s_waitcnt vmcnt(0)" ::: "memory");
    }
  }
  __syncthreads();
}

DI void gemm_tile(char* lds, const bf16_t* __restrict__ A, int lda, const bf16_t* __restrict__ Bt, int ldb, int K, f32x16 (&acc)[2][2]) {
  const int tid = threadIdx.x, lane = tid & 63, wave = tid >> 6, wm = wave >> 1, wn = wave & 1;
#pragma unroll
  for (int i = 0; i < 2; ++i)
#pragma unroll
    for (int j = 0; j < 2; ++j)
#pragma unroll
      for (int r = 0; r < 16; ++r) acc[i][j][r] = 0.f;
  const int arow0 = tid >> 3, ac = tid & 7;
  const bf16_t* ap = A + (size_t)arow0 * lda + ac * 8;
  const bf16_t* bp = Bt + (size_t)arow0 * ldb + ac * 8;
  const int sw = ((ac ^ (arow0 >> 1)) & 7) << 4;
  const int st_off = arow0 * 128 + sw;
  uint4 ra[4], rb[2];
#pragma unroll
  for (int i = 0; i < 4; ++i) ra[i] = *(const uint4*)(ap + (size_t)i * 64 * lda);
#pragma unroll
  for (int i = 0; i < 2; ++i) rb[i] = *(const uint4*)(bp + (size_t)i * 64 * ldb);
#pragma unroll
  for (int i = 0; i < 4; ++i) *(uint4*)(lds + st_off + i * 8192) = ra[i];
#pragma unroll
  for (int i = 0; i < 2; ++i) *(uint4*)(lds + 65536 + st_off + i * 8192) = rb[i];
  __syncthreads();
  const int nk = K >> 6;
  const int r31 = lane & 31, hh = lane >> 5;
  for (int kt = 0; kt < nk; ++kt) {
    const int cur = kt & 1;
    if (kt + 1 < nk) {
#pragma unroll
      for (int i = 0; i < 4; ++i) ra[i] = *(const uint4*)(ap + (size_t)i * 64 * lda + (kt + 1) * 64);
#pragma unroll
      for (int i = 0; i < 2; ++i) rb[i] = *(const uint4*)(bp + (size_t)i * 64 * ldb + (kt + 1) * 64);
    }
    const char* la = lds + cur * 32768;
    const char* lb = lds + 65536 + cur * 16384;
#pragma unroll
    for (int kk = 0; kk < 4; ++kk) {
      const int c = kk * 2 + hh;
      bf16x8 a[2], b[2];
#pragma unroll
      for (int mi = 0; mi < 2; ++mi) { const int row = wm * 64 + mi * 32 + r31; a[mi] = *(const bf16x8*)(la + row * 128 + (((c ^ (row >> 1)) & 7) << 4)); }
#pragma unroll
      for (int ni = 0; ni < 2; ++ni) { const int row = wn * 64 + ni * 32 + r31; b[ni] = *(const bf16x8*)(lb + row * 128 + (((c ^ (row >> 1)) & 7) << 4)); }
#pragma unroll
      for (int mi = 0; mi < 2; ++mi)
#pragma unroll
        for (int ni = 0; ni < 2; ++ni) acc[mi][ni] = MFMA32(a[mi], b[ni], acc[mi][ni]);
    }
    if (kt + 1 < nk) {
      char* wa = lds + (cur ^ 1) * 32768;
      char* wb = lds + 65536 + (cur ^ 1) * 16384;
#pragma unroll
      for (int i = 0; i < 4; ++i) *(uint4*)(wa + st_off + i * 8192) = ra[i];
#pragma unroll
      for (int i = 0; i < 2; ++i) *(uint4*)(wb + st_off + i * 8192) = rb[i];
    }
    __syncthreads();
  }
}

DI void gemm_store_phase(char* lds, const bf16_t* A, int lda, const bf16_t* Bt, int ldb, int M, int Npad, int K, bf16_t* C, int ldc, int nvalid) {
  const int ntn = Npad / 128, ntm = M / 256;
  const int lane = threadIdx.x & 63, wave = threadIdx.x >> 6, wm = wave >> 1, wn = wave & 1;
  for (int tile = blockIdx.x; tile < ntm * ntn; tile += gridDim.x) {
    const int mt = tile / ntn, nt = tile - mt * ntn;
    f32x16 acc[2][2];
    gemm_tile(lds, A + (size_t)mt * 256 * lda, lda, Bt + (size_t)nt * 128 * ldb, ldb, K, acc);
#pragma unroll
    for (int mi = 0; mi < 2; ++mi)
#pragma unroll
      for (int ni = 0; ni < 2; ++ni) {
        const int col = nt * 128 + wn * 64 + ni * 32 + (lane & 31);
        if (col < nvalid) {
#pragma unroll
          for (int r = 0; r < 16; ++r) {
            const int row = mt * 256 + wm * 64 + mi * 32 + ACC_ROW(r, lane);
            C[(size_t)row * ldc + col] = f2bf(acc[mi][ni][r]);
          }
        }
      }
  }
}

namespace pg8 {
typedef float f32x4 __attribute__((ext_vector_type(4)));
typedef unsigned u32x4 __attribute__((ext_vector_type(4)));
constexpr int BM = 256, BK = 64, HALF = 128, HTB = HALF * BK * 2, STAGE_BYTES = 8 * HTB, NXCD = 8, WGM = 8;
DI int lds_byte(int r, int c) { const int st = (r >> 4) * 2 + (c >> 5), rr = r & 15, cc = c & 31, ob = rr * 64 + cc * 2; return st * 1024 + (ob ^ (((ob >> 9) & 1) << 5)); }
DI void stage_rc(int b, int& R_, int& C_) { const int st = b / 1024, sb = b % 1024, swz = sb ^ (((sb >> 9) & 1) << 5); R_ = (st >> 1) * 16 + swz / 64; C_ = (st & 1) * 32 + (swz % 64) / 2; }
DI int perm32(int rho) { const int n = rho >> 4, i = rho & 15; return 8 * (i >> 2) + 4 * n + (i & 3); }
struct Unit { int pm, pn; };
struct Gemm { const bf16_t* A; const bf16_t* Bt; int lda, K; int headmajor; };
struct Order {
  int nM, nN, nwg, G, c, skipctx;
  DI void init(int nM_, int nN_, int G_, int c_, int skipctx_) { nM = nM_; nN = nN_; nwg = nM * nN; G = G_; c = c_; skipctx = skipctx_; }
  DI bool next(int i, Unit& u) const {
    const long L = (long)i * G + c; if (L >= nwg) return false;
    int wgid = (int)L; { const int q = nwg / NXCD, r = nwg % NXCD, xcd = wgid % NXCD, off = wgid / NXCD; wgid = (xcd < r ? xcd * (q + 1) : r * (q + 1) + (xcd - r) * q) + off; }
    const int nig = WGM * nN, gid = wgid / nig, fm = gid * WGM, gsz = (nM - fm) < WGM ? (nM - fm) : WGM;
    int pm = fm + ((wgid % nig) % gsz); u.pn = (wgid % nig) / gsz;
    if (skipctx) pm = (pm >> 4) * 17 + 1 + (pm & 15);
    u.pm = pm; return true;
  }
};
template <class Epi>
DI void gemm_phase(char* lds_generic, const Gemm g, const Order& S, const Epi& E) {
  LAS unsigned char* lds = (LAS unsigned char*)lds_generic;
  const int tid = threadIdx.x, wid = __builtin_amdgcn_readfirstlane(tid >> 6), lane = tid & 63, wr = wid >> 2, wc = wid & 3, fr = lane & 15, fq = lane >> 4;
  const int K = g.K, nt = K / BK, lda = g.lda;
  unsigned voffA[2], voffB[2];
#pragma unroll
  for (int i = 0; i < 2; ++i) { int R_, C_; stage_rc(tid * 16 + i * 8192, R_, C_); const int Rb = Epi::PERM ? ((R_ & ~31) + perm32(R_ & 31)) : R_;
    voffA[i] = (unsigned)(R_ * lda + C_) * 2u; voffB[i] = (unsigned)(Rb * K + C_) * 2u; }
  const size_t kstep = (size_t)(BK * 2);
  const size_t kstepA = g.headmajor ? (size_t)TPB * 64 * 2 : kstep;
  const size_t hstepA = (size_t)HALF * lda * 2, hstepB = (size_t)HALF * K * 2;
  const size_t tstepB = 2 * hstepB;
#define PG8_ABASE(pm_) ((const char*)g.A + (g.headmajor ? ((size_t)((pm_) / 17) * 32 * TPB + (size_t)((pm_) % 17) * 256) * 128 : (size_t)(pm_) * 2 * hstepA))
  const unsigned ldsw = (unsigned)wid * 1024u;
  const int aoff = lds_byte(wr * 64 + fr, fq * 8), boff = lds_byte(wc * 32 + fr, fq * 8);
#define PG8_SA(b, h) (((b) * 2 + (h)) * HTB)
#define PG8_SB(b, h) ((4 + (b) * 2 + (h)) * HTB)
#define PG8_STAGE(bufoff, gbase, voff) do { _Pragma("unroll") for (int _i = 0; _i < 2; ++_i) \
    __builtin_amdgcn_global_load_lds((const unsigned*)((const char*)(gbase) + (voff)[_i]), (LAS unsigned*)(lds + (bufoff) + ldsw + _i * 8192), 16, 0, 0); } while (0)
#define PG8_LDA(dst, b, h) do { _Pragma("unroll") for (int m = 0; m < 4; ++m) _Pragma("unroll") for (int k = 0; k < 2; ++k) dst[m][k] = *(const LAS bf16x8*)(lds + PG8_SA(b, h) + aoff + m * 2048 + k * 1024); } while (0)
#define PG8_LDB(dst, b, h) do { _Pragma("unroll") for (int n = 0; n < 2; ++n) _Pragma("unroll") for (int k = 0; k < 2; ++k) dst[n][k] = *(const LAS bf16x8*)(lds + PG8_SB(b, h) + boff + n * 2048 + k * 1024); } while (0)
#define PG8_MMA(ai, bj, At, Bt) do { __builtin_amdgcn_s_setprio(1); _Pragma("unroll") for (int m = 0; m < 4; ++m) _Pragma("unroll") for (int n = 0; n < 2; ++n) _Pragma("unroll") for (int k = 0; k < 2; ++k) \
    acc[ai][bj][m][n] = __builtin_amdgcn_mfma_f32_16x16x32_bf16(Bt[n][k], At[m][k], acc[ai][bj][m][n], 0, 0, 0); __builtin_amdgcn_s_setprio(0); } while (0)
#define PG8_WAIT_V(n) asm volatile("s_waitcnt vmcnt(" #n ")" ::: "memory")
#define PG8_WAIT_L(n) asm volatile("s_waitcnt lgkmcnt(" #n ")" ::: "memory")
#define PG8_BAR __builtin_amdgcn_s_barrier()
#define PG8_SCHED __builtin_amdgcn_sched_barrier(0)
  Unit cur, nxt; int ui = 0;
  if (!S.next(0, cur)) return;
  f32x4 acc[2][2][4][2];
#pragma unroll
  for (int a = 0; a < 2; ++a)
#pragma unroll
    for (int b = 0; b < 2; ++b)
#pragma unroll
      for (int m = 0; m < 4; ++m)
#pragma unroll
        for (int n = 0; n < 2; ++n) acc[a][b][m][n] = (f32x4){0.f, 0.f, 0.f, 0.f};
  bf16x8 At[4][2], B0[2][2], B1[2][2];
  const char* cA = PG8_ABASE(cur.pm); const char* cB = (const char*)g.Bt + (size_t)cur.pn * tstepB;
  PG8_STAGE(PG8_SB(0, 0), cB, voffB); PG8_STAGE(PG8_SA(0, 0), cA, voffA); PG8_STAGE(PG8_SB(0, 1), cB + hstepB, voffB); PG8_STAGE(PG8_SA(0, 1), cA + hstepA, voffA);
  if (wr == 1) PG8_BAR;
  PG8_WAIT_V(4); PG8_BAR;
  PG8_STAGE(PG8_SB(1, 0), cB + kstep, voffB); PG8_STAGE(PG8_SA(1, 0), cA + kstepA, voffA); PG8_STAGE(PG8_SB(1, 1), cB + hstepB + kstep, voffB);
  PG8_WAIT_V(6); PG8_BAR;
  for (;;) {
    const bool has_next = S.next(ui + 1, nxt);
    const char* nA = has_next ? PG8_ABASE(nxt.pm) : cA; const char* nB = has_next ? (const char*)g.Bt + (size_t)nxt.pn * tstepB : cB;
    for (int t = 0; t < nt; t += 2) {
      const bool last = (t == nt - 2);
      const char* a1 = cA + (size_t)(t + 1) * kstepA;
      const char* a2 = last ? nA : cA + (size_t)(t + 2) * kstepA; const char* b2 = last ? nB : cB + (size_t)(t + 2) * kstep;
      const char* a3 = a2 + kstepA; const char* b3 = b2 + kstep;
      PG8_LDB(B0, 0, 0); PG8_SCHED; PG8_LDA(At, 0, 0); PG8_STAGE(PG8_SA(1, 1), a1 + hstepA, voffA);
      PG8_WAIT_L(8); PG8_BAR; PG8_WAIT_L(0); PG8_MMA(0, 0, At, B0); PG8_BAR; PG8_SCHED;
      PG8_LDB(B1, 0, 1); PG8_STAGE(PG8_SB(0, 0), b2, voffB);
      PG8_BAR; PG8_WAIT_L(0); PG8_MMA(0, 1, At, B1); PG8_BAR;
      PG8_LDA(At, 0, 1); PG8_STAGE(PG8_SA(0, 0), a2, voffA);
      PG8_BAR; PG8_WAIT_L(0); PG8_MMA(1, 0, At, B0); PG8_BAR; PG8_SCHED;
      PG8_STAGE(PG8_SB(0, 1), b2 + hstepB, voffB);
      PG8_WAIT_V(6); PG8_BAR; PG8_MMA(1, 1, At, B1); PG8_BAR;
      PG8_LDB(B0, 1, 0); PG8_SCHED; PG8_LDA(At, 1, 0); PG8_STAGE(PG8_SA(0, 1), a2 + hstepA, voffA);
      PG8_WAIT_L(8); PG8_BAR; PG8_WAIT_L(0); PG8_MMA(0, 0, At, B0); PG8_BAR; PG8_SCHED;
      PG8_LDB(B1, 1, 1); PG8_STAGE(PG8_SB(1, 0), b3, voffB);
      PG8_BAR; PG8_WAIT_L(0); PG8_MMA(0, 1, At, B1); PG8_BAR;
      PG8_LDA(At, 1, 1); PG8_STAGE(PG8_SA(1, 0), a3, voffA);
      PG8_BAR; PG8_WAIT_L(0); PG8_MMA(1, 0, At, B0); PG8_BAR; PG8_SCHED;
      PG8_STAGE(PG8_SB(1, 1), b3 + hstepB, voffB);
      PG8_WAIT_V(6); PG8_BAR; PG8_MMA(1, 1, At, B1); PG8_BAR;
    }
    E(acc, cur, wr, wc, fr, fq);
    if (!has_next) break;
#pragma unroll
    for (int a = 0; a < 2; ++a)
#pragma unroll
      for (int b = 0; b < 2; ++b)
#pragma unroll
        for (int m = 0; m < 4; ++m)
#pragma unroll
          for (int n = 0; n < 2; ++n) acc[a][b][m][n] = (f32x4){0.f, 0.f, 0.f, 0.f};
    cur = nxt; cA = nA; cB = nB; ++ui;
  }
  PG8_WAIT_V(0);
  if (wr == 0) PG8_BAR;
  PG8_BAR;
#undef PG8_ABASE
#undef PG8_SA
#undef PG8_SB
#undef PG8_STAGE
#undef PG8_LDA
#undef PG8_LDB
#undef PG8_MMA
#undef PG8_WAIT_V
#undef PG8_WAIT_L
#undef PG8_BAR
#undef PG8_SCHED
}

struct EpiBf16 {
  static constexpr bool PERM = true;
  bf16_t* O; int ldc, nvalid;
  DI void operator()(const f32x4 (&acc)[2][2][4][2], const Unit& u, int wr, int wc, int fr, int fq) const {
    const int row0 = u.pm * BM + wr * 64 + fr, col0 = u.pn * BM + wc * 32 + 8 * fq;
#pragma unroll
    for (int ai = 0; ai < 2; ++ai)
#pragma unroll
      for (int m = 0; m < 4; ++m) { bf16_t* rowp = O + (size_t)(row0 + ai * HALF + m * 16) * ldc + col0;
#pragma unroll
        for (int bj = 0; bj < 2; ++bj) if (col0 + bj * HALF < nvalid) {
          const f32x4 v0 = acc[ai][bj][m][0], v1 = acc[ai][bj][m][1];
          u32x4 w; w.x = pack_bf2(v0[0], v0[1]); w.y = pack_bf2(v0[2], v0[3]); w.z = pack_bf2(v1[0], v1[1]); w.w = pack_bf2(v1[2], v1[3]);
          *(u32x4*)(rowp + bj * HALF) = w; } }
  }
};
struct EpiP0 {
  static constexpr bool PERM = true;
  bf16_t* O; const float2* rope;
  DI void operator()(const f32x4 (&acc)[2][2][4][2], const Unit& u, int wr, int wc, int fr, int fq) const {
    const int row0 = u.pm * BM + wr * 64 + fr, col0 = u.pn * BM + wc * 32 + 8 * fq;
    const bool isctx = (u.pm % 17) == 0; const int b = u.pm / 17;
    const bool qk = u.pn < 4;
    const float qs = (u.pn < 2) ? 0.125f * 1.4426950408889634f : 1.f;
    const int a = wc & 1, half = fq >> 1, f0 = 8 * (fq & 1);
#pragma unroll
    for (int ai = 0; ai < 2; ++ai)
#pragma unroll
      for (int m = 0; m < 4; ++m) {
        const int row = row0 + ai * HALF + m * 16;
        bf16_t* rowp = O + (size_t)row * P0LD + col0;
        const int l = row - b * TPB - CTXL;
#pragma unroll
        for (int bj = 0; bj < 2; ++bj) if (col0 + bj * HALF < P0LD) {
          float v[8];
#pragma unroll
          for (int j = 0; j < 4; ++j) { v[j] = acc[ai][bj][m][0][j]; v[4 + j] = acc[ai][bj][m][1][j]; }
          if (qk) {
            float pv[8];
#pragma unroll
            for (int j = 0; j < 8; ++j) pv[j] = __shfl_xor(v[j], 32);
            if (!isctx) {
              const float4* cs4 = (const float4*)(rope + (size_t)l * 32 + a * 16 + f0);
#pragma unroll
              for (int j2 = 0; j2 < 4; ++j2) {
                const float4 cs = cs4[j2];
                v[2 * j2] = half ? (v[2 * j2] * cs.x + pv[2 * j2] * cs.y) : (v[2 * j2] * cs.x - pv[2 * j2] * cs.y);
                v[2 * j2 + 1] = half ? (v[2 * j2 + 1] * cs.z + pv[2 * j2 + 1] * cs.w) : (v[2 * j2 + 1] * cs.z - pv[2 * j2 + 1] * cs.w);
              }
            }
#pragma unroll
            for (int j = 0; j < 8; ++j) v[j] *= qs;
          }
          u32x4 w; w.x = pack_bf2(v[0], v[1]); w.y = pack_bf2(v[2], v[3]); w.z = pack_bf2(v[4], v[5]); w.w = pack_bf2(v[6], v[7]);
          *(u32x4*)(rowp + bj * HALF) = w; } }
  }
};
struct EpiResid {
  static constexpr bool PERM = false;
  const float* x_in; const float* ctx_in; float* out; float* xc; const float* mods; int layer;
  DI void operator()(const f32x4 (&acc)[2][2][4][2], const Unit& u, int wr, int wc, int fr, int fq) const {
    const int row0 = u.pm * BM + wr * 64 + fr, col0 = u.pn * BM + wc * 32 + 4 * fq;
    const bool isctx = (u.pm % 17) == 0; const int b = u.pm / 17;
    const float* gate = mods + (isctx ? 8 : b) * 6144 + 2 * 1024 + col0;
    f32x4 gv[2][2];
#pragma unroll
    for (int bj = 0; bj < 2; ++bj)
#pragma unroll
      for (int n = 0; n < 2; ++n) gv[bj][n] = *(const f32x4*)(gate + bj * HALF + n * 16);
#pragma unroll
    for (int ai = 0; ai < 2; ++ai)
#pragma unroll
      for (int m = 0; m < 4; ++m) {
        const int row = row0 + ai * HALF + m * 16;
        const int t = row - b * TPB;
        const size_t o = isctx ? ((size_t)(b * CTXL + t)) * D + col0 : ((size_t)(b * SEQ + t - CTXL)) * D + col0;
        const float* src = isctx ? ctx_in : ((layer == 0) ? x_in : out);
        float* dst = isctx ? xc : out;
#pragma unroll
        for (int bj = 0; bj < 2; ++bj)
#pragma unroll
          for (int n = 0; n < 2; ++n) {
            const f32x4 xi = *(const f32x4*)(src + o + bj * HALF + n * 16);
            *(f32x4*)(dst + o + bj * HALF + n * 16) = xi + gv[bj][n] * acc[ai][bj][m][n];
          }
      }
  }
};
struct EpiDelta {
  static constexpr bool PERM = true;
  bf16_t* O; const float* mods;
  DI void operator()(const f32x4 (&acc)[2][2][4][2], const Unit& u, int wr, int wc, int fr, int fq) const {
    const int row0 = u.pm * BM + wr * 64 + fr, col0 = u.pn * BM + wc * 32 + 8 * fq;
    const bool isctx = (u.pm % 17) == 0; const int b = u.pm / 17;
    const float* gate = mods + (isctx ? 8 : b) * 6144 + 2 * 1024 + col0;
    f32x4 g0[2], g1[2];
#pragma unroll
    for (int bj = 0; bj < 2; ++bj) { g0[bj] = *(const f32x4*)(gate + bj * HALF); g1[bj] = *(const f32x4*)(gate + bj * HALF + 4); }
#pragma unroll
    for (int ai = 0; ai < 2; ++ai)
#pragma unroll
      for (int m = 0; m < 4; ++m) { bf16_t* rowp = O + (size_t)(row0 + ai * HALF + m * 16) * D + col0;
#pragma unroll
        for (int bj = 0; bj < 2; ++bj) {
          const f32x4 v0 = acc[ai][bj][m][0] * g0[bj], v1 = acc[ai][bj][m][1] * g1[bj];
          u32x4 w; w.x = pack_bf2(v0[0], v0[1]); w.y = pack_bf2(v0[2], v0[3]); w.z = pack_bf2(v1[0], v1[1]); w.w = pack_bf2(v1[2], v1[3]);
          *(u32x4*)(rowp + bj * HALF) = w; } }
  }
};
struct EpiP1 {
  static constexpr bool PERM = true;
  unsigned char* pb;
  DI void operator()(const f32x4 (&acc)[2][2][4][2], const Unit& u, int wr, int wc, int fr, int fq) const {
    unsigned zo = 0;
    asm volatile("" : "+v"(zo));
    const int row0 = u.pm * BM + wr * 64 + fr, col0 = u.pn * BM + wc * 32 + 8 * fq;
    const int b = u.pm / 17;
    const unsigned t0 = (unsigned)(row0 - b * TPB) + zo;
#pragma unroll
    for (int bj = 0; bj < 2; ++bj) {
      const int c = col0 + bj * HALF;
      if (c >= P1LD) continue;
      unsigned off, tstride;
      if (c < 2048) { off = (unsigned)L1_ZH + ((unsigned)(b * 32 + (c >> 6)) * TPB) * 128u + (unsigned)(c & 63) * 2u; tstride = 128u; }
      else if (c < 4096) { const int cc = c - 2048; off = (unsigned)L1_XH + ((unsigned)(b * 32 + (cc >> 6)) * TPB) * 128u + (unsigned)(cc & 63) * 2u; tstride = 128u; }
      else if (c < 4608) { const int cc = c - 4096; off = (unsigned)L1_BG + ((unsigned)(b * 4 + (cc >> 7)) * TPB) * 256u + (unsigned)(cc & 127) * 2u; tstride = 256u; }
      else if (c < 5120) { const int cc = c - 4608; off = (unsigned)L1_CG + ((unsigned)(b * 4 + (cc >> 7)) * TPB) * 256u + (unsigned)(cc & 127) * 2u; tstride = 256u; }
      else { off = (unsigned)L1_DT + (unsigned)b * TPB * 128u + (unsigned)(c - 5120) * 2u; tstride = 128u; }
      off += t0 * tstride;
#pragma unroll
      for (int ai = 0; ai < 2; ++ai)
#pragma unroll
        for (int m = 0; m < 4; ++m) {
          const f32x4 v0 = acc[ai][bj][m][0], v1 = acc[ai][bj][m][1];
          u32x4 w; w.x = pack_bf2(v0[0], v0[1]); w.y = pack_bf2(v0[2], v0[3]); w.z = pack_bf2(v1[0], v1[1]); w.w = pack_bf2(v1[2], v1[3]);
          *(u32x4*)(pb + off + (unsigned)(ai * HALF + m * 16) * tstride) = w;
        }
    }
  }
};
}

DI void transpose_tile(char* lds, const float* __restrict__ src, int K, int N, bf16_t* __restrict__ dst, int tile) {
  float* T = (float*)lds;
  const int ntk = K / 64;
  const int tn = tile / ntk, tk = tile - tn * ntk;
  const int tid = threadIdx.x;
  __syncthreads();
#pragma unroll
  for (int i = 0; i < 2; ++i) {
    const int kk = (tid >> 4) + 32 * i, n4 = (tid & 15) * 4;
    const int n = tn * 64 + n4;
    float4 v = make_float4(0.f, 0.f, 0.f, 0.f);
    if (n < N) v = *(const float4*)(src + (size_t)(tk * 64 + kk) * N + n);
    *(float4*)(T + kk * 68 + n4) = v;
  }
  __syncthreads();
  {
    const int nn = tid & 63, kc = tid >> 6;
    float f[8];
#pragma unroll
    for (int j = 0; j < 8; ++j) f[j] = T[(kc * 8 + j) * 68 + nn];
    *(uint4*)(dst + (size_t)(tn * 64 + nn) * K + tk * 64 + kc * 8) = pack8(f);
  }
}

DI void phase_prep(const P& p, char* lds) {
  const int tid = threadIdx.x;
  unsigned char* ws = p.ws;
  struct TD { int idx; int K, N, Npad; size_t dst; size_t srcoff; };
  int base = 0;
  const int G = gridDim.x;
#define TRANSPOSE_TASK(SRC, KK, NN, NPAD, DST) { const int nt_ = ((NPAD) / 64) * ((KK) / 64); \
    for (int w = blockIdx.x; w < nt_; w += G) transpose_tile(lds, (SRC), (KK), (NN), (bf16_t*)(DST), w); }
  TRANSPOSE_TASK(p.in[I_WIN0], 1024, 3456, 3584, ws + WS_WIN0T)
  TRANSPOSE_TASK(p.in[I_WOUT0], 1024, 1024, 1024, ws + WS_WOUT0T)
  TRANSPOSE_TASK(p.in[I_PQ0], 1024, 2048, 2048, ws + WS_PQ0T)
  TRANSPOSE_TASK(p.in[I_WIN1], 1024, 5184, 5376, ws + WS_WIN1T)
  TRANSPOSE_TASK(p.in[I_WOUT1], 2048, 1024, 1024, ws + WS_WOUT1T)
  TRANSPOSE_TASK(p.in[I_PQ1], 1024, 2048, 2048, ws + WS_PQ1T)
  TRANSPOSE_TASK(p.in[I_RWW2], 64, 512, 512, ws + WS_RWT)
  TRANSPOSE_TASK(p.in[I_RWW2] + 64 * 512, 64, 512, 512, ws + WS_RWT + 65536)
  TRANSPOSE_TASK(p.in[I_RWA2], 64, 512, 512, ws + WS_RWT + 131072)
  TRANSPOSE_TASK(p.in[I_RWA2] + 64 * 512, 64, 512, 512, ws + WS_RWT + 196608)
  TRANSPOSE_TASK(p.in[I_RWG2], 128, 512, 512, ws + WS_RWT + 262144)
  (void)base;
  {
    const int gt = blockIdx.x * NTHR + tid, gs = G * NTHR;
    bf16_t* k0 = (bf16_t*)(ws + WS_KEYS0); bf16_t* k1 = (bf16_t*)(ws + WS_KEYS1);
    for (int i = gt; i < 262144; i += gs) { k0[i] = f2bf(p.in[I_PK0][i]); k1[i] = f2bf(p.in[I_PK1][i]); }
    float2* rope = (float2*)(ws + WS_ROPE);
    for (int i = gt; i < 4096 * 32; i += gs) {
      const int l = i >> 5, a = (i >> 4) & 1, f = i & 15;
      const float inv = powf(10000.f, -(float)f / 16.f);
      const float pos = (float)(a == 0 ? (l >> 6) : (l & 63));
      float s, c; sincosf(pos * inv, &s, &c);
      rope[i] = make_float2(c, s);
    }
    if (gt == 0) {
      const float* lp = p.in[I_DALAM];
      float s01 = 0.f, s23 = 0.f;
      for (int i = 0; i < 64; ++i) { s01 += lp[i] * lp[64 + i]; s23 += lp[128 + i] * lp[192 + i]; }
      ((float*)(ws + WS_SCAL))[0] = expf(s01) - expf(s23) + 0.2f;
    }
  }
  {
    float* sc = (float*)lds;
    float* red = (float*)(lds + 36864);
    __syncthreads();
    for (int e = tid; e < 9 * 1024; e += NTHR) { const int r = e >> 10, k = e & 1023; const float v = (r < 8) ? p.in[I_C][r * 1024 + k] : p.in[I_CCTX][k]; sc[e] = siluf_(v); }
    __syncthreads();
    float* mods = (float*)(ws + WS_MODS);
    for (int w = blockIdx.x; w < 192; w += G) {
      const int l = w / 96, j0 = (w % 96) * 64;
      const float* aw = p.in[l == 0 ? I_ADAW0 : I_ADAW1];
      const float* ab = p.in[l == 0 ? I_ADAB0 : I_ADAB1];
      const int col = tid & 63, kg = tid >> 6;
      float a[9];
#pragma unroll
      for (int r = 0; r < 9; ++r) a[r] = 0.f;
      for (int k = kg * 128; k < kg * 128 + 128; ++k) {
        const float wv = aw[(size_t)k * 6144 + j0 + col];
#pragma unroll
        for (int r = 0; r < 9; ++r) a[r] += sc[r * 1024 + k] * wv;
      }
      __syncthreads();
#pragma unroll
      for (int r = 0; r < 9; ++r) red[(kg * 64 + col) * 9 + r] = a[r];
      __syncthreads();
      for (int e = tid; e < 64 * 9; e += NTHR) {
        const int c2 = e / 9, r = e - c2 * 9;
        float s = ab[j0 + c2];
        for (int g = 0; g < 8; ++g) s += red[(g * 64 + c2) * 9 + r];
        mods[((size_t)l * 9 + r) * 6144 + j0 + c2] = s;
      }
    }
  }
}

DI float wave_max(float x) {
  x = fmaxf(x, dpp_f<0xB1>(x)); x = fmaxf(x, dpp_f<0x4E>(x)); x = fmaxf(x, dpp_f<0x141>(x)); x = fmaxf(x, dpp_f<0x140>(x));
  x = fmaxf(x, __shfl_xor(x, 16)); x = fmaxf(x, __shfl_xor(x, 32)); return x;
}
DI void convert_tables(const P& p, int layer) {
  const int lane = threadIdx.x & 63, gw = blockIdx.x * 8 + (threadIdx.x >> 6), nw = gridDim.x * 8;
  const float* u = p.in[layer == 0 ? I_PU0 : I_PU1];
  const float* v = p.in[layer == 0 ? I_PV0 : I_PV1];
  unsigned char* du = p.ws + WS_HB + HB_U;
  unsigned char* dv = p.ws + WS_HB + HB_V;
  float* su = (float*)(p.ws + WS_HB + HB_SU);
  float* sv = (float*)(p.ws + WS_HB + HB_SV);
  for (int row = gw; row < 32768; row += nw) {
    const bool isv = row >= 16384;
    const int r = row & 16383;
    const float* src = (isv ? v : u) + (size_t)r * D + lane * 16;
    float x[16];
#pragma unroll
    for (int i = 0; i < 4; ++i) { const float4 f = *(const float4*)(src + i * 4); x[i * 4] = f.x; x[i * 4 + 1] = f.y; x[i * 4 + 2] = f.z; x[i * 4 + 3] = f.w; }
    float am = 0.f, ss = 0.f;
#pragma unroll
    for (int i = 0; i < 16; ++i) { am = fmaxf(am, fabsf(x[i])); ss += x[i] * x[i]; }
    am = fmaxf(wave_max(am), 1e-30f);
    ss = red64(ss);
    const float step = fminf(am * (1.f / 7.5f), fmaxf(0.3352f * sqrtf(ss * (1.f / 1024.f)), 1e-30f));
    const float inv = 1.f / step;
    unsigned w[2];
#pragma unroll
    for (int d2 = 0; d2 < 2; ++d2) {
      unsigned pk = 0;
#pragma unroll
      for (int j = 0; j < 8; ++j) {
        int q = (int)rintf(x[d2 * 8 + j] * inv + 7.5f);
        q = q < 0 ? 0 : (q > 15 ? 15 : q);
        pk |= (unsigned)q << (8 * (j >> 1) + 4 * (j & 1));
      }
      w[d2] = pk;
    }
    *(uint2*)((isv ? dv : du) + (size_t)r * 512 + lane * 8) = make_uint2(w[0], w[1]);
    if (lane == 0) (isv ? sv : su)[r] = step;
  }
}

DI void phase_normmod(const P& p, int layer, int which, bool from_inputs, bool lat_only, bf16_t* dst, const bf16_t* delta = nullptr) {
  const int lane = threadIdx.x & 63, gw = blockIdx.x * 8 + (threadIdx.x >> 6), nw = gridDim.x * 8;
  const float* g = p.in[layer == 0 ? (which == 0 ? I_N1_0 : I_N2_0) : (which == 0 ? I_N1_1 : I_N2_1)];
  const float* mods = (const float*)(p.ws + WS_MODS) + (size_t)layer * 9 * 6144;
  const float* xc = (const float*)(p.ws + WS_XC);
  for (int row = gw; row < R; row += nw) {
    const int b = row / TPB, t = row - b * TPB;
    const bool isctx = t < CTXL;
    if (isctx && lat_only) continue;
    const float* src = isctx ? ((from_inputs ? p.in[I_CTX] : xc) + ((size_t)(b * CTXL + t)) * D)
                             : ((from_inputs ? p.in[I_X] : p.out) + ((size_t)(b * SEQ + t - CTXL)) * D);
    const float* mrow = mods + (isctx ? 8 : b) * 6144 + (which == 0 ? 0 : 3 * 1024);
    float v[16];
#pragma unroll
    for (int i = 0; i < 4; ++i) { const float4 f = *(const float4*)(src + lane * 16 + i * 4); v[i * 4] = f.x; v[i * 4 + 1] = f.y; v[i * 4 + 2] = f.z; v[i * 4 + 3] = f.w; }
    if (delta) {
      float dl[8];
      unpack8(*(const uint4*)(delta + (size_t)row * D + lane * 16), dl);
#pragma unroll
      for (int i = 0; i < 8; ++i) v[i] += dl[i];
      unpack8(*(const uint4*)(delta + (size_t)row * D + lane * 16 + 8), dl);
#pragma unroll
      for (int i = 0; i < 8; ++i) v[8 + i] += dl[i];
      float* xo = isctx ? ((float*)(p.ws + WS_XC) + ((size_t)(b * CTXL + t)) * D) : (p.out + ((size_t)(b * SEQ + t - CTXL)) * D);
#pragma unroll
      for (int i = 0; i < 4; ++i) *(float4*)(xo + lane * 16 + i * 4) = make_float4(v[i * 4], v[i * 4 + 1], v[i * 4 + 2], v[i * 4 + 3]);
    }
    float ss = 0.f;
#pragma unroll
    for (int i = 0; i < 16; ++i) ss += v[i] * v[i];
    ss = red64(ss);
    const float rs = rsqrtf(ss * (1.f / 1024.f) + 1e-6f);
    float o[16];
#pragma unroll
    for (int i = 0; i < 16; ++i) { const int c = lane * 16 + i; o[i] = v[i] * rs * g[c] * (1.f + mrow[1024 + c]) + mrow[c]; }
    uint4 w0, w1;
    w0.x = pack_bf2(o[0], o[1]); w0.y = pack_bf2(o[2], o[3]); w0.z = pack_bf2(o[4], o[5]); w0.w = pack_bf2(o[6], o[7]);
    w1.x = pack_bf2(o[8], o[9]); w1.y = pack_bf2(o[10], o[11]); w1.z = pack_bf2(o[12], o[13]); w1.w = pack_bf2(o[14], o[15]);
    *(uint4*)(dst + (size_t)row * D + lane * 16) = w0;
    *(uint4*)(dst + (size_t)row * D + lane * 16 + 8) = w1;
  }
}

DI void phase_final_norm(const P& p) {
  const int lane = threadIdx.x & 63, gw = blockIdx.x * 8 + (threadIdx.x >> 6), nw = gridDim.x * 8;
  const float* g = p.in[I_NF];
  for (int row = gw; row < NB * SEQ; row += nw) {
    float* src = p.out + (size_t)row * D;
    float v[16];
#pragma unroll
    for (int i = 0; i < 4; ++i) { const float4 f = *(const float4*)(src + lane * 16 + i * 4); v[i * 4] = f.x; v[i * 4 + 1] = f.y; v[i * 4 + 2] = f.z; v[i * 4 + 3] = f.w; }
    float ss = 0.f;
#pragma unroll
    for (int i = 0; i < 16; ++i) ss += v[i] * v[i];
    ss = red64(ss);
    const float rs = rsqrtf(ss * (1.f / 1024.f) + 1e-6f);
#pragma unroll
    for (int i = 0; i < 4; ++i) {
      const int c = lane * 16 + i * 4;
      float4 f; f.x = v[i * 4] * rs * g[c]; f.y = v[i * 4 + 1] * rs * g[c + 1]; f.z = v[i * 4 + 2] * rs * g[c + 2]; f.w = v[i * 4 + 3] * rs * g[c + 3];
      *(float4*)(src + c) = f;
    }
  }
}

typedef __attribute__((ext_vector_type(4))) short s16x4;
DI s16x4 tr_read(const char* p) { return __builtin_amdgcn_ds_read_tr16_b64_v4i16((__attribute__((address_space(3))) s16x4*)(p)); }

DI void attn_flash_unit(const P& p, char* lds, int unit) {
  const int tid = threadIdx.x, lane = tid & 63, wave = tid >> 6;
  const bool isctx = unit >= 1024;
  int b, h, qb;
  if (!isctx) { b = unit >> 7; h = (unit >> 5) & 3; qb = unit & 31; } else { const int u = unit - 1024; b = u >> 3; h = (u >> 1) & 3; qb = u & 1; }
  const int nkt = isctx ? CTXL / 64 : TPB / 64;
  const bf16_t* p0 = (const bf16_t*)(p.ws + WS_PB + PB_P);
  const float lam = ((const float*)(p.ws + WS_SCAL))[0];
  const int qg = wave >> 1, m = wave & 1;
  const int r31 = lane & 31, hh = lane >> 5;
  const int ql = qb * 128 + qg * 32 + r31;
  const size_t qrow = (size_t)b * TPB + (isctx ? ql : CTXL + ql);
  bf16x8 qf[4];
#pragma unroll
  for (int kk = 0; kk < 4; ++kk) qf[kk] = *(const bf16x8*)(p0 + qrow * P0LD + h * 128 + m * 64 + kk * 16 + 8 * hh);
  const int skey = tid >> 4, scc = tid & 15;
  const bf16_t* kg = p0 + ((size_t)b * TPB + skey) * P0LD + 512 + h * 128 + scc * 8;
  const bf16_t* vg = kg + 512;
  const int koff = (scc >> 3) * 8192 + skey * 128 + ((((scc & 7) ^ (skey >> 1)) & 7) << 4);
  const int voff = 16384 + skey * 320 + scc * 16;
  constexpr int BUFSZ = 36864;
  uint4 rk[2], rv[2];
  __syncthreads();
#pragma unroll
  for (int i = 0; i < 2; ++i) { rk[i] = *(const uint4*)(kg + (size_t)i * 32 * P0LD); rv[i] = *(const uint4*)(vg + (size_t)i * 32 * P0LD); }
#pragma unroll
  for (int i = 0; i < 2; ++i) { *(uint4*)(lds + koff + i * 4096) = rk[i]; *(uint4*)(lds + voff + i * 10240) = rv[i]; }
  __syncthreads();
  f32x16 o[4];
#pragma unroll
  for (int v = 0; v < 4; ++v)
#pragma unroll
    for (int r = 0; r < 16; ++r) o[v][r] = 0.f;
  float mrun = -1e30f, lsum = 0.f;
  const int q4 = (lane & 15) >> 2;
  const int vboff = ((lane >> 4) & 1) * 32 + 8 * (lane & 3);
  for (int kt = 0; kt < nkt; ++kt) {
    const int cur = kt & 1;
    if (kt + 1 < nkt) {
#pragma unroll
      for (int i = 0; i < 2; ++i) { rk[i] = *(const uint4*)(kg + (size_t)((kt + 1) * 64 + i * 32) * P0LD); rv[i] = *(const uint4*)(vg + (size_t)((kt + 1) * 64 + i * 32) * P0LD); }
    }
    const char* kb = lds + cur * BUFSZ + m * 8192;
    const char* vb = lds + cur * BUFSZ + 16384;
    f32x16 s[2];
#pragma unroll
    for (int t = 0; t < 2; ++t)
#pragma unroll
      for (int r = 0; r < 16; ++r) s[t][r] = 0.f;
#pragma unroll
    for (int kk = 0; kk < 4; ++kk)
#pragma unroll
      for (int t = 0; t < 2; ++t) {
        const int row = t * 32 + r31;
        const bf16x8 a = *(const bf16x8*)(kb + row * 128 + ((((kk * 2 + hh) ^ (row >> 1)) & 7) << 4));
        s[t] = MFMA32(a, qf[kk], s[t]);
      }
    float mx = s[0][0];
#pragma unroll
    for (int t = 0; t < 2; ++t)
#pragma unroll
      for (int r = 0; r < 16; ++r) mx = fmaxf(mx, s[t][r]);
    mx = fmaxf(mx, __shfl_xor(mx, 32));
    const float mnew = fmaxf(mrun, mx);
    const float corr = __builtin_amdgcn_exp2f(mrun - mnew);
    mrun = mnew;
    lsum *= corr;
#pragma unroll
    for (int v = 0; v < 4; ++v)
#pragma unroll
      for (int r = 0; r < 16; ++r) o[v][r] *= corr;
#pragma unroll
    for (int t = 0; t < 2; ++t)
#pragma unroll
      for (int r = 0; r < 16; ++r) { const float e = __builtin_amdgcn_exp2f(s[t][r] - mnew); s[t][r] = e; lsum += e; }
#pragma unroll
    for (int t = 0; t < 2; ++t)
#pragma unroll
      for (int st = 0; st < 2; ++st) {
        unsigned pk[4];
#pragma unroll
        for (int j = 0; j < 4; ++j) pk[j] = pack_bf2(s[t][8 * st + 2 * j], s[t][8 * st + 2 * j + 1]);
        bf16x8 bp;
        { typedef __attribute__((ext_vector_type(4))) unsigned u32x4; u32x4 u = {pk[0], pk[1], pk[2], pk[3]}; bp = __builtin_bit_cast(bf16x8, u); }
        const int key0 = t * 32 + 16 * st + 4 * hh + q4;
#pragma unroll
        for (int v = 0; v < 4; ++v) {
          const s16x4 lo = tr_read(vb + key0 * 320 + v * 64 + vboff);
          const s16x4 hi = tr_read(vb + (key0 + 8) * 320 + v * 64 + vboff);
          const bf16x8 av = __builtin_shufflevector(lo, hi, 0, 1, 2, 3, 4, 5, 6, 7);
          o[v] = MFMA32(av, bp, o[v]);
        }
      }
    if (kt + 1 < nkt) {
      char* nb = lds + (cur ^ 1) * BUFSZ;
#pragma unroll
      for (int i = 0; i < 2; ++i) { *(uint4*)(nb + koff + i * 4096) = rk[i]; *(uint4*)(nb + voff + i * 10240) = rv[i]; }
    }
    __syncthreads();
  }
  lsum += __shfl_xor(lsum, 32);
  const float inv = 1.f / lsum;
  float* Ex = (float*)lds;
  if (m == 1) {
#pragma unroll
    for (int v = 0; v < 4; ++v)
#pragma unroll
      for (int r = 0; r < 16; ++r) Ex[(qg * 128 + v * 32 + ACC_ROW(r, lane)) * 32 + r31] = o[v][r] * inv;
  }
  __syncthreads();
  if (m == 0) {
    float ss = 0.f;
#pragma unroll
    for (int v = 0; v < 4; ++v)
#pragma unroll
      for (int r = 0; r < 16; ++r) { const float dv = o[v][r] * inv - lam * Ex[(qg * 128 + v * 32 + ACC_ROW(r, lane)) * 32 + r31]; o[v][r] = dv; ss += dv * dv; }
    ss += __shfl_xor(ss, 32);
    const float rs = rsqrtf(ss * (1.f / 128.f) + 1e-6f) * 0.8f;
    const float* sub = p.in[I_DASUB];
    bf16_t* op = (bf16_t*)(p.ws + WS_PB + PB_O0) + qrow * 1024 + h * 128;
#pragma unroll
    for (int v = 0; v < 4; ++v)
#pragma unroll
      for (int g4 = 0; g4 < 4; ++g4) {
        const int vd = v * 32 + 8 * g4 + 4 * hh;
        uint2 w;
        w.x = pack_bf2(o[v][g4 * 4] * rs * sub[vd], o[v][g4 * 4 + 1] * rs * sub[vd + 1]);
        w.y = pack_bf2(o[v][g4 * 4 + 2] * rs * sub[vd + 2], o[v][g4 * 4 + 3] * rs * sub[vd + 3]);
        *(uint2*)(op + vd) = w;
      }
  }
  __syncthreads();
}

DI void phase_ga(const P& p) {
  const bf16_t* p0 = (const bf16_t*)(p.ws + WS_PB + PB_P);
  bf16_t* ga = (bf16_t*)(p.ws + WS_PB + PB_GA);
  const float* mu = p.in[I_RWMU] + 1792;
  for (int i = blockIdx.x * NTHR + threadIdx.x; i < R * 16; i += gridDim.x * NTHR) {
    const int row = i >> 4, c8 = (i & 15) * 8;
    const int t = row % TPB;
    const bool first = (t == 0) || (t == CTXL), last = (t == CTXL - 1) || (t == TPB - 1);
    const bf16_t* sp = p0 + (size_t)row * P0LD + 1536 + 1792 + c8;
    float u[8], um[8], up[8];
    unpack8(*(const uint4*)sp, u);
    if (!first) unpack8(*(const uint4*)(sp - P0LD), um); else { for (int j = 0; j < 8; ++j) um[j] = 0.f; }
    if (!last) unpack8(*(const uint4*)(sp + P0LD), up); else { for (int j = 0; j < 8; ++j) up[j] = 0.f; }
    float o[8];
#pragma unroll
    for (int j = 0; j < 8; ++j) { const float mix = u[j] + mu[c8 + j] * (0.5f * (um[j] + up[j]) - u[j]); o[j] = sigmoidf_(mix); }
    *(uint4*)(ga + (size_t)row * 128 + c8) = pack8(o);
  }
}

DI int scan_token(int d, int s) { return d == 0 ? s : (s < CTXL ? (CTXL - 1 - s) : (TPB + CTXL - 1 - s)); }

typedef __attribute__((ext_vector_type(4))) float f32x4_t;
DI void rwkv_scan_unit(const P& p, char* lds, int unit) {
  int tid_ = threadIdx.x;
  asm volatile("" : "+v"(tid_));
  const int tid = tid_, lane = tid & 63, wave = __builtin_amdgcn_readfirstlane(tid >> 6);
  const int half = unit & 1, d = (unit >> 1) & 1, h = (unit >> 2) & 7, b = unit >> 5;
  constexpr int T = 32, NCHK = TPB / T, BUFB = 45056;
  const bf16_t* p0 = (const bf16_t*)(p.ws + WS_PB + PB_P);
  __syncthreads();
  {
    const bf16_t* w2t = (const bf16_t*)(p.ws + WS_RWT + (size_t)d * 65536) + h * 64 * 64;
    const bf16_t* a2t = (const bf16_t*)(p.ws + WS_RWT + 131072 + (size_t)d * 65536) + h * 64 * 64;
    *(uint4*)(lds + 139264 + tid * 16) = *(const uint4*)(w2t + tid * 8);
    *(uint4*)(lds + 147456 + tid * 16) = *(const uint4*)(a2t + tid * 8);
    float* LC = (float*)(lds + 155648);
    for (int e = tid; e < 640; e += NTHR) {
      const int g = e >> 6, cidx = e & 63;
      float v;
      if (g == 0) v = p.in[I_RWW0][d * 512 + h * 64 + cidx];
      else if (g == 1) v = p.in[I_RWA0][d * 512 + h * 64 + cidx];
      else if (g == 2) v = p.in[I_RWKK][h * 64 + cidx];
      else if (g == 3) v = p.in[I_RWKA][h * 64 + cidx];
      else if (g == 4) v = p.in[I_RWRK][h * 64 + cidx];
      else if (g < 8) v = p.in[I_RWMU][(g - 5) * 512 + h * 64 + cidx];
      else v = p.in[I_RWMU][(g == 8 ? 1536 : 1664) + d * 64 + cidx];
      LC[e] = v;
    }
  }
  __syncthreads();
  if (wave < 4) {
    const int rp = tid >> 4, c16 = tid & 15, c4 = c16 * 4;
    typedef float f32x2 __attribute__((ext_vector_type(2)));
    f32x2 S0a = {0.f, 0.f}, S0b = {0.f, 0.f}, S1a = {0.f, 0.f}, S1b = {0.f, 0.f};
    bf16_t* yout = (bf16_t*)(p.ws + WS_HB + (d == 0 ? HB_YF : HB_YB)) + h * 64 + half * 32 + wave * 8 + (lane & 7);
    SEGR_DECL();
    __syncthreads();
    SEGR_INIT();
    for (int c = 0; c < NCHK; ++c) {
      int zo = 0;
      asm volatile("" : "+v"(zo));
      const char* B0 = lds + (c & 1) * BUFB + zo;
      float* Lyp = (float*)(lds + 122880 + zo);
      const float* La = (const float*)B0 + c4; const float* Lb = (const float*)(B0 + 8192) + c4; const float* Lk = (const float*)(B0 + 16384) + c4;
      const float* Lw = (const float*)(B0 + 24576) + c4; const float* Lr = (const float*)(B0 + 32768) + c4; const float* Lv = (const float*)(B0 + 40960) + rp * 2;
#define RW_LD(s_, A_, B_, K_, W_, R_, V_) const float4 A_ = *(const float4*)(La + (s_) * 64), B_ = *(const float4*)(Lb + (s_) * 64), K_ = *(const float4*)(Lk + (s_) * 64), \
          W_ = *(const float4*)(Lw + (s_) * 64), R_ = *(const float4*)(Lr + (s_) * 64); const float2 V_ = *(const float2*)(Lv + (s_) * 32)
      float4 a4, b4, k4, w4, r4, a4n, b4n, k4n, w4n, r4n; float2 v2, v2n;
      { RW_LD(0, xa, xb, xk, xw, xr, xv); a4 = xa; b4 = xb; k4 = xk; w4 = xw; r4 = xr; v2 = xv; }
      { RW_LD(1, xa, xb, xk, xw, xr, xv); a4n = xa; b4n = xb; k4n = xk; w4n = xw; r4n = xr; v2n = xv; }
#pragma unroll 1
      for (int g8 = 0; g8 < 4; ++g8) {
#pragma unroll
        for (int si = 0; si < 8; ++si) {
          const int s2 = (g8 * 8 + si + 2) & 31;
          RW_LD(s2, a4f, b4f, k4f, w4f, r4f, v2f);
          const f32x2 a01 = {a4.x, a4.y}, a23 = {a4.z, a4.w}, b01 = {b4.x, b4.y}, b23 = {b4.z, b4.w}, k01 = {k4.x, k4.y}, k23 = {k4.z, k4.w};
          const f32x2 w01 = {w4.x, w4.y}, w23 = {w4.z, w4.w}, r01 = {r4.x, r4.y}, r23 = {r4.z, r4.w};
          const f32x2 t0 = S0a * a01 + S0b * a23, t1 = S1a * a01 + S1b * a23;
          float sa0 = t0.x + t0.y, sa1 = t1.x + t1.y;
          const f32x2 vv0 = {v2.x, v2.x}, vv1 = {v2.y, v2.y};
          const f32x2 u0a = S0a * w01 + vv0 * k01, u0b = S0b * w23 + vv0 * k23, u1a = S1a * w01 + vv1 * k01, u1b = S1b * w23 + vv1 * k23;
          sa0 = red16(sa0); sa1 = red16(sa1);
          const f32x2 s0 = {sa0, sa0}, s1 = {sa1, sa1};
          S0a = s0 * b01 + u0a; S0b = s0 * b23 + u0b; S1a = s1 * b01 + u1a; S1b = s1 * b23 + u1b;
          const f32x2 y0 = S0a * r01 + S0b * r23, y1 = S1a * r01 + S1b * r23;
          Lyp[(si * 32 + rp * 2) * 16 + c16] = y0.x + y0.y;
          Lyp[(si * 32 + rp * 2 + 1) * 16 + c16] = y1.x + y1.y;
          a4 = a4n; b4 = b4n; k4 = k4n; w4 = w4n; r4 = r4n; v2 = v2n;
          a4n = a4f; b4n = b4f; k4n = k4f; w4n = w4f; r4n = r4f; v2n = v2f;
        }
        __builtin_amdgcn_wave_barrier();
        asm volatile("s_waitcnt lgkmcnt(0)" ::: "memory");
        {
          const int sj = lane >> 3, ri = lane & 7;
          const float4* pp = (const float4*)(Lyp + (sj * 32 + wave * 8 + ri) * 16);
          const float4 q0 = pp[0], q1 = pp[1], q2 = pp[2], q3 = pp[3];
          const float ysum = ((q0.x + q0.y) + (q0.z + q0.w)) + ((q1.x + q1.y) + (q1.z + q1.w)) + ((q2.x + q2.y) + (q2.z + q2.w)) + ((q3.x + q3.y) + (q3.z + q3.w));
          const int t = scan_token(d, c * T + g8 * 8 + sj);
          yout[((size_t)b * TPB + t) * 512] = f2bf(ysum);
        }
        asm volatile("s_waitcnt lgkmcnt(0)" ::: "memory");
        __builtin_amdgcn_wave_barrier();
      }
      SEGR_ADD(0);
      __syncthreads();
      SEGR_ADD(1);
    }
    SEGR_FLUSH(0);
  } else {
    const int pw = wave - 4;
    const int tok = lane >> 3, cg8 = (lane & 7) * 8;
    const int colsb[5] = {h * 64 + cg8, 512 + h * 64 + cg8, 1024 + h * 64 + cg8, 1536 + d * 64 + cg8, 1664 + d * 64 + cg8};
    const int n16 = lane & 15, q16 = lane >> 4;
    float* bonus = (float*)(p.ws + WS_PB + PB_BONUS) + (size_t)d * R * 8;
    uint4 raw[5][3];
    float fm = 1.f, fp_ = 1.f;
#define RW_ISSUE(CH) do { \
      const int t_ = scan_token(d, (CH) * T + pw * 8 + tok); \
      const bool first_ = (t_ == 0) || (t_ == CTXL), last_ = (t_ == CTXL - 1) || (t_ == TPB - 1); \
      fm = first_ ? 0.f : 1.f; fp_ = last_ ? 0.f : 1.f; \
      const bf16_t* rowp_ = p0 + ((size_t)b * TPB + t_) * P0LD + 1536; \
      const bf16_t* rowm_ = first_ ? rowp_ : rowp_ - P0LD; \
      const bf16_t* rowq_ = last_ ? rowp_ : rowp_ + P0LD; \
      _Pragma("unroll") for (int g_ = 0; g_ < 5; ++g_) { raw[g_][0] = *(const uint4*)(rowm_ + colsb[g_]); raw[g_][1] = *(const uint4*)(rowp_ + colsb[g_]); raw[g_][2] = *(const uint4*)(rowq_ + colsb[g_]); } \
    } while (0)
    RW_ISSUE(0);
    SEGR_DECL();
    SEGR_INIT();
    for (int c = 0; c < NCHK; ++c) {
      int zo = 0;
      asm volatile("" : "+v"(zo));
      char* PS = lds + 90112 + pw * 8192 + zo;
      float* Pk = (float*)PS; bf16_t* PA = (bf16_t*)(PS + 2048); bf16_t* PBa = (bf16_t*)(PS + 4096); float* Pinv = (float*)(PS + 6144);
      const float* LCc = (const float*)(lds + 155648 + zo);
      char* B0 = lds + (c & 1) * BUFB + zo;
      float* La = (float*)B0; float* Lb = (float*)(B0 + 8192); float* Lk = (float*)(B0 + 16384);
      float* Lw = (float*)(B0 + 24576); float* Lr = (float*)(B0 + 32768); float* Lv = (float*)(B0 + 40960);
      const int sl = pw * 8 + tok;
      {
#define RW_MIX(G, OUT) do { float u_[8], um_[8], up_[8]; unpack8(raw[G][1], u_); unpack8(raw[G][0], um_); unpack8(raw[G][2], up_); \
          const float4 m0_ = *(const float4*)(LCc + (5 + G) * 64 + cg8), m1_ = *(const float4*)(LCc + (5 + G) * 64 + cg8 + 4); \
          const float mm_[8] = {m0_.x, m0_.y, m0_.z, m0_.w, m1_.x, m1_.y, m1_.z, m1_.w}; \
          _Pragma("unroll") for (int j = 0; j < 8; ++j) OUT[j] = u_[j] + mm_[j] * (0.5f * (fm * um_[j] + fp_ * up_[j]) - u_[j]); } while (0)
        float mx[8];
        RW_MIX(0, mx);
        *(float4*)(Lr + sl * 64 + cg8) = make_float4(mx[0], mx[1], mx[2], mx[3]);
        *(float4*)(Lr + sl * 64 + cg8 + 4) = make_float4(mx[4], mx[5], mx[6], mx[7]);
        RW_MIX(2, mx);
        if ((cg8 >> 5) == half) {
          *(float4*)(Lv + sl * 32 + (cg8 & 31)) = make_float4(mx[0], mx[1], mx[2], mx[3]);
          *(float4*)(Lv + sl * 32 + (cg8 & 31) + 4) = make_float4(mx[4], mx[5], mx[6], mx[7]);
        }
        RW_MIX(3, mx);
        {
          float tw[8];
#pragma unroll
          for (int j = 0; j < 8; ++j) tw[j] = 1.f - 2.f * frcp_(1.f + __expf(2.f * mx[j]));
          *(uint4*)(PA + tok * 64 + cg8) = pack8(tw);
        }
        RW_MIX(4, mx);
        *(uint4*)(PBa + tok * 64 + cg8) = pack8(mx);
        RW_MIX(1, mx);
        *(float4*)(Pk + tok * 64 + cg8) = make_float4(mx[0], mx[1], mx[2], mx[3]);
        *(float4*)(Pk + tok * 64 + cg8 + 4) = make_float4(mx[4], mx[5], mx[6], mx[7]);
        float nrm = 0.f;
        {
          const float4 q0 = *(const float4*)(LCc + 2 * 64 + cg8), q1 = *(const float4*)(LCc + 2 * 64 + cg8 + 4);
          const float kk8[8] = {q0.x, q0.y, q0.z, q0.w, q1.x, q1.y, q1.z, q1.w};
#pragma unroll
          for (int j = 0; j < 8; ++j) { const float kq = mx[j] * kk8[j]; nrm += kq * kq; }
        }
        nrm = red8(nrm);
        if ((lane & 7) == 0) Pinv[tok] = __builtin_amdgcn_rsqf(fmaxf(nrm, 1e-24f));
        if (c + 1 < NCHK) RW_ISSUE(c + 1);
#undef RW_MIX
      }
      __builtin_amdgcn_wave_barrier();
      asm volatile("s_waitcnt lgkmcnt(0)" ::: "memory");
      SEGR_ADD(2);
      {
        float bon[2] = {0.f, 0.f};
        const int hq = lane >> 5, qq = (lane >> 4) & 1;
#pragma unroll
        for (int gsel = 0; gsel < 2; ++gsel) {
          const bf16_t* Asrc = (gsel == 0 ? PA : PBa) + n16 * 64 + q16 * 8;
          const bf16_t* Wsrc = (const bf16_t*)(lds + (gsel == 0 ? 139264 : 147456) + zo) + n16 * 64 + q16 * 8;
#pragma unroll
          for (int nt = 0; nt < 4; ++nt) {
            f32x4_t acc = {0.f, 0.f, 0.f, 0.f};
#pragma unroll
            for (int ks = 0; ks < 2; ++ks) {
              const bf16x8 af = *(const bf16x8*)(Asrc + ks * 32);
              const bf16x8 bf = *(const bf16x8*)(Wsrc + nt * 16 * 64 + ks * 32);
              acc = __builtin_amdgcn_mfma_f32_16x16x32_bf16(af, bf, acc, 0, 0, 0);
            }
            float xv[2];
            xv[0] = __uint_as_float(__builtin_amdgcn_permlane32_swap(__float_as_uint(acc[0]), __float_as_uint(acc[2]), false, false)[0]);
            xv[1] = __uint_as_float(__builtin_amdgcn_permlane32_swap(__float_as_uint(acc[1]), __float_as_uint(acc[3]), false, false)[0]);
            const int col = nt * 16 + n16;
            const float bias = LCc[gsel * 64 + col];
            const float kkc_ = LCc[2 * 64 + col], kac_ = LCc[3 * 64 + col], rkc_ = LCc[4 * 64 + col];
#pragma unroll
            for (int r = 0; r < 2; ++r) {
              const int tk = qq * 4 + hq * 2 + r, so = (pw * 8 + tk) * 64 + col;
              if (gsel == 0) { Lw[so] = __expf(-0.6065306597126334f * sigmoidf_(xv[r] + bias)); }
              else {
                const float as = sigmoidf_(xv[r] + bias);
                const float k = Pk[tk * 64 + col];
                const float kkv = k * kkc_ * Pinv[tk];
                La[so] = -kkv; Lb[so] = kkv * as;
                const float kd = k * (1.f + (as - 1.f) * kac_);
                Lk[so] = kd;
                bon[r] += Lr[so] * kd * rkc_;
              }
            }
          }
        }
#pragma unroll
        for (int r = 0; r < 2; ++r) bon[r] = red16(bon[r]);
        if (half == 0 && n16 == 0) {
#pragma unroll
          for (int r = 0; r < 2; ++r) {
            const int t = scan_token(d, c * T + pw * 8 + qq * 4 + hq * 2 + r);
            bonus[((size_t)b * TPB + t) * 8 + h] = bon[r];
          }
        }
      }
      SEGR_ADD(3);
      __syncthreads();
      SEGR_ADD(1);
    }
#if defined(PROBE_A) && PROBE_GRP == 1
    if (blockIdx.x == 0 && threadIdx.x == 256) { for (int j__ = 1; j__ < 4; ++j__) ((unsigned long long*)(p.ws + WS_SCAL + 1024))[22 + 4 + j__] += seg_acc_[j__]; }
#endif
    __syncthreads();
#undef RW_ISSUE
  }
}

DI void phase_rwkv_post(const P& p) {
  const bf16_t* p0 = (const bf16_t*)(p.ws + WS_PB + PB_P);
  const bf16_t* yf = (const bf16_t*)(p.ws + WS_HB + HB_YF);
  const bf16_t* yb = (const bf16_t*)(p.ws + WS_HB + HB_YB);
  const bf16_t* G = (const bf16_t*)(p.ws + WS_PB + PB_G);
  const float* bonus = (const float*)(p.ws + WS_PB + PB_BONUS);
  bf16_t* o0 = (bf16_t*)(p.ws + WS_PB + PB_O0);
  const float* mu = p.in[I_RWMU] + 1024;
  const int sub = threadIdx.x & 7;
  for (int it = (blockIdx.x * NTHR + threadIdx.x) >> 3; it < R * 8; it += (gridDim.x * NTHR) >> 3) {
    const int row = it >> 3, h = it & 7;
    const int t = row % TPB;
    const bool first = (t == 0) || (t == CTXL), last = (t == CTXL - 1) || (t == TPB - 1);
    const int cc = h * 64 + sub * 8;
    float y[8], a[8], bb[8];
    unpack8(*(const uint4*)(yf + (size_t)row * 512 + cc), a);
    unpack8(*(const uint4*)(yb + (size_t)row * 512 + cc), bb);
    float mean = 0.f;
#pragma unroll
    for (int j = 0; j < 8; ++j) { y[j] = a[j] + bb[j]; mean += y[j]; }
    mean = red8(mean) * (1.f / 64.f);
    float var = 0.f;
#pragma unroll
    for (int j = 0; j < 8; ++j) { const float dlt = y[j] - mean; var += dlt * dlt; }
    var = red8(var) * (1.f / 64.f);
    const float rs = rsqrtf(var + 64e-5f);
    const float bn = bonus[(size_t)row * 8 + h] + bonus[(size_t)R * 8 + (size_t)row * 8 + h];
    const bf16_t* vp = p0 + (size_t)row * P0LD + 1536 + 1024 + cc;
    float u[8], um[8], up[8], g[8], o[8];
    unpack8(*(const uint4*)vp, u);
    unpack8(*(const uint4*)(first ? vp : vp - P0LD), um);
    unpack8(*(const uint4*)(last ? vp : vp + P0LD), up);
    unpack8(*(const uint4*)(G + (size_t)row * 512 + cc), g);
    const float fm = first ? 0.f : 1.f, fp_ = last ? 0.f : 1.f;
#pragma unroll
    for (int j = 0; j < 8; ++j) {
      const float v = u[j] + mu[cc + j] * (0.5f * (fm * um[j] + fp_ * up[j]) - u[j]);
      const float yn = (y[j] - mean) * rs * p.in[I_LNXW][cc + j] + p.in[I_LNXB][cc + j];
      o[j] = (yn + bn * v) * g[j];
    }
    *(uint4*)(o0 + (size_t)row * 1024 + 512 + cc) = pack8(o);
  }
}

DI unsigned f2ord(float f) { const unsigned u = __float_as_uint(f); return u ^ ((u >> 31) ? 0xFFFFFFFFu : 0x80000000u); }
DI float ord2f(unsigned u) { u ^= ((u >> 31) ? 0x80000000u : 0xFFFFFFFFu); return __uint_as_float(u); }

DI void bitonic_sort16_desc(unsigned (&v)[16]) {
#pragma unroll
  for (int k = 2; k <= 16; k <<= 1)
#pragma unroll
    for (int j = k >> 1; j > 0; j >>= 1)
#pragma unroll
      for (int i = 0; i < 16; ++i) {
        const int l = i ^ j;
        if (l > i) { const unsigned hi = max(v[i], v[l]), lo = min(v[i], v[l]); const bool desc = ((i & k) == 0); v[i] = desc ? hi : lo; v[l] = desc ? lo : hi; }
      }
}
DI void merge_top16_desc(unsigned (&a)[16], const unsigned (&b)[16]) {
#pragma unroll
  for (int i = 0; i < 16; ++i) a[i] = max(a[i], b[15 - i]);
#pragma unroll
  for (int j = 8; j > 0; j >>= 1)
#pragma unroll
    for (int i = 0; i < 16; ++i) { const int l = i ^ j; if (l > i) { const unsigned hi = max(a[i], a[l]), lo = min(a[i], a[l]); a[i] = hi; a[l] = lo; } }
}
struct CandPairs { int ia[25], ja[25], ib[25], jb[25]; };
constexpr CandPairs make_pairs() {
  CandPairs c{};
  int n = 0;
  for (int i = 0; i < 16; ++i) for (int j = 0; j < 16; ++j) if ((i + 1) * (j + 1) <= 16) {
    if ((n & 1) == 0) { c.ia[n >> 1] = i; c.ja[n >> 1] = j; } else { c.ib[n >> 1] = i; c.jb[n >> 1] = j; }
    ++n;
  }
  return c;
}
constexpr CandPairs CP = make_pairs();

DI void peer_topk_unit(const P& p, char* lds, int layer, int unit) {
  const int tid = threadIdx.x, lane = tid & 63, wave = tid >> 6;
  const int mt = unit >> 3, h = unit & 7;
  const bf16_t* q = (const bf16_t*)(p.ws + WS_PB + PB_Q);
  const bf16_t* keys = (const bf16_t*)(p.ws + (layer == 0 ? WS_KEYS0 : WS_KEYS1)) + (size_t)h * 2 * 128 * 128;
  int* idxo = (int*)(p.ws + WS_PB + PB_IDX);
  float* gateo = (float*)(p.ws + WS_PB + PB_GATE);
  __syncthreads();
  for (int e = tid; e < 2 * 128 * 16; e += NTHR) {
    const int pp = e >> 11, row = (e >> 4) & 127, c = e & 15;
    *(uint4*)(lds + pp * 32768 + row * 256 + ((c ^ (row & 15)) << 4)) = *(const uint4*)(keys + (size_t)pp * 16384 + row * 128 + c * 8);
  }
  __syncthreads();
  const int r31 = lane & 31, hh = lane >> 5;
  const size_t trow = (size_t)mt * 256 + wave * 32 + r31;
  unsigned vk[2][16];
#pragma unroll
  for (int pp = 0; pp < 2; ++pp) {
    f32x16 acc[4];
#pragma unroll
    for (int m = 0; m < 4; ++m)
#pragma unroll
      for (int r = 0; r < 16; ++r) acc[m][r] = 0.f;
    const bf16_t* qp = q + trow * 2048 + (h * 2 + pp) * 128;
#pragma unroll
    for (int kk = 0; kk < 8; ++kk) {
      const bf16x8 bq = *(const bf16x8*)(qp + kk * 16 + 8 * hh);
      const int c = kk * 2 + hh;
#pragma unroll
      for (int m = 0; m < 4; ++m) {
        const int row = m * 32 + r31;
        const bf16x8 ak = *(const bf16x8*)(lds + pp * 32768 + row * 256 + ((c ^ (row & 15)) << 4));
        acc[m] = MFMA32(ak, bq, acc[m]);
      }
    }
    unsigned v[16];
#pragma unroll
    for (int m = 0; m < 4; ++m) {
      unsigned kx[16];
#pragma unroll
      for (int r = 0; r < 16; ++r) kx[r] = (f2ord(acc[m][r]) & ~127u) | (unsigned)(127 - (m * 32 + ACC_ROW(r, lane)));
      bitonic_sort16_desc(kx);
      if (m == 0) {
#pragma unroll
        for (int i = 0; i < 16; ++i) v[i] = kx[i];
      } else merge_top16_desc(v, kx);
    }
    unsigned c16[16];
#pragma unroll
    for (int i = 0; i < 16; ++i) c16[i] = (unsigned)__shfl_xor((int)v[i], 32);
    merge_top16_desc(v, c16);
#pragma unroll
    for (int i = 0; i < 16; ++i) vk[pp][i] = v[i];
  }
  float val1[16], val2[16]; int id1[16], id2[16];
#pragma unroll
  for (int i = 0; i < 16; ++i) {
    val1[i] = ord2f(vk[0][i] & ~127u); id1[i] = 127 - (int)(vk[0][i] & 127u);
    val2[i] = ord2f(vk[1][i] & ~127u); id2[i] = 127 - (int)(vk[1][i] & 127u);
  }
  unsigned tk[16];
#pragma unroll
  for (int t = 0; t < 16; ++t) {
    const float va = val1[CP.ia[t]] + val2[CP.ja[t]], vb = val1[CP.ib[t]] + val2[CP.jb[t]];
    const int pa = id1[CP.ia[t]] * 128 + id2[CP.ja[t]], pb = id1[CP.ib[t]] * 128 + id2[CP.jb[t]];
    tk[t] = (f2ord(hh ? vb : va) & ~0x3FFFu) | (unsigned)(hh ? pb : pa);
  }
  bitonic_sort16_desc(tk);
#pragma unroll
  for (int t = 16; t < 25; ++t) {
    const float va = val1[CP.ia[t]] + val2[CP.ja[t]], vb = val1[CP.ib[t]] + val2[CP.jb[t]];
    const int pa = id1[CP.ia[t]] * 128 + id2[CP.ja[t]], pb = id1[CP.ib[t]] * 128 + id2[CP.jb[t]];
    unsigned x = (f2ord(hh ? vb : va) & ~0x3FFFu) | (unsigned)(hh ? pb : pa);
#pragma unroll
    for (int i = 0; i < 16; ++i) { const unsigned hi = max(tk[i], x); x = min(tk[i], x); tk[i] = hi; }
  }
  float cv[16]; int cp[16];
  float mx = -3.0e38f;
#pragma unroll
  for (int i = 0; i < 16; ++i) {
    const unsigned ok = (unsigned)__shfl_xor((int)tk[15 - i], 32);
    const unsigned kk_ = max(tk[i], ok);
    cv[i] = ord2f(kk_ & ~0x3FFFu); cp[i] = (int)(kk_ & 0x3FFFu);
    mx = fmaxf(mx, cv[i]);
  }
  float sum = 0.f;
#pragma unroll
  for (int i = 0; i < 16; ++i) { cv[i] = __expf(cv[i] - mx); sum += cv[i]; }
  const float inv = 1.f / sum;
  if (hh == 0) {
    int* ip = idxo + trow * 128 + h * 16;
    float* gp = gateo + trow * 128 + h * 16;
#pragma unroll
    for (int i = 0; i < 4; ++i) {
      *(int4*)(ip + i * 4) = make_int4(cp[i * 4], cp[i * 4 + 1], cp[i * 4 + 2], cp[i * 4 + 3]);
      *(float4*)(gp + i * 4) = make_float4(cv[i * 4] * inv, cv[i * 4 + 1] * inv, cv[i * 4 + 2] * inv, cv[i * 4 + 3] * inv);
    }
  }
}

DI int wave_sum_i(int x) {
  x += __builtin_amdgcn_update_dpp(0, x, 0xB1, 0xF, 0xF, true);
  x += __builtin_amdgcn_update_dpp(0, x, 0x4E, 0xF, 0xF, true);
  x += __builtin_amdgcn_update_dpp(0, x, 0x141, 0xF, 0xF, true);
  x += __builtin_amdgcn_update_dpp(0, x, 0x140, 0xF, 0xF, true);
  return __builtin_amdgcn_readlane(x, 0) + __builtin_amdgcn_readlane(x, 16) + __builtin_amdgcn_readlane(x, 32) + __builtin_amdgcn_readlane(x, 48);
}
DI int reduce8_transposed(const int (&v)[8], int lane) {
  int x[4], y[2];
#pragma unroll
  for (int j = 0; j < 4; ++j) { const auto r = __builtin_amdgcn_permlane32_swap((unsigned)v[j], (unsigned)v[4 + j], false, false); x[j] = (int)(r[0] + r[1]); }
#pragma unroll
  for (int j = 0; j < 2; ++j) { const auto r = __builtin_amdgcn_permlane16_swap((unsigned)x[j], (unsigned)x[2 + j], false, false); y[j] = (int)(r[0] + r[1]); }
  const bool b3 = (lane >> 3) & 1;
  const int keep = b3 ? y[1] : y[0], send = b3 ? y[0] : y[1];
  int z = keep + __builtin_amdgcn_update_dpp(0, send, 0x128, 0xF, 0xF, true);
  z += __builtin_amdgcn_update_dpp(0, z, 0xB1, 0xF, 0xF, true);
  z += __builtin_amdgcn_update_dpp(0, z, 0x4E, 0xF, 0xF, true);
  z += __builtin_amdgcn_update_dpp(0, z, 0x141, 0xF, 0xF, true);
  return z;
}
DI float gelu_fast(float v) {
  const float av = fabsf(v), t = __builtin_amdgcn_rcpf(av * 0.2316418882f + 1.0f);
  float q = t * 0.5307027145f + (-0.7265760135f); q = q * t + 0.7107068705f; q = q * t + (-0.142248368f); q = q * t + 0.127414796f; q = q * t;
  const float e = __builtin_amdgcn_exp2f((v * v) * (-0.72134752044f));
  const float m = v * (q * e);
  return v < 0.f ? m : v - m;
}
DI int reduce4_half(const int (&v)[4], int lane) {
  int y[2];
#pragma unroll
  for (int j = 0; j < 2; ++j) { const auto r = __builtin_amdgcn_permlane16_swap((unsigned)v[j], (unsigned)v[2 + j], false, false); y[j] = (int)(r[0] + r[1]); }
  const bool b3 = (lane >> 3) & 1;
  const int keep = b3 ? y[1] : y[0], send = b3 ? y[0] : y[1];
  int z = keep + __builtin_amdgcn_update_dpp(0, send, 0x128, 0xF, 0xF, true);
  z += __builtin_amdgcn_update_dpp(0, z, 0xB1, 0xF, 0xF, true);
  z += __builtin_amdgcn_update_dpp(0, z, 0x4E, 0xF, 0xF, true);
  z += __builtin_amdgcn_update_dpp(0, z, 0x141, 0xF, 0xF, true);
  return z;
}
#ifndef PG_VREP
#define PG_VREP 1
#endif
DI void phase_peer_gather(const P& p, int layer) {
  const int lane = threadIdx.x & 63, gw = blockIdx.x * 8 + (threadIdx.x >> 6), nw = gridDim.x * 8;
  const bf16_t* h2 = (const bf16_t*)(p.ws + WS_PB + PB_H2);
  const int* idx = (const int*)(p.ws + WS_PB + PB_IDX);
  const float* gate = (const float*)(p.ws + WS_PB + PB_GATE);
  const unsigned char* U = p.ws + WS_HB + HB_U;
  const unsigned char* V = p.ws + WS_HB + HB_V;
  const float* su = (const float*)(p.ws + WS_HB + HB_SU);
  const float* sv = (const float*)(p.ws + WS_HB + HB_SV);
  const float* mods = (const float*)(p.ws + WS_MODS) + (size_t)layer * 9 * 6144;
  float* xc = (float*)(p.ws + WS_XC);
  const int hs = lane & 31, up = lane >> 5, k4 = (lane >> 3) & 3;
  for (int row = gw; row < R; row += nw) {
    const int b = row / TPB, t = row - b * TPB;
    const bool isctx = t < CTXL;
    if (isctx && layer == 1) continue;
    int hE[4], hO[4]; float sh, hoff;
    {
      float hv[32], f[8];
#pragma unroll
      for (int i = 0; i < 4; ++i) { unpack8(*(const uint4*)(h2 + (size_t)row * D + hs * 32 + i * 8), f);
#pragma unroll
        for (int j = 0; j < 8; ++j) hv[i * 8 + j] = f[j]; }
      float am = 0.f;
#pragma unroll
      for (int j = 0; j < 32; ++j) am = fmaxf(am, fabsf(hv[j]));
      am = fmaxf(wave_max(am), 1e-30f);
      const float inv = 127.f / am;
      sh = am * (1.f / 127.f);
      int hsum = 0;
#pragma unroll
      for (int d4 = 0; d4 < 4; ++d4) {
        unsigned pe = 0, po = 0;
#pragma unroll
        for (int j = 0; j < 4; ++j) {
          const int qe = (int)rintf(hv[d4 * 8 + 2 * j] * inv), qo = (int)rintf(hv[d4 * 8 + 2 * j + 1] * inv);
          hsum += qe + qo;
          pe |= ((unsigned)qe & 0xffu) << (8 * j); po |= ((unsigned)qo & 0xffu) << (8 * j);
        }
        hE[d4] = (int)pe; hO[d4] = (int)po;
      }
      hoff = 7.5f * 0.5f * (float)wave_sum_i(hsum);
    }
    float acc[32];
#pragma unroll
    for (int j = 0; j < 32; ++j) acc[j] = 0.f;
    float corr = 0.f;
    const int my_i0 = idx[(size_t)row * 128 + lane], my_i1 = idx[(size_t)row * 128 + 64 + lane];
    const float my_g0 = gate[(size_t)row * 128 + lane], my_g1 = gate[(size_t)row * 128 + 64 + lane];
#define PG_LOAD(E0, UR, VR, SC) do { _Pragma("unroll") for (int k = 0; k < 4; ++k) { const int e_ = (E0) + 2 * k; \
        const int ea_ = ((E0) < 64) ? __builtin_amdgcn_readlane(my_i0, e_ & 63) : __builtin_amdgcn_readlane(my_i1, e_ & 63); \
        const int eb_ = ((E0) < 64) ? __builtin_amdgcn_readlane(my_i0, (e_ + 1) & 63) : __builtin_amdgcn_readlane(my_i1, (e_ + 1) & 63); \
        const size_t ro_ = (size_t)(up ? eb_ : ea_) * 512 + hs * 16; \
        UR[k] = *(const uint4*)(U + ro_); VR[k] = *(const uint4*)(V + ro_); } \
      { const int es_ = (E0) + 2 * k4 + up; const int ei_ = __shfl(((E0) < 64) ? my_i0 : my_i1, es_ & 63); SC[0] = su[ei_]; SC[1] = sv[ei_]; } } while (0)
#define PG_COMPUTE(E0, UR, VR, SC) do { \
      const int es_ = (E0) + 2 * k4 + up; \
      const float ggA = __shfl(((E0) < 64) ? my_g0 : my_g1, es_ & 63); \
      const float suA = SC[0], svA = SC[1]; \
      int dA[4]; \
      _Pragma("unroll") for (int k = 0; k < 4; ++k) { \
        const unsigned uu[4] = {UR[k].x, UR[k].y, UR[k].z, UR[k].w}; int d = 0; \
        _Pragma("unroll") for (int d4 = 0; d4 < 4; ++d4) { \
          d = __builtin_amdgcn_sdot4(hE[d4], (int)(uu[d4] & 0x0F0F0F0Fu), d, false); \
          d = __builtin_amdgcn_sdot4(hO[d4], (int)((uu[d4] >> 4) & 0x0F0F0F0Fu), d, false); } \
        dA[k] = d; } \
      const int tA = reduce4_half(dA, lane); \
      const float wA = ggA * gelu_fast(((float)tA - hoff) * (sh * suA)) * svA; \
      _Pragma("unroll") for (int k = 0; k < 4; ++k) { \
        const float w0_ = __shfl(wA, (lane & 32) + 8 * k); \
        corr += w0_; \
        const unsigned vv[4] = {VR[k].x, VR[k].y, VR[k].z, VR[k].w}; \
        _Pragma("unroll") for (int rep_ = 0; rep_ < PG_VREP; ++rep_) { const float w = w0_ * (1.f / PG_VREP); \
        _Pragma("unroll") for (int d4 = 0; d4 < 4; ++d4) { \
          const unsigned lo = vv[d4] & 0x0F0F0F0Fu, hi = (vv[d4] >> 4) & 0x0F0F0F0Fu; \
          acc[d4 * 8 + 0] += w * (float)(lo & 0xffu); acc[d4 * 8 + 1] += w * (float)(hi & 0xffu); \
          acc[d4 * 8 + 2] += w * (float)((lo >> 8) & 0xffu); acc[d4 * 8 + 3] += w * (float)((hi >> 8) & 0xffu); \
          acc[d4 * 8 + 4] += w * (float)((lo >> 16) & 0xffu); acc[d4 * 8 + 5] += w * (float)((hi >> 16) & 0xffu); \
          acc[d4 * 8 + 6] += w * (float)(lo >> 24); acc[d4 * 8 + 7] += w * (float)(hi >> 24); } asm volatile("" : "+v"(acc[0])); } } } while (0)
    {
      uint4 urA[4], vrA[4], urB[4], vrB[4];
      float scA[2], scB[2];
      PG_LOAD(0, urA, vrA, scA);
#pragma unroll 1
      for (int e0 = 0; e0 < 128; e0 += 16) {
        PG_LOAD(e0 + 8, urB, vrB, scB);
        PG_COMPUTE(e0, urA, vrA, scA);
        if (e0 + 16 < 128) PG_LOAD(e0 + 16, urA, vrA, scA);
        PG_COMPUTE(e0 + 8, urB, vrB, scB);
      }
    }
#undef PG_LOAD
#undef PG_COMPUTE
    const float c75 = 7.5f * (corr + __shfl_xor(corr, 32));
    float o16[16];
#pragma unroll
    for (int i = 0; i < 16; ++i) {
      const float mine = up ? acc[16 + i] : acc[i], give = up ? acc[i] : acc[16 + i];
      o16[i] = mine + __shfl_xor(give, 32) - c75;
    }
    const int col0 = hs * 32 + up * 16;
    const float* g5 = mods + (isctx ? 8 : b) * 6144 + 5 * 1024 + col0;
    float* xp = isctx ? (xc + ((size_t)(b * CTXL + t)) * D + col0) : (p.out + ((size_t)(b * SEQ + t - CTXL)) * D + col0);
    float xn[16];
    float ssq = 0.f;
#pragma unroll
    for (int i = 0; i < 4; ++i) {
      const float4 x = *(const float4*)(xp + i * 4);
      xn[i * 4] = x.x + g5[i * 4] * o16[i * 4]; xn[i * 4 + 1] = x.y + g5[i * 4 + 1] * o16[i * 4 + 1];
      xn[i * 4 + 2] = x.z + g5[i * 4 + 2] * o16[i * 4 + 2]; xn[i * 4 + 3] = x.w + g5[i * 4 + 3] * o16[i * 4 + 3];
#pragma unroll
      for (int j = 0; j < 4; ++j) ssq += xn[i * 4 + j] * xn[i * 4 + j];
    }
    ssq = red64(ssq);
    const float rs = rsqrtf(ssq * (1.f / 1024.f) + 1e-6f);
    if (layer == 1) {
      const float* gf = p.in[I_NF] + col0;
#pragma unroll
      for (int i = 0; i < 4; ++i)
        *(float4*)(xp + i * 4) = make_float4(xn[i * 4] * rs * gf[i * 4], xn[i * 4 + 1] * rs * gf[i * 4 + 1], xn[i * 4 + 2] * rs * gf[i * 4 + 2], xn[i * 4 + 3] * rs * gf[i * 4 + 3]);
    } else {
#pragma unroll
      for (int i = 0; i < 4; ++i) *(float4*)(xp + i * 4) = make_float4(xn[i * 4], xn[i * 4 + 1], xn[i * 4 + 2], xn[i * 4 + 3]);
      const float* gn1 = p.in[I_N1_1] + col0;
      const float* m1 = mods + 9 * 6144 + (isctx ? 8 : b) * 6144 + col0;
      float hh_[16];
#pragma unroll
      for (int i = 0; i < 16; ++i) hh_[i] = xn[i] * rs * gn1[i] * (1.f + m1[1024 + i]) + m1[i];
      bf16_t* hp = (bf16_t*)(p.ws + WS_HNEXT) + (size_t)row * D + col0;
      uint4 w0, w1;
      w0.x = pack_bf2(hh_[0], hh_[1]); w0.y = pack_bf2(hh_[2], hh_[3]); w0.z = pack_bf2(hh_[4], hh_[5]); w0.w = pack_bf2(hh_[6], hh_[7]);
      w1.x = pack_bf2(hh_[8], hh_[9]); w1.y = pack_bf2(hh_[10], hh_[11]); w1.z = pack_bf2(hh_[12], hh_[13]); w1.w = pack_bf2(hh_[14], hh_[15]);
      *(uint4*)hp = w0; *(uint4*)(hp + 8) = w1;
    }
  }
}

template <int CH>
DI void conv_stream(const P& p, char* lds, bf16_t* base, int pitch  , int chan0  ) {
  const int tid = threadIdx.x;
  constexpr int NT = NTHR / CH;
  constexpr int RPT = TPB / NT;
  const int ck = tid % CH, tl = tid / CH;
  const int t0 = tl * RPT;
  bf16_t* colp = base + ck * 8;
  uint4* halo = (uint4*)lds;
  float w0[8], w1[8], w2[8], bb[8];
#pragma unroll
  for (int j = 0; j < 8; ++j) { const int c = chan0 + ck * 8 + j; w0[j] = p.in[I_CONVW][c]; w1[j] = p.in[I_CONVW][3072 + c]; w2[j] = p.in[I_CONVW][6144 + c]; bb[j] = p.in[I_CONVB][c]; }
  __syncthreads();
  uint4 cur = *(const uint4*)(colp + (size_t)t0 * pitch);
  halo[(tl * 2 + 0) * CH + ck] = cur;
  halo[(tl * 2 + 1) * CH + ck] = *(const uint4*)(colp + (size_t)(t0 + RPT - 1) * pitch);
  __syncthreads();
  uint4 prev = halo[((tl > 0 ? tl - 1 : 0) * 2 + 1) * CH + ck];
  const uint4 nxt_halo = halo[((tl < NT - 1 ? tl + 1 : NT - 1) * 2 + 0) * CH + ck];
  __syncthreads();
  constexpr int UB = (RPT % 4 == 0) ? 4 : 2;
  for (int rb = 0; rb < RPT; rb += UB) {
    uint4 nx[UB];
#pragma unroll
    for (int i = 0; i < UB; ++i) { const int r = rb + i + 1; uint4 v_ = nxt_halo; if (r < RPT) v_ = *(const uint4*)(colp + (size_t)(t0 + r) * pitch); nx[i] = v_; }
#pragma unroll
    for (int i = 0; i < UB; ++i) {
      const int t = t0 + rb + i;
      const bool first = (t == 0) || (t == CTXL), last = (t == CTXL - 1) || (t == TPB - 1);
      float u[8], um[8], up[8], o[8];
      unpack8(cur, u); unpack8(prev, um); unpack8(nx[i], up);
      const float fm = first ? 0.f : 1.f, fp_ = last ? 0.f : 1.f;
#pragma unroll
      for (int j = 0; j < 8; ++j) o[j] = siluf_(w0[j] * (fm * um[j]) + w1[j] * u[j] + w2[j] * (fp_ * up[j]) + bb[j]);
      *(uint4*)(colp + (size_t)t * pitch) = pack8(o);
      prev = cur; cur = nx[i];
    }
  }
}
DI void phase_conv(const P& p, char* lds) {
  unsigned char* pb = p.ws + WS_PB;
  for (int w = blockIdx.x; w < 256; w += gridDim.x) {
    conv_stream<8>(p, lds, (bf16_t*)(pb + L1_XH) + (size_t)w * TPB * 64, 64, (w & 31) * 64);
    const int q = w & 3, sg = (w >> 2) & 31, isC = w >> 7;
    conv_stream<4>(p, lds, (bf16_t*)(pb + (isC ? L1_CG : L1_BG)) + (size_t)sg * TPB * 128 + q * 32, 128, (isC ? 2560 : 2048) + (sg & 3) * 128 + q * 32);
  }
}

DI int swzBC(int row) { return ((row & 3) << 2) | ((row >> 2) & 3); }
DI int swzX(int row) { return ((row >> 1) & 1) << 2; }

DI void ssd_chunk_unit(const P& p, char* lds, int unit) {
  const int tid = threadIdx.x, lane = tid & 63, wave = tid >> 6;
  const int b = unit >> 5, head = unit & 31, grp = head >> 3;
  bf16_t* zh = (bf16_t*)(p.ws + WS_PB + L1_ZH) + (size_t)(b * 32 + head) * TPB * 64;
  const bf16_t* xh = (const bf16_t*)(p.ws + WS_PB + L1_XH) + (size_t)(b * 32 + head) * TPB * 64;
  const bf16_t* bg = (const bf16_t*)(p.ws + WS_PB + L1_BG) + (size_t)(b * 4 + grp) * TPB * 128;
  const bf16_t* cgp_ = (const bf16_t*)(p.ws + WS_PB + L1_CG) + (size_t)(b * 4 + grp) * TPB * 128;
  const bf16_t* dtp = (const bf16_t*)(p.ws + WS_PB + L1_DT) + (size_t)b * TPB * 64;
  bf16_t* yftmp = (bf16_t*)(p.ws + WS_YF) + (size_t)(b * 32 + head) * SEQ * 64;
  const float dsk = p.in[I_DSKIP][head];
  const int r31 = lane & 31, hh = lane >> 5, q4 = (lane & 15) >> 2, grp16 = (lane >> 4) & 1, p3 = lane & 3;
  const int lt = wave >> 1, pt = wave & 1;
  const int cc = tid & 7, rr = tid >> 3;
  const int orow = tid >> 3, ock = tid & 7;
  constexpr int NCH = TPB / 128;
  SEGS_DECL();
  for (int d = 0; d < 2; ++d) {
    const float Aneg = -__expf(p.in[I_ALOG][d * 32 + head]);
    const float dtb = p.in[I_DTB][d * 32 + head];
    f32x16 Hacc;
#pragma unroll
    for (int r = 0; r < 16; ++r) Hacc[r] = 0.f;
    __syncthreads();
    for (int e = tid; e < 1024; e += NTHR) *(uint4*)(lds + 98304 + e * 16) = make_uint4(0, 0, 0, 0);
    uint4 st[2][5];
    float dtr0, dtr1;
    uint4 oyf[2], oz[2];
#define SSD_ISSUE(CH) do { \
      _Pragma("unroll") for (int rh_ = 0; rh_ < 2; ++rh_) { \
        const int t_ = scan_token(d, (CH) * 128 + rh_ * 64 + rr); \
        st[rh_][0] = *(const uint4*)(xh + (size_t)t_ * 64 + cc * 8); \
        st[rh_][1] = *(const uint4*)(bg + (size_t)t_ * 128 + cc * 8); \
        st[rh_][2] = *(const uint4*)(bg + (size_t)t_ * 128 + 64 + cc * 8); \
        st[rh_][3] = *(const uint4*)(cgp_ + (size_t)t_ * 128 + cc * 8); \
        st[rh_][4] = *(const uint4*)(cgp_ + (size_t)t_ * 128 + 64 + cc * 8); \
      } \
      dtr0 = bf2f(dtp[(size_t)scan_token(d, (CH) * 128 + lane) * 64 + d * 32 + head]); \
      dtr1 = bf2f(dtp[(size_t)scan_token(d, (CH) * 128 + 64 + lane) * 64 + d * 32 + head]); \
    } while (0)
    SSD_ISSUE(0);
    SEGS_INIT();
    for (int ch = 0; ch <= NCH; ++ch) {
      int zoff = 0;
      asm volatile("" : "+v"(zoff));
      char* L0 = lds + zoff;
      char* LB = L0; char* LC = L0 + 32768; char* LX = L0 + 65536; char* LXw = L0 + 81920; char* LHs = L0 + 98304;
      float* Lacs = (float*)(L0 + 131072); float* Ldt = (float*)(L0 + 131584); float* Lea = (float*)(L0 + 132096);
      char* LY = L0 + 132608;
      __syncthreads();
      SEGS_ADD(0);
      if (ch - 1 >= CTXL / 128) {
#pragma unroll
        for (int i = 0; i < 2; ++i) {
          const int row = orow + i * 64;
          const int t = scan_token(d, (ch - 1) * 128 + row);
          const uint4 yv = *(const uint4*)(LY + row * 128 + ock * 16);
          if (d == 0) {
            *(uint4*)(yftmp + (size_t)(t - CTXL) * 64 + ock * 8) = yv;
          } else {
            float y[8], yf[8], z[8], o[8];
            unpack8(yv, y); unpack8(oyf[i], yf); unpack8(oz[i], z);
#pragma unroll
            for (int j = 0; j < 8; ++j) o[j] = (yf[j] + y[j]) * siluf_(z[j]);
            *(uint4*)(zh + (size_t)t * 64 + ock * 8) = pack8(o);
          }
        }
      }
      if (ch == NCH) break;
      float dt0, dt1, acs0, acs1, alast;
      {
        dt0 = softplusf_(dtr0 + dtb); dt1 = softplusf_(dtr1 + dtb);
        acs0 = dt0 * Aneg; acs1 = dt1 * Aneg;
#pragma unroll
        for (int off = 1; off < 64; off <<= 1) {
          const float y0 = __shfl_up(acs0, off), y1 = __shfl_up(acs1, off);
          if (lane >= off) { acs0 += y0; acs1 += y1; }
        }
        acs1 += __shfl(acs0, 63);
        alast = __shfl(acs1, 63);
        if (wave == 0) {
          Lacs[lane] = acs0; Lacs[64 + lane] = acs1; Ldt[lane] = dt0; Ldt[64 + lane] = dt1;
          Lea[lane] = __expf(acs0); Lea[64 + lane] = __expf(acs1);
        }
      }
#pragma unroll
      for (int rh = 0; rh < 2; ++rh) {
        const int s_ = rh * 64 + rr;
        const float dts = __shfl(rh ? dt1 : dt0, rr);
        const float ws_ = __expf(alast - __shfl(rh ? acs1 : acs0, rr));
        float xv[8], xw[8];
        unpack8(st[rh][0], xv);
#pragma unroll
        for (int j = 0; j < 8; ++j) { xv[j] *= dts; xw[j] = xv[j] * ws_; }
        const int off = s_ * 128 + ((cc ^ swzX(s_)) << 4);
        *(uint4*)(LX + off) = pack8(xv);
        *(uint4*)(LXw + off) = pack8(xw);
        const int sw = swzBC(s_);
        *(uint4*)(LB + s_ * 256 + ((cc ^ sw) << 4)) = st[rh][1];
        *(uint4*)(LB + s_ * 256 + (((8 + cc) ^ sw) << 4)) = st[rh][2];
        *(uint4*)(LC + s_ * 256 + ((cc ^ sw) << 4)) = st[rh][3];
        *(uint4*)(LC + s_ * 256 + (((8 + cc) ^ sw) << 4)) = st[rh][4];
      }
      SEGS_ADD(1);
      __syncthreads();
      SEGS_ADD(2);
      if (ch + 1 < NCH) SSD_ISSUE(ch + 1);
      if (d == 1 && ch >= CTXL / 128) {
#pragma unroll
        for (int i = 0; i < 2; ++i) {
          const int t = scan_token(d, ch * 128 + orow + i * 64);
          oyf[i] = *(const uint4*)(yftmp + (size_t)(t - CTXL) * 64 + ock * 8);
          oz[i] = *(const uint4*)(zh + (size_t)t * 64 + ock * 8);
        }
      }
      const char* LBz = LB; const char* LCz = LC; const char* LXz = LX; const char* LXwz = LXw;
      const char* Hs = LHs;
      char* LMa = L0 + 114688; char* LMb = L0 + 148992;
      if (ch >= CTXL / 128) {
        f32x16 Y;
#pragma unroll
        for (int r = 0; r < 16; ++r) Y[r] = 0.f;
        const int crow = lt * 32 + r31;
        const char* cbase = LCz + crow * 256;
        const int csw = swzBC(crow);
        {
          const int hrow = pt * 32 + r31;
#pragma unroll 2
          for (int kk = 0; kk < 8; ++kk) {
            const bf16x8 cfk = *(const bf16x8*)(cbase + (((kk * 2 + hh) ^ csw) << 4));
            const bf16x8 hb = *(const bf16x8*)(Hs + hrow * 256 + (((kk * 2 + hh) ^ swzBC(hrow)) << 4));
            Y = MFMA32(cfk, hb, Y);
          }
        }
#pragma unroll
        for (int r = 0; r < 16; ++r) Y[r] *= Lea[lt * 32 + ACC_ROW(r, lane)];
        const int lcol = lt * 32 + r31;
        const float acs_l = Lacs[lcol];
        const float ddiag = (d == 1) ? dsk / Ldt[lcol] : 0.f;
        for (int st_ = pt; st_ <= lt; st_ += 2) {
          f32x16 g;
#pragma unroll
          for (int r = 0; r < 16; ++r) g[r] = 0.f;
          const int row = st_ * 32 + r31;
#pragma unroll 4
          for (int kk = 0; kk < 8; ++kk) {
            const bf16x8 a = *(const bf16x8*)(LBz + row * 256 + (((kk * 2 + hh) ^ swzBC(row)) << 4));
            const bf16x8 cfk = *(const bf16x8*)(cbase + (((kk * 2 + hh) ^ csw) << 4));
            g = MFMA32(a, cfk, g);
          }
#pragma unroll
          for (int r = 0; r < 16; ++r) {
            const int srow = st_ * 32 + ACC_ROW(r, lane);
            const float e = __expf(fminf(acs_l - Lacs[srow], 0.f));
            float val = (srow <= lcol) ? g[r] * e : 0.f;
            if (srow == lcol) val += ddiag;
            g[r] = val;
          }
          const int id = lt * (lt + 1) / 2 + st_;
          char* mt = (id < 8) ? (LMa + id * 2048) : (LMb + (id - 8) * 2048);
#pragma unroll
          for (int k2 = 0; k2 < 2; ++k2) {
            uint4 u; u.x = pack_bf2(g[8 * k2], g[8 * k2 + 1]); u.y = pack_bf2(g[8 * k2 + 2], g[8 * k2 + 3]); u.z = pack_bf2(g[8 * k2 + 4], g[8 * k2 + 5]); u.w = pack_bf2(g[8 * k2 + 6], g[8 * k2 + 7]);
            *(uint4*)(mt + (k2 * 64 + lane) * 16) = u;
          }
        }
        __syncthreads();
        for (int st_ = 0; st_ <= lt; ++st_) {
          const int id = lt * (lt + 1) / 2 + st_;
          const char* mt = (id < 8) ? (LMa + id * 2048) : (LMb + (id - 8) * 2048);
#pragma unroll
          for (int k2 = 0; k2 < 2; ++k2) {
            const bf16x8 am = *(const bf16x8*)(mt + (k2 * 64 + lane) * 16);
            const int s0 = st_ * 32 + 16 * k2 + 4 * hh + q4, s1 = s0 + 8;
            const int cx = pt * 4 + grp16 * 2 + (p3 >> 1);
            const s16x4 lo = tr_read(LXz + s0 * 128 + ((cx ^ swzX(s0)) << 4) + 8 * (p3 & 1));
            const s16x4 hi = tr_read(LXz + s1 * 128 + ((cx ^ swzX(s1)) << 4) + 8 * (p3 & 1));
            const bf16x8 bx = __builtin_shufflevector(lo, hi, 0, 1, 2, 3, 4, 5, 6, 7);
            Y = MFMA32(am, bx, Y);
          }
        }
#pragma unroll
        for (int r = 0; r < 16; ++r) {
          const int srow = lt * 32 + ACC_ROW(r, lane);
          *(bf16_t*)(LY + srow * 128 + (pt * 32 + r31) * 2) = f2bf(Y[r]);
        }
      }
      {
        const float ea = __expf(alast);
#pragma unroll
        for (int r = 0; r < 16; ++r) Hacc[r] *= ea;
        const int cb_ = lt * 4 + grp16 * 2 + (p3 >> 1);
        const int cx = pt * 4 + grp16 * 2 + (p3 >> 1);
        const int sb0 = 8 * hh + q4, sb1 = sb0 + 4;
        const char* pa_lo = LBz + sb0 * 256 + ((cb_ ^ swzBC(sb0)) << 4) + 8 * (p3 & 1);
        const char* pa_hi = LBz + sb1 * 256 + ((cb_ ^ swzBC(sb1)) << 4) + 8 * (p3 & 1);
        const char* pb_lo = LXwz + sb0 * 128 + ((cx ^ swzX(sb0)) << 4) + 8 * (p3 & 1);
        const char* pb_hi = LXwz + sb1 * 128 + ((cx ^ swzX(sb1)) << 4) + 8 * (p3 & 1);
#pragma unroll 2
        for (int k = 0; k < 8; ++k) {
          const s16x4 alo = tr_read(pa_lo + k * 4096);
          const s16x4 ahi = tr_read(pa_hi + k * 4096);
          const s16x4 blo = tr_read(pb_lo + k * 2048);
          const s16x4 bhi = tr_read(pb_hi + k * 2048);
          const bf16x8 a = __builtin_shufflevector(alo, ahi, 0, 1, 2, 3, 4, 5, 6, 7);
          const bf16x8 bb = __builtin_shufflevector(blo, bhi, 0, 1, 2, 3, 4, 5, 6, 7);
          Hacc = MFMA32(a, bb, Hacc);
        }
        char* Hn = LHs;
        const int prow = pt * 32 + r31;
#pragma unroll
        for (int g4 = 0; g4 < 4; ++g4) {
          const int n0 = lt * 32 + 8 * g4 + 4 * hh;
          uint2 w; w.x = pack_bf2(Hacc[g4 * 4], Hacc[g4 * 4 + 1]); w.y = pack_bf2(Hacc[g4 * 4 + 2], Hacc[g4 * 4 + 3]);
          *(uint2*)(Hn + prow * 256 + ((((n0 >> 3)) ^ swzBC(prow)) << 4) + (n0 & 7) * 2) = w;
        }
      }
      SEGS_ADD(3);
    }
  }
  SEGS_FLUSH(4);
  __syncthreads();
}

DI void phase_groupnorm(const P& p) {
  const int lane = threadIdx.x & 63, gw = blockIdx.x * 8 + (threadIdx.x >> 6), nw = gridDim.x * 8;
  bf16_t* zh = (bf16_t*)(p.ws + WS_PB + L1_ZH);
  const float* gn = p.in[I_GNORM];
  for (int lr = gw; lr < NB * SEQ; lr += nw) {
    const int b = lr >> 12, l = lr & 4095;
    bf16_t* rp = zh + ((size_t)(b * 32 + (lane >> 1)) * TPB + CTXL + l) * 64 + (lane & 1) * 32;
    float v[32];
#pragma unroll
    for (int i = 0; i < 4; ++i) { float f[8]; unpack8(*(const uint4*)(rp + i * 8), f);
#pragma unroll
      for (int j = 0; j < 8; ++j) v[i * 8 + j] = f[j]; }
    float ss = 0.f;
#pragma unroll
    for (int i = 0; i < 32; ++i) ss += v[i] * v[i];
    ss = red16(ss);
    const float rs = rsqrtf(ss * (1.f / 512.f) + 1e-6f);
#pragma unroll
    for (int i = 0; i < 4; ++i) {
      float o[8];
#pragma unroll
      for (int j = 0; j < 8; ++j) o[j] = v[i * 8 + j] * rs * gn[lane * 32 + i * 8 + j];
      *(uint4*)(rp + i * 8) = pack8(o);
    }
  }
}


__global__ void __launch_bounds__(NTHR) fwd_kernel(P p) {
  extern __shared__ __attribute__((aligned(16))) char lds[];
  const int lo = p.ph_lo, hi = p.ph_hi;
  unsigned char* ws = p.ws;
  XcdBarrier bar; bar.bar = (unsigned*)(ws + WS_CTL); bar.x = 0; bar.st = nullptr;
  volatile LAS unsigned* stw = (volatile LAS unsigned*)(lds + LDS_BYTES - 16);
  if (hi - lo > 1) {
    if (threadIdx.x == 0) { stw[0] = 0u; stw[1] = 0u; }
    __syncthreads();
    bar = xcd_barrier_post((unsigned*)(ws + WS_CTL), stw);
  }
#ifndef PHASE_MASK
#define PHASE_MASK 0xFFFFFFFFu
#endif
#define IN(k) (((PHASE_MASK >> (k)) & 1u) && lo <= (k) && (k) < hi)
#define SEAM(k) do { if (IN(k) && IN((k) + 1)) xcd_barrier(bar); } while (0)
#ifdef PROBE_A
  unsigned long long* tsp = (unsigned long long*)(ws + WS_SCAL + 1024);
#define STAMP(k) do { if (blockIdx.x == 0 && threadIdx.x == 0) tsp[k] = __builtin_amdgcn_s_memrealtime(); } while (0)
#else
#define STAMP(k) do {} while (0)
#endif
  const int G = gridDim.x;
  bf16_t* HBp = (bf16_t*)(ws + WS_HB);
  bf16_t* PBp = (bf16_t*)(ws + WS_PB + PB_P);

#ifdef PROBE_A
  if (blockIdx.x == 0 && threadIdx.x == 0) for (int k = 22; k < 64; ++k) tsp[k] = 0ull;
#endif
  STAMP(0); if (IN(0)) { phase_prep(p, lds); } SEAM(0);
  STAMP(1); if (IN(1)) { phase_normmod(p, 0, 0, true, false, HBp); } SEAM(1);
  STAMP(2); if (IN(2)) { pg8::Order S; S.init(R / 256, 3584 / 256, G, (int)blockIdx.x, 0);
    pg8::gemm_phase(lds, pg8::Gemm{HBp, (const bf16_t*)(ws + WS_WIN0T), D, D, 0}, S, pg8::EpiP0{PBp, (const float2*)(ws + WS_ROPE)}); } SEAM(2);
  STAMP(3); if (IN(3)) {
    for (int u = blockIdx.x; u < 1024 + 64; u += G) attn_flash_unit(p, lds, u);
    phase_ga(p);
  } SEAM(3);
  STAMP(4); if (IN(4)) {
    for (int u = blockIdx.x; u < 256; u += G) rwkv_scan_unit(p, lds, u);
    __syncthreads();
    gemm_store_phase(lds, (const bf16_t*)(ws + WS_PB + PB_GA), 128, (const bf16_t*)(ws + WS_RWT + 262144), 128, R, 512, 128, (bf16_t*)(ws + WS_PB + PB_G), 512, 512);
  } SEAM(4);
  STAMP(5); if (IN(5)) { phase_rwkv_post(p); } SEAM(5);
  STAMP(6); if (IN(6)) { pg8::Order S; S.init(R / 256, 4, G, (int)blockIdx.x, 0);
    pg8::gemm_phase(lds, pg8::Gemm{(const bf16_t*)(ws + WS_PB + PB_O0), (const bf16_t*)(ws + WS_WOUT0T), D, D, 0}, S,
                    pg8::EpiDelta{(bf16_t*)(ws + WS_PB + PB_H2), (const float*)(ws + WS_MODS)}); } SEAM(6);
  STAMP(7); if (IN(7)) { phase_normmod(p, 0, 1, true, false, (bf16_t*)(ws + WS_PB + PB_H2), (const bf16_t*)(ws + WS_PB + PB_H2)); convert_tables(p, 0); } SEAM(7);
  STAMP(8); if (IN(8)) { pg8::Order S; S.init(R / 256, 8, G, (int)blockIdx.x, 0);
    pg8::gemm_phase(lds, pg8::Gemm{(const bf16_t*)(ws + WS_PB + PB_H2), (const bf16_t*)(ws + WS_PQ0T), D, D, 0}, S, pg8::EpiBf16{(bf16_t*)(ws + WS_PB + PB_Q), 2048, 2048}); } SEAM(8);
  STAMP(9); if (IN(9)) { for (int u = blockIdx.x; u < (R / 256) * 8; u += G) peer_topk_unit(p, lds, 0, u); } SEAM(9);
  STAMP(10); if (IN(10)) { phase_peer_gather(p, 0); } SEAM(10);
  STAMP(11);
  STAMP(12); if (IN(12)) { pg8::Order S; S.init(R / 256, 5376 / 256, G, (int)blockIdx.x, 0);
    pg8::gemm_phase(lds, pg8::Gemm{(const bf16_t*)(ws + WS_HNEXT), (const bf16_t*)(ws + WS_WIN1T), D, D, 0}, S, pg8::EpiP1{ws + WS_PB}); } SEAM(12);
  STAMP(13); if (IN(13)) {
    phase_conv(p, lds);
    if (hi - lo > 1) xcd_barrier(bar);
    for (int u = blockIdx.x; u < 256; u += G) ssd_chunk_unit(p, lds, u);
  } SEAM(13);
  STAMP(14); if (IN(14)) { phase_groupnorm(p); } SEAM(14);
  STAMP(15); if (IN(15)) { pg8::Order S; S.init(NB * SEQ / 256, 4, G, (int)blockIdx.x, 1);
    pg8::gemm_phase(lds, pg8::Gemm{(const bf16_t*)(ws + WS_PB + L1_ZH), (const bf16_t*)(ws + WS_WOUT1T), 64, 2048, 1}, S,
                    pg8::EpiDelta{(bf16_t*)(ws + WS_PB + L1_XH), (const float*)(ws + WS_MODS) + 9 * 6144}); } SEAM(15);
  STAMP(16); if (IN(16)) { phase_normmod(p, 1, 1, false, true, (bf16_t*)(ws + WS_PB + PB_H2), (const bf16_t*)(ws + WS_PB + L1_XH)); convert_tables(p, 1); } SEAM(16);
  STAMP(17); if (IN(17)) { pg8::Order S; S.init(NB * SEQ / 256, 8, G, (int)blockIdx.x, 1);
    pg8::gemm_phase(lds, pg8::Gemm{(const bf16_t*)(ws + WS_PB + PB_H2), (const bf16_t*)(ws + WS_PQ1T), D, D, 0}, S, pg8::EpiBf16{(bf16_t*)(ws + WS_PB + PB_Q), 2048, 2048}); } SEAM(17);
  STAMP(18); if (IN(18)) { for (int u = blockIdx.x; u < (NB * SEQ / 256) * 8; u += G) { const int mtl = u >> 3; peer_topk_unit(p, lds, 1, ((((mtl >> 4) * 17 + 1 + (mtl & 15)) << 3) | (u & 7))); } } SEAM(18);
  STAMP(19); if (IN(19)) { phase_peer_gather(p, 1); }
  STAMP(20);
#ifdef PROBE_A
  xcd_barrier(bar);
  if (blockIdx.x == 0 && threadIdx.x == 0) {
    const unsigned long long tend = __builtin_amdgcn_s_memrealtime();
    tsp[21] = tend;
    unsigned long long ta = 0;
    for (int k = 0; k < 21; ++k) if ((PROBE_A >> k) & 1) ta += tsp[k + 1] - tsp[k];
    for (int k = 22; k < 64; ++k) if ((PROBE_A >> k) & 1ull) ta += tsp[k];
    while (__builtin_amdgcn_s_memrealtime() - tend < ta * PROBE_K) __builtin_amdgcn_s_sleep(8);
  }
#endif
}

extern "C" void kernel_launch(void* const* d_in, const int* in_sizes, int n_in, void* d_out, int out_size, void* d_ws, size_t ws_size, hipStream_t stream) {
  static int inited = 0;
  if (!inited) {
    if (n_in != N_IN || ws_size < WS_XC + 128 * MiB) { fprintf(stderr, "kernel_launch: unexpected n_in %d / ws_size %zu\n", n_in, ws_size); inited = -1; return; }
    if (hipFuncSetAttribute((const void*)fwd_kernel, hipFuncAttributeMaxDynamicSharedMemorySize, LDS_BYTES) != hipSuccess) { fprintf(stderr, "kernel_launch: hipFuncSetAttribute failed\n"); inited = -1; return; }
    inited = 1;
  }
  if (inited < 0) return;
  P p{};
  for (int i = 0; i < N_IN; ++i) p.in[i] = (const float*)d_in[i];
  p.out = (float*)d_out; p.ws = (unsigned char*)d_ws;
  (void)hipMemsetAsync((char*)d_ws + WS_CTL, 0, 65536, stream);
#if N_LAUNCH_MODE == 1
  p.ph_lo = 0; p.ph_hi = N_PHASES;
  hipLaunchKernelGGL(fwd_kernel, dim3(256), dim3(NTHR), LDS_BYTES, stream, p);
#else
  for (int ph = 0; ph < N_PHASES; ++ph) {
    p.ph_lo = ph; p.ph_hi = ph + 1;
    hipLaunchKernelGGL(fwd_kernel, dim3(256), dim3(NTHR), LDS_BYTES, stream, p);
  }
#endif
}
```

```cpp
#include <hip/hip_runtime.h>
#include <stdint.h>
#include <stdio.h>

#ifndef N_LAUNCH_MODE
#define N_LAUNCH_MODE 1
#endif

#define DI __device__ __forceinline__
typedef unsigned short bf16_t;
typedef __attribute__((ext_vector_type(8))) short bf16x8;
typedef __attribute__((ext_vector_type(16))) float f32x16;
typedef __attribute__((ext_vector_type(2))) __bf16 bf2_t;

constexpr int D = 1024, NB = 8, SEQ = 4096, CTXL = 256, TPB = SEQ + CTXL, R = NB * TPB;
constexpr int NTHR = 512;
constexpr int LDS_BYTES = 163840;
constexpr int P0LD = 3456;
constexpr int P1LD = 5184;
constexpr int P1NPAD = 5248;

enum { I_X = 0, I_C, I_CTX, I_CCTX,
       I_ADAW0, I_ADAB0, I_N1_0, I_N2_0, I_WIN0, I_DALAM, I_DASUB, I_RWMU, I_RWW0, I_RWW2, I_RWA0, I_RWA2, I_RWG2, I_RWKK, I_RWKA, I_RWRK, I_LNXW, I_LNXB, I_WOUT0, I_PQ0, I_PK0, I_PU0, I_PV0,
       I_ADAW1, I_ADAB1, I_N1_1, I_N2_1, I_WIN1, I_CONVW, I_CONVB, I_DTB, I_ALOG, I_DSKIP, I_GNORM, I_WOUT1, I_PQ1, I_PK1, I_PU1, I_PV1, I_NF, N_IN };

constexpr size_t MiB = 1048576;
constexpr size_t WS_CTL = 0;
constexpr size_t WS_SCAL = 65536;
constexpr size_t WS_MODS = 131072;
constexpr size_t WS_ROPE = 1 * MiB;
constexpr size_t WS_RWT = 2 * MiB;
constexpr size_t WS_WIN0T = 3 * MiB;
constexpr size_t WS_WOUT0T = 10 * MiB;
constexpr size_t WS_PQ0T = 12 * MiB;
constexpr size_t WS_KEYS0 = 16 * MiB;
constexpr size_t WS_KEYS1 = 16 * MiB + 524288;
constexpr size_t WS_WIN1T = 17 * MiB;
constexpr size_t WS_WOUT1T = 28 * MiB;
constexpr size_t WS_PQ1T = 32 * MiB;
constexpr size_t WS_PB = 36 * MiB;
constexpr size_t WS_XC = 381 * MiB;
constexpr size_t WS_HB = 389 * MiB;
constexpr size_t WS_END = 457 * MiB;
constexpr size_t WS_YF = WS_XC;
constexpr size_t PB_P = 0;
constexpr size_t PB_O0 = 230 * MiB;
constexpr size_t PB_G = 298 * MiB;
constexpr size_t PB_GA = 332 * MiB;
constexpr size_t PB_BONUS = 341 * MiB;
constexpr size_t L1_ZH = 0;
constexpr size_t L1_XH = 136 * MiB;
constexpr size_t L1_BG = 272 * MiB;
constexpr size_t L1_CG = 306 * MiB;
constexpr size_t L1_DT = 340 * MiB;
constexpr size_t PB_H2 = 0;
constexpr size_t PB_Q = 68 * MiB;
constexpr size_t PB_IDX = 204 * MiB;
constexpr size_t PB_GATE = 221 * MiB;
constexpr size_t WS_HNEXT = WS_HB + 33 * MiB;
constexpr size_t HB_YF = 0, HB_YB = 34 * MiB;
constexpr size_t HB_U = 0, HB_V = 8 * MiB;
constexpr size_t HB_SU = 32 * MiB, HB_SV = 32 * MiB + 65536;

struct P {
  const float* in[N_IN];
  float* out;
  unsigned char* ws;
  int ph_lo, ph_hi;
};

constexpr int N_PHASES = 21;
#ifndef PROBE_GRP
#define PROBE_GRP 0
#endif
#define SEG_DECL_() unsigned long long seg_last_ = 0ull, seg_acc_[4] = {0ull, 0ull, 0ull, 0ull}
#define SEG_INIT_() do { seg_last_ = __builtin_amdgcn_s_memrealtime(); } while (0)
#define SEG_ADD_(j) do { const unsigned long long t__ = __builtin_amdgcn_s_memrealtime(); seg_acc_[j] += t__ - seg_last_; seg_last_ = t__; } while (0)
#define SEG_FLUSH_(base) do { if (blockIdx.x == 0 && threadIdx.x == 0) { for (int j__ = 0; j__ < 4; ++j__) ((unsigned long long*)(p.ws + WS_SCAL + 1024))[22 + (base) + j__] += seg_acc_[j__]; } } while (0)
#if defined(PROBE_A) && PROBE_GRP == 1
#define SEGR_DECL() SEG_DECL_()
#define SEGR_INIT() SEG_INIT_()
#define SEGR_ADD(j) SEG_ADD_(j)
#define SEGR_FLUSH(b) SEG_FLUSH_(b)
#else
#define SEGR_DECL() do {} while (0)
#define SEGR_INIT() do {} while (0)
#define SEGR_ADD(j) do {} while (0)
#define SEGR_FLUSH(b) do {} while (0)
#endif
#if defined(PROBE_A) && PROBE_GRP == 2
#define SEGS_DECL() SEG_DECL_()
#define SEGS_INIT() SEG_INIT_()
#define SEGS_ADD(j) SEG_ADD_(j)
#define SEGS_FLUSH(b) SEG_FLUSH_(b)
#else
#define SEGS_DECL() do {} while (0)
#define SEGS_INIT() do {} while (0)
#define SEGS_ADD(j) do {} while (0)
#define SEGS_FLUSH(b) do {} while (0)
#endif

DI unsigned pack_bf2(float a, float b) { bf2_t v; v[0] = (__bf16)a; v[1] = (__bf16)b; return __builtin_bit_cast(unsigned, v); }
DI bf16_t f2bf(float a) { return __builtin_bit_cast(unsigned short, (__bf16)a); }
DI float bf2f(bf16_t v) { return __uint_as_float((unsigned)v << 16); }
DI float bflo(unsigned u) { return __uint_as_float(u << 16); }
DI float bfhi(unsigned u) { return __uint_as_float(u & 0xffff0000u); }
template <int CTRL> DI float dpp_f(float x) { return __int_as_float(__builtin_amdgcn_update_dpp(0, __float_as_int(x), CTRL, 0xF, 0xF, true)); }
DI float red4(float x) { x += dpp_f<0xB1>(x); x += dpp_f<0x4E>(x); return x; }
DI float red8(float x) { x += dpp_f<0x141>(x); return red4(x); }
DI float red16(float x) { x += dpp_f<0x140>(x); return red8(x); }
DI float red64(float x) { x = red16(x); x += __shfl_xor(x, 16); x += __shfl_xor(x, 32); return x; }
DI float frcp_(float x) { return __builtin_amdgcn_rcpf(x); }
DI float sigmoidf_(float x) { return frcp_(1.f + __expf(-x)); }
DI float siluf_(float x) { return x * frcp_(1.f + __expf(-x)); }
DI float softplusf_(float x) { return x > 20.f ? x : log1pf(__expf(x)); }
DI float geluf_(float x) { return 0.5f * x * (1.f + erff(x * 0.70710678118654752f)); }
DI void unpack8(const uint4& u, float (&f)[8]) { f[0] = bflo(u.x); f[1] = bfhi(u.x); f[2] = bflo(u.y); f[3] = bfhi(u.y); f[4] = bflo(u.z); f[5] = bfhi(u.z); f[6] = bflo(u.w); f[7] = bfhi(u.w); }
DI uint4 pack8(const float (&f)[8]) { uint4 u; u.x = pack_bf2(f[0], f[1]); u.y = pack_bf2(f[2], f[3]); u.z = pack_bf2(f[4], f[5]); u.w = pack_bf2(f[6], f[7]); return u; }
#define ACC_ROW(reg, lane) (((reg) & 3) + 8 * ((reg) >> 2) + 4 * ((lane) >> 5))
#define MFMA32(a, b, c) __builtin_amdgcn_mfma_f32_32x32x16_bf16((a), (b), (c), 0, 0, 0)

#define XB_TMO      128
#define XB_XCNT(j)  (256  + 64 * (j))
#define XB_XSUB(j)  (1280 + 64 * (j))
#define XB_XGEN(j)  (2304 + 64 * (j))
#define XB_TOP      3328
#define XB_TOPGEN   3392
#define XCD_BAR_WORDS 3456
#define XB_SPIN_CAP (1u << 22)
#define LAS __attribute__((address_space(3)))
DI unsigned xb_ld(unsigned* p) { return __hip_atomic_load(p, __ATOMIC_RELAXED, __HIP_MEMORY_SCOPE_AGENT); }
DI unsigned xb_add(unsigned* p, unsigned v) { return __hip_atomic_fetch_add(p, v, __ATOMIC_RELAXED, __HIP_MEMORY_SCOPE_AGENT); }
DI unsigned xb_xcc_id() { return (unsigned)__builtin_amdgcn_s_getreg((3 << 11) | 20) & 0xFu; }
#define XB_SPIN(cond, bar) do { unsigned _sp = 0; while (cond) { __builtin_amdgcn_s_sleep(1); \
    if ((++_sp & 255u) == 0u) { if (xb_ld(&(bar)[XB_TMO])) break; if (_sp > XB_SPIN_CAP) { atomicAdd(&(bar)[XB_TMO], 1u); break; } } } } while (0)
struct XcdBarrier { unsigned* bar; unsigned x; volatile LAS unsigned* st; };
DI XcdBarrier xcd_barrier_post(unsigned* bar, volatile LAS unsigned* st) {
  XcdBarrier b; b.bar = bar; b.x = xb_xcc_id(); b.st = st;
  if (threadIdx.x == 0) (void)xb_add(&bar[XB_XCNT(b.x)], 1u);
  return b;
}
DI void xcd_barrier_complete(unsigned* bar, unsigned x, unsigned& nloc, unsigned& nx) {
  const unsigned G = gridDim.x * gridDim.y * gridDim.z;
  unsigned sum, cnt, mine, sp = 0u;
  for (;;) {
    sum = 0u; cnt = 0u; mine = 0u;
#pragma unroll
    for (unsigned j = 0; j < 16; ++j) { const unsigned c = xb_ld(&bar[XB_XCNT(j)]); sum += c; cnt += (c > 0u) ? 1u : 0u; mine = (j == x) ? c : mine; }
    if (sum == G) break;
    __builtin_amdgcn_s_sleep(1);
    if ((++sp & 255u) == 0u) { if (xb_ld(&bar[XB_TMO])) break; if (sp > XB_SPIN_CAP) { atomicAdd(&bar[XB_TMO], 1u); break; } }
  }
  nloc = mine > 0u ? mine : 1u; nx = cnt > 0u ? cnt : 1u;
}
DI void xcd_barrier(const XcdBarrier& b) {
  asm volatile("s_waitcnt vmcnt(0)" ::: "memory");
  __syncthreads();
  if (threadIdx.x == 0) {
    unsigned* bar = b.bar;
    __builtin_amdgcn_s_waitcnt(0);
    unsigned nloc = b.st[0], nx = b.st[1];
    if (nloc == 0u) { xcd_barrier_complete(bar, b.x, nloc, nx); b.st[0] = nloc; b.st[1] = nx; }
    const unsigned old = xb_add(&bar[XB_XSUB(b.x)], 1u);
    const unsigned gen = old / nloc;
    if (old + 1u == (gen + 1u) * nloc) {
      __builtin_amdgcn_fence(__ATOMIC_RELEASE, "agent");
      asm volatile("s_waitcnt vmcnt(0)" ::: "memory");
      const unsigned og = xb_add(&bar[XB_TOP], 1u);
      const unsigned tg = og / nx;
      if (og + 1u == (tg + 1u) * nx) xb_add(&bar[XB_TOPGEN], 1u);
      else XB_SPIN(xb_ld(&bar[XB_TOPGEN]) == tg, bar);
      __builtin_amdgcn_fence(__ATOMIC_ACQUIRE, "agent");
      xb_add(&bar[XB_XGEN(b.x)], 1u);
      asm volatile("s_waitcnt vmcnt(0)" ::: "memory");
    } else {
      XB_SPIN(xb_ld(&bar[XB_XGEN(b.x)]) == gen, bar);
      __builtin_amdgcn_fence(__ATOMIC_ACQUIRE, "agent");
      asm volatile("s_waitcnt vmcnt(0)" ::: "memory");
    }
  }
  __syncthreads();
}

DI void gemm_tile(char* lds, const bf16_t* __restrict__ A, int lda, const bf16_t* __restrict__ Bt, int ldb, int K, f32x16 (&acc)[2][2]) {
  const int tid = threadIdx.x, lane = tid & 63, wave = tid >> 6, wm = wave >> 1, wn = wave & 1;
#pragma unroll
  for (int i = 0; i < 2; ++i)
#pragma unroll
    for (int j = 0; j < 2; ++j)
#pragma unroll
      for (int r = 0; r < 16; ++r) acc[i][j][r] = 0.f;
  const int arow0 = tid >> 3, ac = tid & 7;
  const bf16_t* ap = A + (size_t)arow0 * lda + ac * 8;
  const bf16_t* bp = Bt + (size_t)arow0 * ldb + ac * 8;
  const int sw = ((ac ^ (arow0 >> 1)) & 7) << 4;
  const int st_off = arow0 * 128 + sw;
  uint4 ra[4], rb[2];
#pragma unroll
  for (int i = 0; i < 4; ++i) ra[i] = *(const uint4*)(ap + (size_t)i * 64 * lda);
#pragma unroll
  for (int i = 0; i < 2; ++i) rb[i] = *(const uint4*)(bp + (size_t)i * 64 * ldb);
#pragma unroll
  for (int i = 0; i < 4; ++i) *(uint4*)(lds + st_off + i * 8192) = ra[i];
#pragma unroll
  for (int i = 0; i < 2; ++i) *(uint4*)(lds + 65536 + st_off + i * 8192) = rb[i];
  __syncthreads();
  const int nk = K >> 6;
  const int r31 = lane & 31, hh = lane >> 5;
  for (int kt = 0; kt < nk; ++kt) {
    const int cur = kt & 1;
    if (kt + 1 < nk) {
#pragma unroll
      for (int i = 0; i < 4; ++i) ra[i] = *(const uint4*)(ap + (size_t)i * 64 * lda + (kt + 1) * 64);
#pragma unroll
      for (int i = 0; i < 2; ++i) rb[i] = *(const uint4*)(bp + (size_t)i * 64 * ldb + (kt + 1) * 64);
    }
    const char* la = lds + cur * 32768;
    const char* lb = lds + 65536 + cur * 16384;
#pragma unroll
    for (int kk = 0; kk < 4; ++kk) {
      const int c = kk * 2 + hh;
      bf16x8 a[2], b[2];
#pragma unroll
      for (int mi = 0; mi < 2; ++mi) { const int row = wm * 64 + mi * 32 + r31; a[mi] = *(const bf16x8*)(la + row * 128 + (((c ^ (row >> 1)) & 7) << 4)); }
#pragma unroll
      for (int ni = 0; ni < 2; ++ni) { const int row = wn * 64 + ni * 32 + r31; b[ni] = *(const bf16x8*)(lb + row * 128 + (((c ^ (row >> 1)) & 7) << 4)); }
#pragma unroll
      for (int mi = 0; mi < 2; ++mi)
#pragma unroll
        for (int ni = 0; ni < 2; ++ni) acc[mi][ni] = MFMA32(a[mi], b[ni], acc[mi][ni]);
    }
    if (kt + 1 < nk) {
      char* wa = lds + (cur ^ 1) * 32768;
      char* wb = lds + 65536 + (cur ^ 1) * 16384;
#pragma unroll
      for (int i = 0; i < 4; ++i) *(uint4*)(wa + st_off + i * 8192) = ra[i];
#pragma unroll
      for (int i = 0; i < 2; ++i) *(uint4*)(wb + st_off + i * 8192) = rb[i];
    }
    __syncthreads();
  }
}

DI void gemm_store_phase(char* lds, const bf16_t* A, int lda, const bf16_t* Bt, int ldb, int M, int Npad, int K, bf16_t* C, int ldc, int nvalid) {
  const int ntn = Npad / 128, ntm = M / 256;
  const int lane = threadIdx.x & 63, wave = threadIdx.x >> 6, wm = wave >> 1, wn = wave & 1;
  for (int tile = blockIdx.x; tile < ntm * ntn; tile += gridDim.x) {
    const int mt = tile / ntn, nt = tile - mt * ntn;
    f32x16 acc[2][2];
    gemm_tile(lds, A + (size_t)mt * 256 * lda, lda, Bt + (size_t)nt * 128 * ldb, ldb, K, acc);
#pragma unroll
    for (int mi = 0; mi < 2; ++mi)
#pragma unroll
      for (int ni = 0; ni < 2; ++ni) {
        const int col = nt * 128 + wn * 64 + ni * 32 + (lane & 31);
        if (col < nvalid) {
#pragma unroll
          for (int r = 0; r < 16; ++r) {
            const int row = mt * 256 + wm * 64 + mi * 32 + ACC_ROW(r, lane);
            C[(size_t)row * ldc + col] = f2bf(acc[mi][ni][r]);
          }
        }
      }
  }
}

namespace pg8 {
typedef float f32x4 __attribute__((ext_vector_type(4)));
typedef unsigned u32x4 __attribute__((ext_vector_type(4)));
constexpr int BM = 256, BK = 64, HALF = 128, HTB = HALF * BK * 2, STAGE_BYTES = 8 * HTB, NXCD = 8, WGM = 8;
DI int lds_byte(int r, int c) { const int st = (r >> 4) * 2 + (c >> 5), rr = r & 15, cc = c & 31, ob = rr * 64 + cc * 2; return st * 1024 + (ob ^ (((ob >> 9) & 1) << 5)); }
DI void stage_rc(int b, int& R_, int& C_) { const int st = b / 1024, sb = b % 1024, swz = sb ^ (((sb >> 9) & 1) << 5); R_ = (st >> 1) * 16 + swz / 64; C_ = (st & 1) * 32 + (swz % 64) / 2; }
DI int perm32(int rho) { const int n = rho >> 4, i = rho & 15; return 8 * (i >> 2) + 4 * n + (i & 3); }
struct Unit { int pm, pn; };
struct Gemm { const bf16_t* A; const bf16_t* Bt; int lda, K; int headmajor; };
struct Order {
  int nM, nN, nwg, G, c, skipctx;
  DI void init(int nM_, int nN_, int G_, int c_, int skipctx_) { nM = nM_; nN = nN_; nwg = nM * nN; G = G_; c = c_; skipctx = skipctx_; }
  DI bool next(int i, Unit& u) const {
    const long L = (long)i * G + c; if (L >= nwg) return false;
    int wgid = (int)L; { const int q = nwg / NXCD, r = nwg % NXCD, xcd = wgid % NXCD, off = wgid / NXCD; wgid = (xcd < r ? xcd * (q + 1) : r * (q + 1) + (xcd - r) * q) + off; }
    const int nig = WGM * nN, gid = wgid / nig, fm = gid * WGM, gsz = (nM - fm) < WGM ? (nM - fm) : WGM;
    int pm = fm + ((wgid % nig) % gsz); u.pn = (wgid % nig) / gsz;
    if (skipctx) pm = (pm >> 4) * 17 + 1 + (pm & 15);
    u.pm = pm; return true;
  }
};
template <class Epi>
DI void gemm_phase(char* lds_generic, const Gemm g, const Order& S, const Epi& E) {
  LAS unsigned char* lds = (LAS unsigned char*)lds_generic;
  const int tid = threadIdx.x, wid = __builtin_amdgcn_readfirstlane(tid >> 6), lane = tid & 63, wr = wid >> 2, wc = wid & 3, fr = lane & 15, fq = lane >> 4;
  const int K = g.K, nt = K / BK, lda = g.lda;
  unsigned voffA[2], voffB[2];
#pragma unroll
  for (int i = 0; i < 2; ++i) { int R_, C_; stage_rc(tid * 16 + i * 8192, R_, C_); const int Rb = Epi::PERM ? ((R_ & ~31) + perm32(R_ & 31)) : R_;
    voffA[i] = (unsigned)(R_ * lda + C_) * 2u; voffB[i] = (unsigned)(Rb * K + C_) * 2u; }
  const size_t kstep = (size_t)(BK * 2);
  const size_t kstepA = g.headmajor ? (size_t)TPB * 64 * 2 : kstep;
  const size_t hstepA = (size_t)HALF * lda * 2, hstepB = (size_t)HALF * K * 2;
  const size_t tstepB = 2 * hstepB;
#define PG8_ABASE(pm_) ((const char*)g.A + (g.headmajor ? ((size_t)((pm_) / 17) * 32 * TPB + (size_t)((pm_) % 17) * 256) * 128 : (size_t)(pm_) * 2 * hstepA))
  const unsigned ldsw = (unsigned)wid * 1024u;
  const int aoff = lds_byte(wr * 64 + fr, fq * 8), boff = lds_byte(wc * 32 + fr, fq * 8);
#define PG8_SA(b, h) (((b) * 2 + (h)) * HTB)
#define PG8_SB(b, h) ((4 + (b) * 2 + (h)) * HTB)
#define PG8_STAGE(bufoff, gbase, voff) do { _Pragma("unroll") for (int _i = 0; _i < 2; ++_i) \
    __builtin_amdgcn_global_load_lds((const unsigned*)((const char*)(gbase) + (voff)[_i]), (LAS unsigned*)(lds + (bufoff) + ldsw + _i * 8192), 16, 0, 0); } while (0)
#define PG8_LDA(dst, b, h) do { _Pragma("unroll") for (int m = 0; m < 4; ++m) _Pragma("unroll") for (int k = 0; k < 2; ++k) dst[m][k] = *(const LAS bf16x8*)(lds + PG8_SA(b, h) + aoff + m * 2048 + k * 1024); } while (0)
#define PG8_LDB(dst, b, h) do { _Pragma("unroll") for (int n = 0; n < 2; ++n) _Pragma("unroll") for (int k = 0; k < 2; ++k) dst[n][k] = *(const LAS bf16x8*)(lds + PG8_SB(b, h) + boff + n * 2048 + k * 1024); } while (0)
#define PG8_MMA(ai, bj, At, Bt) do { __builtin_amdgcn_s_setprio(1); _Pragma("unroll") for (int m = 0; m < 4; ++m) _Pragma("unroll") for (int n = 0; n < 2; ++n) _Pragma("unroll") for (int k = 0; k < 2; ++k) \
    acc[ai][bj][m][n] = __builtin_amdgcn_mfma_f32_16x16x32_bf16(Bt[n][k], At[m][k], acc[ai][bj][m][n], 0, 0, 0); __builtin_amdgcn_s_setprio(0); } while (0)
#define PG8_WAIT_V(n) asm volatile("s_waitcnt vmcnt(" #n ")" ::: "memory")
#define PG8_WAIT_L(n) asm volatile("s_waitcnt lgkmcnt(" #n ")" ::: "memory")
#define PG8_BAR __builtin_amdgcn_s_barrier()
#define PG8_SCHED __builtin_amdgcn_sched_barrier(0)
  Unit cur, nxt; int ui = 0;
  if (!S.next(0, cur)) return;
  f32x4 acc[2][2][4][2];
#pragma unroll
  for (int a = 0; a < 2; ++a)
#pragma unroll
    for (int b = 0; b < 2; ++b)
#pragma unroll
      for (int m = 0; m < 4; ++m)
#pragma unroll
        for (int n = 0; n < 2; ++n) acc[a][b][m][n] = (f32x4){0.f, 0.f, 0.f, 0.f};
  bf16x8 At[4][2], B0[2][2], B1[2][2];
  const char* cA = PG8_ABASE(cur.pm); const char* cB = (const char*)g.Bt + (size_t)cur.pn * tstepB;
  PG8_STAGE(PG8_SB(0, 0), cB, voffB); PG8_STAGE(PG8_SA(0, 0), cA, voffA); PG8_STAGE(PG8_SB(0, 1), cB + hstepB, voffB); PG8_STAGE(PG8_SA(0, 1), cA + hstepA, voffA);
  if (wr == 1) PG8_BAR;
  PG8_WAIT_V(4); PG8_BAR;
  PG8_STAGE(PG8_SB(1, 0), cB + kstep, voffB); PG8_STAGE(PG8_SA(1, 0), cA + kstepA, voffA); PG8_STAGE(PG8_SB(1, 1), cB + hstepB + kstep, voffB);
  PG8_WAIT_V(6); PG8_BAR;
  for (;;) {
    const bool has_next = S.next(ui + 1, nxt);
    const char* nA = has_next ? PG8_ABASE(nxt.pm) : cA; const char* nB = has_next ? (const char*)g.Bt + (size_t)nxt.pn * tstepB : cB;
    for (int t = 0; t < nt; t += 2) {
      const bool last = (t == nt - 2);
      const char* a1 = cA + (size_t)(t + 1) * kstepA;
      const char* a2 = last ? nA : cA + (size_t)(t + 2) * kstepA; const char* b2 = last ? nB : cB + (size_t)(t + 2) * kstep;
      const char* a3 = a2 + kstepA; const char* b3 = b2 + kstep;
      PG8_LDB(B0, 0, 0); PG8_SCHED; PG8_LDA(At, 0, 0); PG8_STAGE(PG8_SA(1, 1), a1 + hstepA, voffA);
      PG8_WAIT_L(8); PG8_BAR; PG8_WAIT_L(0); PG8_MMA(0, 0, At, B0); PG8_BAR; PG8_SCHED;
      PG8_LDB(B1, 0, 1); PG8_STAGE(PG8_SB(0, 0), b2, voffB);
      PG8_BAR; PG8_WAIT_L(0); PG8_MMA(0, 1, At, B1); PG8_BAR;
      PG8_LDA(At, 0, 1); PG8_STAGE(PG8_SA(0, 0), a2, voffA);
      PG8_BAR; PG8_WAIT_L(0); PG8_MMA(1, 0, At, B0); PG8_BAR; PG8_SCHED;
      PG8_STAGE(PG8_SB(0, 1), b2 + hstepB, voffB);
      PG8_WAIT_V(6); PG8_BAR; PG8_MMA(1, 1, At, B1); PG8_BAR;
      PG8_LDB(B0, 1, 0); PG8_SCHED; PG8_LDA(At, 1, 0); PG8_STAGE(PG8_SA(0, 1), a2 + hstepA, voffA);
      PG8_WAIT_L(8); PG8_BAR; PG8_WAIT_L(0); PG8_MMA(0, 0, At, B0); PG8_BAR; PG8_SCHED;
      PG8_LDB(B1, 1, 1); PG8_STAGE(PG8_SB(1, 0), b3, voffB);
      PG8_BAR; PG8_WAIT_L(0); PG8_MMA(0, 1, At, B1); PG8_BAR;
      PG8_LDA(At, 1, 1); PG8_STAGE(PG8_SA(1, 0), a3, voffA);
      PG8_BAR; PG8_WAIT_L(0); PG8_MMA(1, 0, At, B0); PG8_BAR; PG8_SCHED;
      PG8_STAGE(PG8_SB(1, 1), b3 + hstepB, voffB);
      PG8_WAIT_V(6); PG8_BAR; PG8_MMA(1, 1, At, B1); PG8_BAR;
    }
    E(acc, cur, wr, wc, fr, fq);
    if (!has_next) break;
#pragma unroll
    for (int a = 0; a < 2; ++a)
#pragma unroll
      for (int b = 0; b < 2; ++b)
#pragma unroll
        for (int m = 0; m < 4; ++m)
#pragma unroll
          for (int n = 0; n < 2; ++n) acc[a][b][m][n] = (f32x4){0.f, 0.f, 0.f, 0.f};
    cur = nxt; cA = nA; cB = nB; ++ui;
  }
  PG8_WAIT_V(0);
  if (wr == 0) PG8_BAR;
  PG8_BAR;
#undef PG8_ABASE
#undef PG8_SA
#undef PG8_SB
#undef PG8_STAGE
#undef PG8_LDA
#undef PG8_LDB
#undef PG8_MMA
#undef PG8_WAIT_V
#undef PG8_WAIT_L
#undef PG8_BAR
#undef PG8_SCHED
}

struct EpiBf16 {
  static constexpr bool PERM = true;
  bf16_t* O; int ldc, nvalid;
  DI void operator()(const f32x4 (&acc)[2][2][4][2], const Unit& u, int wr, int wc, int fr, int fq) const {
    const int row0 = u.pm * BM + wr * 64 + fr, col0 = u.pn * BM + wc * 32 + 8 * fq;
#pragma unroll
    for (int ai = 0; ai < 2; ++ai)
#pragma unroll
      for (int m = 0; m < 4; ++m) { bf16_t* rowp = O + (size_t)(row0 + ai * HALF + m * 16) * ldc + col0;
#pragma unroll
        for (int bj = 0; bj < 2; ++bj) if (col0 + bj * HALF < nvalid) {
          const f32x4 v0 = acc[ai][bj][m][0], v1 = acc[ai][bj][m][1];
          u32x4 w; w.x = pack_bf2(v0[0], v0[1]); w.y = pack_bf2(v0[2], v0[3]); w.z = pack_bf2(v1[0], v1[1]); w.w = pack_bf2(v1[2], v1[3]);
          *(u32x4*)(rowp + bj * HALF) = w; } }
  }
};
struct EpiP0 {
  static constexpr bool PERM = true;
  bf16_t* O; const float2* rope;
  DI void operator()(const f32x4 (&acc)[2][2][4][2], const Unit& u, int wr, int wc, int fr, int fq) const {
    const int row0 = u.pm * BM + wr * 64 + fr, col0 = u.pn * BM + wc * 32 + 8 * fq;
    const bool isctx = (u.pm % 17) == 0; const int b = u.pm / 17;
    const bool qk = u.pn < 4;
    const float qs = (u.pn < 2) ? 0.125f * 1.4426950408889634f : 1.f;
    const int a = wc & 1, half = fq >> 1, f0 = 8 * (fq & 1);
#pragma unroll
    for (int ai = 0; ai < 2; ++ai)
#pragma unroll
      for (int m = 0; m < 4; ++m) {
        const int row = row0 + ai * HALF + m * 16;
        bf16_t* rowp = O + (size_t)row * P0LD + col0;
        const int l = row - b * TPB - CTXL;
#pragma unroll
        for (int bj = 0; bj < 2; ++bj) if (col0 + bj * HALF < P0LD) {
          float v[8];
#pragma unroll
          for (int j = 0; j < 4; ++j) { v[j] = acc[ai][bj][m][0][j]; v[4 + j] = acc[ai][bj][m][1][j]; }
          if (qk) {
            float pv[8];
#pragma unroll
            for (int j = 0; j < 8; ++j) pv[j] = __shfl_xor(v[j], 32);
            if (!isctx) {
              const float4* cs4 = (const float4*)(rope + (size_t)l * 32 + a * 16 + f0);
#pragma unroll
              for (int j2 = 0; j2 < 4; ++j2) {
                const float4 cs = cs4[j2];
                v[2 * j2] = half ? (v[2 * j2] * cs.x + pv[2 * j2] * cs.y) : (v[2 * j2] * cs.x - pv[2 * j2] * cs.y);
                v[2 * j2 + 1] = half ? (v[2 * j2 + 1] * cs.z + pv[2 * j2 + 1] * cs.w) : (v[2 * j2 + 1] * cs.z - pv[2 * j2 + 1] * cs.w);
              }
            }
#pragma unroll
            for (int j = 0; j < 8; ++j) v[j] *= qs;
          }
          u32x4 w; w.x = pack_bf2(v[0], v[1]); w.y = pack_bf2(v[2], v[3]); w.z = pack_bf2(v[4], v[5]); w.w = pack_bf2(v[6], v[7]);
          *(u32x4*)(rowp + bj * HALF) = w; } }
  }
};
struct EpiResid {
  static constexpr bool PERM = false;
  const float* x_in; const float* ctx_in; float* out; float* xc; const float* mods; int layer;
  DI void operator()(const f32x4 (&acc)[2][2][4][2], const Unit& u, int wr, int wc, int fr, int fq) const {
    const int row0 = u.pm * BM + wr * 64 + fr, col0 = u.pn * BM + wc * 32 + 4 * fq;
    const bool isctx = (u.pm % 17) == 0; const int b = u.pm / 17;
    const float* gate = mods + (isctx ? 8 : b) * 6144 + 2 * 1024 + col0;
    f32x4 gv[2][2];
#pragma unroll
    for (int bj = 0; bj < 2; ++bj)
#pragma unroll
      for (int n = 0; n < 2; ++n) gv[bj][n] = *(const f32x4*)(gate + bj * HALF + n * 16);
#pragma unroll
    for (int ai = 0; ai < 2; ++ai)
#pragma unroll
      for (int m = 0; m < 4; ++m) {
        const int row = row0 + ai * HALF + m * 16;
        const int t = row - b * TPB;
        const size_t o = isctx ? ((size_t)(b * CTXL + t)) * D + col0 : ((size_t)(b * SEQ + t - CTXL)) * D + col0;
        const float* src = isctx ? ctx_in : ((layer == 0) ? x_in : out);
        float* dst = isctx ? xc : out;
#pragma unroll
        for (int bj = 0; bj < 2; ++bj)
#pragma unroll
          for (int n = 0; n < 2; ++n) {
            const f32x4 xi = *(const f32x4*)(src + o + bj * HALF + n * 16);
            *(f32x4*)(dst + o + bj * HALF + n * 16) = xi + gv[bj][n] * acc[ai][bj][m][n];
          }
      }
  }
};
struct EpiDelta {
  static constexpr bool PERM = true;
  bf16_t* O; const float* mods;
  DI void operator()(const f32x4 (&acc)[2][2][4][2], const Unit& u, int wr, int wc, int fr, int fq) const {
    const int row0 = u.pm * BM + wr * 64 + fr, col0 = u.pn * BM + wc * 32 + 8 * fq;
    const bool isctx = (u.pm % 17) == 0; const int b = u.pm / 17;
    const float* gate = mods + (isctx ? 8 : b) * 6144 + 2 * 1024 + col0;
    f32x4 g0[2], g1[2];
#pragma unroll
    for (int bj = 0; bj < 2; ++bj) { g0[bj] = *(const f32x4*)(gate + bj * HALF); g1[bj] = *(const f32x4*)(gate + bj * HALF + 4); }
#pragma unroll
    for (int ai = 0; ai < 2; ++ai)
#pragma unroll
      for (int m = 0; m < 4; ++m) { bf16_t* rowp = O + (size_t)(row0 + ai * HALF + m * 16) * D + col0;
#pragma unroll
        for (int bj = 0; bj < 2; ++bj) {
          const f32x4 v0 = acc[ai][bj][m][0] * g0[bj], v1 = acc[ai][bj][m][1] * g1[bj];
          u32x4 w; w.x = pack_bf2(v0[0], v0[1]); w.y = pack_bf2(v0[2], v0[3]); w.z = pack_bf2(v1[0], v1[1]); w.w = pack_bf2(v1[2], v1[3]);
          *(u32x4*)(rowp + bj * HALF) = w; } }
  }
};
struct EpiP1 {
  static constexpr bool PERM = true;
  unsigned char* pb;
  DI void operator()(const f32x4 (&acc)[2][2][4][2], const Unit& u, int wr, int wc, int fr, int fq) const {
    unsigned zo = 0;
    asm volatile("" : "+v"(zo));
    const int row0 = u.pm * BM + wr * 64 + fr, col0 = u.pn * BM + wc * 32 + 8 * fq;
    const int b = u.pm / 17;
    const unsigned t0 = (unsigned)(row0 - b * TPB) + zo;
#pragma unroll
    for (int bj = 0; bj < 2; ++bj) {
      const int c = col0 + bj * HALF;
      if (c >= P1LD) continue;
      unsigned off, tstride;
      if (c < 2048) { off = (unsigned)L1_ZH + ((unsigned)(b * 32 + (c >> 6)) * TPB) * 128u + (unsigned)(c & 63) * 2u; tstride = 128u; }
      else if (c < 4096) { const int cc = c - 2048; off = (unsigned)L1_XH + ((unsigned)(b * 32 + (cc >> 6)) * TPB) * 128u + (unsigned)(cc & 63) * 2u; tstride = 128u; }
      else if (c < 4608) { const int cc = c - 4096; off = (unsigned)L1_BG + ((unsigned)(b * 4 + (cc >> 7)) * TPB) * 256u + (unsigned)(cc & 127) * 2u; tstride = 256u; }
      else if (c < 5120) { const int cc = c - 4608; off = (unsigned)L1_CG + ((unsigned)(b * 4 + (cc >> 7)) * TPB) * 256u + (unsigned)(cc & 127) * 2u; tstride = 256u; }
      else { off = (unsigned)L1_DT + (unsigned)b * TPB * 128u + (unsigned)(c - 5120) * 2u; tstride = 128u; }
      off += t0 * tstride;
#pragma unroll
      for (int ai = 0; ai < 2; ++ai)
#pragma unroll
        for (int m = 0; m < 4; ++m) {
          const f32x4 v0 = acc[ai][bj][m][0], v1 = acc[ai][bj][m][1];
          u32x4 w; w.x = pack_bf2(v0[0], v0[1]); w.y = pack_bf2(v0[2], v0[3]); w.z = pack_bf2(v1[0], v1[1]); w.w = pack_bf2(v1[2], v1[3]);
          *(u32x4*)(pb + off + (unsigned)(ai * HALF + m * 16) * tstride) = w;
        }
    }
  }
};
}

DI void transpose_tile(char* lds, const float* __restrict__ src, int K, int N, bf16_t* __restrict__ dst, int tile) {
  float* T = (float*)lds;
  const int ntk = K / 64;
  const int tn = tile / ntk, tk = tile - tn * ntk;
  const int tid = threadIdx.x;
  __syncthreads();
#pragma unroll
  for (int i = 0; i < 2; ++i) {
    const int kk = (tid >> 4) + 32 * i, n4 = (tid & 15) * 4;
    const int n = tn * 64 + n4;
    float4 v = make_float4(0.f, 0.f, 0.f, 0.f);
    if (n < N) v = *(const float4*)(src + (size_t)(tk * 64 + kk) * N + n);
    *(float4*)(T + kk * 68 + n4) = v;
  }
  __syncthreads();
  {
    const int nn = tid & 63, kc = tid >> 6;
    float f[8];
#pragma unroll
    for (int j = 0; j < 8; ++j) f[j] = T[(kc * 8 + j) * 68 + nn];
    *(uint4*)(dst + (size_t)(tn * 64 + nn) * K + tk * 64 + kc * 8) = pack8(f);
  }
}

DI void phase_prep(const P& p, char* lds) {
  const int tid = threadIdx.x;
  unsigned char* ws = p.ws;
  struct TD { int idx; int K, N, Npad; size_t dst; size_t srcoff; };
  int base = 0;
  const int G = gridDim.x;
#define TRANSPOSE_TASK(SRC, KK, NN, NPAD, DST) { const int nt_ = ((NPAD) / 64) * ((KK) / 64); \
    for (int w = blockIdx.x; w < nt_; w += G) transpose_tile(lds, (SRC), (KK), (NN), (bf16_t*)(DST), w); }
  TRANSPOSE_TASK(p.in[I_WIN0], 1024, 3456, 3584, ws + WS_WIN0T)
  TRANSPOSE_TASK(p.in[I_WOUT0], 1024, 1024, 1024, ws + WS_WOUT0T)
  TRANSPOSE_TASK(p.in[I_PQ0], 1024, 2048, 2048, ws + WS_PQ0T)
  TRANSPOSE_TASK(p.in[I_WIN1], 1024, 5184, 5376, ws + WS_WIN1T)
  TRANSPOSE_TASK(p.in[I_WOUT1], 2048, 1024, 1024, ws + WS_WOUT1T)
  TRANSPOSE_TASK(p.in[I_PQ1], 1024, 2048, 2048, ws + WS_PQ1T)
  TRANSPOSE_TASK(p.in[I_RWW2], 64, 512, 512, ws + WS_RWT)
  TRANSPOSE_TASK(p.in[I_RWW2] + 64 * 512, 64, 512, 512, ws + WS_RWT + 65536)
  TRANSPOSE_TASK(p.in[I_RWA2], 64, 512, 512, ws + WS_RWT + 131072)
  TRANSPOSE_TASK(p.in[I_RWA2] + 64 * 512, 64, 512, 512, ws + WS_RWT + 196608)
  TRANSPOSE_TASK(p.in[I_RWG2], 128, 512, 512, ws + WS_RWT + 262144)
  (void)base;
  {
    const int gt = blockIdx.x * NTHR + tid, gs = G * NTHR;
    bf16_t* k0 = (bf16_t*)(ws + WS_KEYS0); bf16_t* k1 = (bf16_t*)(ws + WS_KEYS1);
    for (int i = gt; i < 262144; i += gs) { k0[i] = f2bf(p.in[I_PK0][i]); k1[i] = f2bf(p.in[I_PK1][i]); }
    float2* rope = (float2*)(ws + WS_ROPE);
    for (int i = gt; i < 4096 * 32; i += gs) {
      const int l = i >> 5, a = (i >> 4) & 1, f = i & 15;
      const float inv = powf(10000.f, -(float)f / 16.f);
      const float pos = (float)(a == 0 ? (l >> 6) : (l & 63));
      float s, c; sincosf(pos * inv, &s, &c);
      rope[i] = make_float2(c, s);
    }
    if (gt == 0) {
      const float* lp = p.in[I_DALAM];
      float s01 = 0.f, s23 = 0.f;
      for (int i = 0; i < 64; ++i) { s01 += lp[i] * lp[64 + i]; s23 += lp[128 + i] * lp[192 + i]; }
      ((float*)(ws + WS_SCAL))[0] = expf(s01) - expf(s23) + 0.2f;
    }
  }
  {
    float* sc = (float*)lds;
    float* red = (float*)(lds + 36864);
    __syncthreads();
    for (int e = tid; e < 9 * 1024; e += NTHR) { const int r = e >> 10, k = e & 1023; const float v = (r < 8) ? p.in[I_C][r * 1024 + k] : p.in[I_CCTX][k]; sc[e] = siluf_(v); }
    __syncthreads();
    float* mods = (float*)(ws + WS_MODS);
    for (int w = blockIdx.x; w < 192; w += G) {
      const int l = w / 96, j0 = (w % 96) * 64;
      const float* aw = p.in[l == 0 ? I_ADAW0 : I_ADAW1];
      const float* ab = p.in[l == 0 ? I_ADAB0 : I_ADAB1];
      const int col = tid & 63, kg = tid >> 6;
      float a[9];
#pragma unroll
      for (int r = 0; r < 9; ++r) a[r] = 0.f;
      for (int k = kg * 128; k < kg * 128 + 128; ++k) {
        const float wv = aw[(size_t)k * 6144 + j0 + col];
#pragma unroll
        for (int r = 0; r < 9; ++r) a[r] += sc[r * 1024 + k] * wv;
      }
      __syncthreads();
#pragma unroll
      for (int r = 0; r < 9; ++r) red[(kg * 64 + col) * 9 + r] = a[r];
      __syncthreads();
      for (int e = tid; e < 64 * 9; e += NTHR) {
        const int c2 = e / 9, r = e - c2 * 9;
        float s = ab[j0 + c2];
        for (int g = 0; g < 8; ++g) s += red[(g * 64 + c2) * 9 + r];
        mods[((size_t)l * 9 + r) * 6144 + j0 + c2] = s;
      }
    }
  }
}

DI float wave_max(float x) {
  x = fmaxf(x, dpp_f<0xB1>(x)); x = fmaxf(x, dpp_f<0x4E>(x)); x = fmaxf(x, dpp_f<0x141>(x)); x = fmaxf(x, dpp_f<0x140>(x));
  x = fmaxf(x, __shfl_xor(x, 16)); x = fmaxf(x, __shfl_xor(x, 32)); return x;
}
DI void convert_tables(const P& p, int layer) {
  const int lane = threadIdx.x & 63, gw = blockIdx.x * 8 + (threadIdx.x >> 6), nw = gridDim.x * 8;
  const float* u = p.in[layer == 0 ? I_PU0 : I_PU1];
  const float* v = p.in[layer == 0 ? I_PV0 : I_PV1];
  unsigned char* du = p.ws + WS_HB + HB_U;
  unsigned char* dv = p.ws + WS_HB + HB_V;
  float* su = (float*)(p.ws + WS_HB + HB_SU);
  float* sv = (float*)(p.ws + WS_HB + HB_SV);
  for (int row = gw; row < 32768; row += nw) {
    const bool isv = row >= 16384;
    const int r = row & 16383;
    const float* src = (isv ? v : u) + (size_t)r * D + lane * 16;
    float x[16];
#pragma unroll
    for (int i = 0; i < 4; ++i) { const float4 f = *(const float4*)(src + i * 4); x[i * 4] = f.x; x[i * 4 + 1] = f.y; x[i * 4 + 2] = f.z; x[i * 4 + 3] = f.w; }
    float am = 0.f, ss = 0.f;
#pragma unroll
    for (int i = 0; i < 16; ++i) { am = fmaxf(am, fabsf(x[i])); ss += x[i] * x[i]; }
    am = fmaxf(wave_max(am), 1e-30f);
    ss = red64(ss);
    const float step = fminf(am * (1.f / 7.5f), fmaxf(0.3352f * sqrtf(ss * (1.f / 1024.f)), 1e-30f));
    const float inv = 1.f / step;
    unsigned w[2];
#pragma unroll
    for (int d2 = 0; d2 < 2; ++d2) {
      unsigned pk = 0;
#pragma unroll
      for (int j = 0; j < 8; ++j) {
        int q = (int)rintf(x[d2 * 8 + j] * inv + 7.5f);
        q = q < 0 ? 0 : (q > 15 ? 15 : q);
        pk |= (unsigned)q << (8 * (j >> 1) + 4 * (j & 1));
      }
      w[d2] = pk;
    }
    *(uint2*)((isv ? dv : du) + (size_t)r * 512 + lane * 8) = make_uint2(w[0], w[1]);
    if (lane == 0) (isv ? sv : su)[r] = step;
  }
}

DI void phase_normmod(const P& p, int layer, int which, bool from_inputs, bool lat_only, bf16_t* dst, const bf16_t* delta = nullptr) {
  const int lane = threadIdx.x & 63, gw = blockIdx.x * 8 + (threadIdx.x >> 6), nw = gridDim.x * 8;
  const float* g = p.in[layer == 0 ? (which == 0 ? I_N1_0 : I_N2_0) : (which == 0 ? I_N1_1 : I_N2_1)];
  const float* mods = (const float*)(p.ws + WS_MODS) + (size_t)layer * 9 * 6144;
  const float* xc = (const float*)(p.ws + WS_XC);
  float4 nx[4]; uint4 nd[2];
#define NM_SRC(ROW) ((((ROW) % TPB) < CTXL) ? ((from_inputs ? p.in[I_CTX] : xc) + ((size_t)(((ROW) / TPB) * CTXL + ((ROW) % TPB))) * D) \
                                             : ((from_inputs ? p.in[I_X] : p.out) + ((size_t)(((ROW) / TPB) * SEQ + ((ROW) % TPB) - CTXL)) * D))
#define NM_LOAD(ROW) do { if (!(lat_only && ((ROW) % TPB) < CTXL)) { const float* s_ = NM_SRC(ROW); \
      _Pragma("unroll") for (int i = 0; i < 4; ++i) nx[i] = *(const float4*)(s_ + lane * 16 + i * 4); \
      if (delta) { nd[0] = *(const uint4*)(delta + (size_t)(ROW) * D + lane * 16); nd[1] = *(const uint4*)(delta + (size_t)(ROW) * D + lane * 16 + 8); } } } while (0)
  if (gw < R) NM_LOAD(gw);
  for (int row = gw; row < R; row += nw) {
    const int b = row / TPB, t = row - b * TPB;
    const bool isctx = t < CTXL;
    float v[16]; uint4 dcur0 = nd[0], dcur1 = nd[1];
#pragma unroll
    for (int i = 0; i < 4; ++i) { v[i * 4] = nx[i].x; v[i * 4 + 1] = nx[i].y; v[i * 4 + 2] = nx[i].z; v[i * 4 + 3] = nx[i].w; }
    if (row + nw < R) NM_LOAD(row + nw);
    if (isctx && lat_only) continue;
    const float* mrow = mods + (isctx ? 8 : b) * 6144 + (which == 0 ? 0 : 3 * 1024);
    if (delta) {
      float dl[8];
      unpack8(dcur0, dl);
#pragma unroll
      for (int i = 0; i < 8; ++i) v[i] += dl[i];
      unpack8(dcur1, dl);
#pragma unroll
      for (int i = 0; i < 8; ++i) v[8 + i] += dl[i];
      float* xo = isctx ? ((float*)(p.ws + WS_XC) + ((size_t)(b * CTXL + t)) * D) : (p.out + ((size_t)(b * SEQ + t - CTXL)) * D);
#pragma unroll
      for (int i = 0; i < 4; ++i) *(float4*)(xo + lane * 16 + i * 4) = make_float4(v[i * 4], v[i * 4 + 1], v[i * 4 + 2], v[i * 4 + 3]);
    }
    float ss = 0.f;
#pragma unroll
    for (int i = 0; i < 16; ++i) ss += v[i] * v[i];
    ss = red64(ss);
    const float rs = rsqrtf(ss * (1.f / 1024.f) + 1e-6f);
    float o[16];
#pragma unroll
    for (int i = 0; i < 16; ++i) { const int c = lane * 16 + i; o[i] = v[i] * rs * g[c] * (1.f + mrow[1024 + c]) + mrow[c]; }
    uint4 w0, w1;
    w0.x = pack_bf2(o[0], o[1]); w0.y = pack_bf2(o[2], o[3]); w0.z = pack_bf2(o[4], o[5]); w0.w = pack_bf2(o[6], o[7]);
    w1.x = pack_bf2(o[8], o[9]); w1.y = pack_bf2(o[10], o[11]); w1.z = pack_bf2(o[12], o[13]); w1.w = pack_bf2(o[14], o[15]);
    *(uint4*)(dst + (size_t)row * D + lane * 16) = w0;
    *(uint4*)(dst + (size_t)row * D + lane * 16 + 8) = w1;
  }
#undef NM_SRC
#undef NM_LOAD
}

DI void phase_final_norm(const P& p) {
  const int lane = threadIdx.x & 63, gw = blockIdx.x * 8 + (threadIdx.x >> 6), nw = gridDim.x * 8;
  const float* g = p.in[I_NF];
  for (int row = gw; row < NB * SEQ; row += nw) {
    float* src = p.out + (size_t)row * D;
    float v[16];
#pragma unroll
    for (int i = 0; i < 4; ++i) { const float4 f = *(const float4*)(src + lane * 16 + i * 4); v[i * 4] = f.x; v[i * 4 + 1] = f.y; v[i * 4 + 2] = f.z; v[i * 4 + 3] = f.w; }
    float ss = 0.f;
#pragma unroll
    for (int i = 0; i < 16; ++i) ss += v[i] * v[i];
    ss = red64(ss);
    const float rs = rsqrtf(ss * (1.f / 1024.f) + 1e-6f);
#pragma unroll
    for (int i = 0; i < 4; ++i) {
      const int c = lane * 16 + i * 4;
      float4 f; f.x = v[i * 4] * rs * g[c]; f.y = v[i * 4 + 1] * rs * g[c + 1]; f.z = v[i * 4 + 2] * rs * g[c + 2]; f.w = v[i * 4 + 3] * rs * g[c + 3];
      *(float4*)(src + c) = f;
    }
  }
}

typedef __attribute__((ext_vector_type(4))) short s16x4;
DI s16x4 tr_read(const char* p) { return __builtin_amdgcn_ds_read_tr16_b64_v4i16((__attribute__((address_space(3))) s16x4*)(p)); }

DI void attn_flash_unit(const P& p, char* lds, int unit) {
  const int tid = threadIdx.x, lane = tid & 63, wave = tid >> 6;
  const bool isctx = unit >= 1024;
  int b, h, qb;
  if (!isctx) { b = unit >> 7; h = (unit >> 5) & 3; qb = unit & 31; } else { const int u = unit - 1024; b = u >> 3; h = (u >> 1) & 3; qb = u & 1; }
  const int nkt = isctx ? CTXL / 64 : TPB / 64;
  const bf16_t* p0 = (const bf16_t*)(p.ws + WS_PB + PB_P);
  const float lam = ((const float*)(p.ws + WS_SCAL))[0];
  const int qg = wave >> 1, m = wave & 1;
  const int r31 = lane & 31, hh = lane >> 5;
  const int ql = qb * 128 + qg * 32 + r31;
  const size_t qrow = (size_t)b * TPB + (isctx ? ql : CTXL + ql);
  bf16x8 qf[4];
#pragma unroll
  for (int kk = 0; kk < 4; ++kk) qf[kk] = *(const bf16x8*)(p0 + qrow * P0LD + h * 128 + m * 64 + kk * 16 + 8 * hh);
  const int skey = tid >> 4, scc = tid & 15;
  const bf16_t* kg = p0 + ((size_t)b * TPB + skey) * P0LD + 512 + h * 128 + scc * 8;
  const bf16_t* vg = kg + 512;
  const int koff = (scc >> 3) * 8192 + skey * 128 + ((((scc & 7) ^ (skey >> 1)) & 7) << 4);
  const int voff = 16384 + skey * 320 + scc * 16;
  constexpr int BUFSZ = 36864;
  uint4 rk[2], rv[2];
  __syncthreads();
#pragma unroll
  for (int i = 0; i < 2; ++i) { rk[i] = *(const uint4*)(kg + (size_t)i * 32 * P0LD); rv[i] = *(const uint4*)(vg + (size_t)i * 32 * P0LD); }
#pragma unroll
  for (int i = 0; i < 2; ++i) { *(uint4*)(lds + koff + i * 4096) = rk[i]; *(uint4*)(lds + voff + i * 10240) = rv[i]; }
  __syncthreads();
  f32x16 o[4];
#pragma unroll
  for (int v = 0; v < 4; ++v)
#pragma unroll
    for (int r = 0; r < 16; ++r) o[v][r] = 0.f;
  float mrun = -1e30f, lsum = 0.f;
  const int q4 = (lane & 15) >> 2;
  const int vboff = ((lane >> 4) & 1) * 32 + 8 * (lane & 3);
  for (int kt = 0; kt < nkt; ++kt) {
    const int cur = kt & 1;
    if (kt + 1 < nkt) {
#pragma unroll
      for (int i = 0; i < 2; ++i) { rk[i] = *(const uint4*)(kg + (size_t)((kt + 1) * 64 + i * 32) * P0LD); rv[i] = *(const uint4*)(vg + (size_t)((kt + 1) * 64 + i * 32) * P0LD); }
    }
    const char* kb = lds + cur * BUFSZ + m * 8192;
    const char* vb = lds + cur * BUFSZ + 16384;
    f32x16 s[2];
#pragma unroll
    for (int t = 0; t < 2; ++t)
#pragma unroll
      for (int r = 0; r < 16; ++r) s[t][r] = 0.f;
#pragma unroll
    for (int kk = 0; kk < 4; ++kk)
#pragma unroll
      for (int t = 0; t < 2; ++t) {
        const int row = t * 32 + r31;
        const bf16x8 a = *(const bf16x8*)(kb + row * 128 + ((((kk * 2 + hh) ^ (row >> 1)) & 7) << 4));
        s[t] = MFMA32(a, qf[kk], s[t]);
      }
    float mx = s[0][0];
#pragma unroll
    for (int t = 0; t < 2; ++t)
#pragma unroll
      for (int r = 0; r < 16; ++r) mx = fmaxf(mx, s[t][r]);
    mx = fmaxf(mx, __shfl_xor(mx, 32));
    const float mnew = fmaxf(mrun, mx);
    const float corr = __builtin_amdgcn_exp2f(mrun - mnew);
    mrun = mnew;
    lsum *= corr;
#pragma unroll
    for (int v = 0; v < 4; ++v)
#pragma unroll
      for (int r = 0; r < 16; ++r) o[v][r] *= corr;
#pragma unroll
    for (int t = 0; t < 2; ++t)
#pragma unroll
      for (int r = 0; r < 16; ++r) { const float e = __builtin_amdgcn_exp2f(s[t][r] - mnew); s[t][r] = e; lsum += e; }
#pragma unroll
    for (int t = 0; t < 2; ++t)
#pragma unroll
      for (int st = 0; st < 2; ++st) {
        unsigned pk[4];
#pragma unroll
        for (int j = 0; j < 4; ++j) pk[j] = pack_bf2(s[t][8 * st + 2 * j], s[t][8 * st + 2 * j + 1]);
        bf16x8 bp;
        { typedef __attribute__((ext_vector_type(4))) unsigned u32x4; u32x4 u = {pk[0], pk[1], pk[2], pk[3]}; bp = __builtin_bit_cast(bf16x8, u); }
        const int key0 = t * 32 + 16 * st + 4 * hh + q4;
#pragma unroll
        for (int v = 0; v < 4; ++v) {
          const s16x4 lo = tr_read(vb + key0 * 320 + v * 64 + vboff);
          const s16x4 hi = tr_read(vb + (key0 + 8) * 320 + v * 64 + vboff);
          const bf16x8 av = __builtin_shufflevector(lo, hi, 0, 1, 2, 3, 4, 5, 6, 7);
          o[v] = MFMA32(av, bp, o[v]);
        }
      }
    if (kt + 1 < nkt) {
      char* nb = lds + (cur ^ 1) * BUFSZ;
#pragma unroll
      for (int i = 0; i < 2; ++i) { *(uint4*)(nb + koff + i * 4096) = rk[i]; *(uint4*)(nb + voff + i * 10240) = rv[i]; }
    }
    __syncthreads();
  }
  lsum += __shfl_xor(lsum, 32);
  const float inv = 1.f / lsum;
  float* Ex = (float*)lds;
  if (m == 1) {
#pragma unroll
    for (int v = 0; v < 4; ++v)
#pragma unroll
      for (int r = 0; r < 16; ++r) Ex[(qg * 128 + v * 32 + ACC_ROW(r, lane)) * 32 + r31] = o[v][r] * inv;
  }
  __syncthreads();
  if (m == 0) {
    float ss = 0.f;
#pragma unroll
    for (int v = 0; v < 4; ++v)
#pragma unroll
      for (int r = 0; r < 16; ++r) { const float dv = o[v][r] * inv - lam * Ex[(qg * 128 + v * 32 + ACC_ROW(r, lane)) * 32 + r31]; o[v][r] = dv; ss += dv * dv; }
    ss += __shfl_xor(ss, 32);
    const float rs = rsqrtf(ss * (1.f / 128.f) + 1e-6f) * 0.8f;
    const float* sub = p.in[I_DASUB];
    bf16_t* op = (bf16_t*)(p.ws + WS_PB + PB_O0) + qrow * 1024 + h * 128;
#pragma unroll
    for (int v = 0; v < 4; ++v)
#pragma unroll
      for (int g4 = 0; g4 < 4; ++g4) {
        const int vd = v * 32 + 8 * g4 + 4 * hh;
        uint2 w;
        w.x = pack_bf2(o[v][g4 * 4] * rs * sub[vd], o[v][g4 * 4 + 1] * rs * sub[vd + 1]);
        w.y = pack_bf2(o[v][g4 * 4 + 2] * rs * sub[vd + 2], o[v][g4 * 4 + 3] * rs * sub[vd + 3]);
        *(uint2*)(op + vd) = w;
      }
  }
  __syncthreads();
}

DI void phase_ga(const P& p) {
  const bf16_t* p0 = (const bf16_t*)(p.ws + WS_PB + PB_P);
  bf16_t* ga = (bf16_t*)(p.ws + WS_PB + PB_GA);
  const float* mu = p.in[I_RWMU] + 1792;
  for (int i = blockIdx.x * NTHR + threadIdx.x; i < R * 16; i += gridDim.x * NTHR) {
    const int row = i >> 4, c8 = (i & 15) * 8;
    const int t = row % TPB;
    const bool first = (t == 0) || (t == CTXL), last = (t == CTXL - 1) || (t == TPB - 1);
    const bf16_t* sp = p0 + (size_t)row * P0LD + 1536 + 1792 + c8;
    float u[8], um[8], up[8];
    unpack8(*(const uint4*)sp, u);
    if (!first) unpack8(*(const uint4*)(sp - P0LD), um); else { for (int j = 0; j < 8; ++j) um[j] = 0.f; }
    if (!last) unpack8(*(const uint4*)(sp + P0LD), up); else { for (int j = 0; j < 8; ++j) up[j] = 0.f; }
    float o[8];
#pragma unroll
    for (int j = 0; j < 8; ++j) { const float mix = u[j] + mu[c8 + j] * (0.5f * (um[j] + up[j]) - u[j]); o[j] = sigmoidf_(mix); }
    *(uint4*)(ga + (size_t)row * 128 + c8) = pack8(o);
  }
}

DI int scan_token(int d, int s) { return d == 0 ? s : (s < CTXL ? (CTXL - 1 - s) : (TPB + CTXL - 1 - s)); }

typedef __attribute__((ext_vector_type(4))) float f32x4_t;
DI void rwkv_scan_unit(const P& p, char* lds, int unit) {
  int tid_ = threadIdx.x;
  asm volatile("" : "+v"(tid_));
  const int tid = tid_, lane = tid & 63, wave = __builtin_amdgcn_readfirstlane(tid >> 6);
  const int half = unit & 1, d = (unit >> 1) & 1, h = (unit >> 2) & 7, b = unit >> 5;
  constexpr int T = 32, NCHK = TPB / T, BUFB = 45056;
  const bf16_t* p0 = (const bf16_t*)(p.ws + WS_PB + PB_P);
  __syncthreads();
  {
    const bf16_t* w2t = (const bf16_t*)(p.ws + WS_RWT + (size_t)d * 65536) + h * 64 * 64;
    const bf16_t* a2t = (const bf16_t*)(p.ws + WS_RWT + 131072 + (size_t)d * 65536) + h * 64 * 64;
    *(uint4*)(lds + 139264 + tid * 16) = *(const uint4*)(w2t + tid * 8);
    *(uint4*)(lds + 147456 + tid * 16) = *(const uint4*)(a2t + tid * 8);
    float* LC = (float*)(lds + 155648);
    for (int e = tid; e < 640; e += NTHR) {
      const int g = e >> 6, cidx = e & 63;
      float v;
      if (g == 0) v = p.in[I_RWW0][d * 512 + h * 64 + cidx];
      else if (g == 1) v = p.in[I_RWA0][d * 512 + h * 64 + cidx];
      else if (g == 2) v = p.in[I_RWKK][h * 64 + cidx];
      else if (g == 3) v = p.in[I_RWKA][h * 64 + cidx];
      else if (g == 4) v = p.in[I_RWRK][h * 64 + cidx];
      else if (g < 8) v = p.in[I_RWMU][(g - 5) * 512 + h * 64 + cidx];
      else v = p.in[I_RWMU][(g == 8 ? 1536 : 1664) + d * 64 + cidx];
      LC[e] = v;
    }
  }
  __syncthreads();
  if (wave < 4) {
    const int rp = tid >> 4, c16 = tid & 15, c4 = c16 * 4;
    typedef float f32x2 __attribute__((ext_vector_type(2)));
    f32x2 S0a = {0.f, 0.f}, S0b = {0.f, 0.f}, S1a = {0.f, 0.f}, S1b = {0.f, 0.f};
    bf16_t* yout = (bf16_t*)(p.ws + WS_HB + (d == 0 ? HB_YF : HB_YB)) + h * 64 + half * 32 + wave * 8 + (lane & 7);
    SEGR_DECL();
    __syncthreads();
    SEGR_INIT();
    for (int c = 0; c < NCHK; ++c) {
      int zo = 0;
      asm volatile("" : "+v"(zo));
      const char* B0 = lds + (c & 1) * BUFB + zo;
      float* Lyp = (float*)(lds + 122880 + zo);
      const float* La = (const float*)B0 + c4; const float* Lb = (const float*)(B0 + 8192) + c4; const float* Lk = (const float*)(B0 + 16384) + c4;
      const float* Lw = (const float*)(B0 + 24576) + c4; const float* Lr = (const float*)(B0 + 32768) + c4; const float* Lv = (const float*)(B0 + 40960) + rp * 2;
#define RW_LD(s_, A_, B_, K_, W_, R_, V_) const float4 A_ = *(const float4*)(La + (s_) * 64), B_ = *(const float4*)(Lb + (s_) * 64), K_ = *(const float4*)(Lk + (s_) * 64), \
          W_ = *(const float4*)(Lw + (s_) * 64), R_ = *(const float4*)(Lr + (s_) * 64); const float2 V_ = *(const float2*)(Lv + (s_) * 32)
      float4 a4, b4, k4, w4, r4, a4n, b4n, k4n, w4n, r4n; float2 v2, v2n;
      { RW_LD(0, xa, xb, xk, xw, xr, xv); a4 = xa; b4 = xb; k4 = xk; w4 = xw; r4 = xr; v2 = xv; }
      { RW_LD(1, xa, xb, xk, xw, xr, xv); a4n = xa; b4n = xb; k4n = xk; w4n = xw; r4n = xr; v2n = xv; }
#pragma unroll 1
      for (int g8 = 0; g8 < 4; ++g8) {
#pragma unroll
        for (int si = 0; si < 8; ++si) {
          const int s2 = (g8 * 8 + si + 2) & 31;
          RW_LD(s2, a4f, b4f, k4f, w4f, r4f, v2f);
          const f32x2 a01 = {a4.x, a4.y}, a23 = {a4.z, a4.w}, b01 = {b4.x, b4.y}, b23 = {b4.z, b4.w}, k01 = {k4.x, k4.y}, k23 = {k4.z, k4.w};
          const f32x2 w01 = {w4.x, w4.y}, w23 = {w4.z, w4.w}, r01 = {r4.x, r4.y}, r23 = {r4.z, r4.w};
          const f32x2 t0 = S0a * a01 + S0b * a23, t1 = S1a * a01 + S1b * a23;
          float sa0 = t0.x + t0.y, sa1 = t1.x + t1.y;
          const f32x2 vv0 = {v2.x, v2.x}, vv1 = {v2.y, v2.y};
          const f32x2 u0a = S0a * w01 + vv0 * k01, u0b = S0b * w23 + vv0 * k23, u1a = S1a * w01 + vv1 * k01, u1b = S1b * w23 + vv1 * k23;
          sa0 = red16(sa0); sa1 = red16(sa1);
          const f32x2 s0 = {sa0, sa0}, s1 = {sa1, sa1};
          S0a = s0 * b01 + u0a; S0b = s0 * b23 + u0b; S1a = s1 * b01 + u1a; S1b = s1 * b23 + u1b;
          const f32x2 y0 = S0a * r01 + S0b * r23, y1 = S1a * r01 + S1b * r23;
          Lyp[(si * 32 + rp * 2) * 16 + c16] = y0.x + y0.y;
          Lyp[(si * 32 + rp * 2 + 1) * 16 + c16] = y1.x + y1.y;
          a4 = a4n; b4 = b4n; k4 = k4n; w4 = w4n; r4 = r4n; v2 = v2n;
          a4n = a4f; b4n = b4f; k4n = k4f; w4n = w4f; r4n = r4f; v2n = v2f;
        }
        __builtin_amdgcn_wave_barrier();
        asm volatile("s_waitcnt lgkmcnt(0)" ::: "memory");
        {
          const int sj = lane >> 3, ri = lane & 7;
          const float4* pp = (const float4*)(Lyp + (sj * 32 + wave * 8 + ri) * 16);
          const float4 q0 = pp[0], q1 = pp[1], q2 = pp[2], q3 = pp[3];
          const float ysum = ((q0.x + q0.y) + (q0.z + q0.w)) + ((q1.x + q1.y) + (q1.z + q1.w)) + ((q2.x + q2.y) + (q2.z + q2.w)) + ((q3.x + q3.y) + (q3.z + q3.w));
          const int t = scan_token(d, c * T + g8 * 8 + sj);
          yout[((size_t)b * TPB + t) * 512] = f2bf(ysum);
        }
        asm volatile("s_waitcnt lgkmcnt(0)" ::: "memory");
        __builtin_amdgcn_wave_barrier();
      }
      SEGR_ADD(0);
      __syncthreads();
      SEGR_ADD(1);
    }
    SEGR_FLUSH(0);
  } else {
    const int pw = wave - 4;
    const int tok = lane >> 3, cg8 = (lane & 7) * 8;
    const int colsb[5] = {h * 64 + cg8, 512 + h * 64 + cg8, 1024 + h * 64 + cg8, 1536 + d * 64 + cg8, 1664 + d * 64 + cg8};
    const int n16 = lane & 15, q16 = lane >> 4;
    float* bonus = (float*)(p.ws + WS_PB + PB_BONUS) + (size_t)d * R * 8;
    uint4 raw[5][3];
    float fm = 1.f, fp_ = 1.f;
#define RW_ISSUE(CH) do { \
      const int t_ = scan_token(d, (CH) * T + pw * 8 + tok); \
      const bool first_ = (t_ == 0) || (t_ == CTXL), last_ = (t_ == CTXL - 1) || (t_ == TPB - 1); \
      fm = first_ ? 0.f : 1.f; fp_ = last_ ? 0.f : 1.f; \
      const bf16_t* rowp_ = p0 + ((size_t)b * TPB + t_) * P0LD + 1536; \
      const bf16_t* rowm_ = first_ ? rowp_ : rowp_ - P0LD; \
      const bf16_t* rowq_ = last_ ? rowp_ : rowp_ + P0LD; \
      _Pragma("unroll") for (int g_ = 0; g_ < 5; ++g_) { raw[g_][0] = *(const uint4*)(rowm_ + colsb[g_]); raw[g_][1] = *(const uint4*)(rowp_ + colsb[g_]); raw[g_][2] = *(const uint4*)(rowq_ + colsb[g_]); } \
    } while (0)
    RW_ISSUE(0);
    SEGR_DECL();
    SEGR_INIT();
    for (int c = 0; c < NCHK; ++c) {
      int zo = 0;
      asm volatile("" : "+v"(zo));
      char* PS = lds + 90112 + pw * 8192 + zo;
      float* Pk = (float*)PS; bf16_t* PA = (bf16_t*)(PS + 2048); bf16_t* PBa = (bf16_t*)(PS + 4096); float* Pinv = (float*)(PS + 6144);
      const float* LCc = (const float*)(lds + 155648 + zo);
      char* B0 = lds + (c & 1) * BUFB + zo;
      float* La = (float*)B0; float* Lb = (float*)(B0 + 8192); float* Lk = (float*)(B0 + 16384);
      float* Lw = (float*)(B0 + 24576); float* Lr = (float*)(B0 + 32768); float* Lv = (float*)(B0 + 40960);
      const int sl = pw * 8 + tok;
      {
#define RW_MIX(G, OUT) do { float u_[8], um_[8], up_[8]; unpack8(raw[G][1], u_); unpack8(raw[G][0], um_); unpack8(raw[G][2], up_); \
          const float4 m0_ = *(const float4*)(LCc + (5 + G) * 64 + cg8), m1_ = *(const float4*)(LCc + (5 + G) * 64 + cg8 + 4); \
          const float mm_[8] = {m0_.x, m0_.y, m0_.z, m0_.w, m1_.x, m1_.y, m1_.z, m1_.w}; \
          _Pragma("unroll") for (int j = 0; j < 8; ++j) OUT[j] = u_[j] + mm_[j] * (0.5f * (fm * um_[j] + fp_ * up_[j]) - u_[j]); } while (0)
        float mx[8];
        RW_MIX(0, mx);
        *(float4*)(Lr + sl * 64 + cg8) = make_float4(mx[0], mx[1], mx[2], mx[3]);
        *(float4*)(Lr + sl * 64 + cg8 + 4) = make_float4(mx[4], mx[5], mx[6], mx[7]);
        RW_MIX(2, mx);
        if ((cg8 >> 5) == half) {
          *(float4*)(Lv + sl * 32 + (cg8 & 31)) = make_float4(mx[0], mx[1], mx[2], mx[3]);
          *(float4*)(Lv + sl * 32 + (cg8 & 31) + 4) = make_float4(mx[4], mx[5], mx[6], mx[7]);
        }
        RW_MIX(3, mx);
        {
          float tw[8];
#pragma unroll
          for (int j = 0; j < 8; ++j) tw[j] = 1.f - 2.f * frcp_(1.f + __expf(2.f * mx[j]));
          *(uint4*)(PA + tok * 64 + cg8) = pack8(tw);
        }
        RW_MIX(4, mx);
        *(uint4*)(PBa + tok * 64 + cg8) = pack8(mx);
        RW_MIX(1, mx);
        *(float4*)(Pk + tok * 64 + cg8) = make_float4(mx[0], mx[1], mx[2], mx[3]);
        *(float4*)(Pk + tok * 64 + cg8 + 4) = make_float4(mx[4], mx[5], mx[6], mx[7]);
        float nrm = 0.f;
        {
          const float4 q0 = *(const float4*)(LCc + 2 * 64 + cg8), q1 = *(const float4*)(LCc + 2 * 64 + cg8 + 4);
          const float kk8[8] = {q0.x, q0.y, q0.z, q0.w, q1.x, q1.y, q1.z, q1.w};
#pragma unroll
          for (int j = 0; j < 8; ++j) { const float kq = mx[j] * kk8[j]; nrm += kq * kq; }
        }
        nrm = red8(nrm);
        if ((lane & 7) == 0) Pinv[tok] = __builtin_amdgcn_rsqf(fmaxf(nrm, 1e-24f));
        if (c + 1 < NCHK) RW_ISSUE(c + 1);
#undef RW_MIX
      }
      __builtin_amdgcn_wave_barrier();
      asm volatile("s_waitcnt lgkmcnt(0)" ::: "memory");
      SEGR_ADD(2);
      {
        float bon[2] = {0.f, 0.f};
        const int hq = lane >> 5, qq = (lane >> 4) & 1;
#pragma unroll
        for (int gsel = 0; gsel < 2; ++gsel) {
          const bf16_t* Asrc = (gsel == 0 ? PA : PBa) + n16 * 64 + q16 * 8;
          const bf16_t* Wsrc = (const bf16_t*)(lds + (gsel == 0 ? 139264 : 147456) + zo) + n16 * 64 + q16 * 8;
#pragma unroll
          for (int nt = 0; nt < 4; ++nt) {
            f32x4_t acc = {0.f, 0.f, 0.f, 0.f};
#pragma unroll
            for (int ks = 0; ks < 2; ++ks) {
              const bf16x8 af = *(const bf16x8*)(Asrc + ks * 32);
              const bf16x8 bf = *(const bf16x8*)(Wsrc + nt * 16 * 64 + ks * 32);
              acc = __builtin_amdgcn_mfma_f32_16x16x32_bf16(af, bf, acc, 0, 0, 0);
            }
            float xv[2];
            xv[0] = __uint_as_float(__builtin_amdgcn_permlane32_swap(__float_as_uint(acc[0]), __float_as_uint(acc[2]), false, false)[0]);
            xv[1] = __uint_as_float(__builtin_amdgcn_permlane32_swap(__float_as_uint(acc[1]), __float_as_uint(acc[3]), false, false)[0]);
            const int col = nt * 16 + n16;
            const float bias = LCc[gsel * 64 + col];
            const float kkc_ = LCc[2 * 64 + col], kac_ = LCc[3 * 64 + col], rkc_ = LCc[4 * 64 + col];
#pragma unroll
            for (int r = 0; r < 2; ++r) {
              const int tk = qq * 4 + hq * 2 + r, so = (pw * 8 + tk) * 64 + col;
              if (gsel == 0) { Lw[so] = __expf(-0.6065306597126334f * sigmoidf_(xv[r] + bias)); }
              else {
                const float as = sigmoidf_(xv[r] + bias);
                const float k = Pk[tk * 64 + col];
                const float kkv = k * kkc_ * Pinv[tk];
                La[so] = -kkv; Lb[so] = kkv * as;
                const float kd = k * (1.f + (as - 1.f) * kac_);
                Lk[so] = kd;
                bon[r] += Lr[so] * kd * rkc_;
              }
            }
          }
        }
#pragma unroll
        for (int r = 0; r < 2; ++r) bon[r] = red16(bon[r]);
        if (half == 0 && n16 == 0) {
#pragma unroll
          for (int r = 0; r < 2; ++r) {
            const int t = scan_token(d, c * T + pw * 8 + qq * 4 + hq * 2 + r);
            bonus[((size_t)b * TPB + t) * 8 + h] = bon[r];
          }
        }
      }
      SEGR_ADD(3);
      __syncthreads();
      SEGR_ADD(1);
    }
#if defined(PROBE_A) && PROBE_GRP == 1
    if (blockIdx.x == 0 && threadIdx.x == 256) { for (int j__ = 1; j__ < 4; ++j__) ((unsigned long long*)(p.ws + WS_SCAL + 1024))[22 + 4 + j__] += seg_acc_[j__]; }
#endif
    __syncthreads();
#undef RW_ISSUE
  }
}

DI void phase_rwkv_post(const P& p) {
  const bf16_t* p0 = (const bf16_t*)(p.ws + WS_PB + PB_P);
  const bf16_t* yf = (const bf16_t*)(p.ws + WS_HB + HB_YF);
  const bf16_t* yb = (const bf16_t*)(p.ws + WS_HB + HB_YB);
  const bf16_t* G = (const bf16_t*)(p.ws + WS_PB + PB_G);
  const float* bonus = (const float*)(p.ws + WS_PB + PB_BONUS);
  bf16_t* o0 = (bf16_t*)(p.ws + WS_PB + PB_O0);
  const float* mu = p.in[I_RWMU] + 1024;
  const int sub = threadIdx.x & 7;
  for (int it = (blockIdx.x * NTHR + threadIdx.x) >> 3; it < R * 8; it += (gridDim.x * NTHR) >> 3) {
    const int row = it >> 3, h = it & 7;
    const int t = row % TPB;
    const bool first = (t == 0) || (t == CTXL), last = (t == CTXL - 1) || (t == TPB - 1);
    const int cc = h * 64 + sub * 8;
    float y[8], a[8], bb[8];
    unpack8(*(const uint4*)(yf + (size_t)row * 512 + cc), a);
    unpack8(*(const uint4*)(yb + (size_t)row * 512 + cc), bb);
    float mean = 0.f;
#pragma unroll
    for (int j = 0; j < 8; ++j) { y[j] = a[j] + bb[j]; mean += y[j]; }
    mean = red8(mean) * (1.f / 64.f);
    float var = 0.f;
#pragma unroll
    for (int j = 0; j < 8; ++j) { const float dlt = y[j] - mean; var += dlt * dlt; }
    var = red8(var) * (1.f / 64.f);
    const float rs = rsqrtf(var + 64e-5f);
    const float bn = bonus[(size_t)row * 8 + h] + bonus[(size_t)R * 8 + (size_t)row * 8 + h];
    const bf16_t* vp = p0 + (size_t)row * P0LD + 1536 + 1024 + cc;
    float u[8], um[8], up[8], g[8], o[8];
    unpack8(*(const uint4*)vp, u);
    unpack8(*(const uint4*)(first ? vp : vp - P0LD), um);
    unpack8(*(const uint4*)(last ? vp : vp + P0LD), up);
    unpack8(*(const uint4*)(G + (size_t)row * 512 + cc), g);
    const float fm = first ? 0.f : 1.f, fp_ = last ? 0.f : 1.f;
#pragma unroll
    for (int j = 0; j < 8; ++j) {
      const float v = u[j] + mu[cc + j] * (0.5f * (fm * um[j] + fp_ * up[j]) - u[j]);
      const float yn = (y[j] - mean) * rs * p.in[I_LNXW][cc + j] + p.in[I_LNXB][cc + j];
      o[j] = (yn + bn * v) * g[j];
    }
    *(uint4*)(o0 + (size_t)row * 1024 + 512 + cc) = pack8(o);
  }
}

DI unsigned f2ord(float f) { const unsigned u = __float_as_uint(f); return u ^ ((u >> 31) ? 0xFFFFFFFFu : 0x80000000u); }
DI float ord2f(unsigned u) { u ^= ((u >> 31) ? 0x80000000u : 0xFFFFFFFFu); return __uint_as_float(u); }

DI void bitonic_sort16_desc(unsigned (&v)[16]) {
#pragma unroll
  for (int k = 2; k <= 16; k <<= 1)
#pragma unroll
    for (int j = k >> 1; j > 0; j >>= 1)
#pragma unroll
      for (int i = 0; i < 16; ++i) {
        const int l = i ^ j;
        if (l > i) { const unsigned hi = max(v[i], v[l]), lo = min(v[i], v[l]); const bool desc = ((i & k) == 0); v[i] = desc ? hi : lo; v[l] = desc ? lo : hi; }
      }
}
DI void merge_top16_desc(unsigned (&a)[16], const unsigned (&b)[16]) {
#pragma unroll
  for (int i = 0; i < 16; ++i) a[i] = max(a[i], b[15 - i]);
#pragma unroll
  for (int j = 8; j > 0; j >>= 1)
#pragma unroll
    for (int i = 0; i < 16; ++i) { const int l = i ^ j; if (l > i) { const unsigned hi = max(a[i], a[l]), lo = min(a[i], a[l]); a[i] = hi; a[l] = lo; } }
}
struct CandPairs { int ia[25], ja[25], ib[25], jb[25]; };
constexpr CandPairs make_pairs() {
  CandPairs c{};
  int n = 0;
  for (int i = 0; i < 16; ++i) for (int j = 0; j < 16; ++j) if ((i + 1) * (j + 1) <= 16) {
    if ((n & 1) == 0) { c.ia[n >> 1] = i; c.ja[n >> 1] = j; } else { c.ib[n >> 1] = i; c.jb[n >> 1] = j; }
    ++n;
  }
  return c;
}
constexpr CandPairs CP = make_pairs();

DI void peer_topk_unit(const P& p, char* lds, int layer, int unit) {
  const int tid = threadIdx.x, lane = tid & 63, wave = tid >> 6;
  const int mt = unit >> 3, h = unit & 7;
  const bf16_t* q = (const bf16_t*)(p.ws + WS_PB + PB_Q);
  const bf16_t* keys = (const bf16_t*)(p.ws + (layer == 0 ? WS_KEYS0 : WS_KEYS1)) + (size_t)h * 2 * 128 * 128;
  int* idxo = (int*)(p.ws + WS_PB + PB_IDX);
  float* gateo = (float*)(p.ws + WS_PB + PB_GATE);
  __syncthreads();
  for (int e = tid; e < 2 * 128 * 16; e += NTHR) {
    const int pp = e >> 11, row = (e >> 4) & 127, c = e & 15;
    *(uint4*)(lds + pp * 32768 + row * 256 + ((c ^ (row & 15)) << 4)) = *(const uint4*)(keys + (size_t)pp * 16384 + row * 128 + c * 8);
  }
  __syncthreads();
  const int r31 = lane & 31, hh = lane >> 5;
  const size_t trow = (size_t)mt * 256 + wave * 32 + r31;
  unsigned vk[2][16];
#pragma unroll
  for (int pp = 0; pp < 2; ++pp) {
    f32x16 acc[4];
#pragma unroll
    for (int m = 0; m < 4; ++m)
#pragma unroll
      for (int r = 0; r < 16; ++r) acc[m][r] = 0.f;
    const bf16_t* qp = q + trow * 2048 + (h * 2 + pp) * 128;
#pragma unroll
    for (int kk = 0; kk < 8; ++kk) {
      const bf16x8 bq = *(const bf16x8*)(qp + kk * 16 + 8 * hh);
      const int c = kk * 2 + hh;
#pragma unroll
      for (int m = 0; m < 4; ++m) {
        const int row = m * 32 + r31;
        const bf16x8 ak = *(const bf16x8*)(lds + pp * 32768 + row * 256 + ((c ^ (row & 15)) << 4));
        acc[m] = MFMA32(ak, bq, acc[m]);
      }
    }
    unsigned v[16];
#pragma unroll
    for (int m = 0; m < 4; ++m) {
      unsigned kx[16];
#pragma unroll
      for (int r = 0; r < 16; ++r) kx[r] = (f2ord(acc[m][r]) & ~127u) | (unsigned)(127 - (m * 32 + ACC_ROW(r, lane)));
      bitonic_sort16_desc(kx);
      if (m == 0) {
#pragma unroll
        for (int i = 0; i < 16; ++i) v[i] = kx[i];
      } else merge_top16_desc(v, kx);
    }
    unsigned c16[16];
#pragma unroll
    for (int i = 0; i < 16; ++i) c16[i] = (unsigned)__shfl_xor((int)v[i], 32);
    merge_top16_desc(v, c16);
#pragma unroll
    for (int i = 0; i < 16; ++i) vk[pp][i] = v[i];
  }
  float val1[16], val2[16]; int id1[16], id2[16];
#pragma unroll
  for (int i = 0; i < 16; ++i) {
    val1[i] = ord2f(vk[0][i] & ~127u); id1[i] = 127 - (int)(vk[0][i] & 127u);
    val2[i] = ord2f(vk[1][i] & ~127u); id2[i] = 127 - (int)(vk[1][i] & 127u);
  }
  unsigned tk[16];
#pragma unroll
  for (int t = 0; t < 16; ++t) {
    const float va = val1[CP.ia[t]] + val2[CP.ja[t]], vb = val1[CP.ib[t]] + val2[CP.jb[t]];
    const int pa = id1[CP.ia[t]] * 128 + id2[CP.ja[t]], pb = id1[CP.ib[t]] * 128 + id2[CP.jb[t]];
    tk[t] = (f2ord(hh ? vb : va) & ~0x3FFFu) | (unsigned)(hh ? pb : pa);
  }
  bitonic_sort16_desc(tk);
#pragma unroll
  for (int t = 16; t < 25; ++t) {
    const float va = val1[CP.ia[t]] + val2[CP.ja[t]], vb = val1[CP.ib[t]] + val2[CP.jb[t]];
    const int pa = id1[CP.ia[t]] * 128 + id2[CP.ja[t]], pb = id1[CP.ib[t]] * 128 + id2[CP.jb[t]];
    unsigned x = (f2ord(hh ? vb : va) & ~0x3FFFu) | (unsigned)(hh ? pb : pa);
#pragma unroll
    for (int i = 0; i < 16; ++i) { const unsigned hi = max(tk[i], x); x = min(tk[i], x); tk[i] = hi; }
  }
  float cv[16]; int cp[16];
  float mx = -3.0e38f;
#pragma unroll
  for (int i = 0; i < 16; ++i) {
    const unsigned ok = (unsigned)__shfl_xor((int)tk[15 - i], 32);
    const unsigned kk_ = max(tk[i], ok);
    cv[i] = ord2f(kk_ & ~0x3FFFu); cp[i] = (int)(kk_ & 0x3FFFu);
    mx = fmaxf(mx, cv[i]);
  }
  float sum = 0.f;
#pragma unroll
  for (int i = 0; i < 16; ++i) { cv[i] = __expf(cv[i] - mx); sum += cv[i]; }
  const float inv = 1.f / sum;
  if (hh == 0) {
    int* ip = idxo + trow * 128 + h * 16;
    float* gp = gateo + trow * 128 + h * 16;
#pragma unroll
    for (int i = 0; i < 4; ++i) {
      *(int4*)(ip + i * 4) = make_int4(cp[i * 4], cp[i * 4 + 1], cp[i * 4 + 2], cp[i * 4 + 3]);
      *(float4*)(gp + i * 4) = make_float4(cv[i * 4] * inv, cv[i * 4 + 1] * inv, cv[i * 4 + 2] * inv, cv[i * 4 + 3] * inv);
    }
  }
}

DI int wave_sum_i(int x) {
  x += __builtin_amdgcn_update_dpp(0, x, 0xB1, 0xF, 0xF, true);
  x += __builtin_amdgcn_update_dpp(0, x, 0x4E, 0xF, 0xF, true);
  x += __builtin_amdgcn_update_dpp(0, x, 0x141, 0xF, 0xF, true);
  x += __builtin_amdgcn_update_dpp(0, x, 0x140, 0xF, 0xF, true);
  return __builtin_amdgcn_readlane(x, 0) + __builtin_amdgcn_readlane(x, 16) + __builtin_amdgcn_readlane(x, 32) + __builtin_amdgcn_readlane(x, 48);
}
DI int reduce8_transposed(const int (&v)[8], int lane) {
  int x[4], y[2];
#pragma unroll
  for (int j = 0; j < 4; ++j) { const auto r = __builtin_amdgcn_permlane32_swap((unsigned)v[j], (unsigned)v[4 + j], false, false); x[j] = (int)(r[0] + r[1]); }
#pragma unroll
  for (int j = 0; j < 2; ++j) { const auto r = __builtin_amdgcn_permlane16_swap((unsigned)x[j], (unsigned)x[2 + j], false, false); y[j] = (int)(r[0] + r[1]); }
  const bool b3 = (lane >> 3) & 1;
  const int keep = b3 ? y[1] : y[0], send = b3 ? y[0] : y[1];
  int z = keep + __builtin_amdgcn_update_dpp(0, send, 0x128, 0xF, 0xF, true);
  z += __builtin_amdgcn_update_dpp(0, z, 0xB1, 0xF, 0xF, true);
  z += __builtin_amdgcn_update_dpp(0, z, 0x4E, 0xF, 0xF, true);
  z += __builtin_amdgcn_update_dpp(0, z, 0x141, 0xF, 0xF, true);
  return z;
}
DI float gelu_fast(float v) {
  const float av = fabsf(v), t = __builtin_amdgcn_rcpf(av * 0.2316418882f + 1.0f);
  float q = t * 0.5307027145f + (-0.7265760135f); q = q * t + 0.7107068705f; q = q * t + (-0.142248368f); q = q * t + 0.127414796f; q = q * t;
  const float e = __builtin_amdgcn_exp2f((v * v) * (-0.72134752044f));
  const float m = v * (q * e);
  return v < 0.f ? m : v - m;
}
DI int reduce4_half(const int (&v)[4], int lane) {
  int y[2];
#pragma unroll
  for (int j = 0; j < 2; ++j) { const auto r = __builtin_amdgcn_permlane16_swap((unsigned)v[j], (unsigned)v[2 + j], false, false); y[j] = (int)(r[0] + r[1]); }
  const bool b3 = (lane >> 3) & 1;
  const int keep = b3 ? y[1] : y[0], send = b3 ? y[0] : y[1];
  int z = keep + __builtin_amdgcn_update_dpp(0, send, 0x128, 0xF, 0xF, true);
  z += __builtin_amdgcn_update_dpp(0, z, 0xB1, 0xF, 0xF, true);
  z += __builtin_amdgcn_update_dpp(0, z, 0x4E, 0xF, 0xF, true);
  z += __builtin_amdgcn_update_dpp(0, z, 0x141, 0xF, 0xF, true);
  return z;
}
#ifndef PG_VREP
#define PG_VREP 1
#endif
DI void phase_peer_gather(const P& p, int layer) {
  const int lane = threadIdx.x & 63, gw = blockIdx.x * 8 + (threadIdx.x >> 6), nw = gridDim.x * 8;
  const bf16_t* h2 = (const bf16_t*)(p.ws + WS_PB + PB_H2);
  const int* idx = (const int*)(p.ws + WS_PB + PB_IDX);
  const float* gate = (const float*)(p.ws + WS_PB + PB_GATE);
  const unsigned char* U = p.ws + WS_HB + HB_U;
  const unsigned char* V = p.ws + WS_HB + HB_V;
  const float* su = (const float*)(p.ws + WS_HB + HB_SU);
  const float* sv = (const float*)(p.ws + WS_HB + HB_SV);
  const float* mods = (const float*)(p.ws + WS_MODS) + (size_t)layer * 9 * 6144;
  float* xc = (float*)(p.ws + WS_XC);
  const int hs = lane & 31, up = lane >> 5, k4 = (lane >> 3) & 3;
  for (int row = gw; row < R; row += nw) {
    const int b = row / TPB, t = row - b * TPB;
    const bool isctx = t < CTXL;
    if (isctx && layer == 1) continue;
    int hE[4], hO[4]; float sh, hoff;
    {
      float hv[32], f[8];
#pragma unroll
      for (int i = 0; i < 4; ++i) { unpack8(*(const uint4*)(h2 + (size_t)row * D + hs * 32 + i * 8), f);
#pragma unroll
        for (int j = 0; j < 8; ++j) hv[i * 8 + j] = f[j]; }
      float am = 0.f;
#pragma unroll
      for (int j = 0; j < 32; ++j) am = fmaxf(am, fabsf(hv[j]));
      am = fmaxf(wave_max(am), 1e-30f);
      const float inv = 127.f / am;
      sh = am * (1.f / 127.f);
      int hsum = 0;
#pragma unroll
      for (int d4 = 0; d4 < 4; ++d4) {
        unsigned pe = 0, po = 0;
#pragma unroll
        for (int j = 0; j < 4; ++j) {
          const int qe = (int)rintf(hv[d4 * 8 + 2 * j] * inv), qo = (int)rintf(hv[d4 * 8 + 2 * j + 1] * inv);
          hsum += qe + qo;
          pe |= ((unsigned)qe & 0xffu) << (8 * j); po |= ((unsigned)qo & 0xffu) << (8 * j);
        }
        hE[d4] = (int)pe; hO[d4] = (int)po;
      }
      hoff = 7.5f * 0.5f * (float)wave_sum_i(hsum);
    }
    float acc[32];
#pragma unroll
    for (int j = 0; j < 32; ++j) acc[j] = 0.f;
    float corr = 0.f;
    const int my_i0 = idx[(size_t)row * 128 + lane], my_i1 = idx[(size_t)row * 128 + 64 + lane];
    const float my_g0 = gate[(size_t)row * 128 + lane], my_g1 = gate[(size_t)row * 128 + 64 + lane];
#define PG_LOAD(E0, UR, VR, SC) do { _Pragma("unroll") for (int k = 0; k < 4; ++k) { const int e_ = (E0) + 2 * k; \
        const int ea_ = ((E0) < 64) ? __builtin_amdgcn_readlane(my_i0, e_ & 63) : __builtin_amdgcn_readlane(my_i1, e_ & 63); \
        const int eb_ = ((E0) < 64) ? __builtin_amdgcn_readlane(my_i0, (e_ + 1) & 63) : __builtin_amdgcn_readlane(my_i1, (e_ + 1) & 63); \
        const size_t ro_ = (size_t)(up ? eb_ : ea_) * 512 + hs * 16; \
        UR[k] = *(const uint4*)(U + ro_); VR[k] = *(const uint4*)(V + ro_); } \
      { const int es_ = (E0) + 2 * k4 + up; const int ei_ = __shfl(((E0) < 64) ? my_i0 : my_i1, es_ & 63); SC[0] = su[ei_]; SC[1] = sv[ei_]; } } while (0)
#define PG_COMPUTE(E0, UR, VR, SC) do { \
      const int es_ = (E0) + 2 * k4 + up; \
      const float ggA = __shfl(((E0) < 64) ? my_g0 : my_g1, es_ & 63); \
      const float suA = SC[0], svA = SC[1]; \
      int dA[4]; \
      _Pragma("unroll") for (int k = 0; k < 4; ++k) { \
        const unsigned uu[4] = {UR[k].x, UR[k].y, UR[k].z, UR[k].w}; int d = 0; \
        _Pragma("unroll") for (int d4 = 0; d4 < 4; ++d4) { \
          d = __builtin_amdgcn_sdot4(hE[d4], (int)(uu[d4] & 0x0F0F0F0Fu), d, false); \
          d = __builtin_amdgcn_sdot4(hO[d4], (int)((uu[d4] >> 4) & 0x0F0F0F0Fu), d, false); } \
        dA[k] = d; } \
      const int tA = reduce4_half(dA, lane); \
      const float wA = ggA * gelu_fast(((float)tA - hoff) * (sh * suA)) * svA; \
      _Pragma("unroll") for (int k = 0; k < 4; ++k) { \
        const float w0_ = __shfl(wA, (lane & 32) + 8 * k); \
        corr += w0_; \
        const unsigned vv[4] = {VR[k].x, VR[k].y, VR[k].z, VR[k].w}; \
        _Pragma("unroll") for (int rep_ = 0; rep_ < PG_VREP; ++rep_) { const float w = w0_ * (1.f / PG_VREP); \
        _Pragma("unroll") for (int d4 = 0; d4 < 4; ++d4) { \
          const unsigned lo = vv[d4] & 0x0F0F0F0Fu, hi = (vv[d4] >> 4) & 0x0F0F0F0Fu; \
          acc[d4 * 8 + 0] += w * (float)(lo & 0xffu); acc[d4 * 8 + 1] += w * (float)(hi & 0xffu); \
          acc[d4 * 8 + 2] += w * (float)((lo >> 8) & 0xffu); acc[d4 * 8 + 3] += w * (float)((hi >> 8) & 0xffu); \
          acc[d4 * 8 + 4] += w * (float)((lo >> 16) & 0xffu); acc[d4 * 8 + 5] += w * (float)((hi >> 16) & 0xffu); \
          acc[d4 * 8 + 6] += w * (float)(lo >> 24); acc[d4 * 8 + 7] += w * (float)(hi >> 24); } asm volatile("" : "+v"(acc[0])); } } } while (0)
    {
      uint4 urA[4], vrA[4], urB[4], vrB[4];
      float scA[2], scB[2];
      PG_LOAD(0, urA, vrA, scA);
#pragma unroll 1
      for (int e0 = 0; e0 < 128; e0 += 16) {
        PG_LOAD(e0 + 8, urB, vrB, scB);
        PG_COMPUTE(e0, urA, vrA, scA);
        if (e0 + 16 < 128) PG_LOAD(e0 + 16, urA, vrA, scA);
        PG_COMPUTE(e0 + 8, urB, vrB, scB);
      }
    }
#undef PG_LOAD
#undef PG_COMPUTE
    const float c75 = 7.5f * (corr + __shfl_xor(corr, 32));
    float o16[16];
#pragma unroll
    for (int i = 0; i < 16; ++i) {
      const float mine = up ? acc[16 + i] : acc[i], give = up ? acc[i] : acc[16 + i];
      o16[i] = mine + __shfl_xor(give, 32) - c75;
    }
    const int col0 = hs * 32 + up * 16;
    const float* g5 = mods + (isctx ? 8 : b) * 6144 + 5 * 1024 + col0;
    float* xp = isctx ? (xc + ((size_t)(b * CTXL + t)) * D + col0) : (p.out + ((size_t)(b * SEQ + t - CTXL)) * D + col0);
    float xn[16];
    float ssq = 0.f;
#pragma unroll
    for (int i = 0; i < 4; ++i) {
      const float4 x = *(const float4*)(xp + i * 4);
      xn[i * 4] = x.x + g5[i * 4] * o16[i * 4]; xn[i * 4 + 1] = x.y + g5[i * 4 + 1] * o16[i * 4 + 1];
      xn[i * 4 + 2] = x.z + g5[i * 4 + 2] * o16[i * 4 + 2]; xn[i * 4 + 3] = x.w + g5[i * 4 + 3] * o16[i * 4 + 3];
#pragma unroll
      for (int j = 0; j < 4; ++j) ssq += xn[i * 4 + j] * xn[i * 4 + j];
    }
    ssq = red64(ssq);
    const float rs = rsqrtf(ssq * (1.f / 1024.f) + 1e-6f);
    if (layer == 1) {
      const float* gf = p.in[I_NF] + col0;
#pragma unroll
      for (int i = 0; i < 4; ++i)
        *(float4*)(xp + i * 4) = make_float4(xn[i * 4] * rs * gf[i * 4], xn[i * 4 + 1] * rs * gf[i * 4 + 1], xn[i * 4 + 2] * rs * gf[i * 4 + 2], xn[i * 4 + 3] * rs * gf[i * 4 + 3]);
    } else {
#pragma unroll
      for (int i = 0; i < 4; ++i) *(float4*)(xp + i * 4) = make_float4(xn[i * 4], xn[i * 4 + 1], xn[i * 4 + 2], xn[i * 4 + 3]);
      const float* gn1 = p.in[I_N1_1] + col0;
      const float* m1 = mods + 9 * 6144 + (isctx ? 8 : b) * 6144 + col0;
      float hh_[16];
#pragma unroll
      for (int i = 0; i < 16; ++i) hh_[i] = xn[i] * rs * gn1[i] * (1.f + m1[1024 + i]) + m1[i];
      bf16_t* hp = (bf16_t*)(p.ws + WS_HNEXT) + (size_t)row * D + col0;
      uint4 w0, w1;
      w0.x = pack_bf2(hh_[0], hh_[1]); w0.y = pack_bf2(hh_[2], hh_[3]); w0.z = pack_bf2(hh_[4], hh_[5]); w0.w = pack_bf2(hh_[6], hh_[7]);
      w1.x = pack_bf2(hh_[8], hh_[9]); w1.y = pack_bf2(hh_[10], hh_[11]); w1.z = pack_bf2(hh_[12], hh_[13]); w1.w = pack_bf2(hh_[14], hh_[15]);
      *(uint4*)hp = w0; *(uint4*)(hp + 8) = w1;
    }
  }
}

template <int CH>
DI void conv_stream(const P& p, char* lds, bf16_t* base, int pitch  , int chan0  ) {
  const int tid = threadIdx.x;
  constexpr int NT = NTHR / CH;
  constexpr int RPT = TPB / NT;
  const int ck = tid % CH, tl = tid / CH;
  const int t0 = tl * RPT;
  bf16_t* colp = base + ck * 8;
  uint4* halo = (uint4*)lds;
  float w0[8], w1[8], w2[8], bb[8];
#pragma unroll
  for (int j = 0; j < 8; ++j) { const int c = chan0 + ck * 8 + j; w0[j] = p.in[I_CONVW][c]; w1[j] = p.in[I_CONVW][3072 + c]; w2[j] = p.in[I_CONVW][6144 + c]; bb[j] = p.in[I_CONVB][c]; }
  __syncthreads();
  uint4 cur = *(const uint4*)(colp + (size_t)t0 * pitch);
  halo[(tl * 2 + 0) * CH + ck] = cur;
  halo[(tl * 2 + 1) * CH + ck] = *(const uint4*)(colp + (size_t)(t0 + RPT - 1) * pitch);
  __syncthreads();
  uint4 prev = halo[((tl > 0 ? tl - 1 : 0) * 2 + 1) * CH + ck];
  const uint4 nxt_halo = halo[((tl < NT - 1 ? tl + 1 : NT - 1) * 2 + 0) * CH + ck];
  __syncthreads();
  constexpr int UB = (RPT % 4 == 0) ? 4 : 2;
  for (int rb = 0; rb < RPT; rb += UB) {
    uint4 nx[UB];
#pragma unroll
    for (int i = 0; i < UB; ++i) { const int r = rb + i + 1; uint4 v_ = nxt_halo; if (r < RPT) v_ = *(const uint4*)(colp + (size_t)(t0 + r) * pitch); nx[i] = v_; }
#pragma unroll
    for (int i = 0; i < UB; ++i) {
      const int t = t0 + rb + i;
      const bool first = (t == 0) || (t == CTXL), last = (t == CTXL - 1) || (t == TPB - 1);
      float u[8], um[8], up[8], o[8];
      unpack8(cur, u); unpack8(prev, um); unpack8(nx[i], up);
      const float fm = first ? 0.f : 1.f, fp_ = last ? 0.f : 1.f;
#pragma unroll
      for (int j = 0; j < 8; ++j) o[j] = siluf_(w0[j] * (fm * um[j]) + w1[j] * u[j] + w2[j] * (fp_ * up[j]) + bb[j]);
      *(uint4*)(colp + (size_t)t * pitch) = pack8(o);
      prev = cur; cur = nx[i];
    }
  }
}
DI void phase_conv(const P& p, char* lds) {
  unsigned char* pb = p.ws + WS_PB;
  for (int w = blockIdx.x; w < 256; w += gridDim.x) {
    conv_stream<8>(p, lds, (bf16_t*)(pb + L1_XH) + (size_t)w * TPB * 64, 64, (w & 31) * 64);
    const int q = w & 3, sg = (w >> 2) & 31, isC = w >> 7;
    conv_stream<4>(p, lds, (bf16_t*)(pb + (isC ? L1_CG : L1_BG)) + (size_t)sg * TPB * 128 + q * 32, 128, (isC ? 2560 : 2048) + (sg & 3) * 128 + q * 32);
  }
}

DI int swzBC(int row) { return ((row & 3) << 2) | ((row >> 2) & 3); }
DI int swzX(int row) { return ((row >> 1) & 1) << 2; }

DI void ssd_chunk_unit(const P& p, char* lds, int unit) {
  const int tid = threadIdx.x, lane = tid & 63, wave = tid >> 6;
  const int b = unit >> 5, head = unit & 31, grp = head >> 3;
  bf16_t* zh = (bf16_t*)(p.ws + WS_PB + L1_ZH) + (size_t)(b * 32 + head) * TPB * 64;
  const bf16_t* xh = (const bf16_t*)(p.ws + WS_PB + L1_XH) + (size_t)(b * 32 + head) * TPB * 64;
  const bf16_t* bg = (const bf16_t*)(p.ws + WS_PB + L1_BG) + (size_t)(b * 4 + grp) * TPB * 128;
  const bf16_t* cgp_ = (const bf16_t*)(p.ws + WS_PB + L1_CG) + (size_t)(b * 4 + grp) * TPB * 128;
  const bf16_t* dtp = (const bf16_t*)(p.ws + WS_PB + L1_DT) + (size_t)b * TPB * 64;
  bf16_t* yftmp = (bf16_t*)(p.ws + WS_YF) + (size_t)(b * 32 + head) * SEQ * 64;
  const float dsk = p.in[I_DSKIP][head];
  const int r31 = lane & 31, hh = lane >> 5, q4 = (lane & 15) >> 2, grp16 = (lane >> 4) & 1, p3 = lane & 3;
  const int lt = wave >> 1, pt = wave & 1;
  const int cc = tid & 7, rr = tid >> 3;
  const int orow = tid >> 3, ock = tid & 7;
  constexpr int NCH = TPB / 128;
  SEGS_DECL();
  for (int d = 0; d < 2; ++d) {
    const float Aneg = -__expf(p.in[I_ALOG][d * 32 + head]);
    const float dtb = p.in[I_DTB][d * 32 + head];
    f32x16 Hacc;
#pragma unroll
    for (int r = 0; r < 16; ++r) Hacc[r] = 0.f;
    __syncthreads();
    for (int e = tid; e < 1024; e += NTHR) *(uint4*)(lds + 98304 + e * 16) = make_uint4(0, 0, 0, 0);
    uint4 st[2][5];
    float dtr0, dtr1;
    uint4 oyf[2], oz[2];
#define SSD_ISSUE(CH) do { \
      _Pragma("unroll") for (int rh_ = 0; rh_ < 2; ++rh_) { \
        const int t_ = scan_token(d, (CH) * 128 + rh_ * 64 + rr); \
        st[rh_][0] = *(const uint4*)(xh + (size_t)t_ * 64 + cc * 8); \
        st[rh_][1] = *(const uint4*)(bg + (size_t)t_ * 128 + cc * 8); \
        st[rh_][2] = *(const uint4*)(bg + (size_t)t_ * 128 + 64 + cc * 8); \
        st[rh_][3] = *(const uint4*)(cgp_ + (size_t)t_ * 128 + cc * 8); \
        st[rh_][4] = *(const uint4*)(cgp_ + (size_t)t_ * 128 + 64 + cc * 8); \
      } \
      dtr0 = bf2f(dtp[(size_t)scan_token(d, (CH) * 128 + lane) * 64 + d * 32 + head]); \
      dtr1 = bf2f(dtp[(size_t)scan_token(d, (CH) * 128 + 64 + lane) * 64 + d * 32 + head]); \
    } while (0)
    SSD_ISSUE(0);
    SEGS_INIT();
    for (int ch = 0; ch <= NCH; ++ch) {
      int zoff = 0;
      asm volatile("" : "+v"(zoff));
      char* L0 = lds + zoff;
      char* LB = L0; char* LC = L0 + 32768; char* LX = L0 + 65536; char* LXw = L0 + 81920; char* LHs = L0 + 98304;
      float* Lacs = (float*)(L0 + 131072); float* Ldt = (float*)(L0 + 131584); float* Lea = (float*)(L0 + 132096);
      char* LY = L0 + 132608;
      __syncthreads();
      SEGS_ADD(0);
      if (ch - 1 >= CTXL / 128) {
#pragma unroll
        for (int i = 0; i < 2; ++i) {
          const int row = orow + i * 64;
          const int t = scan_token(d, (ch - 1) * 128 + row);
          const uint4 yv = *(const uint4*)(LY + row * 128 + ock * 16);
          if (d == 0) {
            *(uint4*)(yftmp + (size_t)(t - CTXL) * 64 + ock * 8) = yv;
          } else {
            float y[8], yf[8], z[8], o[8];
            unpack8(yv, y); unpack8(oyf[i], yf); unpack8(oz[i], z);
#pragma unroll
            for (int j = 0; j < 8; ++j) o[j] = (yf[j] + y[j]) * siluf_(z[j]);
            *(uint4*)(zh + (size_t)t * 64 + ock * 8) = pack8(o);
          }
        }
      }
      if (ch == NCH) break;
      float dt0, dt1, acs0, acs1, alast;
      {
        dt0 = softplusf_(dtr0 + dtb); dt1 = softplusf_(dtr1 + dtb);
        acs0 = dt0 * Aneg; acs1 = dt1 * Aneg;
#pragma unroll
        for (int off = 1; off < 64; off <<= 1) {
          const float y0 = __shfl_up(acs0, off), y1 = __shfl_up(acs1, off);
          if (lane >= off) { acs0 += y0; acs1 += y1; }
        }
        acs1 += __shfl(acs0, 63);
        alast = __shfl(acs1, 63);
        if (wave == 0) {
          Lacs[lane] = acs0; Lacs[64 + lane] = acs1; Ldt[lane] = dt0; Ldt[64 + lane] = dt1;
          Lea[lane] = __expf(acs0); Lea[64 + lane] = __expf(acs1);
        }
      }
#pragma unroll
      for (int rh = 0; rh < 2; ++rh) {
        const int s_ = rh * 64 + rr;
        const float dts = __shfl(rh ? dt1 : dt0, rr);
        const float ws_ = __expf(alast - __shfl(rh ? acs1 : acs0, rr));
        float xv[8], xw[8];
        unpack8(st[rh][0], xv);
#pragma unroll
        for (int j = 0; j < 8; ++j) { xv[j] *= dts; xw[j] = xv[j] * ws_; }
        const int off = s_ * 128 + ((cc ^ swzX(s_)) << 4);
        *(uint4*)(LX + off) = pack8(xv);
        *(uint4*)(LXw + off) = pack8(xw);
        const int sw = swzBC(s_);
        *(uint4*)(LB + s_ * 256 + ((cc ^ sw) << 4)) = st[rh][1];
        *(uint4*)(LB + s_ * 256 + (((8 + cc) ^ sw) << 4)) = st[rh][2];
        *(uint4*)(LC + s_ * 256 + ((cc ^ sw) << 4)) = st[rh][3];
        *(uint4*)(LC + s_ * 256 + (((8 + cc) ^ sw) << 4)) = st[rh][4];
      }
      SEGS_ADD(1);
      __syncthreads();
      SEGS_ADD(2);
      if (ch + 1 < NCH) SSD_ISSUE(ch + 1);
      if (d == 1 && ch >= CTXL / 128) {
#pragma unroll
        for (int i = 0; i < 2; ++i) {
          const int t = scan_token(d, ch * 128 + orow + i * 64);
          oyf[i] = *(const uint4*)(yftmp + (size_t)(t - CTXL) * 64 + ock * 8);
          oz[i] = *(const uint4*)(zh + (size_t)t * 64 + ock * 8);
        }
      }
      const char* LBz = LB; const char* LCz = LC; const char* LXz = LX; const char* LXwz = LXw;
      const char* Hs = LHs;
      char* LMa = L0 + 114688; char* LMb = L0 + 148992;
      if (ch >= CTXL / 128) {
        f32x16 Y;
#pragma unroll
        for (int r = 0; r < 16; ++r) Y[r] = 0.f;
        const int crow = lt * 32 + r31;
        const char* cbase = LCz + crow * 256;
        const int csw = swzBC(crow);
        {
          const int hrow = pt * 32 + r31;
#pragma unroll 2
          for (int kk = 0; kk < 8; ++kk) {
            const bf16x8 cfk = *(const bf16x8*)(cbase + (((kk * 2 + hh) ^ csw) << 4));
            const bf16x8 hb = *(const bf16x8*)(Hs + hrow * 256 + (((kk * 2 + hh) ^ swzBC(hrow)) << 4));
            Y = MFMA32(cfk, hb, Y);
          }
        }
#pragma unroll
        for (int r = 0; r < 16; ++r) Y[r] *= Lea[lt * 32 + ACC_ROW(r, lane)];
        const int lcol = lt * 32 + r31;
        const float acs_l = Lacs[lcol];
        const float ddiag = (d == 1) ? dsk / Ldt[lcol] : 0.f;
        for (int st_ = pt; st_ <= lt; st_ += 2) {
          f32x16 g;
#pragma unroll
          for (int r = 0; r < 16; ++r) g[r] = 0.f;
          const int row = st_ * 32 + r31;
#pragma unroll 4
          for (int kk = 0; kk < 8; ++kk) {
            const bf16x8 a = *(const bf16x8*)(LBz + row * 256 + (((kk * 2 + hh) ^ swzBC(row)) << 4));
            const bf16x8 cfk = *(const bf16x8*)(cbase + (((kk * 2 + hh) ^ csw) << 4));
            g = MFMA32(a, cfk, g);
          }
#pragma unroll
          for (int r = 0; r < 16; ++r) {
            const int srow = st_ * 32 + ACC_ROW(r, lane);
            const float e = __expf(fminf(acs_l - Lacs[srow], 0.f));
            float val = (srow <= lcol) ? g[r] * e : 0.f;
            if (srow == lcol) val += ddiag;
            g[r] = val;
          }
          const int id = lt * (lt + 1) / 2 + st_;
          char* mt = (id < 8) ? (LMa + id * 2048) : (LMb + (id - 8) * 2048);
#pragma unroll
          for (int k2 = 0; k2 < 2; ++k2) {
            uint4 u; u.x = pack_bf2(g[8 * k2], g[8 * k2 + 1]); u.y = pack_bf2(g[8 * k2 + 2], g[8 * k2 + 3]); u.z = pack_bf2(g[8 * k2 + 4], g[8 * k2 + 5]); u.w = pack_bf2(g[8 * k2 + 6], g[8 * k2 + 7]);
            *(uint4*)(mt + (k2 * 64 + lane) * 16) = u;
          }
        }
        __syncthreads();
        for (int st_ = 0; st_ <= lt; ++st_) {
          const int id = lt * (lt + 1) / 2 + st_;
          const char* mt = (id < 8) ? (LMa + id * 2048) : (LMb + (id - 8) * 2048);
#pragma unroll
          for (int k2 = 0; k2 < 2; ++k2) {
            const bf16x8 am = *(const bf16x8*)(mt + (k2 * 64 + lane) * 16);
            const int s0 = st_ * 32 + 16 * k2 + 4 * hh + q4, s1 = s0 + 8;
            const int cx = pt * 4 + grp16 * 2 + (p3 >> 1);
            const s16x4 lo = tr_read(LXz + s0 * 128 + ((cx ^ swzX(s0)) << 4) + 8 * (p3 & 1));
            const s16x4 hi = tr_read(LXz + s1 * 128 + ((cx ^ swzX(s1)) << 4) + 8 * (p3 & 1));
            const bf16x8 bx = __builtin_shufflevector(lo, hi, 0, 1, 2, 3, 4, 5, 6, 7);
            Y = MFMA32(am, bx, Y);
          }
        }
#pragma unroll
        for (int r = 0; r < 16; ++r) {
          const int srow = lt * 32 + ACC_ROW(r, lane);
          *(bf16_t*)(LY + srow * 128 + (pt * 32 + r31) * 2) = f2bf(Y[r]);
        }
      }
      {
        const float ea = __expf(alast);
#pragma unroll
        for (int r = 0; r < 16; ++r) Hacc[r] *= ea;
        const int cb_ = lt * 4 + grp16 * 2 + (p3 >> 1);
        const int cx = pt * 4 + grp16 * 2 + (p3 >> 1);
        const int sb0 = 8 * hh + q4, sb1 = sb0 + 4;
        const char* pa_lo = LBz + sb0 * 256 + ((cb_ ^ swzBC(sb0)) << 4) + 8 * (p3 & 1);
        const char* pa_hi = LBz + sb1 * 256 + ((cb_ ^ swzBC(sb1)) << 4) + 8 * (p3 & 1);
        const char* pb_lo = LXwz + sb0 * 128 + ((cx ^ swzX(sb0)) << 4) + 8 * (p3 & 1);
        const char* pb_hi = LXwz + sb1 * 128 + ((cx ^ swzX(sb1)) << 4) + 8 * (p3 & 1);
#pragma unroll 2
        for (int k = 0; k < 8; ++k) {
          const s16x4 alo = tr_read(pa_lo + k * 4096);
          const s16x4 ahi = tr_read(pa_hi + k * 4096);
          const s16x4 blo = tr_read(pb_lo + k * 2048);
          const s16x4 bhi = tr_read(pb_hi + k * 2048);
          const bf16x8 a = __builtin_shufflevector(alo, ahi, 0, 1, 2, 3, 4, 5, 6, 7);
          const bf16x8 bb = __builtin_shufflevector(blo, bhi, 0, 1, 2, 3, 4, 5, 6, 7);
          Hacc = MFMA32(a, bb, Hacc);
        }
        char* Hn = LHs;
        const int prow = pt * 32 + r31;
#pragma unroll
        for (int g4 = 0; g4 < 4; ++g4) {
          const int n0 = lt * 32 + 8 * g4 + 4 * hh;
          uint2 w; w.x = pack_bf2(Hacc[g4 * 4], Hacc[g4 * 4 + 1]); w.y = pack_bf2(Hacc[g4 * 4 + 2], Hacc[g4 * 4 + 3]);
          *(uint2*)(Hn + prow * 256 + ((((n0 >> 3)) ^ swzBC(prow)) << 4) + (n0 & 7) * 2) = w;
        }
      }
      SEGS_ADD(3);
    }
  }
  SEGS_FLUSH(4);
  __syncthreads();
}

DI void phase_groupnorm(const P& p) {
  const int lane = threadIdx.x & 63, gw = blockIdx.x * 8 + (threadIdx.x >> 6), nw = gridDim.x * 8;
  bf16_t* zh = (bf16_t*)(p.ws + WS_PB + L1_ZH);
  const float* gn = p.in[I_GNORM];
  for (int lr0 = gw * 2; lr0 < NB * SEQ; lr0 += nw * 2) {
    uint4 raw[2][4];
    bf16_t* rp[2];
#pragma unroll
    for (int u = 0; u < 2; ++u) {
      const int lr = lr0 + u, b = lr >> 12, l = lr & 4095;
      rp[u] = zh + ((size_t)(b * 32 + (lane >> 1)) * TPB + CTXL + l) * 64 + (lane & 1) * 32;
#pragma unroll
      for (int i = 0; i < 4; ++i) raw[u][i] = *(const uint4*)(rp[u] + i * 8);
    }
#pragma unroll
    for (int u = 0; u < 2; ++u) {
      float v[32];
#pragma unroll
      for (int i = 0; i < 4; ++i) { float f[8]; unpack8(raw[u][i], f);
#pragma unroll
        for (int j = 0; j < 8; ++j) v[i * 8 + j] = f[j]; }
      float ss = 0.f;
#pragma unroll
      for (int i = 0; i < 32; ++i) ss += v[i] * v[i];
      ss = red16(ss);
      const float rs = rsqrtf(ss * (1.f / 512.f) + 1e-6f);
#pragma unroll
      for (int i = 0; i < 4; ++i) {
        float o[8];
#pragma unroll
        for (int j = 0; j < 8; ++j) o[j] = v[i * 8 + j] * rs * gn[lane * 32 + i * 8 + j];
        *(uint4*)(rp[u] + i * 8) = pack8(o);
      }
    }
  }
}


__global__ void __launch_bounds__(NTHR) fwd_kernel(P p) {
  extern __shared__ __attribute__((aligned(16))) char lds[];
  const int lo = p.ph_lo, hi = p.ph_hi;
  unsigned char* ws = p.ws;
  XcdBarrier bar; bar.bar = (unsigned*)(ws + WS_CTL); bar.x = 0; bar.st = nullptr;
  volatile LAS unsigned* stw = (volatile LAS unsigned*)(lds + LDS_BYTES - 16);
  if (hi - lo > 1) {
    if (threadIdx.x == 0) { stw[0] = 0u; stw[1] = 0u; }
    __syncthreads();
    bar = xcd_barrier_post((unsigned*)(ws + WS_CTL), stw);
  }
#ifndef PHASE_MASK
#define PHASE_MASK 0xFFFFFFFFu
#endif
#define IN(k) (((PHASE_MASK >> (k)) & 1u) && lo <= (k) && (k) < hi)
#define SEAM(k) do { if (IN(k) && IN((k) + 1)) xcd_barrier(bar); } while (0)
#ifdef PROBE_A
  unsigned long long* tsp = (unsigned long long*)(ws + WS_SCAL + 1024);
#define STAMP(k) do { if (blockIdx.x == 0 && threadIdx.x == 0) tsp[k] = __builtin_amdgcn_s_memrealtime(); } while (0)
#else
#define STAMP(k) do {} while (0)
#endif
  const int G = gridDim.x;
  bf16_t* HBp = (bf16_t*)(ws + WS_HB);
  bf16_t* PBp = (bf16_t*)(ws + WS_PB + PB_P);

#ifdef PROBE_A
  if (blockIdx.x == 0 && threadIdx.x == 0) for (int k = 22; k < 64; ++k) tsp[k] = 0ull;
#endif
  STAMP(0); if (IN(0)) { phase_prep(p, lds); } SEAM(0);
  STAMP(1); if (IN(1)) { phase_normmod(p, 0, 0, true, false, HBp); } SEAM(1);
  STAMP(2); if (IN(2)) { pg8::Order S; S.init(R / 256, 3584 / 256, G, (int)blockIdx.x, 0);
    pg8::gemm_phase(lds, pg8::Gemm{HBp, (const bf16_t*)(ws + WS_WIN0T), D, D, 0}, S, pg8::EpiP0{PBp, (const float2*)(ws + WS_ROPE)}); } SEAM(2);
  STAMP(3); if (IN(3)) {
    for (int u = blockIdx.x; u < 1024 + 64; u += G) attn_flash_unit(p, lds, u);
    phase_ga(p);
  } SEAM(3);
  STAMP(4); if (IN(4)) {
    for (int u = blockIdx.x; u < 256; u += G) rwkv_scan_unit(p, lds, u);
    __syncthreads();
    gemm_store_phase(lds, (const bf16_t*)(ws + WS_PB + PB_GA), 128, (const bf16_t*)(ws + WS_RWT + 262144), 128, R, 512, 128, (bf16_t*)(ws + WS_PB + PB_G), 512, 512);
  } SEAM(4);
  STAMP(5); if (IN(5)) { phase_rwkv_post(p); } SEAM(5);
  STAMP(6); if (IN(6)) { pg8::Order S; S.init(R / 256, 4, G, (int)blockIdx.x, 0);
    pg8::gemm_phase(lds, pg8::Gemm{(const bf16_t*)(ws + WS_PB + PB_O0), (const bf16_t*)(ws + WS_WOUT0T), D, D, 0}, S,
                    pg8::EpiDelta{(bf16_t*)(ws + WS_PB + PB_H2), (const float*)(ws + WS_MODS)}); } SEAM(6);
  STAMP(7); if (IN(7)) { phase_normmod(p, 0, 1, true, false, (bf16_t*)(ws + WS_PB + PB_H2), (const bf16_t*)(ws + WS_PB + PB_H2)); convert_tables(p, 0); } SEAM(7);
  STAMP(8); if (IN(8)) { pg8::Order S; S.init(R / 256, 8, G, (int)blockIdx.x, 0);
    pg8::gemm_phase(lds, pg8::Gemm{(const bf16_t*)(ws + WS_PB + PB_H2), (const bf16_t*)(ws + WS_PQ0T), D, D, 0}, S, pg8::EpiBf16{(bf16_t*)(ws + WS_PB + PB_Q), 2048, 2048}); } SEAM(8);
  STAMP(9); if (IN(9)) { for (int u = blockIdx.x; u < (R / 256) * 8; u += G) peer_topk_unit(p, lds, 0, u); } SEAM(9);
  STAMP(10); if (IN(10)) { phase_peer_gather(p, 0); } SEAM(10);
  STAMP(11);
  STAMP(12); if (IN(12)) { pg8::Order S; S.init(R / 256, 5376 / 256, G, (int)blockIdx.x, 0);
    pg8::gemm_phase(lds, pg8::Gemm{(const bf16_t*)(ws + WS_HNEXT), (const bf16_t*)(ws + WS_WIN1T), D, D, 0}, S, pg8::EpiP1{ws + WS_PB}); } SEAM(12);
  STAMP(13); if (IN(13)) {
    phase_conv(p, lds);
    if (hi - lo > 1) xcd_barrier(bar);
    for (int u = blockIdx.x; u < 256; u += G) ssd_chunk_unit(p, lds, u);
  } SEAM(13);
  STAMP(14); if (IN(14)) { phase_groupnorm(p); } SEAM(14);
  STAMP(15); if (IN(15)) { pg8::Order S; S.init(NB * SEQ / 256, 4, G, (int)blockIdx.x, 1);
    pg8::gemm_phase(lds, pg8::Gemm{(const bf16_t*)(ws + WS_PB + L1_ZH), (const bf16_t*)(ws + WS_WOUT1T), 64, 2048, 1}, S,
                    pg8::EpiDelta{(bf16_t*)(ws + WS_PB + L1_XH), (const float*)(ws + WS_MODS) + 9 * 6144}); } SEAM(15);
  STAMP(16); if (IN(16)) { phase_normmod(p, 1, 1, false, true, (bf16_t*)(ws + WS_PB + PB_H2), (const bf16_t*)(ws + WS_PB + L1_XH)); convert_tables(p, 1); } SEAM(16);
  STAMP(17); if (IN(17)) { pg8::Order S; S.init(NB * SEQ / 256, 8, G, (int)blockIdx.x, 1);
    pg8::gemm_phase(lds, pg8::Gemm{(const bf16_t*)(ws + WS_PB + PB_H2), (const bf16_t*)(ws + WS_PQ1T), D, D, 0}, S, pg8::EpiBf16{(bf16_t*)(ws + WS_PB + PB_Q), 2048, 2048}); } SEAM(17);
  STAMP(18); if (IN(18)) { for (int u = blockIdx.x; u < (NB * SEQ / 256) * 8; u += G) { const int mtl = u >> 3; peer_topk_unit(p, lds, 1, ((((mtl >> 4) * 17 + 1 + (mtl & 15)) << 3) | (u & 7))); } } SEAM(18);
  STAMP(19); if (IN(19)) { phase_peer_gather(p, 1); }
  STAMP(20);
#ifdef PROBE_A
  xcd_barrier(bar);
  if (blockIdx.x == 0 && threadIdx.x == 0) {
    const unsigned long long tend = __builtin_amdgcn_s_memrealtime();
    tsp[21] = tend;
    unsigned long long ta = 0;
    for (int k = 0; k < 21; ++k) if ((PROBE_A >> k) & 1) ta += tsp[k + 1] - tsp[k];
    for (int k = 22; k < 64; ++k) if ((PROBE_A >> k) & 1ull) ta += tsp[k];
    while (__builtin_amdgcn_s_memrealtime() - tend < ta * PROBE_K) __builtin_amdgcn_s_sleep(8);
  }
#endif
}

extern "C" void kernel_launch(void* const* d_in, const int* in_sizes, int n_in, void* d_out, int out_size, void* d_ws, size_t ws_size, hipStream_t stream) {
  static int inited = 0;
  if (!inited) {
    if (n_in != N_IN || ws_size < WS_XC + 128 * MiB) { fprintf(stderr, "kernel_launch: unexpected n_in %d / ws_size %zu\n", n_in, ws_size); inited = -1; return; }
    if (hipFuncSetAttribute((const void*)fwd_kernel, hipFuncAttributeMaxDynamicSharedMemorySize, LDS_BYTES) != hipSuccess) { fprintf(stderr, "kernel_launch: hipFuncSetAttribute failed\n"); inited = -1; return; }
    inited = 1;
  }
  if (inited < 0) return;
  P p{};
  for (int i = 0; i < N_IN; ++i) p.in[i] = (const float*)d_in[i];
  p.out = (float*)d_out; p.ws = (unsigned char*)d_ws;
  (void)hipMemsetAsync((char*)d_ws + WS_CTL, 0, 65536, stream);
#if N_LAUNCH_MODE == 1
  p.ph_lo = 0; p.ph_hi = N_PHASES;
  hipLaunchKernelGGL(fwd_kernel, dim3(256), dim3(NTHR), LDS_BYTES, stream, p);
#else
  for (int ph = 0; ph < N_PHASES; ++ph) {
    p.ph_lo = ph; p.ph_hi = ph + 1;
    hipLaunchKernelGGL(fwd_kernel, dim3(256), dim3(NTHR), LDS_BYTES, stream, p);
  }
#endif
}
```

```cpp
#include <hip/hip_runtime.h>
#include <stdint.h>
#include <stdio.h>

#ifndef N_LAUNCH_MODE
#define N_LAUNCH_MODE 1
#endif

#define DI __device__ __forceinline__
typedef unsigned short bf16_t;
typedef __attribute__((ext_vector_type(8))) short bf16x8;
typedef __attribute__((ext_vector_type(16))) float f32x16;
typedef __attribute__((ext_vector_type(2))) __bf16 bf2_t;

constexpr int D = 1024, NB = 8, SEQ = 4096, CTXL = 256, TPB = SEQ + CTXL, R = NB * TPB;
constexpr int NTHR = 512;
constexpr int LDS_BYTES = 163840;
constexpr int P0LD = 3456;
constexpr int P1LD = 5184;
constexpr int P1NPAD = 5248;

enum { I_X = 0, I_C, I_CTX, I_CCTX,
       I_ADAW0, I_ADAB0, I_N1_0, I_N2_0, I_WIN0, I_DALAM, I_DASUB, I_RWMU, I_RWW0, I_RWW2, I_RWA0, I_RWA2, I_RWG2, I_RWKK, I_RWKA, I_RWRK, I_LNXW, I_LNXB, I_WOUT0, I_PQ0, I_PK0, I_PU0, I_PV0,
       I_ADAW1, I_ADAB1, I_N1_1, I_N2_1, I_WIN1, I_CONVW, I_CONVB, I_DTB, I_ALOG, I_DSKIP, I_GNORM, I_WOUT1, I_PQ1, I_PK1, I_PU1, I_PV1, I_NF, N_IN };

constexpr size_t MiB = 1048576;
constexpr size_t WS_CTL = 0;
constexpr size_t WS_SCAL = 65536;
constexpr size_t WS_MODS = 131072;
constexpr size_t WS_ROPE = 1 * MiB;
constexpr size_t WS_RWT = 2 * MiB;
constexpr size_t WS_WIN0T = 3 * MiB;
constexpr size_t WS_WOUT0T = 10 * MiB;
constexpr size_t WS_PQ0T = 12 * MiB;
constexpr size_t WS_KEYS0 = 16 * MiB;
constexpr size_t WS_KEYS1 = 16 * MiB + 524288;
constexpr size_t WS_WIN1T = 17 * MiB;
constexpr size_t WS_WOUT1T = 28 * MiB;
constexpr size_t WS_PQ1T = 32 * MiB;
constexpr size_t WS_PB = 36 * MiB;
constexpr size_t WS_XC = 381 * MiB;
constexpr size_t WS_HB = 389 * MiB;
constexpr size_t WS_END = 457 * MiB;
constexpr size_t WS_YF = WS_XC;
constexpr size_t PB_P = 0;
constexpr size_t PB_O0 = 230 * MiB;
constexpr size_t PB_G = 298 * MiB;
constexpr size_t PB_GA = 332 * MiB;
constexpr size_t PB_BONUS = 341 * MiB;
constexpr size_t L1_ZH = 0;
constexpr size_t L1_XH = 136 * MiB;
constexpr size_t L1_BG = 272 * MiB;
constexpr size_t L1_CG = 306 * MiB;
constexpr size_t L1_DT = 340 * MiB;
constexpr size_t PB_H2 = 0;
constexpr size_t PB_Q = 68 * MiB;
constexpr size_t PB_IDX = 204 * MiB;
constexpr size_t PB_GATE = 221 * MiB;
constexpr size_t WS_HNEXT = WS_HB + 33 * MiB;
constexpr size_t HB_YF = 0, HB_YB = 34 * MiB;
constexpr size_t HB_U = 0, HB_V = 8 * MiB;
constexpr size_t HB_SU = 32 * MiB, HB_SV = 32 * MiB + 65536;

struct P {
  const float* in[N_IN];
  float* out;
  unsigned char* ws;
  int ph_lo, ph_hi;
};

constexpr int N_PHASES = 21;
#ifndef PROBE_GRP
#define PROBE_GRP 0
#endif
#define SEG_DECL_() unsigned long long seg_last_ = 0ull, seg_acc_[4] = {0ull, 0ull, 0ull, 0ull}
#define SEG_INIT_() do { seg_last_ = __builtin_amdgcn_s_memrealtime(); } while (0)
#define SEG_ADD_(j) do { const unsigned long long t__ = __builtin_amdgcn_s_memrealtime(); seg_acc_[j] += t__ - seg_last_; seg_last_ = t__; } while (0)
#define SEG_FLUSH_(base) do { if (blockIdx.x == 0 && threadIdx.x == 0) { for (int j__ = 0; j__ < 4; ++j__) ((unsigned long long*)(p.ws + WS_SCAL + 1024))[22 + (base) + j__] += seg_acc_[j__]; } } while (0)
#if defined(PROBE_A) && PROBE_GRP == 1
#define SEGR_DECL() SEG_DECL_()
#define SEGR_INIT() SEG_INIT_()
#define SEGR_ADD(j) SEG_ADD_(j)
#define SEGR_FLUSH(b) SEG_FLUSH_(b)
#else
#define SEGR_DECL() do {} while (0)
#define SEGR_INIT() do {} while (0)
#define SEGR_ADD(j) do {} while (0)
#define SEGR_FLUSH(b) do {} while (0)
#endif
#if defined(PROBE_A) && PROBE_GRP == 2
#define SEGS_DECL() SEG_DECL_()
#define SEGS_INIT() SEG_INIT_()
#define SEGS_ADD(j) SEG_ADD_(j)
#define SEGS_FLUSH(b) SEG_FLUSH_(b)
#else
#define SEGS_DECL() do {} while (0)
#define SEGS_INIT() do {} while (0)
#define SEGS_ADD(j) do {} while (0)
#define SEGS_FLUSH(b) do {} while (0)
#endif

DI unsigned pack_bf2(float a, float b) { bf2_t v; v[0] = (__bf16)a; v[1] = (__bf16)b; return __builtin_bit_cast(unsigned, v); }
DI bf16_t f2bf(float a) { return __builtin_bit_cast(unsigned short, (__bf16)a); }
DI float bf2f(bf16_t v) { return __uint_as_float((unsigned)v << 16); }
DI float bflo(unsigned u) { return __uint_as_float(u << 16); }
DI float bfhi(unsigned u) { return __uint_as_float(u & 0xffff0000u); }
template <int CTRL> DI float dpp_f(float x) { return __int_as_float(__builtin_amdgcn_update_dpp(0, __float_as_int(x), CTRL, 0xF, 0xF, true)); }
DI float red4(float x) { x += dpp_f<0xB1>(x); x += dpp_f<0x4E>(x); return x; }
DI float red8(float x) { x += dpp_f<0x141>(x); return red4(x); }
DI float red16(float x) { x += dpp_f<0x140>(x); return red8(x); }
DI float red64(float x) { x = red16(x); x += __shfl_xor(x, 16); x += __shfl_xor(x, 32); return x; }
DI float frcp_(float x) { return __builtin_amdgcn_rcpf(x); }
DI float sigmoidf_(float x) { return frcp_(1.f + __expf(-x)); }
DI float siluf_(float x) { return x * frcp_(1.f + __expf(-x)); }
DI float softplusf_(float x) { return x > 20.f ? x : log1pf(__expf(x)); }
DI float geluf_(float x) { return 0.5f * x * (1.f + erff(x * 0.70710678118654752f)); }
DI void unpack8(const uint4& u, float (&f)[8]) { f[0] = bflo(u.x); f[1] = bfhi(u.x); f[2] = bflo(u.y); f[3] = bfhi(u.y); f[4] = bflo(u.z); f[5] = bfhi(u.z); f[6] = bflo(u.w); f[7] = bfhi(u.w); }
DI uint4 pack8(const float (&f)[8]) { uint4 u; u.x = pack_bf2(f[0], f[1]); u.y = pack_bf2(f[2], f[3]); u.z = pack_bf2(f[4], f[5]); u.w = pack_bf2(f[6], f[7]); return u; }
#define ACC_ROW(reg, lane) (((reg) & 3) + 8 * ((reg) >> 2) + 4 * ((lane) >> 5))
#define MFMA32(a, b, c) __builtin_amdgcn_mfma_f32_32x32x16_bf16((a), (b), (c), 0, 0, 0)

#define XB_TMO      128
#define XB_XCNT(j)  (256  + 64 * (j))
#define XB_XSUB(j)  (1280 + 64 * (j))
#define XB_XGEN(j)  (2304 + 64 * (j))
#define XB_TOP      3328
#define XB_TOPGEN   3392
#define XCD_BAR_WORDS 3456
#define XB_SPIN_CAP (1u << 22)
#define LAS __attribute__((address_space(3)))
DI unsigned xb_ld(unsigned* p) { return __hip_atomic_load(p, __ATOMIC_RELAXED, __HIP_MEMORY_SCOPE_AGENT); }
DI unsigned xb_add(unsigned* p, unsigned v) { return __hip_atomic_fetch_add(p, v, __ATOMIC_RELAXED, __HIP_MEMORY_SCOPE_AGENT); }
DI unsigned xb_xcc_id() { return (unsigned)__builtin_amdgcn_s_getreg((3 << 11) | 20) & 0xFu; }
#define XB_SPIN(cond, bar) do { unsigned _sp = 0; while (cond) { __builtin_amdgcn_s_sleep(1); \
    if ((++_sp & 255u) == 0u) { if (xb_ld(&(bar)[XB_TMO])) break; if (_sp > XB_SPIN_CAP) { atomicAdd(&(bar)[XB_TMO], 1u); break; } } } } while (0)
struct XcdBarrier { unsigned* bar; unsigned x; volatile LAS unsigned* st; };
DI XcdBarrier xcd_barrier_post(unsigned* bar, volatile LAS unsigned* st) {
  XcdBarrier b; b.bar = bar; b.x = xb_xcc_id(); b.st = st;
  if (threadIdx.x == 0) (void)xb_add(&bar[XB_XCNT(b.x)], 1u);
  return b;
}
DI void xcd_barrier_complete(unsigned* bar, unsigned x, unsigned& nloc, unsigned& nx) {
  const unsigned G = gridDim.x * gridDim.y * gridDim.z;
  unsigned sum, cnt, mine, sp = 0u;
  for (;;) {
    sum = 0u; cnt = 0u; mine = 0u;
#pragma unroll
    for (unsigned j = 0; j < 16; ++j) { const unsigned c = xb_ld(&bar[XB_XCNT(j)]); sum += c; cnt += (c > 0u) ? 1u : 0u; mine = (j == x) ? c : mine; }
    if (sum == G) break;
    __builtin_amdgcn_s_sleep(1);
    if ((++sp & 255u) == 0u) { if (xb_ld(&bar[XB_TMO])) break; if (sp > XB_SPIN_CAP) { atomicAdd(&bar[XB_TMO], 1u); break; } }
  }
  nloc = mine > 0u ? mine : 1u; nx = cnt > 0u ? cnt : 1u;
}
DI void xcd_barrier(const XcdBarrier& b) {
  asm volatile("s_waitcnt vmcnt(0)" ::: "memory");
  __syncthreads();
  if (threadIdx.x == 0) {
    unsigned* bar = b.bar;
    __builtin_amdgcn_s_waitcnt(0);
    unsigned nloc = b.st[0], nx = b.st[1];
    if (nloc == 0u) { xcd_barrier_complete(bar, b.x, nloc, nx); b.st[0] = nloc; b.st[1] = nx; }
    const unsigned old = xb_add(&bar[XB_XSUB(b.x)], 1u);
    const unsigned gen = old / nloc;
    if (old + 1u == (gen + 1u) * nloc) {
      __builtin_amdgcn_fence(__ATOMIC_RELEASE, "agent");
      asm volatile("s_waitcnt vmcnt(0)" ::: "memory");
      const unsigned og = xb_add(&bar[XB_TOP], 1u);
      const unsigned tg = og / nx;
      if (og + 1u == (tg + 1u) * nx) xb_add(&bar[XB_TOPGEN], 1u);
      else XB_SPIN(xb_ld(&bar[XB_TOPGEN]) == tg, bar);
      __builtin_amdgcn_fence(__ATOMIC_ACQUIRE, "agent");
      xb_add(&bar[XB_XGEN(b.x)], 1u);
      asm volatile("s_waitcnt vmcnt(0)" ::: "memory");
    } else {
      XB_SPIN(xb_ld(&bar[XB_XGEN(b.x)]) == gen, bar);
      __builtin_amdgcn_fence(__ATOMIC_ACQUIRE, "agent");
      asm volatile("s_waitcnt vmcnt(0)" ::: "memory");
    }
  }
  __syncthreads();
}

DI void gemm_tile(char* lds, const bf16_t* __restrict__ A, int lda, const bf16_t* __restrict__ Bt, int ldb, int K, f32x16 (&acc)[2][2]) {
  const int tid = threadIdx.x, lane = tid & 63, wave = tid >> 6, wm = wave >> 1, wn = wave & 1;
#pragma unroll
  for (int i = 0; i < 2; ++i)
#pragma unroll
    for (int j = 0; j < 2; ++j)
#pragma unroll
      for (int r = 0; r < 16; ++r) acc[i][j][r] = 0.f;
  const int arow0 = tid >> 3, ac = tid & 7;
  const bf16_t* ap = A + (size_t)arow0 * lda + ac * 8;
  const bf16_t* bp = Bt + (size_t)arow0 * ldb + ac * 8;
  const int sw = ((ac ^ (arow0 >> 1)) & 7) << 4;
  const int st_off = arow0 * 128 + sw;
  uint4 ra[4], rb[2];
#pragma unroll
  for (int i = 0; i < 4; ++i) ra[i] = *(const uint4*)(ap + (size_t)i * 64 * lda);
#pragma unroll
  for (int i = 0; i < 2; ++i) rb[i] = *(const uint4*)(bp + (size_t)i * 64 * ldb);
#pragma unroll
  for (int i = 0; i < 4; ++i) *(uint4*)(lds + st_off + i * 8192) = ra[i];
#pragma unroll
  for (int i = 0; i < 2; ++i) *(uint4*)(lds + 65536 + st_off + i * 8192) = rb[i];
  __syncthreads();
  const int nk = K >> 6;
  const int r31 = lane & 31, hh = lane >> 5;
  for (int kt = 0; kt < nk; ++kt) {
    const int cur = kt & 1;
    if (kt + 1 < nk) {
#pragma unroll
      for (int i = 0; i < 4; ++i) ra[i] = *(const uint4*)(ap + (size_t)i * 64 * lda + (kt + 1) * 64);
#pragma unroll
      for (int i = 0; i < 2; ++i) rb[i] = *(const uint4*)(bp + (size_t)i * 64 * ldb + (kt + 1) * 64);
    }
    const char* la = lds + cur * 32768;
    const char* lb = lds + 65536 + cur * 16384;
#pragma unroll
    for (int kk = 0; kk < 4; ++kk) {
      const int c = kk * 2 + hh;
      bf16x8 a[2], b[2];
#pragma unroll
      for (int mi = 0; mi < 2; ++mi) { const int row = wm * 64 + mi * 32 + r31; a[mi] = *(const bf16x8*)(la + row * 128 + (((c ^ (row >> 1)) & 7) << 4)); }
#pragma unroll
      for (int ni = 0; ni < 2; ++ni) { const int row = wn * 64 + ni * 32 + r31; b[ni] = *(const bf16x8*)(lb + row * 128 + (((c ^ (row >> 1)) & 7) << 4)); }
#pragma unroll
      for (int mi = 0; mi < 2; ++mi)
#pragma unroll
        for (int ni = 0; ni < 2; ++ni) acc[mi][ni] = MFMA32(a[mi], b[ni], acc[mi][ni]);
    }
    if (kt + 1 < nk) {
      char* wa = lds + (cur ^ 1) * 32768;
      char* wb = lds + 65536 + (cur ^ 1) * 16384;
#pragma unroll
      for (int i = 0; i < 4; ++i) *(uint4*)(wa + st_off + i * 8192) = ra[i];
#pragma unroll
      for (int i = 0; i < 2; ++i) *(uint4*)(wb + st_off + i * 8192) = rb[i];
    }
    __syncthreads();
  }
}

DI void gemm_store_phase(char* lds, const bf16_t* A, int lda, const bf16_t* Bt, int ldb, int M, int Npad, int K, bf16_t* C, int ldc, int nvalid) {
  const int ntn = Npad / 128, ntm = M / 256;
  const int lane = threadIdx.x & 63, wave = threadIdx.x >> 6, wm = wave >> 1, wn = wave & 1;
  for (int tile = blockIdx.x; tile < ntm * ntn; tile += gridDim.x) {
    const int mt = tile / ntn, nt = tile - mt * ntn;
    f32x16 acc[2][2];
    gemm_tile(lds, A + (size_t)mt * 256 * lda, lda, Bt + (size_t)nt * 128 * ldb, ldb, K, acc);
#pragma unroll
    for (int mi = 0; mi < 2; ++mi)
#pragma unroll
      for (int ni = 0; ni < 2; ++ni) {
        const int col = nt * 128 + wn * 64 + ni * 32 + (lane & 31);
        if (col < nvalid) {
#pragma unroll
          for (int r = 0; r < 16; ++r) {
            const int row = mt * 256 + wm * 64 + mi * 32 + ACC_ROW(r, lane);
            C[(size_t)row * ldc + col] = f2bf(acc[mi][ni][r]);
          }
        }
      }
  }
}

namespace pg8 {
typedef float f32x4 __attribute__((ext_vector_type(4)));
typedef unsigned u32x4 __attribute__((ext_vector_type(4)));
constexpr int BM = 256, BK = 64, HALF = 128, HTB = HALF * BK * 2, STAGE_BYTES = 8 * HTB, NXCD = 8, WGM = 8;
DI int lds_byte(int r, int c) { const int st = (r >> 4) * 2 + (c >> 5), rr = r & 15, cc = c & 31, ob = rr * 64 + cc * 2; return st * 1024 + (ob ^ (((ob >> 9) & 1) << 5)); }
DI void stage_rc(int b, int& R_, int& C_) { const int st = b / 1024, sb = b % 1024, swz = sb ^ (((sb >> 9) & 1) << 5); R_ = (st >> 1) * 16 + swz / 64; C_ = (st & 1) * 32 + (swz % 64) / 2; }
DI int perm32(int rho) { const int n = rho >> 4, i = rho & 15; return 8 * (i >> 2) + 4 * n + (i & 3); }
struct Unit { int pm, pn; };
struct Gemm { const bf16_t* A; const bf16_t* Bt; int lda, K; int headmajor; };
struct Order {
  int nM, nN, nwg, G, c, skipctx;
  DI void init(int nM_, int nN_, int G_, int c_, int skipctx_) { nM = nM_; nN = nN_; nwg = nM * nN; G = G_; c = c_; skipctx = skipctx_; }
  DI bool next(int i, Unit& u) const {
    const long L = (long)i * G + c; if (L >= nwg) return false;
    int wgid = (int)L; { const int q = nwg / NXCD, r = nwg % NXCD, xcd = wgid % NXCD, off = wgid / NXCD; wgid = (xcd < r ? xcd * (q + 1) : r * (q + 1) + (xcd - r) * q) + off; }
    const int nig = WGM * nN, gid = wgid / nig, fm = gid * WGM, gsz = (nM - fm) < WGM ? (nM - fm) : WGM;
    int pm = fm + ((wgid % nig) % gsz); u.pn = (wgid % nig) / gsz;
    if (skipctx) pm = (pm >> 4) * 17 + 1 + (pm & 15);
    u.pm = pm; return true;
  }
};
template <class Epi>
DI void gemm_phase(char* lds_generic, const Gemm g, const Order& S, const Epi& E) {
  LAS unsigned char* lds = (LAS unsigned char*)lds_generic;
  const int tid = threadIdx.x, wid = __builtin_amdgcn_readfirstlane(tid >> 6), lane = tid & 63, wr = wid >> 2, wc = wid & 3, fr = lane & 15, fq = lane >> 4;
  const int K = g.K, nt = K / BK, lda = g.lda;
  unsigned voffA[2], voffB[2];
#pragma unroll
  for (int i = 0; i < 2; ++i) { int R_, C_; stage_rc(tid * 16 + i * 8192, R_, C_); const int Rb = Epi::PERM ? ((R_ & ~31) + perm32(R_ & 31)) : R_;
    voffA[i] = (unsigned)(R_ * lda + C_) * 2u; voffB[i] = (unsigned)(Rb * K + C_) * 2u; }
  const size_t kstep = (size_t)(BK * 2);
  const size_t kstepA = g.headmajor ? (size_t)TPB * 64 * 2 : kstep;
  const size_t hstepA = (size_t)HALF * lda * 2, hstepB = (size_t)HALF * K * 2;
  const size_t tstepB = 2 * hstepB;
#define PG8_ABASE(pm_) ((const char*)g.A + (g.headmajor ? ((size_t)((pm_) / 17) * 32 * TPB + (size_t)((pm_) % 17) * 256) * 128 : (size_t)(pm_) * 2 * hstepA))
  const unsigned ldsw = (unsigned)wid * 1024u;
  const int aoff = lds_byte(wr * 64 + fr, fq * 8), boff = lds_byte(wc * 32 + fr, fq * 8);
#define PG8_SA(b, h) (((b) * 2 + (h)) * HTB)
#define PG8_SB(b, h) ((4 + (b) * 2 + (h)) * HTB)
#define PG8_STAGE(bufoff, gbase, voff) do { _Pragma("unroll") for (int _i = 0; _i < 2; ++_i) \
    __builtin_amdgcn_global_load_lds((const unsigned*)((const char*)(gbase) + (voff)[_i]), (LAS unsigned*)(lds + (bufoff) + ldsw + _i * 8192), 16, 0, 0); } while (0)
#define PG8_LDA(dst, b, h) do { _Pragma("unroll") for (int m = 0; m < 4; ++m) _Pragma("unroll") for (int k = 0; k < 2; ++k) dst[m][k] = *(const LAS bf16x8*)(lds + PG8_SA(b, h) + aoff + m * 2048 + k * 1024); } while (0)
#define PG8_LDB(dst, b, h) do { _Pragma("unroll") for (int n = 0; n < 2; ++n) _Pragma("unroll") for (int k = 0; k < 2; ++k) dst[n][k] = *(const LAS bf16x8*)(lds + PG8_SB(b, h) + boff + n * 2048 + k * 1024); } while (0)
#define PG8_MMA(ai, bj, At, Bt) do { __builtin_amdgcn_s_setprio(1); _Pragma("unroll") for (int m = 0; m < 4; ++m) _Pragma("unroll") for (int n = 0; n < 2; ++n) _Pragma("unroll") for (int k = 0; k < 2; ++k) \
    acc[ai][bj][m][n] = __builtin_amdgcn_mfma_f32_16x16x32_bf16(Bt[n][k], At[m][k], acc[ai][bj][m][n], 0, 0, 0); __builtin_amdgcn_s_setprio(0); } while (0)
#define PG8_WAIT_V(n) asm volatile("s_waitcnt vmcnt(" #n ")" ::: "memory")
#define PG8_WAIT_L(n) asm volatile("s_waitcnt lgkmcnt(" #n ")" ::: "memory")
#define PG8_BAR __builtin_amdgcn_s_barrier()
#define PG8_SCHED __builtin_amdgcn_sched_barrier(0)
  Unit cur, nxt; int ui = 0;
  if (!S.next(0, cur)) return;
  f32x4 acc[2][2][4][2];
#pragma unroll
  for (int a = 0; a < 2; ++a)
#pragma unroll
    for (int b = 0; b < 2; ++b)
#pragma unroll
      for (int m = 0; m < 4; ++m)
#pragma unroll
        for (int n = 0; n < 2; ++n) acc[a][b][m][n] = (f32x4){0.f, 0.f, 0.f, 0.f};
  bf16x8 At[4][2], B0[2][2], B1[2][2];
  const char* cA = PG8_ABASE(cur.pm); const char* cB = (const char*)g.Bt + (size_t)cur.pn * tstepB;
  PG8_STAGE(PG8_SB(0, 0), cB, voffB); PG8_STAGE(PG8_SA(0, 0), cA, voffA); PG8_STAGE(PG8_SB(0, 1), cB + hstepB, voffB); PG8_STAGE(PG8_SA(0, 1), cA + hstepA, voffA);
  if (wr == 1) PG8_BAR;
  PG8_WAIT_V(4); PG8_BAR;
  PG8_STAGE(PG8_SB(1, 0), cB + kstep, voffB); PG8_STAGE(PG8_SA(1, 0), cA + kstepA, voffA); PG8_STAGE(PG8_SB(1, 1), cB + hstepB + kstep, voffB);
  PG8_WAIT_V(6); PG8_BAR;
  for (;;) {
    const bool has_next = S.next(ui + 1, nxt);
    const char* nA = has_next ? PG8_ABASE(nxt.pm) : cA; const char* nB = has_next ? (const char*)g.Bt + (size_t)nxt.pn * tstepB : cB;
    for (int t = 0; t < nt; t += 2) {
      const bool last = (t == nt - 2);
      const char* a1 = cA + (size_t)(t + 1) * kstepA;
      const char* a2 = last ? nA : cA + (size_t)(t + 2) * kstepA; const char* b2 = last ? nB : cB + (size_t)(t + 2) * kstep;
      const char* a3 = a2 + kstepA; const char* b3 = b2 + kstep;
      PG8_LDB(B0, 0, 0); PG8_SCHED; PG8_LDA(At, 0, 0); PG8_STAGE(PG8_SA(1, 1), a1 + hstepA, voffA);
      PG8_WAIT_L(8); PG8_BAR; PG8_WAIT_L(0); PG8_MMA(0, 0, At, B0); PG8_BAR; PG8_SCHED;
      PG8_LDB(B1, 0, 1); PG8_STAGE(PG8_SB(0, 0), b2, voffB);
      PG8_BAR; PG8_WAIT_L(0); PG8_MMA(0, 1, At, B1); PG8_BAR;
      PG8_LDA(At, 0, 1); PG8_STAGE(PG8_SA(0, 0), a2, voffA);
      PG8_BAR; PG8_WAIT_L(0); PG8_MMA(1, 0, At, B0); PG8_BAR; PG8_SCHED;
      PG8_STAGE(PG8_SB(0, 1), b2 + hstepB, voffB);
      PG8_WAIT_V(6); PG8_BAR; PG8_MMA(1, 1, At, B1); PG8_BAR;
      PG8_LDB(B0, 1, 0); PG8_SCHED; PG8_LDA(At, 1, 0); PG8_STAGE(PG8_SA(0, 1), a2 + hstepA, voffA);
      PG8_WAIT_L(8); PG8_BAR; PG8_WAIT_L(0); PG8_MMA(0, 0, At, B0); PG8_BAR; PG8_SCHED;
      PG8_LDB(B1, 1, 1); PG8_STAGE(PG8_SB(1, 0), b3, voffB);
      PG8_BAR; PG8_WAIT_L(0); PG8_MMA(0, 1, At, B1); PG8_BAR;
      PG8_LDA(At, 1, 1); PG8_STAGE(PG8_SA(1, 0), a3, voffA);
      PG8_BAR; PG8_WAIT_L(0); PG8_MMA(1, 0, At, B0); PG8_BAR; PG8_SCHED;
      PG8_STAGE(PG8_SB(1, 1), b3 + hstepB, voffB);
      PG8_WAIT_V(6); PG8_BAR; PG8_MMA(1, 1, At, B1); PG8_BAR;
    }
    E(acc, cur, wr, wc, fr, fq);
    if (!has_next) break;
#pragma unroll
    for (int a = 0; a < 2; ++a)
#pragma unroll
      for (int b = 0; b < 2; ++b)
#pragma unroll
        for (int m = 0; m < 4; ++m)
#pragma unroll
          for (int n = 0; n < 2; ++n) acc[a][b][m][n] = (f32x4){0.f, 0.f, 0.f, 0.f};
    cur = nxt; cA = nA; cB = nB; ++ui;
  }
  PG8_WAIT_V(0);
  if (wr == 0) PG8_BAR;
  PG8_BAR;
#undef PG8_ABASE
#undef PG8_SA
#undef PG8_SB
#undef PG8_STAGE
#undef PG8_LDA
#undef PG8_LDB
#undef PG8_MMA
#undef PG8_WAIT_V
#undef PG8_WAIT_L
#undef PG8_BAR
#undef PG8_SCHED
}

struct EpiBf16 {
  static constexpr bool PERM = true;
  bf16_t* O; int ldc, nvalid;
  DI void operator()(const f32x4 (&acc)[2][2][4][2], const Unit& u, int wr, int wc, int fr, int fq) const {
    const int row0 = u.pm * BM + wr * 64 + fr, col0 = u.pn * BM + wc * 32 + 8 * fq;
#pragma unroll
    for (int ai = 0; ai < 2; ++ai)
#pragma unroll
      for (int m = 0; m < 4; ++m) { bf16_t* rowp = O + (size_t)(row0 + ai * HALF + m * 16) * ldc + col0;
#pragma unroll
        for (int bj = 0; bj < 2; ++bj) if (col0 + bj * HALF < nvalid) {
          const f32x4 v0 = acc[ai][bj][m][0], v1 = acc[ai][bj][m][1];
          u32x4 w; w.x = pack_bf2(v0[0], v0[1]); w.y = pack_bf2(v0[2], v0[3]); w.z = pack_bf2(v1[0], v1[1]); w.w = pack_bf2(v1[2], v1[3]);
          *(u32x4*)(rowp + bj * HALF) = w; } }
  }
};
struct EpiP0 {
  static constexpr bool PERM = true;
  bf16_t* O; const float2* rope;
  DI void operator()(const f32x4 (&acc)[2][2][4][2], const Unit& u, int wr, int wc, int fr, int fq) const {
    const int row0 = u.pm * BM + wr * 64 + fr, col0 = u.pn * BM + wc * 32 + 8 * fq;
    const bool isctx = (u.pm % 17) == 0; const int b = u.pm / 17;
    const bool qk = u.pn < 4;
    const float qs = (u.pn < 2) ? 0.125f * 1.4426950408889634f : 1.f;
    const int a = wc & 1, half = fq >> 1, f0 = 8 * (fq & 1);
#pragma unroll
    for (int ai = 0; ai < 2; ++ai)
#pragma unroll
      for (int m = 0; m < 4; ++m) {
        const int row = row0 + ai * HALF + m * 16;
        bf16_t* rowp = O + (size_t)row * P0LD + col0;
        const int l = row - b * TPB - CTXL;
#pragma unroll
        for (int bj = 0; bj < 2; ++bj) if (col0 + bj * HALF < P0LD) {
          float v[8];
#pragma unroll
          for (int j = 0; j < 4; ++j) { v[j] = acc[ai][bj][m][0][j]; v[4 + j] = acc[ai][bj][m][1][j]; }
          if (qk) {
            float pv[8];
#pragma unroll
            for (int j = 0; j < 8; ++j) pv[j] = __shfl_xor(v[j], 32);
            if (!isctx) {
              const float4* cs4 = (const float4*)(rope + (size_t)l * 32 + a * 16 + f0);
#pragma unroll
              for (int j2 = 0; j2 < 4; ++j2) {
                const float4 cs = cs4[j2];
                v[2 * j2] = half ? (v[2 * j2] * cs.x + pv[2 * j2] * cs.y) : (v[2 * j2] * cs.x - pv[2 * j2] * cs.y);
                v[2 * j2 + 1] = half ? (v[2 * j2 + 1] * cs.z + pv[2 * j2 + 1] * cs.w) : (v[2 * j2 + 1] * cs.z - pv[2 * j2 + 1] * cs.w);
              }
            }
#pragma unroll
            for (int j = 0; j < 8; ++j) v[j] *= qs;
          }
          u32x4 w; w.x = pack_bf2(v[0], v[1]); w.y = pack_bf2(v[2], v[3]); w.z = pack_bf2(v[4], v[5]); w.w = pack_bf2(v[6], v[7]);
          *(u32x4*)(rowp + bj * HALF) = w; } }
  }
};
struct EpiResid {
  static constexpr bool PERM = false;
  const float* x_in; const float* ctx_in; float* out; float* xc; const float* mods; int layer;
  DI void operator()(const f32x4 (&acc)[2][2][4][2], const Unit& u, int wr, int wc, int fr, int fq) const {
    const int row0 = u.pm * BM + wr * 64 + fr, col0 = u.pn * BM + wc * 32 + 4 * fq;
    const bool isctx = (u.pm % 17) == 0; const int b = u.pm / 17;
    const float* gate = mods + (isctx ? 8 : b) * 6144 + 2 * 1024 + col0;
    f32x4 gv[2][2];
#pragma unroll
    for (int bj = 0; bj < 2; ++bj)
#pragma unroll
      for (int n = 0; n < 2; ++n) gv[bj][n] = *(const f32x4*)(gate + bj * HALF + n * 16);
#pragma unroll
    for (int ai = 0; ai < 2; ++ai)
#pragma unroll
      for (int m = 0; m < 4; ++m) {
        const int row = row0 + ai * HALF + m * 16;
        const int t = row - b * TPB;
        const size_t o = isctx ? ((size_t)(b * CTXL + t)) * D + col0 : ((size_t)(b * SEQ + t - CTXL)) * D + col0;
        const float* src = isctx ? ctx_in : ((layer == 0) ? x_in : out);
        float* dst = isctx ? xc : out;
#pragma unroll
        for (int bj = 0; bj < 2; ++bj)
#pragma unroll
          for (int n = 0; n < 2; ++n) {
            const f32x4 xi = *(const f32x4*)(src + o + bj * HALF + n * 16);
            *(f32x4*)(dst + o + bj * HALF + n * 16) = xi + gv[bj][n] * acc[ai][bj][m][n];
          }
      }
  }
};
struct EpiDelta {
  static constexpr bool PERM = true;
  bf16_t* O; const float* mods;
  DI void operator()(const f32x4 (&acc)[2][2][4][2], const Unit& u, int wr, int wc, int fr, int fq) const {
    const int row0 = u.pm * BM + wr * 64 + fr, col0 = u.pn * BM + wc * 32 + 8 * fq;
    const bool isctx = (u.pm % 17) == 0; const int b = u.pm / 17;
    const float* gate = mods + (isctx ? 8 : b) * 6144 + 2 * 1024 + col0;
    f32x4 g0[2], g1[2];
#pragma unroll
    for (int bj = 0; bj < 2; ++bj) { g0[bj] = *(const f32x4*)(gate + bj * HALF); g1[bj] = *(const f32x4*)(gate + bj * HALF + 4); }
#pragma unroll
    for (int ai = 0; ai < 2; ++ai)
#pragma unroll
      for (int m = 0; m < 4; ++m) { bf16_t* rowp = O + (size_t)(row0 + ai * HALF + m * 16) * D + col0;
#pragma unroll
        for (int bj = 0; bj < 2; ++bj) {
          const f32x4 v0 = acc[ai][bj][m][0] * g0[bj], v1 = acc[ai][bj][m][1] * g1[bj];
          u32x4 w; w.x = pack_bf2(v0[0], v0[1]); w.y = pack_bf2(v0[2], v0[3]); w.z = pack_bf2(v1[0], v1[1]); w.w = pack_bf2(v1[2], v1[3]);
          *(u32x4*)(rowp + bj * HALF) = w; } }
  }
};
struct EpiP1 {
  static constexpr bool PERM = true;
  unsigned char* pb;
  DI void operator()(const f32x4 (&acc)[2][2][4][2], const Unit& u, int wr, int wc, int fr, int fq) const {
    unsigned zo = 0;
    asm volatile("" : "+v"(zo));
    const int row0 = u.pm * BM + wr * 64 + fr, col0 = u.pn * BM + wc * 32 + 8 * fq;
    const int b = u.pm / 17;
    const unsigned t0 = (unsigned)(row0 - b * TPB) + zo;
#pragma unroll
    for (int bj = 0; bj < 2; ++bj) {
      const int c = col0 + bj * HALF;
      if (c >= P1LD) continue;
      unsigned off, tstride;
      if (c < 2048) { off = (unsigned)L1_ZH + ((unsigned)(b * 32 + (c >> 6)) * TPB) * 128u + (unsigned)(c & 63) * 2u; tstride = 128u; }
      else if (c < 4096) { const int cc = c - 2048; off = (unsigned)L1_XH + ((unsigned)(b * 32 + (cc >> 6)) * TPB) * 128u + (unsigned)(cc & 63) * 2u; tstride = 128u; }
      else if (c < 4608) { const int cc = c - 4096; off = (unsigned)L1_BG + ((unsigned)(b * 4 + (cc >> 7)) * TPB) * 256u + (unsigned)(cc & 127) * 2u; tstride = 256u; }
      else if (c < 5120) { const int cc = c - 4608; off = (unsigned)L1_CG + ((unsigned)(b * 4 + (cc >> 7)) * TPB) * 256u + (unsigned)(cc & 127) * 2u; tstride = 256u; }
      else { off = (unsigned)L1_DT + (unsigned)b * TPB * 128u + (unsigned)(c - 5120) * 2u; tstride = 128u; }
      off += t0 * tstride;
#pragma unroll
      for (int ai = 0; ai < 2; ++ai)
#pragma unroll
        for (int m = 0; m < 4; ++m) {
          const f32x4 v0 = acc[ai][bj][m][0], v1 = acc[ai][bj][m][1];
          u32x4 w; w.x = pack_bf2(v0[0], v0[1]); w.y = pack_bf2(v0[2], v0[3]); w.z = pack_bf2(v1[0], v1[1]); w.w = pack_bf2(v1[2], v1[3]);
          *(u32x4*)(pb + off + (unsigned)(ai * HALF + m * 16) * tstride) = w;
        }
    }
  }
};
}

DI void transpose_tile(char* lds, const float* __restrict__ src, int K, int N, bf16_t* __restrict__ dst, int tile) {
  float* T = (float*)lds;
  const int ntk = K / 64;
  const int tn = tile / ntk, tk = tile - tn * ntk;
  const int tid = threadIdx.x;
  __syncthreads();
#pragma unroll
  for (int i = 0; i < 2; ++i) {
    const int kk = (tid >> 4) + 32 * i, n4 = (tid & 15) * 4;
    const int n = tn * 64 + n4;
    float4 v = make_float4(0.f, 0.f, 0.f, 0.f);
    if (n < N) v = *(const float4*)(src + (size_t)(tk * 64 + kk) * N + n);
    *(float4*)(T + kk * 68 + n4) = v;
  }
  __syncthreads();
  {
    const int nn = tid & 63, kc = tid >> 6;
    float f[8];
#pragma unroll
    for (int j = 0; j < 8; ++j) f[j] = T[(kc * 8 + j) * 68 + nn];
    *(uint4*)(dst + (size_t)(tn * 64 + nn) * K + tk * 64 + kc * 8) = pack8(f);
  }
}

DI void phase_prep(const P& p, char* lds) {
  const int tid = threadIdx.x;
  unsigned char* ws = p.ws;
  struct TD { int idx; int K, N, Npad; size_t dst; size_t srcoff; };
  int base = 0;
  const int G = gridDim.x;
#define TRANSPOSE_TASK(SRC, KK, NN, NPAD, DST) { const int nt_ = ((NPAD) / 64) * ((KK) / 64); \
    for (int w = blockIdx.x; w < nt_; w += G) transpose_tile(lds, (SRC), (KK), (NN), (bf16_t*)(DST), w); }
  TRANSPOSE_TASK(p.in[I_WIN0], 1024, 3456, 3584, ws + WS_WIN0T)
  TRANSPOSE_TASK(p.in[I_WOUT0], 1024, 1024, 1024, ws + WS_WOUT0T)
  TRANSPOSE_TASK(p.in[I_PQ0], 1024, 2048, 2048, ws + WS_PQ0T)
  TRANSPOSE_TASK(p.in[I_WIN1], 1024, 5184, 5376, ws + WS_WIN1T)
  TRANSPOSE_TASK(p.in[I_WOUT1], 2048, 1024, 1024, ws + WS_WOUT1T)
  TRANSPOSE_TASK(p.in[I_PQ1], 1024, 2048, 2048, ws + WS_PQ1T)
  TRANSPOSE_TASK(p.in[I_RWW2], 64, 512, 512, ws + WS_RWT)
  TRANSPOSE_TASK(p.in[I_RWW2] + 64 * 512, 64, 512, 512, ws + WS_RWT + 65536)
  TRANSPOSE_TASK(p.in[I_RWA2], 64, 512, 512, ws + WS_RWT + 131072)
  TRANSPOSE_TASK(p.in[I_RWA2] + 64 * 512, 64, 512, 512, ws + WS_RWT + 196608)
  TRANSPOSE_TASK(p.in[I_RWG2], 128, 512, 512, ws + WS_RWT + 262144)
  (void)base;
  {
    const int gt = blockIdx.x * NTHR + tid, gs = G * NTHR;
    bf16_t* k0 = (bf16_t*)(ws + WS_KEYS0); bf16_t* k1 = (bf16_t*)(ws + WS_KEYS1);
    for (int i = gt; i < 262144; i += gs) { k0[i] = f2bf(p.in[I_PK0][i]); k1[i] = f2bf(p.in[I_PK1][i]); }
    float2* rope = (float2*)(ws + WS_ROPE);
    for (int i = gt; i < 4096 * 32; i += gs) {
      const int l = i >> 5, a = (i >> 4) & 1, f = i & 15;
      const float inv = powf(10000.f, -(float)f / 16.f);
      const float pos = (float)(a == 0 ? (l >> 6) : (l & 63));
      float s, c; sincosf(pos * inv, &s, &c);
      rope[i] = make_float2(c, s);
    }
    if (gt == 0) {
      const float* lp = p.in[I_DALAM];
      float s01 = 0.f, s23 = 0.f;
      for (int i = 0; i < 64; ++i) { s01 += lp[i] * lp[64 + i]; s23 += lp[128 + i] * lp[192 + i]; }
      ((float*)(ws + WS_SCAL))[0] = expf(s01) - expf(s23) + 0.2f;
    }
  }
  {
    float* sc = (float*)lds;
    float* red = (float*)(lds + 36864);
    __syncthreads();
    for (int e = tid; e < 9 * 1024; e += NTHR) { const int r = e >> 10, k = e & 1023; const float v = (r < 8) ? p.in[I_C][r * 1024 + k] : p.in[I_CCTX][k]; sc[e] = siluf_(v); }
    __syncthreads();
    float* mods = (float*)(ws + WS_MODS);
    for (int w = blockIdx.x; w < 192; w += G) {
      const int l = w / 96, j0 = (w % 96) * 64;
      const float* aw = p.in[l == 0 ? I_ADAW0 : I_ADAW1];
      const float* ab = p.in[l == 0 ? I_ADAB0 : I_ADAB1];
      const int col = tid & 63, kg = tid >> 6;
      float a[9];
#pragma unroll
      for (int r = 0; r < 9; ++r) a[r] = 0.f;
      for (int k = kg * 128; k < kg * 128 + 128; ++k) {
        const float wv = aw[(size_t)k * 6144 + j0 + col];
#pragma unroll
        for (int r = 0; r < 9; ++r) a[r] += sc[r * 1024 + k] * wv;
      }
      __syncthreads();
#pragma unroll
      for (int r = 0; r < 9; ++r) red[(kg * 64 + col) * 9 + r] = a[r];
      __syncthreads();
      for (int e = tid; e < 64 * 9; e += NTHR) {
        const int c2 = e / 9, r = e - c2 * 9;
        float s = ab[j0 + c2];
        for (int g = 0; g < 8; ++g) s += red[(g * 64 + c2) * 9 + r];
        mods[((size_t)l * 9 + r) * 6144 + j0 + c2] = s;
      }
    }
  }
}

DI float wave_max(float x) {
  x = fmaxf(x, dpp_f<0xB1>(x)); x = fmaxf(x, dpp_f<0x4E>(x)); x = fmaxf(x, dpp_f<0x141>(x)); x = fmaxf(x, dpp_f<0x140>(x));
  x = fmaxf(x, __shfl_xor(x, 16)); x = fmaxf(x, __shfl_xor(x, 32)); return x;
}
DI void convert_tables(const P& p, int layer) {
  const int lane = threadIdx.x & 63, gw = blockIdx.x * 8 + (threadIdx.x >> 6), nw = gridDim.x * 8;
  const float* u = p.in[layer == 0 ? I_PU0 : I_PU1];
  const float* v = p.in[layer == 0 ? I_PV0 : I_PV1];
  unsigned char* du = p.ws + WS_HB + HB_U;
  unsigned char* dv = p.ws + WS_HB + HB_V;
  float* su = (float*)(p.ws + WS_HB + HB_SU);
  float* sv = (float*)(p.ws + WS_HB + HB_SV);
  for (int row = gw; row < 32768; row += nw) {
    const bool isv = row >= 16384;
    const int r = row & 16383;
    const float* src = (isv ? v : u) + (size_t)r * D + lane * 16;
    float x[16];
#pragma unroll
    for (int i = 0; i < 4; ++i) { const float4 f = *(const float4*)(src + i * 4); x[i * 4] = f.x; x[i * 4 + 1] = f.y; x[i * 4 + 2] = f.z; x[i * 4 + 3] = f.w; }
    float am = 0.f, ss = 0.f;
#pragma unroll
    for (int i = 0; i < 16; ++i) { am = fmaxf(am, fabsf(x[i])); ss += x[i] * x[i]; }
    am = fmaxf(wave_max(am), 1e-30f);
    ss = red64(ss);
    const float step = fminf(am * (1.f / 7.5f), fmaxf(0.3352f * sqrtf(ss * (1.f / 1024.f)), 1e-30f));
    const float inv = 1.f / step;
    unsigned w[2];
#pragma unroll
    for (int d2 = 0; d2 < 2; ++d2) {
      unsigned pk = 0;
#pragma unroll
      for (int j = 0; j < 8; ++j) {
        int q = (int)rintf(x[d2 * 8 + j] * inv + 7.5f);
        q = q < 0 ? 0 : (q > 15 ? 15 : q);
        pk |= (unsigned)q << (8 * (j >> 1) + 4 * (j & 1));
      }
      w[d2] = pk;
    }
    *(uint2*)((isv ? dv : du) + (size_t)r * 512 + lane * 8) = make_uint2(w[0], w[1]);
    if (lane == 0) (isv ? sv : su)[r] = step;
  }
}

DI void phase_normmod(const P& p, int layer, int which, bool from_inputs, bool lat_only, bf16_t* dst, const bf16_t* delta = nullptr) {
  const int lane = threadIdx.x & 63, gw = blockIdx.x * 8 + (threadIdx.x >> 6), nw = gridDim.x * 8;
  const float* g = p.in[layer == 0 ? (which == 0 ? I_N1_0 : I_N2_0) : (which == 0 ? I_N1_1 : I_N2_1)];
  const float* mods = (const float*)(p.ws + WS_MODS) + (size_t)layer * 9 * 6144;
  const float* xc = (const float*)(p.ws + WS_XC);
  float4 nx[4]; uint4 nd[2];
#define NM_SRC(ROW) ((((ROW) % TPB) < CTXL) ? ((from_inputs ? p.in[I_CTX] : xc) + ((size_t)(((ROW) / TPB) * CTXL + ((ROW) % TPB))) * D) \
                                             : ((from_inputs ? p.in[I_X] : p.out) + ((size_t)(((ROW) / TPB) * SEQ + ((ROW) % TPB) - CTXL)) * D))
#define NM_LOAD(ROW) do { if (!(lat_only && ((ROW) % TPB) < CTXL)) { const float* s_ = NM_SRC(ROW); \
      _Pragma("unroll") for (int i = 0; i < 4; ++i) nx[i] = *(const float4*)(s_ + lane * 16 + i * 4); \
      if (delta) { nd[0] = *(const uint4*)(delta + (size_t)(ROW) * D + lane * 16); nd[1] = *(const uint4*)(delta + (size_t)(ROW) * D + lane * 16 + 8); } } } while (0)
  if (gw < R) NM_LOAD(gw);
  for (int row = gw; row < R; row += nw) {
    const int b = row / TPB, t = row - b * TPB;
    const bool isctx = t < CTXL;
    float v[16]; uint4 dcur0 = nd[0], dcur1 = nd[1];
#pragma unroll
    for (int i = 0; i < 4; ++i) { v[i * 4] = nx[i].x; v[i * 4 + 1] = nx[i].y; v[i * 4 + 2] = nx[i].z; v[i * 4 + 3] = nx[i].w; }
    if (row + nw < R) NM_LOAD(row + nw);
    if (isctx && lat_only) continue;
    const float* mrow = mods + (isctx ? 8 : b) * 6144 + (which == 0 ? 0 : 3 * 1024);
    if (delta) {
      float dl[8];
      unpack8(dcur0, dl);
#pragma unroll
      for (int i = 0; i < 8; ++i) v[i] += dl[i];
      unpack8(dcur1, dl);
#pragma unroll
      for (int i = 0; i < 8; ++i) v[8 + i] += dl[i];
      float* xo = isctx ? ((float*)(p.ws + WS_XC) + ((size_t)(b * CTXL + t)) * D) : (p.out + ((size_t)(b * SEQ + t - CTXL)) * D);
#pragma unroll
      for (int i = 0; i < 4; ++i) *(float4*)(xo + lane * 16 + i * 4) = make_float4(v[i * 4], v[i * 4 + 1], v[i * 4 + 2], v[i * 4 + 3]);
    }
    float ss = 0.f;
#pragma unroll
    for (int i = 0; i < 16; ++i) ss += v[i] * v[i];
    ss = red64(ss);
    const float rs = rsqrtf(ss * (1.f / 1024.f) + 1e-6f);
    float o[16];
#pragma unroll
    for (int i = 0; i < 16; ++i) { const int c = lane * 16 + i; o[i] = v[i] * rs * g[c] * (1.f + mrow[1024 + c]) + mrow[c]; }
    uint4 w0, w1;
    w0.x = pack_bf2(o[0], o[1]); w0.y = pack_bf2(o[2], o[3]); w0.z = pack_bf2(o[4], o[5]); w0.w = pack_bf2(o[6], o[7]);
    w1.x = pack_bf2(o[8], o[9]); w1.y = pack_bf2(o[10], o[11]); w1.z = pack_bf2(o[12], o[13]); w1.w = pack_bf2(o[14], o[15]);
    *(uint4*)(dst + (size_t)row * D + lane * 16) = w0;
    *(uint4*)(dst + (size_t)row * D + lane * 16 + 8) = w1;
  }
#undef NM_SRC
#undef NM_LOAD
}

DI void phase_final_norm(const P& p) {
  const int lane = threadIdx.x & 63, gw = blockIdx.x * 8 + (threadIdx.x >> 6), nw = gridDim.x * 8;
  const float* g = p.in[I_NF];
  for (int row = gw; row < NB * SEQ; row += nw) {
    float* src = p.out + (size_t)row * D;
    float v[16];
#pragma unroll
    for (int i = 0; i < 4; ++i) { const float4 f = *(const float4*)(src + lane * 16 + i * 4); v[i * 4] = f.x; v[i * 4 + 1] = f.y; v[i * 4 + 2] = f.z; v[i * 4 + 3] = f.w; }
    float ss = 0.f;
#pragma unroll
    for (int i = 0; i < 16; ++i) ss += v[i] * v[i];
    ss = red64(ss);
    const float rs = rsqrtf(ss * (1.f / 1024.f) + 1e-6f);
#pragma unroll
    for (int i = 0; i < 4; ++i) {
      const int c = lane * 16 + i * 4;
      float4 f; f.x = v[i * 4] * rs * g[c]; f.y = v[i * 4 + 1] * rs * g[c + 1]; f.z = v[i * 4 + 2] * rs * g[c + 2]; f.w = v[i * 4 + 3] * rs * g[c + 3];
      *(float4*)(src + c) = f;
    }
  }
}

typedef __attribute__((ext_vector_type(4))) short s16x4;
DI s16x4 tr_read(const char* p) { return __builtin_amdgcn_ds_read_tr16_b64_v4i16((__attribute__((address_space(3))) s16x4*)(p)); }

DI void attn_flash_unit(const P& p, char* lds, int unit) {
  const int tid = threadIdx.x, lane = tid & 63, wave = tid >> 6;
  const bool isctx = unit >= 1024;
  int b, h, qb;
  if (!isctx) { b = unit >> 7; h = (unit >> 5) & 3; qb = unit & 31; } else { const int u = unit - 1024; b = u >> 3; h = (u >> 1) & 3; qb = u & 1; }
  const int nkt = isctx ? CTXL / 64 : TPB / 64;
  const bf16_t* p0 = (const bf16_t*)(p.ws + WS_PB + PB_P);
  const float lam = ((const float*)(p.ws + WS_SCAL))[0];
  const int qg = wave >> 1, m = wave & 1;
  const int r31 = lane & 31, hh = lane >> 5;
  const int ql = qb * 128 + qg * 32 + r31;
  const size_t qrow = (size_t)b * TPB + (isctx ? ql : CTXL + ql);
  bf16x8 qf[4];
#pragma unroll
  for (int kk = 0; kk < 4; ++kk) qf[kk] = *(const bf16x8*)(p0 + qrow * P0LD + h * 128 + m * 64 + kk * 16 + 8 * hh);
  const int skey = tid >> 4, scc = tid & 15;
  const bf16_t* kg = p0 + ((size_t)b * TPB + skey) * P0LD + 512 + h * 128 + scc * 8;
  const bf16_t* vg = kg + 512;
  const int koff = (scc >> 3) * 8192 + skey * 128 + ((((scc & 7) ^ (skey >> 1)) & 7) << 4);
  const int voff = 16384 + skey * 320 + scc * 16;
  constexpr int BUFSZ = 36864;
  uint4 rk[2], rv[2];
  __syncthreads();
#pragma unroll
  for (int i = 0; i < 2; ++i) { rk[i] = *(const uint4*)(kg + (size_t)i * 32 * P0LD); rv[i] = *(const uint4*)(vg + (size_t)i * 32 * P0LD); }
#pragma unroll
  for (int i = 0; i < 2; ++i) { *(uint4*)(lds + koff + i * 4096) = rk[i]; *(uint4*)(lds + voff + i * 10240) = rv[i]; }
  __syncthreads();
  f32x16 o[4];
#pragma unroll
  for (int v = 0; v < 4; ++v)
#pragma unroll
    for (int r = 0; r < 16; ++r) o[v][r] = 0.f;
  float mrun = -1e30f, lsum = 0.f;
  const int q4 = (lane & 15) >> 2;
  const int vboff = ((lane >> 4) & 1) * 32 + 8 * (lane & 3);
  for (int kt = 0; kt < nkt; ++kt) {
    const int cur = kt & 1;
    if (kt + 1 < nkt) {
#pragma unroll
      for (int i = 0; i < 2; ++i) { rk[i] = *(const uint4*)(kg + (size_t)((kt + 1) * 64 + i * 32) * P0LD); rv[i] = *(const uint4*)(vg + (size_t)((kt + 1) * 64 + i * 32) * P0LD); }
    }
    const char* kb = lds + cur * BUFSZ + m * 8192;
    const char* vb = lds + cur * BUFSZ + 16384;
    f32x16 s[2];
#pragma unroll
    for (int t = 0; t < 2; ++t)
#pragma unroll
      for (int r = 0; r < 16; ++r) s[t][r] = 0.f;
#pragma unroll
    for (int kk = 0; kk < 4; ++kk)
#pragma unroll
      for (int t = 0; t < 2; ++t) {
        const int row = t * 32 + r31;
        const bf16x8 a = *(const bf16x8*)(kb + row * 128 + ((((kk * 2 + hh) ^ (row >> 1)) & 7) << 4));
        s[t] = MFMA32(a, qf[kk], s[t]);
      }
    float mx = s[0][0];
#pragma unroll
    for (int t = 0; t < 2; ++t)
#pragma unroll
      for (int r = 0; r < 16; ++r) mx = fmaxf(mx, s[t][r]);
    mx = fmaxf(mx, __shfl_xor(mx, 32));
    const float mnew = fmaxf(mrun, mx);
    const float corr = __builtin_amdgcn_exp2f(mrun - mnew);
    mrun = mnew;
    lsum *= corr;
#pragma unroll
    for (int v = 0; v < 4; ++v)
#pragma unroll
      for (int r = 0; r < 16; ++r) o[v][r] *= corr;
#pragma unroll
    for (int t = 0; t < 2; ++t)
#pragma unroll
      for (int r = 0; r < 16; ++r) { const float e = __builtin_amdgcn_exp2f(s[t][r] - mnew); s[t][r] = e; lsum += e; }
#pragma unroll
    for (int t = 0; t < 2; ++t)
#pragma unroll
      for (int st = 0; st < 2; ++st) {
        unsigned pk[4];
#pragma unroll
        for (int j = 0; j < 4; ++j) pk[j] = pack_bf2(s[t][8 * st + 2 * j], s[t][8 * st + 2 * j + 1]);
        bf16x8 bp;
        { typedef __attribute__((ext_vector_type(4))) unsigned u32x4; u32x4 u = {pk[0], pk[1], pk[2], pk[3]}; bp = __builtin_bit_cast(bf16x8, u); }
        const int key0 = t * 32 + 16 * st + 4 * hh + q4;
#pragma unroll
        for (int v = 0; v < 4; ++v) {
          const s16x4 lo = tr_read(vb + key0 * 320 + v * 64 + vboff);
          const s16x4 hi = tr_read(vb + (key0 + 8) * 320 + v * 64 + vboff);
          const bf16x8 av = __builtin_shufflevector(lo, hi, 0, 1, 2, 3, 4, 5, 6, 7);
          o[v] = MFMA32(av, bp, o[v]);
        }
      }
    if (kt + 1 < nkt) {
      char* nb = lds + (cur ^ 1) * BUFSZ;
#pragma unroll
      for (int i = 0; i < 2; ++i) { *(uint4*)(nb + koff + i * 4096) = rk[i]; *(uint4*)(nb + voff + i * 10240) = rv[i]; }
    }
    __syncthreads();
  }
  lsum += __shfl_xor(lsum, 32);
  const float inv = 1.f / lsum;
  float* Ex = (float*)lds;
  if (m == 1) {
#pragma unroll
    for (int v = 0; v < 4; ++v)
#pragma unroll
      for (int r = 0; r < 16; ++r) Ex[(qg * 128 + v * 32 + ACC_ROW(r, lane)) * 32 + r31] = o[v][r] * inv;
  }
  __syncthreads();
  if (m == 0) {
    float ss = 0.f;
#pragma unroll
    for (int v = 0; v < 4; ++v)
#pragma unroll
      for (int r = 0; r < 16; ++r) { const float dv = o[v][r] * inv - lam * Ex[(qg * 128 + v * 32 + ACC_ROW(r, lane)) * 32 + r31]; o[v][r] = dv; ss += dv * dv; }
    ss += __shfl_xor(ss, 32);
    const float rs = rsqrtf(ss * (1.f / 128.f) + 1e-6f) * 0.8f;
    const float* sub = p.in[I_DASUB];
    bf16_t* op = (bf16_t*)(p.ws + WS_PB + PB_O0) + qrow * 1024 + h * 128;
#pragma unroll
    for (int v = 0; v < 4; ++v)
#pragma unroll
      for (int g4 = 0; g4 < 4; ++g4) {
        const int vd = v * 32 + 8 * g4 + 4 * hh;
        uint2 w;
        w.x = pack_bf2(o[v][g4 * 4] * rs * sub[vd], o[v][g4 * 4 + 1] * rs * sub[vd + 1]);
        w.y = pack_bf2(o[v][g4 * 4 + 2] * rs * sub[vd + 2], o[v][g4 * 4 + 3] * rs * sub[vd + 3]);
        *(uint2*)(op + vd) = w;
      }
  }
  __syncthreads();
}

DI void phase_ga(const P& p) {
  const bf16_t* p0 = (const bf16_t*)(p.ws + WS_PB + PB_P);
  bf16_t* ga = (bf16_t*)(p.ws + WS_PB + PB_GA);
  const float* mu = p.in[I_RWMU] + 1792;
  for (int i = blockIdx.x * NTHR + threadIdx.x; i < R * 16; i += gridDim.x * NTHR) {
    const int row = i >> 4, c8 = (i & 15) * 8;
    const int t = row % TPB;
    const bool first = (t == 0) || (t == CTXL), last = (t == CTXL - 1) || (t == TPB - 1);
    const bf16_t* sp = p0 + (size_t)row * P0LD + 1536 + 1792 + c8;
    float u[8], um[8], up[8];
    unpack8(*(const uint4*)sp, u);
    if (!first) unpack8(*(const uint4*)(sp - P0LD), um); else { for (int j = 0; j < 8; ++j) um[j] = 0.f; }
    if (!last) unpack8(*(const uint4*)(sp + P0LD), up); else { for (int j = 0; j < 8; ++j) up[j] = 0.f; }
    float o[8];
#pragma unroll
    for (int j = 0; j < 8; ++j) { const float mix = u[j] + mu[c8 + j] * (0.5f * (um[j] + up[j]) - u[j]); o[j] = sigmoidf_(mix); }
    *(uint4*)(ga + (size_t)row * 128 + c8) = pack8(o);
  }
}

DI int scan_token(int d, int s) { return d == 0 ? s : (s < CTXL ? (CTXL - 1 - s) : (TPB + CTXL - 1 - s)); }

typedef __attribute__((ext_vector_type(4))) float f32x4_t;
DI void rwkv_scan_unit(const P& p, char* lds, int unit) {
  int tid_ = threadIdx.x;
  asm volatile("" : "+v"(tid_));
  const int tid = tid_, lane = tid & 63, wave = __builtin_amdgcn_readfirstlane(tid >> 6);
  const int half = unit & 1, d = (unit >> 1) & 1, h = (unit >> 2) & 7, b = unit >> 5;
  constexpr int T = 32, NCHK = TPB / T, BUFB = 45056;
  const bf16_t* p0 = (const bf16_t*)(p.ws + WS_PB + PB_P);
  __syncthreads();
  {
    const bf16_t* w2t = (const bf16_t*)(p.ws + WS_RWT + (size_t)d * 65536) + h * 64 * 64;
    const bf16_t* a2t = (const bf16_t*)(p.ws + WS_RWT + 131072 + (size_t)d * 65536) + h * 64 * 64;
    *(uint4*)(lds + 139264 + tid * 16) = *(const uint4*)(w2t + tid * 8);
    *(uint4*)(lds + 147456 + tid * 16) = *(const uint4*)(a2t + tid * 8);
    float* LC = (float*)(lds + 155648);
    for (int e = tid; e < 640; e += NTHR) {
      const int g = e >> 6, cidx = e & 63;
      float v;
      if (g == 0) v = p.in[I_RWW0][d * 512 + h * 64 + cidx];
      else if (g == 1) v = p.in[I_RWA0][d * 512 + h * 64 + cidx];
      else if (g == 2) v = p.in[I_RWKK][h * 64 + cidx];
      else if (g == 3) v = p.in[I_RWKA][h * 64 + cidx];
      else if (g == 4) v = p.in[I_RWRK][h * 64 + cidx];
      else if (g < 8) v = p.in[I_RWMU][(g - 5) * 512 + h * 64 + cidx];
      else v = p.in[I_RWMU][(g == 8 ? 1536 : 1664) + d * 64 + cidx];
      LC[e] = v;
    }
  }
  __syncthreads();
  if (wave < 4) {
    const int rp = tid >> 4, c16 = tid & 15, c4 = c16 * 4;
    typedef float f32x2 __attribute__((ext_vector_type(2)));
    f32x2 S0a = {0.f, 0.f}, S0b = {0.f, 0.f}, S1a = {0.f, 0.f}, S1b = {0.f, 0.f};
    bf16_t* yout = (bf16_t*)(p.ws + WS_HB + (d == 0 ? HB_YF : HB_YB)) + h * 64 + half * 32 + wave * 8 + (lane & 7);
    SEGR_DECL();
    __syncthreads();
    SEGR_INIT();
    for (int c = 0; c < NCHK; ++c) {
      int zo = 0;
      asm volatile("" : "+v"(zo));
      const char* B0 = lds + (c & 1) * BUFB + zo;
      float* Lyp = (float*)(lds + 122880 + zo);
      const float* La = (const float*)B0 + c4; const float* Lb = (const float*)(B0 + 8192) + c4; const float* Lk = (const float*)(B0 + 16384) + c4;
      const float* Lw = (const float*)(B0 + 24576) + c4; const float* Lr = (const float*)(B0 + 32768) + c4; const float* Lv = (const float*)(B0 + 40960) + rp * 2;
#define RW_LD(s_, A_, B_, K_, W_, R_, V_) const float4 A_ = *(const float4*)(La + (s_) * 64), B_ = *(const float4*)(Lb + (s_) * 64), K_ = *(const float4*)(Lk + (s_) * 64), \
          W_ = *(const float4*)(Lw + (s_) * 64), R_ = *(const float4*)(Lr + (s_) * 64); const float2 V_ = *(const float2*)(Lv + (s_) * 32)
      float4 a4, b4, k4, w4, r4, a4n, b4n, k4n, w4n, r4n; float2 v2, v2n;
      { RW_LD(0, xa, xb, xk, xw, xr, xv); a4 = xa; b4 = xb; k4 = xk; w4 = xw; r4 = xr; v2 = xv; }
      { RW_LD(1, xa, xb, xk, xw, xr, xv); a4n = xa; b4n = xb; k4n = xk; w4n = xw; r4n = xr; v2n = xv; }
#pragma unroll 1
      for (int g8 = 0; g8 < 4; ++g8) {
#pragma unroll
        for (int si = 0; si < 8; ++si) {
          const int s2 = (g8 * 8 + si + 2) & 31;
          RW_LD(s2, a4f, b4f, k4f, w4f, r4f, v2f);
          const f32x2 a01 = {a4.x, a4.y}, a23 = {a4.z, a4.w}, b01 = {b4.x, b4.y}, b23 = {b4.z, b4.w}, k01 = {k4.x, k4.y}, k23 = {k4.z, k4.w};
          const f32x2 w01 = {w4.x, w4.y}, w23 = {w4.z, w4.w}, r01 = {r4.x, r4.y}, r23 = {r4.z, r4.w};
          const f32x2 t0 = S0a * a01 + S0b * a23, t1 = S1a * a01 + S1b * a23;
          float sa0 = t0.x + t0.y, sa1 = t1.x + t1.y;
          const f32x2 vv0 = {v2.x, v2.x}, vv1 = {v2.y, v2.y};
          const f32x2 u0a = S0a * w01 + vv0 * k01, u0b = S0b * w23 + vv0 * k23, u1a = S1a * w01 + vv1 * k01, u1b = S1b * w23 + vv1 * k23;
          sa0 = red16(sa0); sa1 = red16(sa1);
          const f32x2 s0 = {sa0, sa0}, s1 = {sa1, sa1};
          S0a = s0 * b01 + u0a; S0b = s0 * b23 + u0b; S1a = s1 * b01 + u1a; S1b = s1 * b23 + u1b;
          const f32x2 y0 = S0a * r01 + S0b * r23, y1 = S1a * r01 + S1b * r23;
          Lyp[(si * 32 + rp * 2) * 16 + c16] = y0.x + y0.y;
          Lyp[(si * 32 + rp * 2 + 1) * 16 + c16] = y1.x + y1.y;
          a4 = a4n; b4 = b4n; k4 = k4n; w4 = w4n; r4 = r4n; v2 = v2n;
          a4n = a4f; b4n = b4f; k4n = k4f; w4n = w4f; r4n = r4f; v2n = v2f;
        }
        __builtin_amdgcn_wave_barrier();
        asm volatile("s_waitcnt lgkmcnt(0)" ::: "memory");
        {
          const int sj = lane >> 3, ri = lane & 7;
          const float4* pp = (const float4*)(Lyp + (sj * 32 + wave * 8 + ri) * 16);
          const float4 q0 = pp[0], q1 = pp[1], q2 = pp[2], q3 = pp[3];
          const float ysum = ((q0.x + q0.y) + (q0.z + q0.w)) + ((q1.x + q1.y) + (q1.z + q1.w)) + ((q2.x + q2.y) + (q2.z + q2.w)) + ((q3.x + q3.y) + (q3.z + q3.w));
          const int t = scan_token(d, c * T + g8 * 8 + sj);
          yout[((size_t)b * TPB + t) * 512] = f2bf(ysum);
        }
        asm volatile("s_waitcnt lgkmcnt(0)" ::: "memory");
        __builtin_amdgcn_wave_barrier();
      }
      SEGR_ADD(0);
      __syncthreads();
      SEGR_ADD(1);
    }
    SEGR_FLUSH(0);
  } else {
    const int pw = wave - 4;
    const int tok = lane >> 3, cg8 = (lane & 7) * 8;
    const int colsb[5] = {h * 64 + cg8, 512 + h * 64 + cg8, 1024 + h * 64 + cg8, 1536 + d * 64 + cg8, 1664 + d * 64 + cg8};
    const int n16 = lane & 15, q16 = lane >> 4;
    float* bonus = (float*)(p.ws + WS_PB + PB_BONUS) + (size_t)d * R * 8;
    uint4 raw[5][3];
    float fm = 1.f, fp_ = 1.f;
#define RW_ISSUE(CH) do { \
      const int t_ = scan_token(d, (CH) * T + pw * 8 + tok); \
      const bool first_ = (t_ == 0) || (t_ == CTXL), last_ = (t_ == CTXL - 1) || (t_ == TPB - 1); \
      fm = first_ ? 0.f : 1.f; fp_ = last_ ? 0.f : 1.f; \
      const bf16_t* rowp_ = p0 + ((size_t)b * TPB + t_) * P0LD + 1536; \
      const bf16_t* rowm_ = first_ ? rowp_ : rowp_ - P0LD; \
      const bf16_t* rowq_ = last_ ? rowp_ : rowp_ + P0LD; \
      _Pragma("unroll") for (int g_ = 0; g_ < 5; ++g_) { raw[g_][0] = *(const uint4*)(rowm_ + colsb[g_]); raw[g_][1] = *(const uint4*)(rowp_ + colsb[g_]); raw[g_][2] = *(const uint4*)(rowq_ + colsb[g_]); } \
    } while (0)
    RW_ISSUE(0);
    SEGR_DECL();
    SEGR_INIT();
    for (int c = 0; c < NCHK; ++c) {
      int zo = 0;
      asm volatile("" : "+v"(zo));
      char* PS = lds + 90112 + pw * 8192 + zo;
      float* Pk = (float*)PS; bf16_t* PA = (bf16_t*)(PS + 2048); bf16_t* PBa = (bf16_t*)(PS + 4096); float* Pinv = (float*)(PS + 6144);
      const float* LCc = (const float*)(lds + 155648 + zo);
      char* B0 = lds + (c & 1) * BUFB + zo;
      float* La = (float*)B0; float* Lb = (float*)(B0 + 8192); float* Lk = (float*)(B0 + 16384);
      float* Lw = (float*)(B0 + 24576); float* Lr = (float*)(B0 + 32768); float* Lv = (float*)(B0 + 40960);
      const int sl = pw * 8 + tok;
      {
#define RW_MIX(G, OUT) do { float u_[8], um_[8], up_[8]; unpack8(raw[G][1], u_); unpack8(raw[G][0], um_); unpack8(raw[G][2], up_); \
          const float4 m0_ = *(const float4*)(LCc + (5 + G) * 64 + cg8), m1_ = *(const float4*)(LCc + (5 + G) * 64 + cg8 + 4); \
          const float mm_[8] = {m0_.x, m0_.y, m0_.z, m0_.w, m1_.x, m1_.y, m1_.z, m1_.w}; \
          _Pragma("unroll") for (int j = 0; j < 8; ++j) OUT[j] = u_[j] + mm_[j] * (0.5f * (fm * um_[j] + fp_ * up_[j]) - u_[j]); } while (0)
        float mx[8];
        RW_MIX(0, mx);
        *(float4*)(Lr + sl * 64 + cg8) = make_float4(mx[0], mx[1], mx[2], mx[3]);
        *(float4*)(Lr + sl * 64 + cg8 + 4) = make_float4(mx[4], mx[5], mx[6], mx[7]);
        RW_MIX(2, mx);
        if ((cg8 >> 5) == half) {
          *(float4*)(Lv + sl * 32 + (cg8 & 31)) = make_float4(mx[0], mx[1], mx[2], mx[3]);
          *(float4*)(Lv + sl * 32 + (cg8 & 31) + 4) = make_float4(mx[4], mx[5], mx[6], mx[7]);
        }
        RW_MIX(3, mx);
        {
          float tw[8];
#pragma unroll
          for (int j = 0; j < 8; ++j) tw[j] = 1.f - 2.f * frcp_(1.f + __expf(2.f * mx[j]));
          *(uint4*)(PA + tok * 64 + cg8) = pack8(tw);
        }
        RW_MIX(4, mx);
        *(uint4*)(PBa + tok * 64 + cg8) = pack8(mx);
        RW_MIX(1, mx);
        *(float4*)(Pk + tok * 64 + cg8) = make_float4(mx[0], mx[1], mx[2], mx[3]);
        *(float4*)(Pk + tok * 64 + cg8 + 4) = make_float4(mx[4], mx[5], mx[6], mx[7]);
        float nrm = 0.f;
        {
          const float4 q0 = *(const float4*)(LCc + 2 * 64 + cg8), q1 = *(const float4*)(LCc + 2 * 64 + cg8 + 4);
          const float kk8[8] = {q0.x, q0.y, q0.z, q0.w, q1.x, q1.y, q1.z, q1.w};
#pragma unroll
          for (int j = 0; j < 8; ++j) { const float kq = mx[j] * kk8[j]; nrm += kq * kq; }
        }
        nrm = red8(nrm);
        if ((lane & 7) == 0) Pinv[tok] = __builtin_amdgcn_rsqf(fmaxf(nrm, 1e-24f));
        if (c + 1 < NCHK) RW_ISSUE(c + 1);
#undef RW_MIX
      }
      __builtin_amdgcn_wave_barrier();
      asm volatile("s_waitcnt lgkmcnt(0)" ::: "memory");
      SEGR_ADD(2);
      {
        float bon[2] = {0.f, 0.f};
        const int hq = lane >> 5, qq = (lane >> 4) & 1;
#pragma unroll
        for (int gsel = 0; gsel < 2; ++gsel) {
          const bf16_t* Asrc = (gsel == 0 ? PA : PBa) + n16 * 64 + q16 * 8;
          const bf16_t* Wsrc = (const bf16_t*)(lds + (gsel == 0 ? 139264 : 147456) + zo) + n16 * 64 + q16 * 8;
#pragma unroll
          for (int nt = 0; nt < 4; ++nt) {
            f32x4_t acc = {0.f, 0.f, 0.f, 0.f};
#pragma unroll
            for (int ks = 0; ks < 2; ++ks) {
              const bf16x8 af = *(const bf16x8*)(Asrc + ks * 32);
              const bf16x8 bf = *(const bf16x8*)(Wsrc + nt * 16 * 64 + ks * 32);
              acc = __builtin_amdgcn_mfma_f32_16x16x32_bf16(af, bf, acc, 0, 0, 0);
            }
            float xv[2];
            xv[0] = __uint_as_float(__builtin_amdgcn_permlane32_swap(__float_as_uint(acc[0]), __float_as_uint(acc[2]), false, false)[0]);
            xv[1] = __uint_as_float(__builtin_amdgcn_permlane32_swap(__float_as_uint(acc[1]), __float_as_uint(acc[3]), false, false)[0]);
            const int col = nt * 16 + n16;
            const float bias = LCc[gsel * 64 + col];
            const float kkc_ = LCc[2 * 64 + col], kac_ = LCc[3 * 64 + col], rkc_ = LCc[4 * 64 + col];
#pragma unroll
            for (int r = 0; r < 2; ++r) {
              const int tk = qq * 4 + hq * 2 + r, so = (pw * 8 + tk) * 64 + col;
              if (gsel == 0) { Lw[so] = __expf(-0.6065306597126334f * sigmoidf_(xv[r] + bias)); }
              else {
                const float as = sigmoidf_(xv[r] + bias);
                const float k = Pk[tk * 64 + col];
                const float kkv = k * kkc_ * Pinv[tk];
                La[so] = -kkv; Lb[so] = kkv * as;
                const float kd = k * (1.f + (as - 1.f) * kac_);
                Lk[so] = kd;
                bon[r] += Lr[so] * kd * rkc_;
              }
            }
          }
        }
#pragma unroll
        for (int r = 0; r < 2; ++r) bon[r] = red16(bon[r]);
        if (half == 0 && n16 == 0) {
#pragma unroll
          for (int r = 0; r < 2; ++r) {
            const int t = scan_token(d, c * T + pw * 8 + qq * 4 + hq * 2 + r);
            bonus[((size_t)b * TPB + t) * 8 + h] = bon[r];
          }
        }
      }
      SEGR_ADD(3);
      __syncthreads();
      SEGR_ADD(1);
    }
#if defined(PROBE_A) && PROBE_GRP == 1
    if (blockIdx.x == 0 && threadIdx.x == 256) { for (int j__ = 1; j__ < 4; ++j__) ((unsigned long long*)(p.ws + WS_SCAL + 1024))[22 + 4 + j__] += seg_acc_[j__]; }
#endif
    __syncthreads();
#undef RW_ISSUE
  }
}

DI void phase_rwkv_post(const P& p) {
  const bf16_t* p0 = (const bf16_t*)(p.ws + WS_PB + PB_P);
  const bf16_t* yf = (const bf16_t*)(p.ws + WS_HB + HB_YF);
  const bf16_t* yb = (const bf16_t*)(p.ws + WS_HB + HB_YB);
  const bf16_t* G = (const bf16_t*)(p.ws + WS_PB + PB_G);
  const float* bonus = (const float*)(p.ws + WS_PB + PB_BONUS);
  bf16_t* o0 = (bf16_t*)(p.ws + WS_PB + PB_O0);
  const float* mu = p.in[I_RWMU] + 1024;
  const int sub = threadIdx.x & 7;
  for (int it = (blockIdx.x * NTHR + threadIdx.x) >> 3; it < R * 8; it += (gridDim.x * NTHR) >> 3) {
    const int row = it >> 3, h = it & 7;
    const int t = row % TPB;
    const bool first = (t == 0) || (t == CTXL), last = (t == CTXL - 1) || (t == TPB - 1);
    const int cc = h * 64 + sub * 8;
    float y[8], a[8], bb[8];
    unpack8(*(const uint4*)(yf + (size_t)row * 512 + cc), a);
    unpack8(*(const uint4*)(yb + (size_t)row * 512 + cc), bb);
    float mean = 0.f;
#pragma unroll
    for (int j = 0; j < 8; ++j) { y[j] = a[j] + bb[j]; mean += y[j]; }
    mean = red8(mean) * (1.f / 64.f);
    float var = 0.f;
#pragma unroll
    for (int j = 0; j < 8; ++j) { const float dlt = y[j] - mean; var += dlt * dlt; }
    var = red8(var) * (1.f / 64.f);
    const float rs = rsqrtf(var + 64e-5f);
    const float bn = bonus[(size_t)row * 8 + h] + bonus[(size_t)R * 8 + (size_t)row * 8 + h];
    const bf16_t* vp = p0 + (size_t)row * P0LD + 1536 + 1024 + cc;
    float u[8], um[8], up[8], g[8], o[8];
    unpack8(*(const uint4*)vp, u);
    unpack8(*(const uint4*)(first ? vp : vp - P0LD), um);
    unpack8(*(const uint4*)(last ? vp : vp + P0LD), up);
    unpack8(*(const uint4*)(G + (size_t)row * 512 + cc), g);
    const float fm = first ? 0.f : 1.f, fp_ = last ? 0.f : 1.f;
#pragma unroll
    for (int j = 0; j < 8; ++j) {
      const float v = u[j] + mu[cc + j] * (0.5f * (fm * um[j] + fp_ * up[j]) - u[j]);
      const float yn = (y[j] - mean) * rs * p.in[I_LNXW][cc + j] + p.in[I_LNXB][cc + j];
      o[j] = (yn + bn * v) * g[j];
    }
    *(uint4*)(o0 + (size_t)row * 1024 + 512 + cc) = pack8(o);
  }
}

DI unsigned f2ord(float f) { const unsigned u = __float_as_uint(f); return u ^ ((u >> 31) ? 0xFFFFFFFFu : 0x80000000u); }
DI float ord2f(unsigned u) { u ^= ((u >> 31) ? 0x80000000u : 0xFFFFFFFFu); return __uint_as_float(u); }

DI void bitonic_sort16_desc(unsigned (&v)[16]) {
#pragma unroll
  for (int k = 2; k <= 16; k <<= 1)
#pragma unroll
    for (int j = k >> 1; j > 0; j >>= 1)
#pragma unroll
      for (int i = 0; i < 16; ++i) {
        const int l = i ^ j;
        if (l > i) { const unsigned hi = max(v[i], v[l]), lo = min(v[i], v[l]); const bool desc = ((i & k) == 0); v[i] = desc ? hi : lo; v[l] = desc ? lo : hi; }
      }
}
DI void merge_top16_desc(unsigned (&a)[16], const unsigned (&b)[16]) {
#pragma unroll
  for (int i = 0; i < 16; ++i) a[i] = max(a[i], b[15 - i]);
#pragma unroll
  for (int j = 8; j > 0; j >>= 1)
#pragma unroll
    for (int i = 0; i < 16; ++i) { const int l = i ^ j; if (l > i) { const unsigned hi = max(a[i], a[l]), lo = min(a[i], a[l]); a[i] = hi; a[l] = lo; } }
}
struct CandPairs { int ia[25], ja[25], ib[25], jb[25]; };
constexpr CandPairs make_pairs() {
  CandPairs c{};
  int n = 0;
  for (int i = 0; i < 16; ++i) for (int j = 0; j < 16; ++j) if ((i + 1) * (j + 1) <= 16) {
    if ((n & 1) == 0) { c.ia[n >> 1] = i; c.ja[n >> 1] = j; } else { c.ib[n >> 1] = i; c.jb[n >> 1] = j; }
    ++n;
  }
  return c;
}
constexpr CandPairs CP = make_pairs();

DI void peer_topk_unit(const P& p, char* lds, int layer, int unit) {
  const int tid = threadIdx.x, lane = tid & 63, wave = tid >> 6;
  const int mt = unit >> 3, h = unit & 7;
  const bf16_t* q = (const bf16_t*)(p.ws + WS_PB + PB_Q);
  const bf16_t* keys = (const bf16_t*)(p.ws + (layer == 0 ? WS_KEYS0 : WS_KEYS1)) + (size_t)h * 2 * 128 * 128;
  int* idxo = (int*)(p.ws + WS_PB + PB_IDX);
  float* gateo = (float*)(p.ws + WS_PB + PB_GATE);
  __syncthreads();
  for (int e = tid; e < 2 * 128 * 16; e += NTHR) {
    const int pp = e >> 11, row = (e >> 4) & 127, c = e & 15;
    *(uint4*)(lds + pp * 32768 + row * 256 + ((c ^ (row & 15)) << 4)) = *(const uint4*)(keys + (size_t)pp * 16384 + row * 128 + c * 8);
  }
  __syncthreads();
  const int r31 = lane & 31, hh = lane >> 5;
  const size_t trow = (size_t)mt * 256 + wave * 32 + r31;
  unsigned vk[2][16];
#pragma unroll
  for (int pp = 0; pp < 2; ++pp) {
    f32x16 acc[4];
#pragma unroll
    for (int m = 0; m < 4; ++m)
#pragma unroll
      for (int r = 0; r < 16; ++r) acc[m][r] = 0.f;
    const bf16_t* qp = q + trow * 2048 + (h * 2 + pp) * 128;
#pragma unroll
    for (int kk = 0; kk < 8; ++kk) {
      const bf16x8 bq = *(const bf16x8*)(qp + kk * 16 + 8 * hh);
      const int c = kk * 2 + hh;
#pragma unroll
      for (int m = 0; m < 4; ++m) {
        const int row = m * 32 + r31;
        const bf16x8 ak = *(const bf16x8*)(lds + pp * 32768 + row * 256 + ((c ^ (row & 15)) << 4));
        acc[m] = MFMA32(ak, bq, acc[m]);
      }
    }
    unsigned v[16];
#pragma unroll
    for (int m = 0; m < 4; ++m) {
      unsigned kx[16];
#pragma unroll
      for (int r = 0; r < 16; ++r) kx[r] = (f2ord(acc[m][r]) & ~127u) | (unsigned)(127 - (m * 32 + ACC_ROW(r, lane)));
      bitonic_sort16_desc(kx);
      if (m == 0) {
#pragma unroll
        for (int i = 0; i < 16; ++i) v[i] = kx[i];
      } else merge_top16_desc(v, kx);
    }
    unsigned c16[16];
#pragma unroll
    for (int i = 0; i < 16; ++i) c16[i] = (unsigned)__shfl_xor((int)v[i], 32);
    merge_top16_desc(v, c16);
#pragma unroll
    for (int i = 0; i < 16; ++i) vk[pp][i] = v[i];
  }
  float val1[16], val2[16]; int id1[16], id2[16];
#pragma unroll
  for (int i = 0; i < 16; ++i) {
    val1[i] = ord2f(vk[0][i] & ~127u); id1[i] = 127 - (int)(vk[0][i] & 127u);
    val2[i] = ord2f(vk[1][i] & ~127u); id2[i] = 127 - (int)(vk[1][i] & 127u);
  }
  unsigned tk[16];
#pragma unroll
  for (int t = 0; t < 16; ++t) {
    const float va = val1[CP.ia[t]] + val2[CP.ja[t]], vb = val1[CP.ib[t]] + val2[CP.jb[t]];
    const int pa = id1[CP.ia[t]] * 128 + id2[CP.ja[t]], pb = id1[CP.ib[t]] * 128 + id2[CP.jb[t]];
    tk[t] = (f2ord(hh ? vb : va) & ~0x3FFFu) | (unsigned)(hh ? pb : pa);
  }
  bitonic_sort16_desc(tk);
#pragma unroll
  for (int t = 16; t < 25; ++t) {
    const float va = val1[CP.ia[t]] + val2[CP.ja[t]], vb = val1[CP.ib[t]] + val2[CP.jb[t]];
    const int pa = id1[CP.ia[t]] * 128 + id2[CP.ja[t]], pb = id1[CP.ib[t]] * 128 + id2[CP.jb[t]];
    unsigned x = (f2ord(hh ? vb : va) & ~0x3FFFu) | (unsigned)(hh ? pb : pa);
#pragma unroll
    for (int i = 0; i < 16; ++i) { const unsigned hi = max(tk[i], x); x = min(tk[i], x); tk[i] = hi; }
  }
  float cv[16]; int cp[16];
  float mx = -3.0e38f;
#pragma unroll
  for (int i = 0; i < 16; ++i) {
    const unsigned ok = (unsigned)__shfl_xor((int)tk[15 - i], 32);
    const unsigned kk_ = max(tk[i], ok);
    cv[i] = ord2f(kk_ & ~0x3FFFu); cp[i] = (int)(kk_ & 0x3FFFu);
    mx = fmaxf(mx, cv[i]);
  }
  float sum = 0.f;
#pragma unroll
  for (int i = 0; i < 16; ++i) { cv[i] = __expf(cv[i] - mx); sum += cv[i]; }
  const float inv = 1.f / sum;
  if (hh == 0) {
    int* ip = idxo + trow * 128 + h * 16;
    float* gp = gateo + trow * 128 + h * 16;
#pragma unroll
    for (int i = 0; i < 4; ++i) {
      *(int4*)(ip + i * 4) = make_int4(cp[i * 4], cp[i * 4 + 1], cp[i * 4 + 2], cp[i * 4 + 3]);
      *(float4*)(gp + i * 4) = make_float4(cv[i * 4] * inv, cv[i * 4 + 1] * inv, cv[i * 4 + 2] * inv, cv[i * 4 + 3] * inv);
    }
  }
}

DI int wave_sum_i(int x) {
  x += __builtin_amdgcn_update_dpp(0, x, 0xB1, 0xF, 0xF, true);
  x += __builtin_amdgcn_update_dpp(0, x, 0x4E, 0xF, 0xF, true);
  x += __builtin_amdgcn_update_dpp(0, x, 0x141, 0xF, 0xF, true);
  x += __builtin_amdgcn_update_dpp(0, x, 0x140, 0xF, 0xF, true);
  return __builtin_amdgcn_readlane(x, 0) + __builtin_amdgcn_readlane(x, 16) + __builtin_amdgcn_readlane(x, 32) + __builtin_amdgcn_readlane(x, 48);
}
DI int reduce8_transposed(const int (&v)[8], int lane) {
  int x[4], y[2];
#pragma unroll
  for (int j = 0; j < 4; ++j) { const auto r = __builtin_amdgcn_permlane32_swap((unsigned)v[j], (unsigned)v[4 + j], false, false); x[j] = (int)(r[0] + r[1]); }
#pragma unroll
  for (int j = 0; j < 2; ++j) { const auto r = __builtin_amdgcn_permlane16_swap((unsigned)x[j], (unsigned)x[2 + j], false, false); y[j] = (int)(r[0] + r[1]); }
  const bool b3 = (lane >> 3) & 1;
  const int keep = b3 ? y[1] : y[0], send = b3 ? y[0] : y[1];
  int z = keep + __builtin_amdgcn_update_dpp(0, send, 0x128, 0xF, 0xF, true);
  z += __builtin_amdgcn_update_dpp(0, z, 0xB1, 0xF, 0xF, true);
  z += __builtin_amdgcn_update_dpp(0, z, 0x4E, 0xF, 0xF, true);
  z += __builtin_amdgcn_update_dpp(0, z, 0x141, 0xF, 0xF, true);
  return z;
}
DI float gelu_fast(float v) {
  const float av = fabsf(v), t = __builtin_amdgcn_rcpf(av * 0.2316418882f + 1.0f);
  float q = t * 0.5307027145f + (-0.7265760135f); q = q * t + 0.7107068705f; q = q * t + (-0.142248368f); q = q * t + 0.127414796f; q = q * t;
  const float e = __builtin_amdgcn_exp2f((v * v) * (-0.72134752044f));
  const float m = v * (q * e);
  return v < 0.f ? m : v - m;
}
DI int reduce4_half(const int (&v)[4], int lane) {
  int y[2];
#pragma unroll
  for (int j = 0; j < 2; ++j) { const auto r = __builtin_amdgcn_permlane16_swap((unsigned)v[j], (unsigned)v[2 + j], false, false); y[j] = (int)(r[0] + r[1]); }
  const bool b3 = (lane >> 3) & 1;
  const int keep = b3 ? y[1] : y[0], send = b3 ? y[0] : y[1];
  int z = keep + __builtin_amdgcn_update_dpp(0, send, 0x128, 0xF, 0xF, true);
  z += __builtin_amdgcn_update_dpp(0, z, 0xB1, 0xF, 0xF, true);
  z += __builtin_amdgcn_update_dpp(0, z, 0x4E, 0xF, 0xF, true);
  z += __builtin_amdgcn_update_dpp(0, z, 0x141, 0xF, 0xF, true);
  return z;
}
#ifndef PG_VREP
#define PG_VREP 1
#endif
DI void phase_peer_gather(const P& p, int layer) {
  const int lane = threadIdx.x & 63, gw = blockIdx.x * 8 + (threadIdx.x >> 6), nw = gridDim.x * 8;
  const bf16_t* h2 = (const bf16_t*)(p.ws + WS_PB + PB_H2);
  const int* idx = (const int*)(p.ws + WS_PB + PB_IDX);
  const float* gate = (const float*)(p.ws + WS_PB + PB_GATE);
  const unsigned char* U = p.ws + WS_HB + HB_U;
  const unsigned char* V = p.ws + WS_HB + HB_V;
  const float* su = (const float*)(p.ws + WS_HB + HB_SU);
  const float* sv = (const float*)(p.ws + WS_HB + HB_SV);
  const float* mods = (const float*)(p.ws + WS_MODS) + (size_t)layer * 9 * 6144;
  float* xc = (float*)(p.ws + WS_XC);
  const int hs = lane & 31, up = lane >> 5, k4 = (lane >> 3) & 3;
  for (int row = gw; row < R; row += nw) {
    const int b = row / TPB, t = row - b * TPB;
    const bool isctx = t < CTXL;
    if (isctx && layer == 1) continue;
    int hE[4], hO[4]; float sh, hoff;
    {
      float hv[32], f[8];
#pragma unroll
      for (int i = 0; i < 4; ++i) { unpack8(*(const uint4*)(h2 + (size_t)row * D + hs * 32 + i * 8), f);
#pragma unroll
        for (int j = 0; j < 8; ++j) hv[i * 8 + j] = f[j]; }
      float am = 0.f;
#pragma unroll
      for (int j = 0; j < 32; ++j) am = fmaxf(am, fabsf(hv[j]));
      am = fmaxf(wave_max(am), 1e-30f);
      const float inv = 127.f / am;
      sh = am * (1.f / 127.f);
      int hsum = 0;
#pragma unroll
      for (int d4 = 0; d4 < 4; ++d4) {
        unsigned pe = 0, po = 0;
#pragma unroll
        for (int j = 0; j < 4; ++j) {
          const int qe = (int)rintf(hv[d4 * 8 + 2 * j] * inv), qo = (int)rintf(hv[d4 * 8 + 2 * j + 1] * inv);
          hsum += qe + qo;
          pe |= ((unsigned)qe & 0xffu) << (8 * j); po |= ((unsigned)qo & 0xffu) << (8 * j);
        }
        hE[d4] = (int)pe; hO[d4] = (int)po;
      }
      hoff = 7.5f * 0.5f * (float)wave_sum_i(hsum);
    }
    float acc[32];
#pragma unroll
    for (int j = 0; j < 32; ++j) acc[j] = 0.f;
    float corr = 0.f;
    const int my_i0 = idx[(size_t)row * 128 + lane], my_i1 = idx[(size_t)row * 128 + 64 + lane];
    const float my_g0 = gate[(size_t)row * 128 + lane], my_g1 = gate[(size_t)row * 128 + 64 + lane];
#define PG_LOAD(E0, UR, VR, SC) do { _Pragma("unroll") for (int k = 0; k < 4; ++k) { const int e_ = (E0) + 2 * k; \
        const int ea_ = ((E0) < 64) ? __builtin_amdgcn_readlane(my_i0, e_ & 63) : __builtin_amdgcn_readlane(my_i1, e_ & 63); \
        const int eb_ = ((E0) < 64) ? __builtin_amdgcn_readlane(my_i0, (e_ + 1) & 63) : __builtin_amdgcn_readlane(my_i1, (e_ + 1) & 63); \
        const size_t ro_ = (size_t)(up ? eb_ : ea_) * 512 + hs * 16; \
        UR[k] = *(const uint4*)(U + ro_); VR[k] = *(const uint4*)(V + ro_); } \
      { const int es_ = (E0) + 2 * k4 + up; const int ei_ = __shfl(((E0) < 64) ? my_i0 : my_i1, es_ & 63); SC[0] = su[ei_]; SC[1] = sv[ei_]; } } while (0)
#define PG_COMPUTE(E0, UR, VR, SC) do { \
      const int es_ = (E0) + 2 * k4 + up; \
      const float ggA = __shfl(((E0) < 64) ? my_g0 : my_g1, es_ & 63); \
      const float suA = SC[0], svA = SC[1]; \
      int dA[4]; \
      _Pragma("unroll") for (int k = 0; k < 4; ++k) { \
        const unsigned uu[4] = {UR[k].x, UR[k].y, UR[k].z, UR[k].w}; int d = 0; \
        _Pragma("unroll") for (int d4 = 0; d4 < 4; ++d4) { \
          d = __builtin_amdgcn_sdot4(hE[d4], (int)(uu[d4] & 0x0F0F0F0Fu), d, false); \
          d = __builtin_amdgcn_sdot4(hO[d4], (int)((uu[d4] >> 4) & 0x0F0F0F0Fu), d, false); } \
        dA[k] = d; } \
      const int tA = reduce4_half(dA, lane); \
      const float wA = ggA * gelu_fast(((float)tA - hoff) * (sh * suA)) * svA; \
      _Pragma("unroll") for (int k = 0; k < 4; ++k) { \
        const float w0_ = __shfl(wA, (lane & 32) + 8 * k); \
        corr += w0_; \
        const unsigned vv[4] = {VR[k].x, VR[k].y, VR[k].z, VR[k].w}; \
        _Pragma("unroll") for (int rep_ = 0; rep_ < PG_VREP; ++rep_) { const float w = w0_ * (1.f / PG_VREP); \
        _Pragma("unroll") for (int d4 = 0; d4 < 4; ++d4) { \
          const unsigned lo = vv[d4] & 0x0F0F0F0Fu, hi = (vv[d4] >> 4) & 0x0F0F0F0Fu; \
          acc[d4 * 8 + 0] += w * (float)(lo & 0xffu); acc[d4 * 8 + 1] += w * (float)(hi & 0xffu); \
          acc[d4 * 8 + 2] += w * (float)((lo >> 8) & 0xffu); acc[d4 * 8 + 3] += w * (float)((hi >> 8) & 0xffu); \
          acc[d4 * 8 + 4] += w * (float)((lo >> 16) & 0xffu); acc[d4 * 8 + 5] += w * (float)((hi >> 16) & 0xffu); \
          acc[d4 * 8 + 6] += w * (float)(lo >> 24); acc[d4 * 8 + 7] += w * (float)(hi >> 24); } asm volatile("" : "+v"(acc[0])); } } } while (0)
    {
      uint4 urA[4], vrA[4], urB[4], vrB[4];
      float scA[2], scB[2];
      PG_LOAD(0, urA, vrA, scA);
#pragma unroll 1
      for (int e0 = 0; e0 < 128; e0 += 16) {
        PG_LOAD(e0 + 8, urB, vrB, scB);
        PG_COMPUTE(e0, urA, vrA, scA);
        if (e0 + 16 < 128) PG_LOAD(e0 + 16, urA, vrA, scA);
        PG_COMPUTE(e0 + 8, urB, vrB, scB);
      }
    }
#undef PG_LOAD
#undef PG_COMPUTE
    const float c75 = 7.5f * (corr + __shfl_xor(corr, 32));
    float o16[16];
#pragma unroll
    for (int i = 0; i < 16; ++i) {
      const float mine = up ? acc[16 + i] : acc[i], give = up ? acc[i] : acc[16 + i];
      o16[i] = mine + __shfl_xor(give, 32) - c75;
    }
    const int col0 = hs * 32 + up * 16;
    const float* g5 = mods + (isctx ? 8 : b) * 6144 + 5 * 1024 + col0;
    float* xp = isctx ? (xc + ((size_t)(b * CTXL + t)) * D + col0) : (p.out + ((size_t)(b * SEQ + t - CTXL)) * D + col0);
    float xn[16];
    float ssq = 0.f;
#pragma unroll
    for (int i = 0; i < 4; ++i) {
      const float4 x = *(const float4*)(xp + i * 4);
      xn[i * 4] = x.x + g5[i * 4] * o16[i * 4]; xn[i * 4 + 1] = x.y + g5[i * 4 + 1] * o16[i * 4 + 1];
      xn[i * 4 + 2] = x.z + g5[i * 4 + 2] * o16[i * 4 + 2]; xn[i * 4 + 3] = x.w + g5[i * 4 + 3] * o16[i * 4 + 3];
#pragma unroll
      for (int j = 0; j < 4; ++j) ssq += xn[i * 4 + j] * xn[i * 4 + j];
    }
    ssq = red64(ssq);
    const float rs = rsqrtf(ssq * (1.f / 1024.f) + 1e-6f);
    if (layer == 1) {
      const float* gf = p.in[I_NF] + col0;
#pragma unroll
      for (int i = 0; i < 4; ++i)
        *(float4*)(xp + i * 4) = make_float4(xn[i * 4] * rs * gf[i * 4], xn[i * 4 + 1] * rs * gf[i * 4 + 1], xn[i * 4 + 2] * rs * gf[i * 4 + 2], xn[i * 4 + 3] * rs * gf[i * 4 + 3]);
    } else {
#pragma unroll
      for (int i = 0; i < 4; ++i) *(float4*)(xp + i * 4) = make_float4(xn[i * 4], xn[i * 4 + 1], xn[i * 4 + 2], xn[i * 4 + 3]);
      const float* gn1 = p.in[I_N1_1] + col0;
      const float* m1 = mods + 9 * 6144 + (isctx ? 8 : b) * 6144 + col0;
      float hh_[16];
#pragma unroll
      for (int i = 0; i < 16; ++i) hh_[i] = xn[i] * rs * gn1[i] * (1.f + m1[1024 + i]) + m1[i];
      bf16_t* hp = (bf16_t*)(p.ws + WS_HNEXT) + (size_t)row * D + col0;
      uint4 w0, w1;
      w0.x = pack_bf2(hh_[0], hh_[1]); w0.y = pack_bf2(hh_[2], hh_[3]); w0.z = pack_bf2(hh_[4], hh_[5]); w0.w = pack_bf2(hh_[6], hh_[7]);
      w1.x = pack_bf2(hh_[8], hh_[9]); w1.y = pack_bf2(hh_[10], hh_[11]); w1.z = pack_bf2(hh_[12], hh_[13]); w1.w = pack_bf2(hh_[14], hh_[15]);
      *(uint4*)hp = w0; *(uint4*)(hp + 8) = w1;
    }
  }
}

template <int CH>
DI void conv_stream(const P& p, char* lds, bf16_t* base, int pitch  , int chan0  ) {
  const int tid = threadIdx.x;
  constexpr int NT = NTHR / CH;
  constexpr int RPT = TPB / NT;
  const int ck = tid % CH, tl = tid / CH;
  const int t0 = tl * RPT;
  bf16_t* colp = base + ck * 8;
  uint4* halo = (uint4*)lds;
  float w0[8], w1[8], w2[8], bb[8];
#pragma unroll
  for (int j = 0; j < 8; ++j) { const int c = chan0 + ck * 8 + j; w0[j] = p.in[I_CONVW][c]; w1[j] = p.in[I_CONVW][3072 + c]; w2[j] = p.in[I_CONVW][6144 + c]; bb[j] = p.in[I_CONVB][c]; }
  __syncthreads();
  uint4 cur = *(const uint4*)(colp + (size_t)t0 * pitch);
  halo[(tl * 2 + 0) * CH + ck] = cur;
  halo[(tl * 2 + 1) * CH + ck] = *(const uint4*)(colp + (size_t)(t0 + RPT - 1) * pitch);
  __syncthreads();
  uint4 prev = halo[((tl > 0 ? tl - 1 : 0) * 2 + 1) * CH + ck];
  const uint4 nxt_halo = halo[((tl < NT - 1 ? tl + 1 : NT - 1) * 2 + 0) * CH + ck];
  __syncthreads();
  constexpr int UB = (RPT % 4 == 0) ? 4 : 2;
  for (int rb = 0; rb < RPT; rb += UB) {
    uint4 nx[UB];
#pragma unroll
    for (int i = 0; i < UB; ++i) { const int r = rb + i + 1; uint4 v_ = nxt_halo; if (r < RPT) v_ = *(const uint4*)(colp + (size_t)(t0 + r) * pitch); nx[i] = v_; }
#pragma unroll
    for (int i = 0; i < UB; ++i) {
      const int t = t0 + rb + i;
      const bool first = (t == 0) || (t == CTXL), last = (t == CTXL - 1) || (t == TPB - 1);
      float u[8], um[8], up[8], o[8];
      unpack8(cur, u); unpack8(prev, um); unpack8(nx[i], up);
      const float fm = first ? 0.f : 1.f, fp_ = last ? 0.f : 1.f;
#pragma unroll
      for (int j = 0; j < 8; ++j) o[j] = siluf_(w0[j] * (fm * um[j]) + w1[j] * u[j] + w2[j] * (fp_ * up[j]) + bb[j]);
      *(uint4*)(colp + (size_t)t * pitch) = pack8(o);
      prev = cur; cur = nx[i];
    }
  }
}
DI void phase_conv(const P& p, char* lds) {
  unsigned char* pb = p.ws + WS_PB;
  for (int w = blockIdx.x; w < 256; w += gridDim.x) {
    conv_stream<8>(p, lds, (bf16_t*)(pb + L1_XH) + (size_t)w * TPB * 64, 64, (w & 31) * 64);
    const int q = w & 3, sg = (w >> 2) & 31, isC = w >> 7;
    conv_stream<4>(p, lds, (bf16_t*)(pb + (isC ? L1_CG : L1_BG)) + (size_t)sg * TPB * 128 + q * 32, 128, (isC ? 2560 : 2048) + (sg & 3) * 128 + q * 32);
  }
}

DI int swzBC(int row) { return ((row & 3) << 2) | ((row >> 2) & 3); }
DI int swzX(int row) { return ((row >> 1) & 1) << 2; }

DI void ssd_chunk_unit(const P& p, char* lds, int unit) {
  const int tid = threadIdx.x, lane = tid & 63, wave = tid >> 6;
  const int b = unit >> 5, head = unit & 31, grp = head >> 3;
  bf16_t* zh = (bf16_t*)(p.ws + WS_PB + L1_ZH) + (size_t)(b * 32 + head) * TPB * 64;
  const bf16_t* xh = (const bf16_t*)(p.ws + WS_PB + L1_XH) + (size_t)(b * 32 + head) * TPB * 64;
  const bf16_t* bg = (const bf16_t*)(p.ws + WS_PB + L1_BG) + (size_t)(b * 4 + grp) * TPB * 128;
  const bf16_t* cgp_ = (const bf16_t*)(p.ws + WS_PB + L1_CG) + (size_t)(b * 4 + grp) * TPB * 128;
  const bf16_t* dtp = (const bf16_t*)(p.ws + WS_PB + L1_DT) + (size_t)b * TPB * 64;
  bf16_t* yftmp = (bf16_t*)(p.ws + WS_YF) + (size_t)(b * 32 + head) * SEQ * 64;
  const float dsk = p.in[I_DSKIP][head];
  const int r31 = lane & 31, hh = lane >> 5, q4 = (lane & 15) >> 2, grp16 = (lane >> 4) & 1, p3 = lane & 3;
  const int lt = wave >> 1, pt = wave & 1;
  const int cc = tid & 7, rr = tid >> 3;
  const int orow = tid >> 3, ock = tid & 7;
  constexpr int NCH = TPB / 128;
  SEGS_DECL();
  for (int d = 0; d < 2; ++d) {
    const float Aneg = -__expf(p.in[I_ALOG][d * 32 + head]);
    const float dtb = p.in[I_DTB][d * 32 + head];
    f32x16 Hacc;
#pragma unroll
    for (int r = 0; r < 16; ++r) Hacc[r] = 0.f;
    __syncthreads();
    for (int e = tid; e < 1024; e += NTHR) *(uint4*)(lds + 98304 + e * 16) = make_uint4(0, 0, 0, 0);
    uint4 st[2][5];
    float dtr0, dtr1;
    uint4 oyf[2], oz[2];
#define SSD_ISSUE(CH) do { \
      _Pragma("unroll") for (int rh_ = 0; rh_ < 2; ++rh_) { \
        const int t_ = scan_token(d, (CH) * 128 + rh_ * 64 + rr); \
        st[rh_][0] = *(const uint4*)(xh + (size_t)t_ * 64 + cc * 8); \
        st[rh_][1] = *(const uint4*)(bg + (size_t)t_ * 128 + cc * 8); \
        st[rh_][2] = *(const uint4*)(bg + (size_t)t_ * 128 + 64 + cc * 8); \
        st[rh_][3] = *(const uint4*)(cgp_ + (size_t)t_ * 128 + cc * 8); \
        st[rh_][4] = *(const uint4*)(cgp_ + (size_t)t_ * 128 + 64 + cc * 8); \
      } \
      dtr0 = bf2f(dtp[(size_t)scan_token(d, (CH) * 128 + lane) * 64 + d * 32 + head]); \
      dtr1 = bf2f(dtp[(size_t)scan_token(d, (CH) * 128 + 64 + lane) * 64 + d * 32 + head]); \
    } while (0)
    SSD_ISSUE(0);
    SEGS_INIT();
    for (int ch = 0; ch <= NCH; ++ch) {
      int zoff = 0;
      asm volatile("" : "+v"(zoff));
      char* L0 = lds + zoff;
      char* LB = L0; char* LC = L0 + 32768; char* LX = L0 + 65536; char* LXw = L0 + 81920; char* LHs = L0 + 98304;
      float* Lacs = (float*)(L0 + 131072); float* Ldt = (float*)(L0 + 131584); float* Lea = (float*)(L0 + 132096);
      char* LY = L0 + 132608;
      __syncthreads();
      SEGS_ADD(0);
      if (ch - 1 >= CTXL / 128) {
#pragma unroll
        for (int i = 0; i < 2; ++i) {
          const int row = orow + i * 64;
          const int t = scan_token(d, (ch - 1) * 128 + row);
          const uint4 yv = *(const uint4*)(LY + row * 128 + ock * 16);
          if (d == 0) {
            *(uint4*)(yftmp + (size_t)(t - CTXL) * 64 + ock * 8) = yv;
          } else {
            float y[8], yf[8], z[8], o[8];
            unpack8(yv, y); unpack8(oyf[i], yf); unpack8(oz[i], z);
#pragma unroll
            for (int j = 0; j < 8; ++j) o[j] = (yf[j] + y[j]) * siluf_(z[j]);
            *(uint4*)(zh + (size_t)t * 64 + ock * 8) = pack8(o);
          }
        }
      }
      if (ch == NCH) break;
      float dt0, dt1, acs0, acs1, alast;
      {
        dt0 = softplusf_(dtr0 + dtb); dt1 = softplusf_(dtr1 + dtb);
        acs0 = dt0 * Aneg; acs1 = dt1 * Aneg;
#pragma unroll
        for (int off = 1; off < 64; off <<= 1) {
          const float y0 = __shfl_up(acs0, off), y1 = __shfl_up(acs1, off);
          if (lane >= off) { acs0 += y0; acs1 += y1; }
        }
        acs1 += __shfl(acs0, 63);
        alast = __shfl(acs1, 63);
        if (wave == 0) {
          Lacs[lane] = acs0; Lacs[64 + lane] = acs1; Ldt[lane] = dt0; Ldt[64 + lane] = dt1;
          Lea[lane] = __expf(acs0); Lea[64 + lane] = __expf(acs1);
        }
      }
#pragma unroll
      for (int rh = 0; rh < 2; ++rh) {
        const int s_ = rh * 64 + rr;
        const float dts = __shfl(rh ? dt1 : dt0, rr);
        const float ws_ = __expf(alast - __shfl(rh ? acs1 : acs0, rr));
        float xv[8], xw[8];
        unpack8(st[rh][0], xv);
#pragma unroll
        for (int j = 0; j < 8; ++j) { xv[j] *= dts; xw[j] = xv[j] * ws_; }
        const int off = s_ * 128 + ((cc ^ swzX(s_)) << 4);
        *(uint4*)(LX + off) = pack8(xv);
        *(uint4*)(LXw + off) = pack8(xw);
        const int sw = swzBC(s_);
        *(uint4*)(LB + s_ * 256 + ((cc ^ sw) << 4)) = st[rh][1];
        *(uint4*)(LB + s_ * 256 + (((8 + cc) ^ sw) << 4)) = st[rh][2];
        *(uint4*)(LC + s_ * 256 + ((cc ^ sw) << 4)) = st[rh][3];
        *(uint4*)(LC + s_ * 256 + (((8 + cc) ^ sw) << 4)) = st[rh][4];
      }
      SEGS_ADD(1);
      __syncthreads();
      SEGS_ADD(2);
      if (ch + 1 < NCH) SSD_ISSUE(ch + 1);
      if (d == 1 && ch >= CTXL / 128) {
#pragma unroll
        for (int i = 0; i < 2; ++i) {
          const int t = scan_token(d, ch * 128 + orow + i * 64);
          oyf[i] = *(const uint4*)(yftmp + (size_t)(t - CTXL) * 64 + ock * 8);
          oz[i] = *(const uint4*)(zh + (size_t)t * 64 + ock * 8);
        }
      }
      const char* LBz = LB; const char* LCz = LC; const char* LXz = LX; const char* LXwz = LXw;
      const char* Hs = LHs;
      char* LMa = L0 + 114688; char* LMb = L0 + 148992;
      if (ch >= CTXL / 128) {
        f32x16 Y;
#pragma unroll
        for (int r = 0; r < 16; ++r) Y[r] = 0.f;
        const int crow = lt * 32 + r31;
        const char* cbase = LCz + crow * 256;
        const int csw = swzBC(crow);
        {
          const int hrow = pt * 32 + r31;
#pragma unroll 2
          for (int kk = 0; kk < 8; ++kk) {
            const bf16x8 cfk = *(const bf16x8*)(cbase + (((kk * 2 + hh) ^ csw) << 4));
            const bf16x8 hb = *(const bf16x8*)(Hs + hrow * 256 + (((kk * 2 + hh) ^ swzBC(hrow)) << 4));
            Y = MFMA32(cfk, hb, Y);
          }
        }
#pragma unroll
        for (int r = 0; r < 16; ++r) Y[r] *= Lea[lt * 32 + ACC_ROW(r, lane)];
        const int lcol = lt * 32 + r31;
        const float acs_l = Lacs[lcol];
        const float ddiag = (d == 1) ? dsk / Ldt[lcol] : 0.f;
        for (int st_ = pt; st_ <= lt; st_ += 2) {
          f32x16 g;
#pragma unroll
          for (int r = 0; r < 16; ++r) g[r] = 0.f;
          const int row = st_ * 32 + r31;
#pragma unroll 4
          for (int kk = 0; kk < 8; ++kk) {
            const bf16x8 a = *(const bf16x8*)(LBz + row * 256 + (((kk * 2 + hh) ^ swzBC(row)) << 4));
            const bf16x8 cfk = *(const bf16x8*)(cbase + (((kk * 2 + hh) ^ csw) << 4));
            g = MFMA32(a, cfk, g);
          }
#pragma unroll
          for (int r = 0; r < 16; ++r) {
            const int srow = st_ * 32 + ACC_ROW(r, lane);
            const float e = __expf(fminf(acs_l - Lacs[srow], 0.f));
            float val = (srow <= lcol) ? g[r] * e : 0.f;
            if (srow == lcol) val += ddiag;
            g[r] = val;
          }
          const int id = lt * (lt + 1) / 2 + st_;
          char* mt = (id < 8) ? (LMa + id * 2048) : (LMb + (id - 8) * 2048);
#pragma unroll
          for (int k2 = 0; k2 < 2; ++k2) {
            uint4 u; u.x = pack_bf2(g[8 * k2], g[8 * k2 + 1]); u.y = pack_bf2(g[8 * k2 + 2], g[8 * k2 + 3]); u.z = pack_bf2(g[8 * k2 + 4], g[8 * k2 + 5]); u.w = pack_bf2(g[8 * k2 + 6], g[8 * k2 + 7]);
            *(uint4*)(mt + (k2 * 64 + lane) * 16) = u;
          }
        }
        __syncthreads();
        for (int st_ = 0; st_ <= lt; ++st_) {
          const int id = lt * (lt + 1) / 2 + st_;
          const char* mt = (id < 8) ? (LMa + id * 2048) : (LMb + (id - 8) * 2048);
#pragma unroll
          for (int k2 = 0; k2 < 2; ++k2) {
            const bf16x8 am = *(const bf16x8*)(mt + (k2 * 64 + lane) * 16);
            const int s0 = st_ * 32 + 16 * k2 + 4 * hh + q4, s1 = s0 + 8;
            const int cx = pt * 4 + grp16 * 2 + (p3 >> 1);
            const s16x4 lo = tr_read(LXz + s0 * 128 + ((cx ^ swzX(s0)) << 4) + 8 * (p3 & 1));
            const s16x4 hi = tr_read(LXz + s1 * 128 + ((cx ^ swzX(s1)) << 4) + 8 * (p3 & 1));
            const bf16x8 bx = __builtin_shufflevector(lo, hi, 0, 1, 2, 3, 4, 5, 6, 7);
            Y = MFMA32(am, bx, Y);
          }
        }
#pragma unroll
        for (int r = 0; r < 16; ++r) {
          const int srow = lt * 32 + ACC_ROW(r, lane);
          *(bf16_t*)(LY + srow * 128 + (pt * 32 + r31) * 2) = f2bf(Y[r]);
        }
      }
      {
        const float ea = __expf(alast);
#pragma unroll
        for (int r = 0; r < 16; ++r) Hacc[r] *= ea;
        const int cb_ = lt * 4 + grp16 * 2 + (p3 >> 1);
        const int cx = pt * 4 + grp16 * 2 + (p3 >> 1);
        const int sb0 = 8 * hh + q4, sb1 = sb0 + 4;
        const char* pa_lo = LBz + sb0 * 256 + ((cb_ ^ swzBC(sb0)) << 4) + 8 * (p3 & 1);
        const char* pa_hi = LBz + sb1 * 256 + ((cb_ ^ swzBC(sb1)) << 4) + 8 * (p3 & 1);
        const char* pb_lo = LXwz + sb0 * 128 + ((cx ^ swzX(sb0)) << 4) + 8 * (p3 & 1);
        const char* pb_hi = LXwz + sb1 * 128 + ((cx ^ swzX(sb1)) << 4) + 8 * (p3 & 1);
#pragma unroll 2
        for (int k = 0; k < 8; ++k) {
          const s16x4 alo = tr_read(pa_lo + k * 4096);
          const s16x4 ahi = tr_read(pa_hi + k * 4096);
          const s16x4 blo = tr_read(pb_lo + k * 2048);
          const s16x4 bhi = tr_read(pb_hi + k * 2048);
          const bf16x8 a = __builtin_shufflevector(alo, ahi, 0, 1, 2, 3, 4, 5, 6, 7);
          const bf16x8 bb = __builtin_shufflevector(blo, bhi, 0, 1, 2, 3, 4, 5, 6, 7);
          Hacc = MFMA32(a, bb, Hacc);
        }
        char* Hn = LHs;
        const int prow = pt * 32 + r31;
#pragma unroll
        for (int g4 = 0; g4 < 4; ++g4) {
          const int n0 = lt * 32 + 8 * g4 + 4 * hh;
          uint2 w; w.x = pack_bf2(Hacc[g4 * 4], Hacc[g4 * 4 + 1]); w.y = pack_bf2(Hacc[g4 * 4 + 2], Hacc[g4 * 4 + 3]);
          *(uint2*)(Hn + prow * 256 + ((((n0 >> 3)) ^ swzBC(prow)) << 4) + (n0 & 7) * 2) = w;
        }
      }
      SEGS_ADD(3);
    }
  }
  SEGS_FLUSH(4);
  __syncthreads();
}

DI void phase_groupnorm(const P& p) {
  const int lane = threadIdx.x & 63, gw = blockIdx.x * 8 + (threadIdx.x >> 6), nw = gridDim.x * 8;
  bf16_t* zh = (bf16_t*)(p.ws + WS_PB + L1_ZH);
  const float* gn = p.in[I_GNORM];
  for (int lr0 = gw * 2; lr0 < NB * SEQ; lr0 += nw * 2) {
    uint4 raw[2][4];
    bf16_t* rp[2];
#pragma unroll
    for (int u = 0; u < 2; ++u) {
      const int lr = lr0 + u, b = lr >> 12, l = lr & 4095;
      rp[u] = zh + ((size_t)(b * 32 + (lane >> 1)) * TPB + CTXL + l) * 64 + (lane & 1) * 32;
#pragma unroll
      for (int i = 0; i < 4; ++i) raw[u][i] = *(const uint4*)(rp[u] + i * 8);
    }
#pragma unroll
    for (int u = 0; u < 2; ++u) {
      float v[32];
#pragma unroll
      for (int i = 0; i < 4; ++i) { float f[8]; unpack8(raw[u][i], f);
#pragma unroll
        for (int j = 0; j < 8; ++j) v[i * 8 + j] = f[j]; }
      float ss = 0.f;
#pragma unroll
      for (int i = 0; i < 32; ++i) ss += v[i] * v[i];
      ss = red16(ss);
      const float rs = rsqrtf(ss * (1.f / 512.f) + 1e-6f);
#pragma unroll
      for (int i = 0; i < 4; ++i) {
        float o[8];
#pragma unroll
        for (int j = 0; j < 8; ++j) o[j] = v[i * 8 + j] * rs * gn[lane * 32 + i * 8 + j];
        *(uint4*)(rp[u] + i * 8) = pack8(o);
      }
    }
  }
}


__global__ void __launch_bounds__(NTHR) fwd_kernel(P p) {
  extern __shared__ __attribute__((aligned(16))) char lds[];
  const int lo = p.ph_lo, hi = p.ph_hi;
  unsigned char* ws = p.ws;
  XcdBarrier bar; bar.bar = (unsigned*)(ws + WS_CTL); bar.x = 0; bar.st = nullptr;
  volatile LAS unsigned* stw = (volatile LAS unsigned*)(lds + LDS_BYTES - 16);
  if (hi - lo > 1) {
    if (threadIdx.x == 0) { stw[0] = 0u; stw[1] = 0u; }
    __syncthreads();
    bar = xcd_barrier_post((unsigned*)(ws + WS_CTL), stw);
  }
#ifndef PHASE_MASK
#define PHASE_MASK 0xFFFFFFFFu
#endif
#define IN(k) (((PHASE_MASK >> (k)) & 1u) && lo <= (k) && (k) < hi)
#define SEAM(k) do { if (IN(k) && IN((k) + 1)) xcd_barrier(bar); } while (0)
#ifdef PROBE_A
  unsigned long long* tsp = (unsigned long long*)(ws + WS_SCAL + 1024);
#define STAMP(k) do { if (blockIdx.x == 0 && threadIdx.x == 0) tsp[k] = __builtin_amdgcn_s_memrealtime(); } while (0)
#else
#define STAMP(k) do {} while (0)
#endif
  const int G = gridDim.x;
  bf16_t* HBp = (bf16_t*)(ws + WS_HB);
  bf16_t* PBp = (bf16_t*)(ws + WS_PB + PB_P);

#ifdef PROBE_A
  if (blockIdx.x == 0 && threadIdx.x == 0) for (int k = 22; k < 64; ++k) tsp[k] = 0ull;
#endif
  STAMP(0); if (IN(0)) { phase_prep(p, lds); } SEAM(0);
  STAMP(1); if (IN(1)) { phase_normmod(p, 0, 0, true, false, HBp); } SEAM(1);
  STAMP(2); if (IN(2)) { pg8::Order S; S.init(R / 256, 3584 / 256, G, (int)blockIdx.x, 0);
    pg8::gemm_phase(lds, pg8::Gemm{HBp, (const bf16_t*)(ws + WS_WIN0T), D, D, 0}, S, pg8::EpiP0{PBp, (const float2*)(ws + WS_ROPE)}); } SEAM(2);
  STAMP(3); if (IN(3)) {
    if (G == 256) {
      const int xg = blockIdx.x & 7, jg = blockIdx.x >> 3;
      for (int r = 0; r < 4; ++r) attn_flash_unit(p, lds, ((r * 8 + xg) << 5) | jg);
      if (jg < 8) attn_flash_unit(p, lds, 1024 + xg * 8 + jg);
    } else {
      for (int u = blockIdx.x; u < 1024 + 64; u += G) attn_flash_unit(p, lds, u);
    }
    phase_ga(p);
  } SEAM(3);
  STAMP(4); if (IN(4)) {
    if (G == 256) {
      const int xg = blockIdx.x & 7, jg = blockIdx.x >> 3;
      rwkv_scan_unit(p, lds, ((xg + 8 * (jg >> 2)) << 2) | (jg & 3));
    } else {
      for (int u = blockIdx.x; u < 256; u += G) rwkv_scan_unit(p, lds, u);
    }
    __syncthreads();
    gemm_store_phase(lds, (const bf16_t*)(ws + WS_PB + PB_GA), 128, (const bf16_t*)(ws + WS_RWT + 262144), 128, R, 512, 128, (bf16_t*)(ws + WS_PB + PB_G), 512, 512);
  } SEAM(4);
  STAMP(5); if (IN(5)) { phase_rwkv_post(p); } SEAM(5);
  STAMP(6); if (IN(6)) { pg8::Order S; S.init(R / 256, 4, G, (int)blockIdx.x, 0);
    pg8::gemm_phase(lds, pg8::Gemm{(const bf16_t*)(ws + WS_PB + PB_O0), (const bf16_t*)(ws + WS_WOUT0T), D, D, 0}, S,
                    pg8::EpiDelta{(bf16_t*)(ws + WS_PB + PB_H2), (const float*)(ws + WS_MODS)}); } SEAM(6);
  STAMP(7); if (IN(7)) { phase_normmod(p, 0, 1, true, false, (bf16_t*)(ws + WS_PB + PB_H2), (const bf16_t*)(ws + WS_PB + PB_H2)); convert_tables(p, 0); } SEAM(7);
  STAMP(8); if (IN(8)) { pg8::Order S; S.init(R / 256, 8, G, (int)blockIdx.x, 0);
    pg8::gemm_phase(lds, pg8::Gemm{(const bf16_t*)(ws + WS_PB + PB_H2), (const bf16_t*)(ws + WS_PQ0T), D, D, 0}, S, pg8::EpiBf16{(bf16_t*)(ws + WS_PB + PB_Q), 2048, 2048}); } SEAM(8);
  STAMP(9); if (IN(9)) { for (int u = blockIdx.x; u < (R / 256) * 8; u += G) peer_topk_unit(p, lds, 0, u); } SEAM(9);
  STAMP(10); if (IN(10)) { phase_peer_gather(p, 0); } SEAM(10);
  STAMP(11);
  STAMP(12); if (IN(12)) { pg8::Order S; S.init(R / 256, 5376 / 256, G, (int)blockIdx.x, 0);
    pg8::gemm_phase(lds, pg8::Gemm{(const bf16_t*)(ws + WS_HNEXT), (const bf16_t*)(ws + WS_WIN1T), D, D, 0}, S, pg8::EpiP1{ws + WS_PB}); } SEAM(12);
  STAMP(13); if (IN(13)) {
    phase_conv(p, lds);
    if (hi - lo > 1) xcd_barrier(bar);
    if (G == 256) {
      const int xg = blockIdx.x & 7, jg = blockIdx.x >> 3;
      const int gidx = xg + 8 * (jg >> 3);
      ssd_chunk_unit(p, lds, (gidx >> 2) * 32 + (gidx & 3) * 8 + (jg & 7));
    } else {
      for (int u = blockIdx.x; u < 256; u += G) ssd_chunk_unit(p, lds, u);
    }
  } SEAM(13);
  STAMP(14); if (IN(14)) { phase_groupnorm(p); } SEAM(14);
  STAMP(15); if (IN(15)) { pg8::Order S; S.init(NB * SEQ / 256, 4, G, (int)blockIdx.x, 1);
    pg8::gemm_phase(lds, pg8::Gemm{(const bf16_t*)(ws + WS_PB + L1_ZH), (const bf16_t*)(ws + WS_WOUT1T), 64, 2048, 1}, S,
                    pg8::EpiDelta{(bf16_t*)(ws + WS_PB + L1_XH), (const float*)(ws + WS_MODS) + 9 * 6144}); } SEAM(15);
  STAMP(16); if (IN(16)) { phase_normmod(p, 1, 1, false, true, (bf16_t*)(ws + WS_PB + PB_H2), (const bf16_t*)(ws + WS_PB + L1_XH)); convert_tables(p, 1); } SEAM(16);
  STAMP(17); if (IN(17)) { pg8::Order S; S.init(NB * SEQ / 256, 8, G, (int)blockIdx.x, 1);
    pg8::gemm_phase(lds, pg8::Gemm{(const bf16_t*)(ws + WS_PB + PB_H2), (const bf16_t*)(ws + WS_PQ1T), D, D, 0}, S, pg8::EpiBf16{(bf16_t*)(ws + WS_PB + PB_Q), 2048, 2048}); } SEAM(17);
  STAMP(18); if (IN(18)) { for (int u = blockIdx.x; u < (NB * SEQ / 256) * 8; u += G) { const int mtl = u >> 3; peer_topk_unit(p, lds, 1, ((((mtl >> 4) * 17 + 1 + (mtl & 15)) << 3) | (u & 7))); } } SEAM(18);
  STAMP(19); if (IN(19)) { phase_peer_gather(p, 1); }
  STAMP(20);
#ifdef PROBE_A
  xcd_barrier(bar);
  if (blockIdx.x == 0 && threadIdx.x == 0) {
    const unsigned long long tend = __builtin_amdgcn_s_memrealtime();
    tsp[21] = tend;
    unsigned long long ta = 0;
    for (int k = 0; k < 21; ++k) if ((PROBE_A >> k) & 1) ta += tsp[k + 1] - tsp[k];
    for (int k = 22; k < 64; ++k) if ((PROBE_A >> k) & 1ull) ta += tsp[k];
    while (__builtin_amdgcn_s_memrealtime() - tend < ta * PROBE_K) __builtin_amdgcn_s_sleep(8);
  }
#endif
}

extern "C" void kernel_launch(void* const* d_in, const int* in_sizes, int n_in, void* d_out, int out_size, void* d_ws, size_t ws_size, hipStream_t stream) {
  static int inited = 0;
  if (!inited) {
    if (n_in != N_IN || ws_size < WS_XC + 128 * MiB) { fprintf(stderr, "kernel_launch: unexpected n_in %d / ws_size %zu\n", n_in, ws_size); inited = -1; return; }
    if (hipFuncSetAttribute((const void*)fwd_kernel, hipFuncAttributeMaxDynamicSharedMemorySize, LDS_BYTES) != hipSuccess) { fprintf(stderr, "kernel_launch: hipFuncSetAttribute failed\n"); inited = -1; return; }
    inited = 1;
  }
  if (inited < 0) return;
  P p{};
  for (int i = 0; i < N_IN; ++i) p.in[i] = (const float*)d_in[i];
  p.out = (float*)d_out; p.ws = (unsigned char*)d_ws;
  (void)hipMemsetAsync((char*)d_ws + WS_CTL, 0, 65536, stream);
#if N_LAUNCH_MODE == 1
  p.ph_lo = 0; p.ph_hi = N_PHASES;
  hipLaunchKernelGGL(fwd_kernel, dim3(256), dim3(NTHR), LDS_BYTES, stream, p);
#else
  for (int ph = 0; ph < N_PHASES; ++ph) {
    p.ph_lo = ph; p.ph_hi = ph + 1;
    hipLaunchKernelGGL(fwd_kernel, dim3(256), dim3(NTHR), LDS_BYTES, stream, p);
  }
#endif
}
```

```cpp
#include <hip/hip_runtime.h>
#include <stdint.h>
#include <stdio.h>

#ifndef N_LAUNCH_MODE
#define N_LAUNCH_MODE 1
#endif

#define DI __device__ __forceinline__
typedef unsigned short bf16_t;
typedef __attribute__((ext_vector_type(8))) short bf16x8;
typedef __attribute__((ext_vector_type(16))) float f32x16;
typedef __attribute__((ext_vector_type(2))) __bf16 bf2_t;

constexpr int D = 1024, NB = 8, SEQ = 4096, CTXL = 256, TPB = SEQ + CTXL, R = NB * TPB;
constexpr int NTHR = 512;
constexpr int LDS_BYTES = 163840;
constexpr int P0LD = 3456;
constexpr int P1LD = 5184;
constexpr int P1NPAD = 5248;

enum { I_X = 0, I_C, I_CTX, I_CCTX,
       I_ADAW0, I_ADAB0, I_N1_0, I_N2_0, I_WIN0, I_DALAM, I_DASUB, I_RWMU, I_RWW0, I_RWW2, I_RWA0, I_RWA2, I_RWG2, I_RWKK, I_RWKA, I_RWRK, I_LNXW, I_LNXB, I_WOUT0, I_PQ0, I_PK0, I_PU0, I_PV0,
       I_ADAW1, I_ADAB1, I_N1_1, I_N2_1, I_WIN1, I_CONVW, I_CONVB, I_DTB, I_ALOG, I_DSKIP, I_GNORM, I_WOUT1, I_PQ1, I_PK1, I_PU1, I_PV1, I_NF, N_IN };

constexpr size_t MiB = 1048576;
constexpr size_t WS_CTL = 0;
constexpr size_t WS_SCAL = 65536;
constexpr size_t WS_MODS = 131072;
constexpr size_t WS_ROPE = 1 * MiB;
constexpr size_t WS_RWT = 2 * MiB;
constexpr size_t WS_WIN0T = 3 * MiB;
constexpr size_t WS_WOUT0T = 10 * MiB;
constexpr size_t WS_PQ0T = 12 * MiB;
constexpr size_t WS_KEYS0 = 16 * MiB;
constexpr size_t WS_KEYS1 = 16 * MiB + 524288;
constexpr size_t WS_WIN1T = 17 * MiB;
constexpr size_t WS_WOUT1T = 28 * MiB;
constexpr size_t WS_PQ1T = 32 * MiB;
constexpr size_t WS_PB = 36 * MiB;
constexpr size_t WS_XC = 381 * MiB;
constexpr size_t WS_HB = 389 * MiB;
constexpr size_t WS_END = 457 * MiB;
constexpr size_t WS_YF = WS_XC;
constexpr size_t PB_P = 0;
constexpr size_t PB_O0 = 230 * MiB;
constexpr size_t PB_G = 298 * MiB;
constexpr size_t PB_GA = 332 * MiB;
constexpr size_t PB_BONUS = 341 * MiB;
constexpr size_t L1_ZH = 0;
constexpr size_t L1_XH = 136 * MiB;
constexpr size_t L1_BG = 272 * MiB;
constexpr size_t L1_CG = 306 * MiB;
constexpr size_t L1_DT = 340 * MiB;
constexpr size_t PB_H2 = 0;
constexpr size_t PB_Q = 68 * MiB;
constexpr size_t PB_IDX = 204 * MiB;
constexpr size_t PB_GATE = 221 * MiB;
constexpr size_t WS_HNEXT = WS_HB + 33 * MiB;
constexpr size_t HB_YF = 0, HB_YB = 34 * MiB;
constexpr size_t HB_U = 0, HB_V = 8 * MiB;
constexpr size_t HB_SU = 32 * MiB, HB_SV = 32 * MiB + 65536;

struct P {
  const float* in[N_IN];
  float* out;
  unsigned char* ws;
  int ph_lo, ph_hi;
};

constexpr int N_PHASES = 21;
#ifndef PROBE_GRP
#define PROBE_GRP 0
#endif
#define SEG_DECL_() unsigned long long seg_last_ = 0ull, seg_acc_[4] = {0ull, 0ull, 0ull, 0ull}
#define SEG_INIT_() do { seg_last_ = __builtin_amdgcn_s_memrealtime(); } while (0)
#define SEG_ADD_(j) do { const unsigned long long t__ = __builtin_amdgcn_s_memrealtime(); seg_acc_[j] += t__ - seg_last_; seg_last_ = t__; } while (0)
#define SEG_FLUSH_(base) do { if (blockIdx.x == 0 && threadIdx.x == 0) { for (int j__ = 0; j__ < 4; ++j__) ((unsigned long long*)(p.ws + WS_SCAL + 1024))[22 + (base) + j__] += seg_acc_[j__]; } } while (0)
#if defined(PROBE_A) && PROBE_GRP == 1
#define SEGR_DECL() SEG_DECL_()
#define SEGR_INIT() SEG_INIT_()
#define SEGR_ADD(j) SEG_ADD_(j)
#define SEGR_FLUSH(b) SEG_FLUSH_(b)
#else
#define SEGR_DECL() do {} while (0)
#define SEGR_INIT() do {} while (0)
#define SEGR_ADD(j) do {} while (0)
#define SEGR_FLUSH(b) do {} while (0)
#endif
#if defined(PROBE_A) && PROBE_GRP == 2
#define SEGS_DECL() SEG_DECL_()
#define SEGS_INIT() SEG_INIT_()
#define SEGS_ADD(j) SEG_ADD_(j)
#define SEGS_FLUSH(b) SEG_FLUSH_(b)
#else
#define SEGS_DECL() do {} while (0)
#define SEGS_INIT() do {} while (0)
#define SEGS_ADD(j) do {} while (0)
#define SEGS_FLUSH(b) do {} while (0)
#endif

DI unsigned pack_bf2(float a, float b) { bf2_t v; v[0] = (__bf16)a; v[1] = (__bf16)b; return __builtin_bit_cast(unsigned, v); }
DI bf16_t f2bf(float a) { return __builtin_bit_cast(unsigned short, (__bf16)a); }
DI float bf2f(bf16_t v) { return __uint_as_float((unsigned)v << 16); }
DI float bflo(unsigned u) { return __uint_as_float(u << 16); }
DI float bfhi(unsigned u) { return __uint_as_float(u & 0xffff0000u); }
template <int CTRL> DI float dpp_f(float x) { return __int_as_float(__builtin_amdgcn_update_dpp(0, __float_as_int(x), CTRL, 0xF, 0xF, true)); }
DI float red4(float x) { x += dpp_f<0xB1>(x); x += dpp_f<0x4E>(x); return x; }
DI float red8(float x) { x += dpp_f<0x141>(x); return red4(x); }
DI float red16(float x) { x += dpp_f<0x140>(x); return red8(x); }
DI float red64(float x) { x = red16(x); x += __shfl_xor(x, 16); x += __shfl_xor(x, 32); return x; }
DI float frcp_(float x) { return __builtin_amdgcn_rcpf(x); }
DI float sigmoidf_(float x) { return frcp_(1.f + __expf(-x)); }
DI float siluf_(float x) { return x * frcp_(1.f + __expf(-x)); }
DI float softplusf_(float x) { return x > 20.f ? x : log1pf(__expf(x)); }
DI float geluf_(float x) { return 0.5f * x * (1.f + erff(x * 0.70710678118654752f)); }
DI void unpack8(const uint4& u, float (&f)[8]) { f[0] = bflo(u.x); f[1] = bfhi(u.x); f[2] = bflo(u.y); f[3] = bfhi(u.y); f[4] = bflo(u.z); f[5] = bfhi(u.z); f[6] = bflo(u.w); f[7] = bfhi(u.w); }
DI uint4 pack8(const float (&f)[8]) { uint4 u; u.x = pack_bf2(f[0], f[1]); u.y = pack_bf2(f[2], f[3]); u.z = pack_bf2(f[4], f[5]); u.w = pack_bf2(f[6], f[7]); return u; }
#define ACC_ROW(reg, lane) (((reg) & 3) + 8 * ((reg) >> 2) + 4 * ((lane) >> 5))
#define MFMA32(a, b, c) __builtin_amdgcn_mfma_f32_32x32x16_bf16((a), (b), (c), 0, 0, 0)

#define XB_TMO      128
#define XB_XCNT(j)  (256  + 64 * (j))
#define XB_XSUB(j)  (1280 + 64 * (j))
#define XB_XGEN(j)  (2304 + 64 * (j))
#define XB_TOP      3328
#define XB_TOPGEN   3392
#define XCD_BAR_WORDS 3456
#define XB_SPIN_CAP (1u << 22)
#define LAS __attribute__((address_space(3)))
DI unsigned xb_ld(unsigned* p) { return __hip_atomic_load(p, __ATOMIC_RELAXED, __HIP_MEMORY_SCOPE_AGENT); }
DI unsigned xb_add(unsigned* p, unsigned v) { return __hip_atomic_fetch_add(p, v, __ATOMIC_RELAXED, __HIP_MEMORY_SCOPE_AGENT); }
DI unsigned xb_xcc_id() { return (unsigned)__builtin_amdgcn_s_getreg((3 << 11) | 20) & 0xFu; }
#define XB_SPIN(cond, bar) do { unsigned _sp = 0; while (cond) { __builtin_amdgcn_s_sleep(1); \
    if ((++_sp & 255u) == 0u) { if (xb_ld(&(bar)[XB_TMO])) break; if (_sp > XB_SPIN_CAP) { atomicAdd(&(bar)[XB_TMO], 1u); break; } } } } while (0)
struct XcdBarrier { unsigned* bar; unsigned x; volatile LAS unsigned* st; };
DI XcdBarrier xcd_barrier_post(unsigned* bar, volatile LAS unsigned* st) {
  XcdBarrier b; b.bar = bar; b.x = xb_xcc_id(); b.st = st;
  if (threadIdx.x == 0) (void)xb_add(&bar[XB_XCNT(b.x)], 1u);
  return b;
}
DI void xcd_barrier_complete(unsigned* bar, unsigned x, unsigned& nloc, unsigned& nx) {
  const unsigned G = gridDim.x * gridDim.y * gridDim.z;
  unsigned sum, cnt, mine, sp = 0u;
  for (;;) {
    sum = 0u; cnt = 0u; mine = 0u;
#pragma unroll
    for (unsigned j = 0; j < 16; ++j) { const unsigned c = xb_ld(&bar[XB_XCNT(j)]); sum += c; cnt += (c > 0u) ? 1u : 0u; mine = (j == x) ? c : mine; }
    if (sum == G) break;
    __builtin_amdgcn_s_sleep(1);
    if ((++sp & 255u) == 0u) { if (xb_ld(&bar[XB_TMO])) break; if (sp > XB_SPIN_CAP) { atomicAdd(&bar[XB_TMO], 1u); break; } }
  }
  nloc = mine > 0u ? mine : 1u; nx = cnt > 0u ? cnt : 1u;
}
DI void xcd_barrier(const XcdBarrier& b) {
  asm volatile("s_waitcnt vmcnt(0)" ::: "memory");
  __syncthreads();
  if (threadIdx.x == 0) {
    unsigned* bar = b.bar;
    __builtin_amdgcn_s_waitcnt(0);
    unsigned nloc = b.st[0], nx = b.st[1];
    if (nloc == 0u) { xcd_barrier_complete(bar, b.x, nloc, nx); b.st[0] = nloc; b.st[1] = nx; }
    const unsigned old = xb_add(&bar[XB_XSUB(b.x)], 1u);
    const unsigned gen = old / nloc;
    if (old + 1u == (gen + 1u) * nloc) {
      __builtin_amdgcn_fence(__ATOMIC_RELEASE, "agent");
      asm volatile("s_waitcnt vmcnt(0)" ::: "memory");
      const unsigned og = xb_add(&bar[XB_TOP], 1u);
      const unsigned tg = og / nx;
      if (og + 1u == (tg + 1u) * nx) xb_add(&bar[XB_TOPGEN], 1u);
      else XB_SPIN(xb_ld(&bar[XB_TOPGEN]) == tg, bar);
      __builtin_amdgcn_fence(__ATOMIC_ACQUIRE, "agent");
      xb_add(&bar[XB_XGEN(b.x)], 1u);
      asm volatile("s_waitcnt vmcnt(0)" ::: "memory");
    } else {
      XB_SPIN(xb_ld(&bar[XB_XGEN(b.x)]) == gen, bar);
      __builtin_amdgcn_fence(__ATOMIC_ACQUIRE, "agent");
      asm volatile("s_waitcnt vmcnt(0)" ::: "memory");
    }
  }
  __syncthreads();
}

DI void gemm_tile(char* lds, const bf16_t* __restrict__ A, int lda, const bf16_t* __restrict__ Bt, int ldb, int K, f32x16 (&acc)[2][2]) {
  const int tid = threadIdx.x, lane = tid & 63, wave = tid >> 6, wm = wave >> 1, wn = wave & 1;
#pragma unroll
  for (int i = 0; i < 2; ++i)
#pragma unroll
    for (int j = 0; j < 2; ++j)
#pragma unroll
      for (int r = 0; r < 16; ++r) acc[i][j][r] = 0.f;
  const int arow0 = tid >> 3, ac = tid & 7;
  const bf16_t* ap = A + (size_t)arow0 * lda + ac * 8;
  const bf16_t* bp = Bt + (size_t)arow0 * ldb + ac * 8;
  const int sw = ((ac ^ (arow0 >> 1)) & 7) << 4;
  const int st_off = arow0 * 128 + sw;
  uint4 ra[4], rb[2];
#pragma unroll
  for (int i = 0; i < 4; ++i) ra[i] = *(const uint4*)(ap + (size_t)i * 64 * lda);
#pragma unroll
  for (int i = 0; i < 2; ++i) rb[i] = *(const uint4*)(bp + (size_t)i * 64 * ldb);
#pragma unroll
  for (int i = 0; i < 4; ++i) *(uint4*)(lds + st_off + i * 8192) = ra[i];
#pragma unroll
  for (int i = 0; i < 2; ++i) *(uint4*)(lds + 65536 + st_off + i * 8192) = rb[i];
  __syncthreads();
  const int nk = K >> 6;
  const int r31 = lane & 31, hh = lane >> 5;
  for (int kt = 0; kt < nk; ++kt) {
    const int cur = kt & 1;
    if (kt + 1 < nk) {
#pragma unroll
      for (int i = 0; i < 4; ++i) ra[i] = *(const uint4*)(ap + (size_t)i * 64 * lda + (kt + 1) * 64);
#pragma unroll
      for (int i = 0; i < 2; ++i) rb[i] = *(const uint4*)(bp + (size_t)i * 64 * ldb + (kt + 1) * 64);
    }
    const char* la = lds + cur * 32768;
    const char* lb = lds + 65536 + cur * 16384;
#pragma unroll
    for (int kk = 0; kk < 4; ++kk) {
      const int c = kk * 2 + hh;
      bf16x8 a[2], b[2];
#pragma unroll
      for (int mi = 0; mi < 2; ++mi) { const int row = wm * 64 + mi * 32 + r31; a[mi] = *(const bf16x8*)(la + row * 128 + (((c ^ (row >> 1)) & 7) << 4)); }
#pragma unroll
      for (int ni = 0; ni < 2; ++ni) { const int row = wn * 64 + ni * 32 + r31; b[ni] = *(const bf16x8*)(lb + row * 128 + (((c ^ (row >> 1)) & 7) << 4)); }
#pragma unroll
      for (int mi = 0; mi < 2; ++mi)
#pragma unroll
        for (int ni = 0; ni < 2; ++ni) acc[mi][ni] = MFMA32(a[mi], b[ni], acc[mi][ni]);
    }
    if (kt + 1 < nk) {
      char* wa = lds + (cur ^ 1) * 32768;
      char* wb = lds + 65536 + (cur ^ 1) * 16384;
#pragma unroll
      for (int i = 0; i < 4; ++i) *(uint4*)(wa + st_off + i * 8192) = ra[i];
#pragma unroll
      for (int i = 0; i < 2; ++i) *(uint4*)(wb + st_off + i * 8192) = rb[i];
    }
    __syncthreads();
  }
}

DI void gemm_store_phase(char* lds, const bf16_t* A, int lda, const bf16_t* Bt, int ldb, int M, int Npad, int K, bf16_t* C, int ldc, int nvalid) {
  const int ntn = Npad / 128, ntm = M / 256;
  const int lane = threadIdx.x & 63, wave = threadIdx.x >> 6, wm = wave >> 1, wn = wave & 1;
  for (int tile = blockIdx.x; tile < ntm * ntn; tile += gridDim.x) {
    const int mt = tile / ntn, nt = tile - mt * ntn;
    f32x16 acc[2][2];
    gemm_tile(lds, A + (size_t)mt * 256 * lda, lda, Bt + (size_t)nt * 128 * ldb, ldb, K, acc);
#pragma unroll
    for (int mi = 0; mi < 2; ++mi)
#pragma unroll
      for (int ni = 0; ni < 2; ++ni) {
        const int col = nt * 128 + wn * 64 + ni * 32 + (lane & 31);
        if (col < nvalid) {
#pragma unroll
          for (int r = 0; r < 16; ++r) {
            const int row = mt * 256 + wm * 64 + mi * 32 + ACC_ROW(r, lane);
            C[(size_t)row * ldc + col] = f2bf(acc[mi][ni][r]);
          }
        }
      }
  }
}

namespace pg8 {
typedef float f32x4 __attribute__((ext_vector_type(4)));
typedef unsigned u32x4 __attribute__((ext_vector_type(4)));
constexpr int BM = 256, BK = 64, HALF = 128, HTB = HALF * BK * 2, STAGE_BYTES = 8 * HTB, NXCD = 8, WGM = 8;
DI int lds_byte(int r, int c) { const int st = (r >> 4) * 2 + (c >> 5), rr = r & 15, cc = c & 31, ob = rr * 64 + cc * 2; return st * 1024 + (ob ^ (((ob >> 9) & 1) << 5)); }
DI void stage_rc(int b, int& R_, int& C_) { const int st = b / 1024, sb = b % 1024, swz = sb ^ (((sb >> 9) & 1) << 5); R_ = (st >> 1) * 16 + swz / 64; C_ = (st & 1) * 32 + (swz % 64) / 2; }
DI int perm32(int rho) { const int n = rho >> 4, i = rho & 15; return 8 * (i >> 2) + 4 * n + (i & 3); }
struct Unit { int pm, pn; };
struct Gemm { const bf16_t* A; const bf16_t* Bt; int lda, K; int headmajor; };
struct Order {
  int nM, nN, nwg, G, c, skipctx;
  DI void init(int nM_, int nN_, int G_, int c_, int skipctx_) { nM = nM_; nN = nN_; nwg = nM * nN; G = G_; c = c_; skipctx = skipctx_; }
  DI bool next(int i, Unit& u) const {
    const long L = (long)i * G + c; if (L >= nwg) return false;
    int wgid = (int)L; { const int q = nwg / NXCD, r = nwg % NXCD, xcd = wgid % NXCD, off = wgid / NXCD; wgid = (xcd < r ? xcd * (q + 1) : r * (q + 1) + (xcd - r) * q) + off; }
    const int nig = WGM * nN, gid = wgid / nig, fm = gid * WGM, gsz = (nM - fm) < WGM ? (nM - fm) : WGM;
    int pm = fm + ((wgid % nig) % gsz); u.pn = (wgid % nig) / gsz;
    if (skipctx) pm = (pm >> 4) * 17 + 1 + (pm & 15);
    u.pm = pm; return true;
  }
};
template <class Epi>
DI void gemm_phase(char* lds_generic, const Gemm g, const Order& S, const Epi& E) {
  LAS unsigned char* lds = (LAS unsigned char*)lds_generic;
  const int tid = threadIdx.x, wid = __builtin_amdgcn_readfirstlane(tid >> 6), lane = tid & 63, wr = wid >> 2, wc = wid & 3, fr = lane & 15, fq = lane >> 4;
  const int K = g.K, nt = K / BK, lda = g.lda;
  unsigned voffA[2], voffB[2];
#pragma unroll
  for (int i = 0; i < 2; ++i) { int R_, C_; stage_rc(tid * 16 + i * 8192, R_, C_); const int Rb = Epi::PERM ? ((R_ & ~31) + perm32(R_ & 31)) : R_;
    voffA[i] = (unsigned)(R_ * lda + C_) * 2u; voffB[i] = (unsigned)(Rb * K + C_) * 2u; }
  const size_t kstep = (size_t)(BK * 2);
  const size_t kstepA = g.headmajor ? (size_t)TPB * 64 * 2 : kstep;
  const size_t hstepA = (size_t)HALF * lda * 2, hstepB = (size_t)HALF * K * 2;
  const size_t tstepB = 2 * hstepB;
#define PG8_ABASE(pm_) ((const char*)g.A + (g.headmajor ? ((size_t)((pm_) / 17) * 32 * TPB + (size_t)((pm_) % 17) * 256) * 128 : (size_t)(pm_) * 2 * hstepA))
  const unsigned ldsw = (unsigned)wid * 1024u;
  const int aoff = lds_byte(wr * 64 + fr, fq * 8), boff = lds_byte(wc * 32 + fr, fq * 8);
#define PG8_SA(b, h) (((b) * 2 + (h)) * HTB)
#define PG8_SB(b, h) ((4 + (b) * 2 + (h)) * HTB)
#define PG8_STAGE(bufoff, gbase, voff) do { _Pragma("unroll") for (int _i = 0; _i < 2; ++_i) \
    __builtin_amdgcn_global_load_lds((const unsigned*)((const char*)(gbase) + (voff)[_i]), (LAS unsigned*)(lds + (bufoff) + ldsw + _i * 8192), 16, 0, 0); } while (0)
#define PG8_LDA(dst, b, h) do { _Pragma("unroll") for (int m = 0; m < 4; ++m) _Pragma("unroll") for (int k = 0; k < 2; ++k) dst[m][k] = *(const LAS bf16x8*)(lds + PG8_SA(b, h) + aoff + m * 2048 + k * 1024); } while (0)
#define PG8_LDB(dst, b, h) do { _Pragma("unroll") for (int n = 0; n < 2; ++n) _Pragma("unroll") for (int k = 0; k < 2; ++k) dst[n][k] = *(const LAS bf16x8*)(lds + PG8_SB(b, h) + boff + n * 2048 + k * 1024); } while (0)
#define PG8_MMA(ai, bj, At, Bt) do { __builtin_amdgcn_s_setprio(1); _Pragma("unroll") for (int m = 0; m < 4; ++m) _Pragma("unroll") for (int n = 0; n < 2; ++n) _Pragma("unroll") for (int k = 0; k < 2; ++k) \
    acc[ai][bj][m][n] = __builtin_amdgcn_mfma_f32_16x16x32_bf16(Bt[n][k], At[m][k], acc[ai][bj][m][n], 0, 0, 0); __builtin_amdgcn_s_setprio(0); } while (0)
#define PG8_WAIT_V(n) asm volatile("s_waitcnt vmcnt(" #n ")" ::: "memory")
#define PG8_WAIT_L(n) asm volatile("s_waitcnt lgkmcnt(" #n ")" ::: "memory")
#define PG8_BAR __builtin_amdgcn_s_barrier()
#define PG8_SCHED __builtin_amdgcn_sched_barrier(0)
  Unit cur, nxt; int ui = 0;
  if (!S.next(0, cur)) return;
  f32x4 acc[2][2][4][2];
#pragma unroll
  for (int a = 0; a < 2; ++a)
#pragma unroll
    for (int b = 0; b < 2; ++b)
#pragma unroll
      for (int m = 0; m < 4; ++m)
#pragma unroll
        for (int n = 0; n < 2; ++n) acc[a][b][m][n] = (f32x4){0.f, 0.f, 0.f, 0.f};
  bf16x8 At[4][2], B0[2][2], B1[2][2];
  const char* cA = PG8_ABASE(cur.pm); const char* cB = (const char*)g.Bt + (size_t)cur.pn * tstepB;
  PG8_STAGE(PG8_SB(0, 0), cB, voffB); PG8_STAGE(PG8_SA(0, 0), cA, voffA); PG8_STAGE(PG8_SB(0, 1), cB + hstepB, voffB); PG8_STAGE(PG8_SA(0, 1), cA + hstepA, voffA);
  if (wr == 1) PG8_BAR;
  PG8_WAIT_V(4); PG8_BAR;
  PG8_STAGE(PG8_SB(1, 0), cB + kstep, voffB); PG8_STAGE(PG8_SA(1, 0), cA + kstepA, voffA); PG8_STAGE(PG8_SB(1, 1), cB + hstepB + kstep, voffB);
  PG8_WAIT_V(6); PG8_BAR;
  for (;;) {
    const bool has_next = S.next(ui + 1, nxt);
    const char* nA = has_next ? PG8_ABASE(nxt.pm) : cA; const char* nB = has_next ? (const char*)g.Bt + (size_t)nxt.pn * tstepB : cB;
    for (int t = 0; t < nt; t += 2) {
      const bool last = (t == nt - 2);
      const char* a1 = cA + (size_t)(t + 1) * kstepA;
      const char* a2 = last ? nA : cA + (size_t)(t + 2) * kstepA; const char* b2 = last ? nB : cB + (size_t)(t + 2) * kstep;
      const char* a3 = a2 + kstepA; const char* b3 = b2 + kstep;
      PG8_LDB(B0, 0, 0); PG8_SCHED; PG8_LDA(At, 0, 0); PG8_STAGE(PG8_SA(1, 1), a1 + hstepA, voffA);
      PG8_WAIT_L(8); PG8_BAR; PG8_WAIT_L(0); PG8_MMA(0, 0, At, B0); PG8_BAR; PG8_SCHED;
      PG8_LDB(B1, 0, 1); PG8_STAGE(PG8_SB(0, 0), b2, voffB);
      PG8_BAR; PG8_WAIT_L(0); PG8_MMA(0, 1, At, B1); PG8_BAR;
      PG8_LDA(At, 0, 1); PG8_STAGE(PG8_SA(0, 0), a2, voffA);
      PG8_BAR; PG8_WAIT_L(0); PG8_MMA(1, 0, At, B0); PG8_BAR; PG8_SCHED;
      PG8_STAGE(PG8_SB(0, 1), b2 + hstepB, voffB);
      PG8_WAIT_V(6); PG8_BAR; PG8_MMA(1, 1, At, B1); PG8_BAR;
      PG8_LDB(B0, 1, 0); PG8_SCHED; PG8_LDA(At, 1, 0); PG8_STAGE(PG8_SA(0, 1), a2 + hstepA, voffA);
      PG8_WAIT_L(8); PG8_BAR; PG8_WAIT_L(0); PG8_MMA(0, 0, At, B0); PG8_BAR; PG8_SCHED;
      PG8_LDB(B1, 1, 1); PG8_STAGE(PG8_SB(1, 0), b3, voffB);
      PG8_BAR; PG8_WAIT_L(0); PG8_MMA(0, 1, At, B1); PG8_BAR;
      PG8_LDA(At, 1, 1); PG8_STAGE(PG8_SA(1, 0), a3, voffA);
      PG8_BAR; PG8_WAIT_L(0); PG8_MMA(1, 0, At, B0); PG8_BAR; PG8_SCHED;
      PG8_STAGE(PG8_SB(1, 1), b3 + hstepB, voffB);
      PG8_WAIT_V(6); PG8_BAR; PG8_MMA(1, 1, At, B1); PG8_BAR;
    }
    E(acc, cur, wr, wc, fr, fq);
    if (!has_next) break;
#pragma unroll
    for (int a = 0; a < 2; ++a)
#pragma unroll
      for (int b = 0; b < 2; ++b)
#pragma unroll
        for (int m = 0; m < 4; ++m)
#pragma unroll
          for (int n = 0; n < 2; ++n) acc[a][b][m][n] = (f32x4){0.f, 0.f, 0.f, 0.f};
    cur = nxt; cA = nA; cB = nB; ++ui;
  }
  PG8_WAIT_V(0);
  if (wr == 0) PG8_BAR;
  PG8_BAR;
#undef PG8_ABASE
#undef PG8_SA
#undef PG8_SB
#undef PG8_STAGE
#undef PG8_LDA
#undef PG8_LDB
#undef PG8_MMA
#undef PG8_WAIT_V
#undef PG8_WAIT_L
#undef PG8_BAR
#undef PG8_SCHED
}

struct EpiBf16 {
  static constexpr bool PERM = true;
  bf16_t* O; int ldc, nvalid;
  DI void operator()(const f32x4 (&acc)[2][2][4][2], const Unit& u, int wr, int wc, int fr, int fq) const {
    const int row0 = u.pm * BM + wr * 64 + fr, col0 = u.pn * BM + wc * 32 + 8 * fq;
#pragma unroll
    for (int ai = 0; ai < 2; ++ai)
#pragma unroll
      for (int m = 0; m < 4; ++m) { bf16_t* rowp = O + (size_t)(row0 + ai * HALF + m * 16) * ldc + col0;
#pragma unroll
        for (int bj = 0; bj < 2; ++bj) if (col0 + bj * HALF < nvalid) {
          const f32x4 v0 = acc[ai][bj][m][0], v1 = acc[ai][bj][m][1];
          u32x4 w; w.x = pack_bf2(v0[0], v0[1]); w.y = pack_bf2(v0[2], v0[3]); w.z = pack_bf2(v1[0], v1[1]); w.w = pack_bf2(v1[2], v1[3]);
          *(u32x4*)(rowp + bj * HALF) = w; } }
  }
};
struct EpiP0 {
  static constexpr bool PERM = true;
  bf16_t* O; const float2* rope;
  DI void operator()(const f32x4 (&acc)[2][2][4][2], const Unit& u, int wr, int wc, int fr, int fq) const {
    const int row0 = u.pm * BM + wr * 64 + fr, col0 = u.pn * BM + wc * 32 + 8 * fq;
    const bool isctx = (u.pm % 17) == 0; const int b = u.pm / 17;
    const bool qk = u.pn < 4;
    const float qs = (u.pn < 2) ? 0.125f * 1.4426950408889634f : 1.f;
    const int a = wc & 1, half = fq >> 1, f0 = 8 * (fq & 1);
#pragma unroll
    for (int ai = 0; ai < 2; ++ai)
#pragma unroll
      for (int m = 0; m < 4; ++m) {
        const int row = row0 + ai * HALF + m * 16;
        bf16_t* rowp = O + (size_t)row * P0LD + col0;
        const int l = row - b * TPB - CTXL;
#pragma unroll
        for (int bj = 0; bj < 2; ++bj) if (col0 + bj * HALF < P0LD) {
          float v[8];
#pragma unroll
          for (int j = 0; j < 4; ++j) { v[j] = acc[ai][bj][m][0][j]; v[4 + j] = acc[ai][bj][m][1][j]; }
          if (qk) {
            float pv[8];
#pragma unroll
            for (int j = 0; j < 8; ++j) pv[j] = __shfl_xor(v[j], 32);
            if (!isctx) {
              const float4* cs4 = (const float4*)(rope + (size_t)l * 32 + a * 16 + f0);
#pragma unroll
              for (int j2 = 0; j2 < 4; ++j2) {
                const float4 cs = cs4[j2];
                v[2 * j2] = half ? (v[2 * j2] * cs.x + pv[2 * j2] * cs.y) : (v[2 * j2] * cs.x - pv[2 * j2] * cs.y);
                v[2 * j2 + 1] = half ? (v[2 * j2 + 1] * cs.z + pv[2 * j2 + 1] * cs.w) : (v[2 * j2 + 1] * cs.z - pv[2 * j2 + 1] * cs.w);
              }
            }
#pragma unroll
            for (int j = 0; j < 8; ++j) v[j] *= qs;
          }
          u32x4 w; w.x = pack_bf2(v[0], v[1]); w.y = pack_bf2(v[2], v[3]); w.z = pack_bf2(v[4], v[5]); w.w = pack_bf2(v[6], v[7]);
          *(u32x4*)(rowp + bj * HALF) = w; } }
  }
};
struct EpiResid {
  static constexpr bool PERM = false;
  const float* x_in; const float* ctx_in; float* out; float* xc; const float* mods; int layer;
  DI void operator()(const f32x4 (&acc)[2][2][4][2], const Unit& u, int wr, int wc, int fr, int fq) const {
    const int row0 = u.pm * BM + wr * 64 + fr, col0 = u.pn * BM + wc * 32 + 4 * fq;
    const bool isctx = (u.pm % 17) == 0; const int b = u.pm / 17;
    const float* gate = mods + (isctx ? 8 : b) * 6144 + 2 * 1024 + col0;
    f32x4 gv[2][2];
#pragma unroll
    for (int bj = 0; bj < 2; ++bj)
#pragma unroll
      for (int n = 0; n < 2; ++n) gv[bj][n] = *(const f32x4*)(gate + bj * HALF + n * 16);
#pragma unroll
    for (int ai = 0; ai < 2; ++ai)
#pragma unroll
      for (int m = 0; m < 4; ++m) {
        const int row = row0 + ai * HALF + m * 16;
        const int t = row - b * TPB;
        const size_t o = isctx ? ((size_t)(b * CTXL + t)) * D + col0 : ((size_t)(b * SEQ + t - CTXL)) * D + col0;
        const float* src = isctx ? ctx_in : ((layer == 0) ? x_in : out);
        float* dst = isctx ? xc : out;
#pragma unroll
        for (int bj = 0; bj < 2; ++bj)
#pragma unroll
          for (int n = 0; n < 2; ++n) {
            const f32x4 xi = *(const f32x4*)(src + o + bj * HALF + n * 16);
            *(f32x4*)(dst + o + bj * HALF + n * 16) = xi + gv[bj][n] * acc[ai][bj][m][n];
          }
      }
  }
};
struct EpiDelta {
  static constexpr bool PERM = true;
  bf16_t* O; const float* mods;
  DI void operator()(const f32x4 (&acc)[2][2][4][2], const Unit& u, int wr, int wc, int fr, int fq) const {
    const int row0 = u.pm * BM + wr * 64 + fr, col0 = u.pn * BM + wc * 32 + 8 * fq;
    const bool isctx = (u.pm % 17) == 0; const int b = u.pm / 17;
    const float* gate = mods + (isctx ? 8 : b) * 6144 + 2 * 1024 + col0;
    f32x4 g0[2], g1[2];
#pragma unroll
    for (int bj = 0; bj < 2; ++bj) { g0[bj] = *(const f32x4*)(gate + bj * HALF); g1[bj] = *(const f32x4*)(gate + bj * HALF + 4); }
#pragma unroll
    for (int ai = 0; ai < 2; ++ai)
#pragma unroll
      for (int m = 0; m < 4; ++m) { bf16_t* rowp = O + (size_t)(row0 + ai * HALF + m * 16) * D + col0;
#pragma unroll
        for (int bj = 0; bj < 2; ++bj) {
          const f32x4 v0 = acc[ai][bj][m][0] * g0[bj], v1 = acc[ai][bj][m][1] * g1[bj];
          u32x4 w; w.x = pack_bf2(v0[0], v0[1]); w.y = pack_bf2(v0[2], v0[3]); w.z = pack_bf2(v1[0], v1[1]); w.w = pack_bf2(v1[2], v1[3]);
          *(u32x4*)(rowp + bj * HALF) = w; } }
  }
};
struct EpiP1 {
  static constexpr bool PERM = true;
  unsigned char* pb;
  DI void operator()(const f32x4 (&acc)[2][2][4][2], const Unit& u, int wr, int wc, int fr, int fq) const {
    unsigned zo = 0;
    asm volatile("" : "+v"(zo));
    const int row0 = u.pm * BM + wr * 64 + fr, col0 = u.pn * BM + wc * 32 + 8 * fq;
    const int b = u.pm / 17;
    const unsigned t0 = (unsigned)(row0 - b * TPB) + zo;
#pragma unroll
    for (int bj = 0; bj < 2; ++bj) {
      const int c = col0 + bj * HALF;
      if (c >= P1LD) continue;
      unsigned off, tstride;
      if (c < 2048) { off = (unsigned)L1_ZH + ((unsigned)(b * 32 + (c >> 6)) * TPB) * 128u + (unsigned)(c & 63) * 2u; tstride = 128u; }
      else if (c < 4096) { const int cc = c - 2048; off = (unsigned)L1_XH + ((unsigned)(b * 32 + (cc >> 6)) * TPB) * 128u + (unsigned)(cc & 63) * 2u; tstride = 128u; }
      else if (c < 4608) { const int cc = c - 4096; off = (unsigned)L1_BG + ((unsigned)(b * 4 + (cc >> 7)) * TPB) * 256u + (unsigned)(cc & 127) * 2u; tstride = 256u; }
      else if (c < 5120) { const int cc = c - 4608; off = (unsigned)L1_CG + ((unsigned)(b * 4 + (cc >> 7)) * TPB) * 256u + (unsigned)(cc & 127) * 2u; tstride = 256u; }
      else { off = (unsigned)L1_DT + (unsigned)b * TPB * 128u + (unsigned)(c - 5120) * 2u; tstride = 128u; }
      off += t0 * tstride;
#pragma unroll
      for (int ai = 0; ai < 2; ++ai)
#pragma unroll
        for (int m = 0; m < 4; ++m) {
          const f32x4 v0 = acc[ai][bj][m][0], v1 = acc[ai][bj][m][1];
          u32x4 w; w.x = pack_bf2(v0[0], v0[1]); w.y = pack_bf2(v0[2], v0[3]); w.z = pack_bf2(v1[0], v1[1]); w.w = pack_bf2(v1[2], v1[3]);
          *(u32x4*)(pb + off + (unsigned)(ai * HALF + m * 16) * tstride) = w;
        }
    }
  }
};
}

DI void transpose_tile(char* lds, const float* __restrict__ src, int K, int N, bf16_t* __restrict__ dst, int tile) {
  float* T = (float*)lds;
  const int ntk = K / 64;
  const int tn = tile / ntk, tk = tile - tn * ntk;
  const int tid = threadIdx.x;
  __syncthreads();
#pragma unroll
  for (int i = 0; i < 2; ++i) {
    const int kk = (tid >> 4) + 32 * i, n4 = (tid & 15) * 4;
    const int n = tn * 64 + n4;
    float4 v = make_float4(0.f, 0.f, 0.f, 0.f);
    if (n < N) v = *(const float4*)(src + (size_t)(tk * 64 + kk) * N + n);
    *(float4*)(T + kk * 68 + n4) = v;
  }
  __syncthreads();
  {
    const int nn = tid & 63, kc = tid >> 6;
    float f[8];
#pragma unroll
    for (int j = 0; j < 8; ++j) f[j] = T[(kc * 8 + j) * 68 + nn];
    *(uint4*)(dst + (size_t)(tn * 64 + nn) * K + tk * 64 + kc * 8) = pack8(f);
  }
}

DI void phase_prep(const P& p, char* lds) {
  const int tid = threadIdx.x;
  unsigned char* ws = p.ws;
  struct TD { int idx; int K, N, Npad; size_t dst; size_t srcoff; };
  int base = 0;
  const int G = gridDim.x;
#define TRANSPOSE_TASK(SRC, KK, NN, NPAD, DST) { const int nt_ = ((NPAD) / 64) * ((KK) / 64); \
    for (int w = blockIdx.x; w < nt_; w += G) transpose_tile(lds, (SRC), (KK), (NN), (bf16_t*)(DST), w); }
  TRANSPOSE_TASK(p.in[I_WIN0], 1024, 3456, 3584, ws + WS_WIN0T)
  TRANSPOSE_TASK(p.in[I_WOUT0], 1024, 1024, 1024, ws + WS_WOUT0T)
  TRANSPOSE_TASK(p.in[I_PQ0], 1024, 2048, 2048, ws + WS_PQ0T)
  TRANSPOSE_TASK(p.in[I_WIN1], 1024, 5184, 5376, ws + WS_WIN1T)
  TRANSPOSE_TASK(p.in[I_WOUT1], 2048, 1024, 1024, ws + WS_WOUT1T)
  TRANSPOSE_TASK(p.in[I_PQ1], 1024, 2048, 2048, ws + WS_PQ1T)
  TRANSPOSE_TASK(p.in[I_RWW2], 64, 512, 512, ws + WS_RWT)
  TRANSPOSE_TASK(p.in[I_RWW2] + 64 * 512, 64, 512, 512, ws + WS_RWT + 65536)
  TRANSPOSE_TASK(p.in[I_RWA2], 64, 512, 512, ws + WS_RWT + 131072)
  TRANSPOSE_TASK(p.in[I_RWA2] + 64 * 512, 64, 512, 512, ws + WS_RWT + 196608)
  TRANSPOSE_TASK(p.in[I_RWG2], 128, 512, 512, ws + WS_RWT + 262144)
  (void)base;
  {
    const int gt = blockIdx.x * NTHR + tid, gs = G * NTHR;
    bf16_t* k0 = (bf16_t*)(ws + WS_KEYS0); bf16_t* k1 = (bf16_t*)(ws + WS_KEYS1);
    for (int i = gt; i < 262144; i += gs) { k0[i] = f2bf(p.in[I_PK0][i]); k1[i] = f2bf(p.in[I_PK1][i]); }
    float2* rope = (float2*)(ws + WS_ROPE);
    for (int i = gt; i < 4096 * 32; i += gs) {
      const int l = i >> 5, a = (i >> 4) & 1, f = i & 15;
      const float inv = powf(10000.f, -(float)f / 16.f);
      const float pos = (float)(a == 0 ? (l >> 6) : (l & 63));
      float s, c; sincosf(pos * inv, &s, &c);
      rope[i] = make_float2(c, s);
    }
    if (gt == 0) {
      const float* lp = p.in[I_DALAM];
      float s01 = 0.f, s23 = 0.f;
      for (int i = 0; i < 64; ++i) { s01 += lp[i] * lp[64 + i]; s23 += lp[128 + i] * lp[192 + i]; }
      ((float*)(ws + WS_SCAL))[0] = expf(s01) - expf(s23) + 0.2f;
    }
  }
  {
    float* sc = (float*)lds;
    float* red = (float*)(lds + 36864);
    __syncthreads();
    for (int e = tid; e < 9 * 1024; e += NTHR) { const int r = e >> 10, k = e & 1023; const float v = (r < 8) ? p.in[I_C][r * 1024 + k] : p.in[I_CCTX][k]; sc[e] = siluf_(v); }
    __syncthreads();
    float* mods = (float*)(ws + WS_MODS);
    for (int w = blockIdx.x; w < 192; w += G) {
      const int l = w / 96, j0 = (w % 96) * 64;
      const float* aw = p.in[l == 0 ? I_ADAW0 : I_ADAW1];
      const float* ab = p.in[l == 0 ? I_ADAB0 : I_ADAB1];
      const int col = tid & 63, kg = tid >> 6;
      float a[9];
#pragma unroll
      for (int r = 0; r < 9; ++r) a[r] = 0.f;
      for (int k = kg * 128; k < kg * 128 + 128; ++k) {
        const float wv = aw[(size_t)k * 6144 + j0 + col];
#pragma unroll
        for (int r = 0; r < 9; ++r) a[r] += sc[r * 1024 + k] * wv;
      }
      __syncthreads();
#pragma unroll
      for (int r = 0; r < 9; ++r) red[(kg * 64 + col) * 9 + r] = a[r];
      __syncthreads();
      for (int e = tid; e < 64 * 9; e += NTHR) {
        const int c2 = e / 9, r = e - c2 * 9;
        float s = ab[j0 + c2];
        for (int g = 0; g < 8; ++g) s += red[(g * 64 + c2) * 9 + r];
        mods[((size_t)l * 9 + r) * 6144 + j0 + c2] = s;
      }
    }
  }
}

DI float wave_max(float x) {
  x = fmaxf(x, dpp_f<0xB1>(x)); x = fmaxf(x, dpp_f<0x4E>(x)); x = fmaxf(x, dpp_f<0x141>(x)); x = fmaxf(x, dpp_f<0x140>(x));
  x = fmaxf(x, __shfl_xor(x, 16)); x = fmaxf(x, __shfl_xor(x, 32)); return x;
}
DI void convert_tables(const P& p, int layer) {
  const int lane = threadIdx.x & 63, gw = blockIdx.x * 8 + (threadIdx.x >> 6), nw = gridDim.x * 8;
  const float* u = p.in[layer == 0 ? I_PU0 : I_PU1];
  const float* v = p.in[layer == 0 ? I_PV0 : I_PV1];
  unsigned char* du = p.ws + WS_HB + HB_U;
  unsigned char* dv = p.ws + WS_HB + HB_V;
  float* su = (float*)(p.ws + WS_HB + HB_SU);
  float* sv = (float*)(p.ws + WS_HB + HB_SV);
  for (int row = gw; row < 32768; row += nw) {
    const bool isv = row >= 16384;
    const int r = row & 16383;
    const float* src = (isv ? v : u) + (size_t)r * D + lane * 16;
    float x[16];
#pragma unroll
    for (int i = 0; i < 4; ++i) { const float4 f = *(const float4*)(src + i * 4); x[i * 4] = f.x; x[i * 4 + 1] = f.y; x[i * 4 + 2] = f.z; x[i * 4 + 3] = f.w; }
    float am = 0.f, ss = 0.f;
#pragma unroll
    for (int i = 0; i < 16; ++i) { am = fmaxf(am, fabsf(x[i])); ss += x[i] * x[i]; }
    am = fmaxf(wave_max(am), 1e-30f);
    ss = red64(ss);
    const float step = fminf(am * (1.f / 7.5f), fmaxf(0.3352f * sqrtf(ss * (1.f / 1024.f)), 1e-30f));
    const float inv = 1.f / step;
    unsigned w[2];
#pragma unroll
    for (int d2 = 0; d2 < 2; ++d2) {
      unsigned pk = 0;
#pragma unroll
      for (int j = 0; j < 8; ++j) {
        int q = (int)rintf(x[d2 * 8 + j] * inv + 7.5f);
        q = q < 0 ? 0 : (q > 15 ? 15 : q);
        pk |= (unsigned)q << (8 * (j >> 1) + 4 * (j & 1));
      }
      w[d2] = pk;
    }
    *(uint2*)((isv ? dv : du) + (size_t)r * 512 + lane * 8) = make_uint2(w[0], w[1]);
    if (lane == 0) (isv ? sv : su)[r] = step;
  }
}

DI void phase_normmod(const P& p, int layer, int which, bool from_inputs, bool lat_only, bf16_t* dst, const bf16_t* delta = nullptr) {
  const int lane = threadIdx.x & 63, gw = blockIdx.x * 8 + (threadIdx.x >> 6), nw = gridDim.x * 8;
  const float* g = p.in[layer == 0 ? (which == 0 ? I_N1_0 : I_N2_0) : (which == 0 ? I_N1_1 : I_N2_1)];
  const float* mods = (const float*)(p.ws + WS_MODS) + (size_t)layer * 9 * 6144;
  const float* xc = (const float*)(p.ws + WS_XC);
  float4 nx[4]; uint4 nd[2];
#define NM_SRC(ROW) ((((ROW) % TPB) < CTXL) ? ((from_inputs ? p.in[I_CTX] : xc) + ((size_t)(((ROW) / TPB) * CTXL + ((ROW) % TPB))) * D) \
                                             : ((from_inputs ? p.in[I_X] : p.out) + ((size_t)(((ROW) / TPB) * SEQ + ((ROW) % TPB) - CTXL)) * D))
#define NM_LOAD(ROW) do { if (!(lat_only && ((ROW) % TPB) < CTXL)) { const float* s_ = NM_SRC(ROW); \
      _Pragma("unroll") for (int i = 0; i < 4; ++i) nx[i] = *(const float4*)(s_ + lane * 16 + i * 4); \
      if (delta) { nd[0] = *(const uint4*)(delta + (size_t)(ROW) * D + lane * 16); nd[1] = *(const uint4*)(delta + (size_t)(ROW) * D + lane * 16 + 8); } } } while (0)
  if (gw < R) NM_LOAD(gw);
  for (int row = gw; row < R; row += nw) {
    const int b = row / TPB, t = row - b * TPB;
    const bool isctx = t < CTXL;
    float v[16]; uint4 dcur0 = nd[0], dcur1 = nd[1];
#pragma unroll
    for (int i = 0; i < 4; ++i) { v[i * 4] = nx[i].x; v[i * 4 + 1] = nx[i].y; v[i * 4 + 2] = nx[i].z; v[i * 4 + 3] = nx[i].w; }
    if (row + nw < R) NM_LOAD(row + nw);
    if (isctx && lat_only) continue;
    const float* mrow = mods + (isctx ? 8 : b) * 6144 + (which == 0 ? 0 : 3 * 1024);
    if (delta) {
      float dl[8];
      unpack8(dcur0, dl);
#pragma unroll
      for (int i = 0; i < 8; ++i) v[i] += dl[i];
      unpack8(dcur1, dl);
#pragma unroll
      for (int i = 0; i < 8; ++i) v[8 + i] += dl[i];
      float* xo = isctx ? ((float*)(p.ws + WS_XC) + ((size_t)(b * CTXL + t)) * D) : (p.out + ((size_t)(b * SEQ + t - CTXL)) * D);
#pragma unroll
      for (int i = 0; i < 4; ++i) *(float4*)(xo + lane * 16 + i * 4) = make_float4(v[i * 4], v[i * 4 + 1], v[i * 4 + 2], v[i * 4 + 3]);
    }
    float ss = 0.f;
#pragma unroll
    for (int i = 0; i < 16; ++i) ss += v[i] * v[i];
    ss = red64(ss);
    const float rs = rsqrtf(ss * (1.f / 1024.f) + 1e-6f);
    float o[16];
#pragma unroll
    for (int i = 0; i < 16; ++i) { const int c = lane * 16 + i; o[i] = v[i] * rs * g[c] * (1.f + mrow[1024 + c]) + mrow[c]; }
    uint4 w0, w1;
    w0.x = pack_bf2(o[0], o[1]); w0.y = pack_bf2(o[2], o[3]); w0.z = pack_bf2(o[4], o[5]); w0.w = pack_bf2(o[6], o[7]);
    w1.x = pack_bf2(o[8], o[9]); w1.y = pack_bf2(o[10], o[11]); w1.z = pack_bf2(o[12], o[13]); w1.w = pack_bf2(o[14], o[15]);
    *(uint4*)(dst + (size_t)row * D + lane * 16) = w0;
    *(uint4*)(dst + (size_t)row * D + lane * 16 + 8) = w1;
  }
#undef NM_SRC
#undef NM_LOAD
}

DI void phase_final_norm(const P& p) {
  const int lane = threadIdx.x & 63, gw = blockIdx.x * 8 + (threadIdx.x >> 6), nw = gridDim.x * 8;
  const float* g = p.in[I_NF];
  for (int row = gw; row < NB * SEQ; row += nw) {
    float* src = p.out + (size_t)row * D;
    float v[16];
#pragma unroll
    for (int i = 0; i < 4; ++i) { const float4 f = *(const float4*)(src + lane * 16 + i * 4); v[i * 4] = f.x; v[i * 4 + 1] = f.y; v[i * 4 + 2] = f.z; v[i * 4 + 3] = f.w; }
    float ss = 0.f;
#pragma unroll
    for (int i = 0; i < 16; ++i) ss += v[i] * v[i];
    ss = red64(ss);
    const float rs = rsqrtf(ss * (1.f / 1024.f) + 1e-6f);
#pragma unroll
    for (int i = 0; i < 4; ++i) {
      const int c = lane * 16 + i * 4;
      float4 f; f.x = v[i * 4] * rs * g[c]; f.y = v[i * 4 + 1] * rs * g[c + 1]; f.z = v[i * 4 + 2] * rs * g[c + 2]; f.w = v[i * 4 + 3] * rs * g[c + 3];
      *(float4*)(src + c) = f;
    }
  }
}

typedef __attribute__((ext_vector_type(4))) short s16x4;
DI s16x4 tr_read(const char* p) { return __builtin_amdgcn_ds_read_tr16_b64_v4i16((__attribute__((address_space(3))) s16x4*)(p)); }

DI void attn_flash_unit(const P& p, char* lds, int unit) {
  const int tid = threadIdx.x, lane = tid & 63, wave = tid >> 6;
  const bool isctx = unit >= 1024;
  int b, h, qb;
  if (!isctx) { b = unit >> 7; h = (unit >> 5) & 3; qb = unit & 31; } else { const int u = unit - 1024; b = u >> 3; h = (u >> 1) & 3; qb = u & 1; }
  const int nkt = isctx ? CTXL / 64 : TPB / 64;
  const bf16_t* p0 = (const bf16_t*)(p.ws + WS_PB + PB_P);
  const float lam = ((const float*)(p.ws + WS_SCAL))[0];
  const int qg = wave >> 1, m = wave & 1;
  const int r31 = lane & 31, hh = lane >> 5;
  const int ql = qb * 128 + qg * 32 + r31;
  const size_t qrow = (size_t)b * TPB + (isctx ? ql : CTXL + ql);
  bf16x8 qf[4];
#pragma unroll
  for (int kk = 0; kk < 4; ++kk) qf[kk] = *(const bf16x8*)(p0 + qrow * P0LD + h * 128 + m * 64 + kk * 16 + 8 * hh);
  const int skey = tid >> 4, scc = tid & 15;
  const bf16_t* kg = p0 + ((size_t)b * TPB + skey) * P0LD + 512 + h * 128 + scc * 8;
  const bf16_t* vg = kg + 512;
  const int koff = (scc >> 3) * 8192 + skey * 128 + ((((scc & 7) ^ (skey >> 1)) & 7) << 4);
  const int voff = 16384 + skey * 320 + scc * 16;
  constexpr int BUFSZ = 36864;
  uint4 rk[2], rv[2];
  __syncthreads();
#pragma unroll
  for (int i = 0; i < 2; ++i) { rk[i] = *(const uint4*)(kg + (size_t)i * 32 * P0LD); rv[i] = *(const uint4*)(vg + (size_t)i * 32 * P0LD); }
#pragma unroll
  for (int i = 0; i < 2; ++i) { *(uint4*)(lds + koff + i * 4096) = rk[i]; *(uint4*)(lds + voff + i * 10240) = rv[i]; }
  __syncthreads();
  f32x16 o[4];
#pragma unroll
  for (int v = 0; v < 4; ++v)
#pragma unroll
    for (int r = 0; r < 16; ++r) o[v][r] = 0.f;
  float mrun = -1e30f, lsum = 0.f;
  const int q4 = (lane & 15) >> 2;
  const int vboff = ((lane >> 4) & 1) * 32 + 8 * (lane & 3);
  for (int kt = 0; kt < nkt; ++kt) {
    const int cur = kt & 1;
    if (kt + 1 < nkt) {
#pragma unroll
      for (int i = 0; i < 2; ++i) { rk[i] = *(const uint4*)(kg + (size_t)((kt + 1) * 64 + i * 32) * P0LD); rv[i] = *(const uint4*)(vg + (size_t)((kt + 1) * 64 + i * 32) * P0LD); }
    }
    const char* kb = lds + cur * BUFSZ + m * 8192;
    const char* vb = lds + cur * BUFSZ + 16384;
    f32x16 s[2];
#pragma unroll
    for (int t = 0; t < 2; ++t)
#pragma unroll
      for (int r = 0; r < 16; ++r) s[t][r] = 0.f;
#pragma unroll
    for (int kk = 0; kk < 4; ++kk)
#pragma unroll
      for (int t = 0; t < 2; ++t) {
        const int row = t * 32 + r31;
        const bf16x8 a = *(const bf16x8*)(kb + row * 128 + ((((kk * 2 + hh) ^ (row >> 1)) & 7) << 4));
        s[t] = MFMA32(a, qf[kk], s[t]);
      }
    float mx = s[0][0];
#pragma unroll
    for (int t = 0; t < 2; ++t)
#pragma unroll
      for (int r = 0; r < 16; ++r) mx = fmaxf(mx, s[t][r]);
    mx = fmaxf(mx, __shfl_xor(mx, 32));
    const float mnew = fmaxf(mrun, mx);
    const float corr = __builtin_amdgcn_exp2f(mrun - mnew);
    mrun = mnew;
    lsum *= corr;
#pragma unroll
    for (int v = 0; v < 4; ++v)
#pragma unroll
      for (int r = 0; r < 16; ++r) o[v][r] *= corr;
#pragma unroll
    for (int t = 0; t < 2; ++t)
#pragma unroll
      for (int r = 0; r < 16; ++r) { const float e = __builtin_amdgcn_exp2f(s[t][r] - mnew); s[t][r] = e; lsum += e; }
#pragma unroll
    for (int t = 0; t < 2; ++t)
#pragma unroll
      for (int st = 0; st < 2; ++st) {
        unsigned pk[4];
#pragma unroll
        for (int j = 0; j < 4; ++j) pk[j] = pack_bf2(s[t][8 * st + 2 * j], s[t][8 * st + 2 * j + 1]);
        bf16x8 bp;
        { typedef __attribute__((ext_vector_type(4))) unsigned u32x4; u32x4 u = {pk[0], pk[1], pk[2], pk[3]}; bp = __builtin_bit_cast(bf16x8, u); }
        const int key0 = t * 32 + 16 * st + 4 * hh + q4;
#pragma unroll
        for (int v = 0; v < 4; ++v) {
          const s16x4 lo = tr_read(vb + key0 * 320 + v * 64 + vboff);
          const s16x4 hi = tr_read(vb + (key0 + 8) * 320 + v * 64 + vboff);
          const bf16x8 av = __builtin_shufflevector(lo, hi, 0, 1, 2, 3, 4, 5, 6, 7);
          o[v] = MFMA32(av, bp, o[v]);
        }
      }
    if (kt + 1 < nkt) {
      char* nb = lds + (cur ^ 1) * BUFSZ;
#pragma unroll
      for (int i = 0; i < 2; ++i) { *(uint4*)(nb + koff + i * 4096) = rk[i]; *(uint4*)(nb + voff + i * 10240) = rv[i]; }
    }
    __syncthreads();
  }
  lsum += __shfl_xor(lsum, 32);
  const float inv = 1.f / lsum;
  float* Ex = (float*)lds;
  if (m == 1) {
#pragma unroll
    for (int v = 0; v < 4; ++v)
#pragma unroll
      for (int r = 0; r < 16; ++r) Ex[(qg * 128 + v * 32 + ACC_ROW(r, lane)) * 32 + r31] = o[v][r] * inv;
  }
  __syncthreads();
  if (m == 0) {
    float ss = 0.f;
#pragma unroll
    for (int v = 0; v < 4; ++v)
#pragma unroll
      for (int r = 0; r < 16; ++r) { const float dv = o[v][r] * inv - lam * Ex[(qg * 128 + v * 32 + ACC_ROW(r, lane)) * 32 + r31]; o[v][r] = dv; ss += dv * dv; }
    ss += __shfl_xor(ss, 32);
    const float rs = rsqrtf(ss * (1.f / 128.f) + 1e-6f) * 0.8f;
    const float* sub = p.in[I_DASUB];
    bf16_t* op = (bf16_t*)(p.ws + WS_PB + PB_O0) + qrow * 1024 + h * 128;
#pragma unroll
    for (int v = 0; v < 4; ++v)
#pragma unroll
      for (int g4 = 0; g4 < 4; ++g4) {
        const int vd = v * 32 + 8 * g4 + 4 * hh;
        uint2 w;
        w.x = pack_bf2(o[v][g4 * 4] * rs * sub[vd], o[v][g4 * 4 + 1] * rs * sub[vd + 1]);
        w.y = pack_bf2(o[v][g4 * 4 + 2] * rs * sub[vd + 2], o[v][g4 * 4 + 3] * rs * sub[vd + 3]);
        *(uint2*)(op + vd) = w;
      }
  }
  __syncthreads();
}

DI void phase_ga(const P& p) {
  const bf16_t* p0 = (const bf16_t*)(p.ws + WS_PB + PB_P);
  bf16_t* ga = (bf16_t*)(p.ws + WS_PB + PB_GA);
  const float* mu = p.in[I_RWMU] + 1792;
  for (int i = blockIdx.x * NTHR + threadIdx.x; i < R * 16; i += gridDim.x * NTHR) {
    const int row = i >> 4, c8 = (i & 15) * 8;
    const int t = row % TPB;
    const bool first = (t == 0) || (t == CTXL), last = (t == CTXL - 1) || (t == TPB - 1);
    const bf16_t* sp = p0 + (size_t)row * P0LD + 1536 + 1792 + c8;
    float u[8], um[8], up[8];
    unpack8(*(const uint4*)sp, u);
    if (!first) unpack8(*(const uint4*)(sp - P0LD), um); else { for (int j = 0; j < 8; ++j) um[j] = 0.f; }
    if (!last) unpack8(*(const uint4*)(sp + P0LD), up); else { for (int j = 0; j < 8; ++j) up[j] = 0.f; }
    float o[8];
#pragma unroll
    for (int j = 0; j < 8; ++j) { const float mix = u[j] + mu[c8 + j] * (0.5f * (um[j] + up[j]) - u[j]); o[j] = sigmoidf_(mix); }
    *(uint4*)(ga + (size_t)row * 128 + c8) = pack8(o);
  }
}

DI int scan_token(int d, int s) { return d == 0 ? s : (s < CTXL ? (CTXL - 1 - s) : (TPB + CTXL - 1 - s)); }

typedef __attribute__((ext_vector_type(4))) float f32x4_t;
DI void rwkv_scan_unit(const P& p, char* lds, int unit) {
  int tid_ = threadIdx.x;
  asm volatile("" : "+v"(tid_));
  const int tid = tid_, lane = tid & 63, wave = __builtin_amdgcn_readfirstlane(tid >> 6);
  const int half = unit & 1, d = (unit >> 1) & 1, h = (unit >> 2) & 7, b = unit >> 5;
  constexpr int T = 32, NCHK = TPB / T, BUFB = 45056;
  const bf16_t* p0 = (const bf16_t*)(p.ws + WS_PB + PB_P);
  __syncthreads();
  {
    const bf16_t* w2t = (const bf16_t*)(p.ws + WS_RWT + (size_t)d * 65536) + h * 64 * 64;
    const bf16_t* a2t = (const bf16_t*)(p.ws + WS_RWT + 131072 + (size_t)d * 65536) + h * 64 * 64;
    *(uint4*)(lds + 139264 + tid * 16) = *(const uint4*)(w2t + tid * 8);
    *(uint4*)(lds + 147456 + tid * 16) = *(const uint4*)(a2t + tid * 8);
    float* LC = (float*)(lds + 155648);
    for (int e = tid; e < 640; e += NTHR) {
      const int g = e >> 6, cidx = e & 63;
      float v;
      if (g == 0) v = p.in[I_RWW0][d * 512 + h * 64 + cidx];
      else if (g == 1) v = p.in[I_RWA0][d * 512 + h * 64 + cidx];
      else if (g == 2) v = p.in[I_RWKK][h * 64 + cidx];
      else if (g == 3) v = p.in[I_RWKA][h * 64 + cidx];
      else if (g == 4) v = p.in[I_RWRK][h * 64 + cidx];
      else if (g < 8) v = p.in[I_RWMU][(g - 5) * 512 + h * 64 + cidx];
      else v = p.in[I_RWMU][(g == 8 ? 1536 : 1664) + d * 64 + cidx];
      LC[e] = v;
    }
  }
  __syncthreads();
  if (wave < 4) {
    const int rp = tid >> 4, c16 = tid & 15, c4 = c16 * 4;
    typedef float f32x2 __attribute__((ext_vector_type(2)));
    f32x2 S0a = {0.f, 0.f}, S0b = {0.f, 0.f}, S1a = {0.f, 0.f}, S1b = {0.f, 0.f};
    bf16_t* yout = (bf16_t*)(p.ws + WS_HB + (d == 0 ? HB_YF : HB_YB)) + h * 64 + half * 32 + wave * 8 + (lane & 7);
    SEGR_DECL();
    __syncthreads();
    SEGR_INIT();
    for (int c = 0; c < NCHK; ++c) {
      int zo = 0;
      asm volatile("" : "+v"(zo));
      const char* B0 = lds + (c & 1) * BUFB + zo;
      float* Lyp = (float*)(lds + 122880 + zo);
      const float* La = (const float*)B0 + c4; const float* Lb = (const float*)(B0 + 8192) + c4; const float* Lk = (const float*)(B0 + 16384) + c4;
      const float* Lw = (const float*)(B0 + 24576) + c4; const float* Lr = (const float*)(B0 + 32768) + c4; const float* Lv = (const float*)(B0 + 40960) + rp * 2;
#define RW_LD(s_, A_, B_, K_, W_, R_, V_) const float4 A_ = *(const float4*)(La + (s_) * 64), B_ = *(const float4*)(Lb + (s_) * 64), K_ = *(const float4*)(Lk + (s_) * 64), \
          W_ = *(const float4*)(Lw + (s_) * 64), R_ = *(const float4*)(Lr + (s_) * 64); const float2 V_ = *(const float2*)(Lv + (s_) * 32)
      float4 a4, b4, k4, w4, r4, a4n, b4n, k4n, w4n, r4n; float2 v2, v2n;
      { RW_LD(0, xa, xb, xk, xw, xr, xv); a4 = xa; b4 = xb; k4 = xk; w4 = xw; r4 = xr; v2 = xv; }
      { RW_LD(1, xa, xb, xk, xw, xr, xv); a4n = xa; b4n = xb; k4n = xk; w4n = xw; r4n = xr; v2n = xv; }
#pragma unroll 1
      for (int g8 = 0; g8 < 4; ++g8) {
#pragma unroll
        for (int si = 0; si < 8; ++si) {
          const int s2 = (g8 * 8 + si + 2) & 31;
          RW_LD(s2, a4f, b4f, k4f, w4f, r4f, v2f);
          const f32x2 a01 = {a4.x, a4.y}, a23 = {a4.z, a4.w}, b01 = {b4.x, b4.y}, b23 = {b4.z, b4.w}, k01 = {k4.x, k4.y}, k23 = {k4.z, k4.w};
          const f32x2 w01 = {w4.x, w4.y}, w23 = {w4.z, w4.w}, r01 = {r4.x, r4.y}, r23 = {r4.z, r4.w};
          const f32x2 t0 = S0a * a01 + S0b * a23, t1 = S1a * a01 + S1b * a23;
          float sa0 = t0.x + t0.y, sa1 = t1.x + t1.y;
          const f32x2 vv0 = {v2.x, v2.x}, vv1 = {v2.y, v2.y};
          const f32x2 u0a = S0a * w01 + vv0 * k01, u0b = S0b * w23 + vv0 * k23, u1a = S1a * w01 + vv1 * k01, u1b = S1b * w23 + vv1 * k23;
          sa0 = red16(sa0); sa1 = red16(sa1);
          const f32x2 s0 = {sa0, sa0}, s1 = {sa1, sa1};
          S0a = s0 * b01 + u0a; S0b = s0 * b23 + u0b; S1a = s1 * b01 + u1a; S1b = s1 * b23 + u1b;
          const f32x2 y0 = S0a * r01 + S0b * r23, y1 = S1a * r01 + S1b * r23;
          Lyp[(si * 32 + rp * 2) * 16 + c16] = y0.x + y0.y;
          Lyp[(si * 32 + rp * 2 + 1) * 16 + c16] = y1.x + y1.y;
          a4 = a4n; b4 = b4n; k4 = k4n; w4 = w4n; r4 = r4n; v2 = v2n;
          a4n = a4f; b4n = b4f; k4n = k4f; w4n = w4f; r4n = r4f; v2n = v2f;
        }
        __builtin_amdgcn_wave_barrier();
        asm volatile("s_waitcnt lgkmcnt(0)" ::: "memory");
        {
          const int sj = lane >> 3, ri = lane & 7;
          const float4* pp = (const float4*)(Lyp + (sj * 32 + wave * 8 + ri) * 16);
          const float4 q0 = pp[0], q1 = pp[1], q2 = pp[2], q3 = pp[3];
          const float ysum = ((q0.x + q0.y) + (q0.z + q0.w)) + ((q1.x + q1.y) + (q1.z + q1.w)) + ((q2.x + q2.y) + (q2.z + q2.w)) + ((q3.x + q3.y) + (q3.z + q3.w));
          const int t = scan_token(d, c * T + g8 * 8 + sj);
          yout[((size_t)b * TPB + t) * 512] = f2bf(ysum);
        }
        asm volatile("s_waitcnt lgkmcnt(0)" ::: "memory");
        __builtin_amdgcn_wave_barrier();
      }
      SEGR_ADD(0);
      __syncthreads();
      SEGR_ADD(1);
    }
    SEGR_FLUSH(0);
  } else {
    const int pw = wave - 4;
    const int tok = lane >> 3, cg8 = (lane & 7) * 8;
    const int colsb[5] = {h * 64 + cg8, 512 + h * 64 + cg8, 1024 + h * 64 + cg8, 1536 + d * 64 + cg8, 1664 + d * 64 + cg8};
    const int n16 = lane & 15, q16 = lane >> 4;
    float* bonus = (float*)(p.ws + WS_PB + PB_BONUS) + (size_t)d * R * 8;
    uint4 raw[5][3];
    float fm = 1.f, fp_ = 1.f;
#define RW_ISSUE(CH) do { \
      const int t_ = scan_token(d, (CH) * T + pw * 8 + tok); \
      const bool first_ = (t_ == 0) || (t_ == CTXL), last_ = (t_ == CTXL - 1) || (t_ == TPB - 1); \
      fm = first_ ? 0.f : 1.f; fp_ = last_ ? 0.f : 1.f; \
      const bf16_t* rowp_ = p0 + ((size_t)b * TPB + t_) * P0LD + 1536; \
      const bf16_t* rowm_ = first_ ? rowp_ : rowp_ - P0LD; \
      const bf16_t* rowq_ = last_ ? rowp_ : rowp_ + P0LD; \
      _Pragma("unroll") for (int g_ = 0; g_ < 5; ++g_) { raw[g_][0] = *(const uint4*)(rowm_ + colsb[g_]); raw[g_][1] = *(const uint4*)(rowp_ + colsb[g_]); raw[g_][2] = *(const uint4*)(rowq_ + colsb[g_]); } \
    } while (0)
    RW_ISSUE(0);
    SEGR_DECL();
    SEGR_INIT();
    for (int c = 0; c < NCHK; ++c) {
      int zo = 0;
      asm volatile("" : "+v"(zo));
      char* PS = lds + 90112 + pw * 8192 + zo;
      float* Pk = (float*)PS; bf16_t* PA = (bf16_t*)(PS + 2048); bf16_t* PBa = (bf16_t*)(PS + 4096); float* Pinv = (float*)(PS + 6144);
      const float* LCc = (const float*)(lds + 155648 + zo);
      char* B0 = lds + (c & 1) * BUFB + zo;
      float* La = (float*)B0; float* Lb = (float*)(B0 + 8192); float* Lk = (float*)(B0 + 16384);
      float* Lw = (float*)(B0 + 24576); float* Lr = (float*)(B0 + 32768); float* Lv = (float*)(B0 + 40960);
      const int sl = pw * 8 + tok;
      {
#define RW_MIX(G, OUT) do { float u_[8], um_[8], up_[8]; unpack8(raw[G][1], u_); unpack8(raw[G][0], um_); unpack8(raw[G][2], up_); \
          const float4 m0_ = *(const float4*)(LCc + (5 + G) * 64 + cg8), m1_ = *(const float4*)(LCc + (5 + G) * 64 + cg8 + 4); \
          const float mm_[8] = {m0_.x, m0_.y, m0_.z, m0_.w, m1_.x, m1_.y, m1_.z, m1_.w}; \
          _Pragma("unroll") for (int j = 0; j < 8; ++j) OUT[j] = u_[j] + mm_[j] * (0.5f * (fm * um_[j] + fp_ * up_[j]) - u_[j]); } while (0)
        float mx[8];
        RW_MIX(0, mx);
        *(float4*)(Lr + sl * 64 + cg8) = make_float4(mx[0], mx[1], mx[2], mx[3]);
        *(float4*)(Lr + sl * 64 + cg8 + 4) = make_float4(mx[4], mx[5], mx[6], mx[7]);
        RW_MIX(2, mx);
        if ((cg8 >> 5) == half) {
          *(float4*)(Lv + sl * 32 + (cg8 & 31)) = make_float4(mx[0], mx[1], mx[2], mx[3]);
          *(float4*)(Lv + sl * 32 + (cg8 & 31) + 4) = make_float4(mx[4], mx[5], mx[6], mx[7]);
        }
        RW_MIX(3, mx);
        {
          float tw[8];
#pragma unroll
          for (int j = 0; j < 8; ++j) tw[j] = 1.f - 2.f * frcp_(1.f + __expf(2.f * mx[j]));
          *(uint4*)(PA + tok * 64 + cg8) = pack8(tw);
        }
        RW_MIX(4, mx);
        *(uint4*)(PBa + tok * 64 + cg8) = pack8(mx);
        RW_MIX(1, mx);
        *(float4*)(Pk + tok * 64 + cg8) = make_float4(mx[0], mx[1], mx[2], mx[3]);
        *(float4*)(Pk + tok * 64 + cg8 + 4) = make_float4(mx[4], mx[5], mx[6], mx[7]);
        float nrm = 0.f;
        {
          const float4 q0 = *(const float4*)(LCc + 2 * 64 + cg8), q1 = *(const float4*)(LCc + 2 * 64 + cg8 + 4);
          const float kk8[8] = {q0.x, q0.y, q0.z, q0.w, q1.x, q1.y, q1.z, q1.w};
#pragma unroll
          for (int j = 0; j < 8; ++j) { const float kq = mx[j] * kk8[j]; nrm += kq * kq; }
        }
        nrm = red8(nrm);
        if ((lane & 7) == 0) Pinv[tok] = __builtin_amdgcn_rsqf(fmaxf(nrm, 1e-24f));
        if (c + 1 < NCHK) RW_ISSUE(c + 1);
#undef RW_MIX
      }
      __builtin_amdgcn_wave_barrier();
      asm volatile("s_waitcnt lgkmcnt(0)" ::: "memory");
      SEGR_ADD(2);
      {
        float bon[2] = {0.f, 0.f};
        const int hq = lane >> 5, qq = (lane >> 4) & 1;
#pragma unroll
        for (int gsel = 0; gsel < 2; ++gsel) {
          const bf16_t* Asrc = (gsel == 0 ? PA : PBa) + n16 * 64 + q16 * 8;
          const bf16_t* Wsrc = (const bf16_t*)(lds + (gsel == 0 ? 139264 : 147456) + zo) + n16 * 64 + q16 * 8;
#pragma unroll
          for (int nt = 0; nt < 4; ++nt) {
            f32x4_t acc = {0.f, 0.f, 0.f, 0.f};
#pragma unroll
            for (int ks = 0; ks < 2; ++ks) {
              const bf16x8 af = *(const bf16x8*)(Asrc + ks * 32);
              const bf16x8 bf = *(const bf16x8*)(Wsrc + nt * 16 * 64 + ks * 32);
              acc = __builtin_amdgcn_mfma_f32_16x16x32_bf16(af, bf, acc, 0, 0, 0);
            }
            float xv[2];
            xv[0] = __uint_as_float(__builtin_amdgcn_permlane32_swap(__float_as_uint(acc[0]), __float_as_uint(acc[2]), false, false)[0]);
            xv[1] = __uint_as_float(__builtin_amdgcn_permlane32_swap(__float_as_uint(acc[1]), __float_as_uint(acc[3]), false, false)[0]);
            const int col = nt * 16 + n16;
            const float bias = LCc[gsel * 64 + col];
            const float kkc_ = LCc[2 * 64 + col], kac_ = LCc[3 * 64 + col], rkc_ = LCc[4 * 64 + col];
#pragma unroll
            for (int r = 0; r < 2; ++r) {
              const int tk = qq * 4 + hq * 2 + r, so = (pw * 8 + tk) * 64 + col;
              if (gsel == 0) { Lw[so] = __expf(-0.6065306597126334f * sigmoidf_(xv[r] + bias)); }
              else {
                const float as = sigmoidf_(xv[r] + bias);
                const float k = Pk[tk * 64 + col];
                const float kkv = k * kkc_ * Pinv[tk];
                La[so] = -kkv; Lb[so] = kkv * as;
                const float kd = k * (1.f + (as - 1.f) * kac_);
                Lk[so] = kd;
                bon[r] += Lr[so] * kd * rkc_;
              }
            }
          }
        }
#pragma unroll
        for (int r = 0; r < 2; ++r) bon[r] = red16(bon[r]);
        if (half == 0 && n16 == 0) {
#pragma unroll
          for (int r = 0; r < 2; ++r) {
            const int t = scan_token(d, c * T + pw * 8 + qq * 4 + hq * 2 + r);
            bonus[((size_t)b * TPB + t) * 8 + h] = bon[r];
          }
        }
      }
      SEGR_ADD(3);
      __syncthreads();
      SEGR_ADD(1);
    }
#if defined(PROBE_A) && PROBE_GRP == 1
    if (blockIdx.x == 0 && threadIdx.x == 256) { for (int j__ = 1; j__ < 4; ++j__) ((unsigned long long*)(p.ws + WS_SCAL + 1024))[22 + 4 + j__] += seg_acc_[j__]; }
#endif
    __syncthreads();
#undef RW_ISSUE
  }
}

DI void phase_rwkv_post(const P& p) {
  const bf16_t* p0 = (const bf16_t*)(p.ws + WS_PB + PB_P);
  const bf16_t* yf = (const bf16_t*)(p.ws + WS_HB + HB_YF);
  const bf16_t* yb = (const bf16_t*)(p.ws + WS_HB + HB_YB);
  const bf16_t* G = (const bf16_t*)(p.ws + WS_PB + PB_G);
  const float* bonus = (const float*)(p.ws + WS_PB + PB_BONUS);
  bf16_t* o0 = (bf16_t*)(p.ws + WS_PB + PB_O0);
  const float* mu = p.in[I_RWMU] + 1024;
  const int sub = threadIdx.x & 7;
  for (int it = (blockIdx.x * NTHR + threadIdx.x) >> 3; it < R * 8; it += (gridDim.x * NTHR) >> 3) {
    const int row = it >> 3, h = it & 7;
    const int t = row % TPB;
    const bool first = (t == 0) || (t == CTXL), last = (t == CTXL - 1) || (t == TPB - 1);
    const int cc = h * 64 + sub * 8;
    float y[8], a[8], bb[8];
    unpack8(*(const uint4*)(yf + (size_t)row * 512 + cc), a);
    unpack8(*(const uint4*)(yb + (size_t)row * 512 + cc), bb);
    float mean = 0.f;
#pragma unroll
    for (int j = 0; j < 8; ++j) { y[j] = a[j] + bb[j]; mean += y[j]; }
    mean = red8(mean) * (1.f / 64.f);
    float var = 0.f;
#pragma unroll
    for (int j = 0; j < 8; ++j) { const float dlt = y[j] - mean; var += dlt * dlt; }
    var = red8(var) * (1.f / 64.f);
    const float rs = rsqrtf(var + 64e-5f);
    const float bn = bonus[(size_t)row * 8 + h] + bonus[(size_t)R * 8 + (size_t)row * 8 + h];
    const bf16_t* vp = p0 + (size_t)row * P0LD + 1536 + 1024 + cc;
    float u[8], um[8], up[8], g[8], o[8];
    unpack8(*(const uint4*)vp, u);
    unpack8(*(const uint4*)(first ? vp : vp - P0LD), um);
    unpack8(*(const uint4*)(last ? vp : vp + P0LD), up);
    unpack8(*(const uint4*)(G + (size_t)row * 512 + cc), g);
    const float fm = first ? 0.f : 1.f, fp_ = last ? 0.f : 1.f;
#pragma unroll
    for (int j = 0; j < 8; ++j) {
      const float v = u[j] + mu[cc + j] * (0.5f * (fm * um[j] + fp_ * up[j]) - u[j]);
      const float yn = (y[j] - mean) * rs * p.in[I_LNXW][cc + j] + p.in[I_LNXB][cc + j];
      o[j] = (yn + bn * v) * g[j];
    }
    *(uint4*)(o0 + (size_t)row * 1024 + 512 + cc) = pack8(o);
  }
}

DI unsigned f2ord(float f) { const unsigned u = __float_as_uint(f); return u ^ ((u >> 31) ? 0xFFFFFFFFu : 0x80000000u); }
DI float ord2f(unsigned u) { u ^= ((u >> 31) ? 0x80000000u : 0xFFFFFFFFu); return __uint_as_float(u); }

DI void bitonic_sort16_desc(unsigned (&v)[16]) {
#pragma unroll
  for (int k = 2; k <= 16; k <<= 1)
#pragma unroll
    for (int j = k >> 1; j > 0; j >>= 1)
#pragma unroll
      for (int i = 0; i < 16; ++i) {
        const int l = i ^ j;
        if (l > i) { const unsigned hi = max(v[i], v[l]), lo = min(v[i], v[l]); const bool desc = ((i & k) == 0); v[i] = desc ? hi : lo; v[l] = desc ? lo : hi; }
      }
}
DI void merge_top16_desc(unsigned (&a)[16], const unsigned (&b)[16]) {
#pragma unroll
  for (int i = 0; i < 16; ++i) a[i] = max(a[i], b[15 - i]);
#pragma unroll
  for (int j = 8; j > 0; j >>= 1)
#pragma unroll
    for (int i = 0; i < 16; ++i) { const int l = i ^ j; if (l > i) { const unsigned hi = max(a[i], a[l]), lo = min(a[i], a[l]); a[i] = hi; a[l] = lo; } }
}
struct CandPairs { int ia[25], ja[25], ib[25], jb[25]; };
constexpr CandPairs make_pairs() {
  CandPairs c{};
  int n = 0;
  for (int i = 0; i < 16; ++i) for (int j = 0; j < 16; ++j) if ((i + 1) * (j + 1) <= 16) {
    if ((n & 1) == 0) { c.ia[n >> 1] = i; c.ja[n >> 1] = j; } else { c.ib[n >> 1] = i; c.jb[n >> 1] = j; }
    ++n;
  }
  return c;
}
constexpr CandPairs CP = make_pairs();

DI void peer_topk_unit(const P& p, char* lds, int layer, int unit) {
  const int tid = threadIdx.x, lane = tid & 63, wave = tid >> 6;
  const int mt = unit >> 3, h = unit & 7;
  const bf16_t* q = (const bf16_t*)(p.ws + WS_PB + PB_Q);
  const bf16_t* keys = (const bf16_t*)(p.ws + (layer == 0 ? WS_KEYS0 : WS_KEYS1)) + (size_t)h * 2 * 128 * 128;
  int* idxo = (int*)(p.ws + WS_PB + PB_IDX);
  float* gateo = (float*)(p.ws + WS_PB + PB_GATE);
  __syncthreads();
  for (int e = tid; e < 2 * 128 * 16; e += NTHR) {
    const int pp = e >> 11, row = (e >> 4) & 127, c = e & 15;
    *(uint4*)(lds + pp * 32768 + row * 256 + ((c ^ (row & 15)) << 4)) = *(const uint4*)(keys + (size_t)pp * 16384 + row * 128 + c * 8);
  }
  __syncthreads();
  const int r31 = lane & 31, hh = lane >> 5;
  const size_t trow = (size_t)mt * 256 + wave * 32 + r31;
  unsigned vk[2][16];
#pragma unroll
  for (int pp = 0; pp < 2; ++pp) {
    f32x16 acc[4];
#pragma unroll
    for (int m = 0; m < 4; ++m)
#pragma unroll
      for (int r = 0; r < 16; ++r) acc[m][r] = 0.f;
    const bf16_t* qp = q + trow * 2048 + (h * 2 + pp) * 128;
#pragma unroll
    for (int kk = 0; kk < 8; ++kk) {
      const bf16x8 bq = *(const bf16x8*)(qp + kk * 16 + 8 * hh);
      const int c = kk * 2 + hh;
#pragma unroll
      for (int m = 0; m < 4; ++m) {
        const int row = m * 32 + r31;
        const bf16x8 ak = *(const bf16x8*)(lds + pp * 32768 + row * 256 + ((c ^ (row & 15)) << 4));
        acc[m] = MFMA32(ak, bq, acc[m]);
      }
    }
    unsigned v[16];
#pragma unroll
    for (int m = 0; m < 4; ++m) {
      unsigned kx[16];
#pragma unroll
      for (int r = 0; r < 16; ++r) kx[r] = (f2ord(acc[m][r]) & ~127u) | (unsigned)(127 - (m * 32 + ACC_ROW(r, lane)));
      bitonic_sort16_desc(kx);
      if (m == 0) {
#pragma unroll
        for (int i = 0; i < 16; ++i) v[i] = kx[i];
      } else merge_top16_desc(v, kx);
    }
    unsigned c16[16];
#pragma unroll
    for (int i = 0; i < 16; ++i) c16[i] = (unsigned)__shfl_xor((int)v[i], 32);
    merge_top16_desc(v, c16);
#pragma unroll
    for (int i = 0; i < 16; ++i) vk[pp][i] = v[i];
  }
  float val1[16], val2[16]; int id1[16], id2[16];
#pragma unroll
  for (int i = 0; i < 16; ++i) {
    val1[i] = ord2f(vk[0][i] & ~127u); id1[i] = 127 - (int)(vk[0][i] & 127u);
    val2[i] = ord2f(vk[1][i] & ~127u); id2[i] = 127 - (int)(vk[1][i] & 127u);
  }
  unsigned tk[16];
#pragma unroll
  for (int t = 0; t < 16; ++t) {
    const float va = val1[CP.ia[t]] + val2[CP.ja[t]], vb = val1[CP.ib[t]] + val2[CP.jb[t]];
    const int pa = id1[CP.ia[t]] * 128 + id2[CP.ja[t]], pb = id1[CP.ib[t]] * 128 + id2[CP.jb[t]];
    tk[t] = (f2ord(hh ? vb : va) & ~0x3FFFu) | (unsigned)(hh ? pb : pa);
  }
  bitonic_sort16_desc(tk);
#pragma unroll
  for (int t = 16; t < 25; ++t) {
    const float va = val1[CP.ia[t]] + val2[CP.ja[t]], vb = val1[CP.ib[t]] + val2[CP.jb[t]];
    const int pa = id1[CP.ia[t]] * 128 + id2[CP.ja[t]], pb = id1[CP.ib[t]] * 128 + id2[CP.jb[t]];
    unsigned x = (f2ord(hh ? vb : va) & ~0x3FFFu) | (unsigned)(hh ? pb : pa);
#pragma unroll
    for (int i = 0; i < 16; ++i) { const unsigned hi = max(tk[i], x); x = min(tk[i], x); tk[i] = hi; }
  }
  float cv[16]; int cp[16];
  float mx = -3.0e38f;
#pragma unroll
  for (int i = 0; i < 16; ++i) {
    const unsigned ok = (unsigned)__shfl_xor((int)tk[15 - i], 32);
    const unsigned kk_ = max(tk[i], ok);
    cv[i] = ord2f(kk_ & ~0x3FFFu); cp[i] = (int)(kk_ & 0x3FFFu);
    mx = fmaxf(mx, cv[i]);
  }
  float sum = 0.f;
#pragma unroll
  for (int i = 0; i < 16; ++i) { cv[i] = __expf(cv[i] - mx); sum += cv[i]; }
  const float inv = 1.f / sum;
  if (hh == 0) {
    int* ip = idxo + trow * 128 + h * 16;
    float* gp = gateo + trow * 128 + h * 16;
#pragma unroll
    for (int i = 0; i < 4; ++i) {
      *(int4*)(ip + i * 4) = make_int4(cp[i * 4], cp[i * 4 + 1], cp[i * 4 + 2], cp[i * 4 + 3]);
      *(float4*)(gp + i * 4) = make_float4(cv[i * 4] * inv, cv[i * 4 + 1] * inv, cv[i * 4 + 2] * inv, cv[i * 4 + 3] * inv);
    }
  }
}

DI int wave_sum_i(int x) {
  x += __builtin_amdgcn_update_dpp(0, x, 0xB1, 0xF, 0xF, true);
  x += __builtin_amdgcn_update_dpp(0, x, 0x4E, 0xF, 0xF, true);
  x += __builtin_amdgcn_update_dpp(0, x, 0x141, 0xF, 0xF, true);
  x += __builtin_amdgcn_update_dpp(0, x, 0x140, 0xF, 0xF, true);
  return __builtin_amdgcn_readlane(x, 0) + __builtin_amdgcn_readlane(x, 16) + __builtin_amdgcn_readlane(x, 32) + __builtin_amdgcn_readlane(x, 48);
}
DI int reduce8_transposed(const int (&v)[8], int lane) {
  int x[4], y[2];
#pragma unroll
  for (int j = 0; j < 4; ++j) { const auto r = __builtin_amdgcn_permlane32_swap((unsigned)v[j], (unsigned)v[4 + j], false, false); x[j] = (int)(r[0] + r[1]); }
#pragma unroll
  for (int j = 0; j < 2; ++j) { const auto r = __builtin_amdgcn_permlane16_swap((unsigned)x[j], (unsigned)x[2 + j], false, false); y[j] = (int)(r[0] + r[1]); }
  const bool b3 = (lane >> 3) & 1;
  const int keep = b3 ? y[1] : y[0], send = b3 ? y[0] : y[1];
  int z = keep + __builtin_amdgcn_update_dpp(0, send, 0x128, 0xF, 0xF, true);
  z += __builtin_amdgcn_update_dpp(0, z, 0xB1, 0xF, 0xF, true);
  z += __builtin_amdgcn_update_dpp(0, z, 0x4E, 0xF, 0xF, true);
  z += __builtin_amdgcn_update_dpp(0, z, 0x141, 0xF, 0xF, true);
  return z;
}
DI float gelu_fast(float v) {
  const float av = fabsf(v), t = __builtin_amdgcn_rcpf(av * 0.2316418882f + 1.0f);
  float q = t * 0.5307027145f + (-0.7265760135f); q = q * t + 0.7107068705f; q = q * t + (-0.142248368f); q = q * t + 0.127414796f; q = q * t;
  const float e = __builtin_amdgcn_exp2f((v * v) * (-0.72134752044f));
  const float m = v * (q * e);
  return v < 0.f ? m : v - m;
}
DI int reduce4_half(const int (&v)[4], int lane) {
  int y[2];
#pragma unroll
  for (int j = 0; j < 2; ++j) { const auto r = __builtin_amdgcn_permlane16_swap((unsigned)v[j], (unsigned)v[2 + j], false, false); y[j] = (int)(r[0] + r[1]); }
  const bool b3 = (lane >> 3) & 1;
  const int keep = b3 ? y[1] : y[0], send = b3 ? y[0] : y[1];
  int z = keep + __builtin_amdgcn_update_dpp(0, send, 0x128, 0xF, 0xF, true);
  z += __builtin_amdgcn_update_dpp(0, z, 0xB1, 0xF, 0xF, true);
  z += __builtin_amdgcn_update_dpp(0, z, 0x4E, 0xF, 0xF, true);
  z += __builtin_amdgcn_update_dpp(0, z, 0x141, 0xF, 0xF, true);
  return z;
}
#ifndef PG_VREP
#define PG_VREP 1
#endif
DI void phase_peer_gather(const P& p, int layer) {
  const int lane = threadIdx.x & 63, gw = blockIdx.x * 8 + (threadIdx.x >> 6), nw = gridDim.x * 8;
  const bf16_t* h2 = (const bf16_t*)(p.ws + WS_PB + PB_H2);
  const int* idx = (const int*)(p.ws + WS_PB + PB_IDX);
  const float* gate = (const float*)(p.ws + WS_PB + PB_GATE);
  const unsigned char* U = p.ws + WS_HB + HB_U;
  const unsigned char* V = p.ws + WS_HB + HB_V;
  const float* su = (const float*)(p.ws + WS_HB + HB_SU);
  const float* sv = (const float*)(p.ws + WS_HB + HB_SV);
  const float* mods = (const float*)(p.ws + WS_MODS) + (size_t)layer * 9 * 6144;
  float* xc = (float*)(p.ws + WS_XC);
  const int hs = lane & 31, up = lane >> 5, k4 = (lane >> 3) & 3;
  for (int row = gw; row < R; row += nw) {
    const int b = row / TPB, t = row - b * TPB;
    const bool isctx = t < CTXL;
    if (isctx && layer == 1) continue;
    int hE[4], hO[4]; float sh, hoff;
    {
      float hv[32], f[8];
#pragma unroll
      for (int i = 0; i < 4; ++i) { unpack8(*(const uint4*)(h2 + (size_t)row * D + hs * 32 + i * 8), f);
#pragma unroll
        for (int j = 0; j < 8; ++j) hv[i * 8 + j] = f[j]; }
      float am = 0.f;
#pragma unroll
      for (int j = 0; j < 32; ++j) am = fmaxf(am, fabsf(hv[j]));
      am = fmaxf(wave_max(am), 1e-30f);
      const float inv = 127.f / am;
      sh = am * (1.f / 127.f);
      int hsum = 0;
#pragma unroll
      for (int d4 = 0; d4 < 4; ++d4) {
        unsigned pe = 0, po = 0;
#pragma unroll
        for (int j = 0; j < 4; ++j) {
          const int qe = (int)rintf(hv[d4 * 8 + 2 * j] * inv), qo = (int)rintf(hv[d4 * 8 + 2 * j + 1] * inv);
          hsum += qe + qo;
          pe |= ((unsigned)qe & 0xffu) << (8 * j); po |= ((unsigned)qo & 0xffu) << (8 * j);
        }
        hE[d4] = (int)pe; hO[d4] = (int)po;
      }
      hoff = 7.5f * 0.5f * (float)wave_sum_i(hsum);
    }
    float acc[32];
#pragma unroll
    for (int j = 0; j < 32; ++j) acc[j] = 0.f;
    float corr = 0.f;
    const int my_i0 = idx[(size_t)row * 128 + lane], my_i1 = idx[(size_t)row * 128 + 64 + lane];
    const float my_g0 = gate[(size_t)row * 128 + lane], my_g1 = gate[(size_t)row * 128 + 64 + lane];
#define PG_LOAD(E0, UR, VR, SC) do { _Pragma("unroll") for (int k = 0; k < 4; ++k) { const int e_ = (E0) + 2 * k; \
        const int ea_ = ((E0) < 64) ? __builtin_amdgcn_readlane(my_i0, e_ & 63) : __builtin_amdgcn_readlane(my_i1, e_ & 63); \
        const int eb_ = ((E0) < 64) ? __builtin_amdgcn_readlane(my_i0, (e_ + 1) & 63) : __builtin_amdgcn_readlane(my_i1, (e_ + 1) & 63); \
        const size_t ro_ = (size_t)(up ? eb_ : ea_) * 512 + hs * 16; \
        UR[k] = *(const uint4*)(U + ro_); VR[k] = *(const uint4*)(V + ro_); } \
      { const int es_ = (E0) + 2 * k4 + up; const int ei_ = __shfl(((E0) < 64) ? my_i0 : my_i1, es_ & 63); SC[0] = su[ei_]; SC[1] = sv[ei_]; } } while (0)
#define PG_COMPUTE(E0, UR, VR, SC) do { \
      const int es_ = (E0) + 2 * k4 + up; \
      const float ggA = __shfl(((E0) < 64) ? my_g0 : my_g1, es_ & 63); \
      const float suA = SC[0], svA = SC[1]; \
      int dA[4]; \
      _Pragma("unroll") for (int k = 0; k < 4; ++k) { \
        const unsigned uu[4] = {UR[k].x, UR[k].y, UR[k].z, UR[k].w}; int d = 0; \
        _Pragma("unroll") for (int d4 = 0; d4 < 4; ++d4) { \
          d = __builtin_amdgcn_sdot4(hE[d4], (int)(uu[d4] & 0x0F0F0F0Fu), d, false); \
          d = __builtin_amdgcn_sdot4(hO[d4], (int)((uu[d4] >> 4) & 0x0F0F0F0Fu), d, false); } \
        dA[k] = d; } \
      const int tA = reduce4_half(dA, lane); \
      const float wA = ggA * gelu_fast(((float)tA - hoff) * (sh * suA)) * svA; \
      _Pragma("unroll") for (int k = 0; k < 4; ++k) { \
        const float w0_ = __shfl(wA, (lane & 32) + 8 * k); \
        corr += w0_; \
        const unsigned vv[4] = {VR[k].x, VR[k].y, VR[k].z, VR[k].w}; \
        _Pragma("unroll") for (int rep_ = 0; rep_ < PG_VREP; ++rep_) { const float w = w0_ * (1.f / PG_VREP); \
        _Pragma("unroll") for (int d4 = 0; d4 < 4; ++d4) { \
          unsigned lo = vv[d4] & 0x0F0F0F0Fu, hi = (vv[d4] >> 4) & 0x0F0F0F0Fu; \
          asm volatile("" : "+v"(lo), "+v"(hi));        \
          acc[d4 * 8 + 0] += w * (float)(lo & 0xffu); acc[d4 * 8 + 1] += w * (float)(hi & 0xffu); \
          acc[d4 * 8 + 2] += w * (float)((lo >> 8) & 0xffu); acc[d4 * 8 + 3] += w * (float)((hi >> 8) & 0xffu); \
          acc[d4 * 8 + 4] += w * (float)((lo >> 16) & 0xffu); acc[d4 * 8 + 5] += w * (float)((hi >> 16) & 0xffu); \
          acc[d4 * 8 + 6] += w * (float)(lo >> 24); acc[d4 * 8 + 7] += w * (float)(hi >> 24); } asm volatile("" : "+v"(acc[0])); } } } while (0)
    {
      uint4 urA[4], vrA[4], urB[4], vrB[4];
      float scA[2], scB[2];
      PG_LOAD(0, urA, vrA, scA);
#pragma unroll 1
      for (int e0 = 0; e0 < 128; e0 += 16) {
        PG_LOAD(e0 + 8, urB, vrB, scB);
        PG_COMPUTE(e0, urA, vrA, scA);
        if (e0 + 16 < 128) PG_LOAD(e0 + 16, urA, vrA, scA);
        PG_COMPUTE(e0 + 8, urB, vrB, scB);
      }
    }
#undef PG_LOAD
#undef PG_COMPUTE
    const float c75 = 7.5f * (corr + __shfl_xor(corr, 32));
    float o16[16];
#pragma unroll
    for (int i = 0; i < 16; ++i) {
      const float mine = up ? acc[16 + i] : acc[i], give = up ? acc[i] : acc[16 + i];
      o16[i] = mine + __shfl_xor(give, 32) - c75;
    }
    const int col0 = hs * 32 + up * 16;
    const float* g5 = mods + (isctx ? 8 : b) * 6144 + 5 * 1024 + col0;
    float* xp = isctx ? (xc + ((size_t)(b * CTXL + t)) * D + col0) : (p.out + ((size_t)(b * SEQ + t - CTXL)) * D + col0);
    float xn[16];
    float ssq = 0.f;
#pragma unroll
    for (int i = 0; i < 4; ++i) {
      const float4 x = *(const float4*)(xp + i * 4);
      xn[i * 4] = x.x + g5[i * 4] * o16[i * 4]; xn[i * 4 + 1] = x.y + g5[i * 4 + 1] * o16[i * 4 + 1];
      xn[i * 4 + 2] = x.z + g5[i * 4 + 2] * o16[i * 4 + 2]; xn[i * 4 + 3] = x.w + g5[i * 4 + 3] * o16[i * 4 + 3];
#pragma unroll
      for (int j = 0; j < 4; ++j) ssq += xn[i * 4 + j] * xn[i * 4 + j];
    }
    ssq = red64(ssq);
    const float rs = rsqrtf(ssq * (1.f / 1024.f) + 1e-6f);
    if (layer == 1) {
      const float* gf = p.in[I_NF] + col0;
#pragma unroll
      for (int i = 0; i < 4; ++i)
        *(float4*)(xp + i * 4) = make_float4(xn[i * 4] * rs * gf[i * 4], xn[i * 4 + 1] * rs * gf[i * 4 + 1], xn[i * 4 + 2] * rs * gf[i * 4 + 2], xn[i * 4 + 3] * rs * gf[i * 4 + 3]);
    } else {
#pragma unroll
      for (int i = 0; i < 4; ++i) *(float4*)(xp + i * 4) = make_float4(xn[i * 4], xn[i * 4 + 1], xn[i * 4 + 2], xn[i * 4 + 3]);
      const float* gn1 = p.in[I_N1_1] + col0;
      const float* m1 = mods + 9 * 6144 + (isctx ? 8 : b) * 6144 + col0;
      float hh_[16];
#pragma unroll
      for (int i = 0; i < 16; ++i) hh_[i] = xn[i] * rs * gn1[i] * (1.f + m1[1024 + i]) + m1[i];
      bf16_t* hp = (bf16_t*)(p.ws + WS_HNEXT) + (size_t)row * D + col0;
      uint4 w0, w1;
      w0.x = pack_bf2(hh_[0], hh_[1]); w0.y = pack_bf2(hh_[2], hh_[3]); w0.z = pack_bf2(hh_[4], hh_[5]); w0.w = pack_bf2(hh_[6], hh_[7]);
      w1.x = pack_bf2(hh_[8], hh_[9]); w1.y = pack_bf2(hh_[10], hh_[11]); w1.z = pack_bf2(hh_[12], hh_[13]); w1.w = pack_bf2(hh_[14], hh_[15]);
      *(uint4*)hp = w0; *(uint4*)(hp + 8) = w1;
    }
  }
}

template <int CH>
DI void conv_stream(const P& p, char* lds, bf16_t* base, int pitch  , int chan0  ) {
  const int tid = threadIdx.x;
  constexpr int NT = NTHR / CH;
  constexpr int RPT = TPB / NT;
  const int ck = tid % CH, tl = tid / CH;
  const int t0 = tl * RPT;
  bf16_t* colp = base + ck * 8;
  uint4* halo = (uint4*)lds;
  float w0[8], w1[8], w2[8], bb[8];
#pragma unroll
  for (int j = 0; j < 8; ++j) { const int c = chan0 + ck * 8 + j; w0[j] = p.in[I_CONVW][c]; w1[j] = p.in[I_CONVW][3072 + c]; w2[j] = p.in[I_CONVW][6144 + c]; bb[j] = p.in[I_CONVB][c]; }
  __syncthreads();
  uint4 cur = *(const uint4*)(colp + (size_t)t0 * pitch);
  halo[(tl * 2 + 0) * CH + ck] = cur;
  halo[(tl * 2 + 1) * CH + ck] = *(const uint4*)(colp + (size_t)(t0 + RPT - 1) * pitch);
  __syncthreads();
  uint4 prev = halo[((tl > 0 ? tl - 1 : 0) * 2 + 1) * CH + ck];
  const uint4 nxt_halo = halo[((tl < NT - 1 ? tl + 1 : NT - 1) * 2 + 0) * CH + ck];
  __syncthreads();
  constexpr int UB = (RPT % 4 == 0) ? 4 : 2;
  for (int rb = 0; rb < RPT; rb += UB) {
    uint4 nx[UB];
#pragma unroll
    for (int i = 0; i < UB; ++i) { const int r = rb + i + 1; uint4 v_ = nxt_halo; if (r < RPT) v_ = *(const uint4*)(colp + (size_t)(t0 + r) * pitch); nx[i] = v_; }
#pragma unroll
    for (int i = 0; i < UB; ++i) {
      const int t = t0 + rb + i;
      const bool first = (t == 0) || (t == CTXL), last = (t == CTXL - 1) || (t == TPB - 1);
      float u[8], um[8], up[8], o[8];
      unpack8(cur, u); unpack8(prev, um); unpack8(nx[i], up);
      const float fm = first ? 0.f : 1.f, fp_ = last ? 0.f : 1.f;
#pragma unroll
      for (int j = 0; j < 8; ++j) o[j] = siluf_(w0[j] * (fm * um[j]) + w1[j] * u[j] + w2[j] * (fp_ * up[j]) + bb[j]);
      *(uint4*)(colp + (size_t)t * pitch) = pack8(o);
      prev = cur; cur = nx[i];
    }
  }
}
DI void phase_conv(const P& p, char* lds) {
  unsigned char* pb = p.ws + WS_PB;
  for (int w = blockIdx.x; w < 256; w += gridDim.x) {
    conv_stream<8>(p, lds, (bf16_t*)(pb + L1_XH) + (size_t)w * TPB * 64, 64, (w & 31) * 64);
    const int q = w & 3, sg = (w >> 2) & 31, isC = w >> 7;
    conv_stream<4>(p, lds, (bf16_t*)(pb + (isC ? L1_CG : L1_BG)) + (size_t)sg * TPB * 128 + q * 32, 128, (isC ? 2560 : 2048) + (sg & 3) * 128 + q * 32);
  }
}

DI int swzBC(int row) { return ((row & 3) << 2) | ((row >> 2) & 3); }
DI int swzX(int row) { return ((row >> 1) & 1) << 2; }

DI void ssd_chunk_unit(const P& p, char* lds, int unit) {
  const int tid = threadIdx.x, lane = tid & 63, wave = tid >> 6;
  const int b = unit >> 5, head = unit & 31, grp = head >> 3;
  bf16_t* zh = (bf16_t*)(p.ws + WS_PB + L1_ZH) + (size_t)(b * 32 + head) * TPB * 64;
  const bf16_t* xh = (const bf16_t*)(p.ws + WS_PB + L1_XH) + (size_t)(b * 32 + head) * TPB * 64;
  const bf16_t* bg = (const bf16_t*)(p.ws + WS_PB + L1_BG) + (size_t)(b * 4 + grp) * TPB * 128;
  const bf16_t* cgp_ = (const bf16_t*)(p.ws + WS_PB + L1_CG) + (size_t)(b * 4 + grp) * TPB * 128;
  const bf16_t* dtp = (const bf16_t*)(p.ws + WS_PB + L1_DT) + (size_t)b * TPB * 64;
  bf16_t* yftmp = (bf16_t*)(p.ws + WS_YF) + (size_t)(b * 32 + head) * SEQ * 64;
  const float dsk = p.in[I_DSKIP][head];
  const int r31 = lane & 31, hh = lane >> 5, q4 = (lane & 15) >> 2, grp16 = (lane >> 4) & 1, p3 = lane & 3;
  const int lt = wave >> 1, pt = wave & 1;
  const int cc = tid & 7, rr = tid >> 3;
  const int orow = tid >> 3, ock = tid & 7;
  constexpr int NCH = TPB / 128;
  SEGS_DECL();
  for (int d = 0; d < 2; ++d) {
    const float Aneg = -__expf(p.in[I_ALOG][d * 32 + head]);
    const float dtb = p.in[I_DTB][d * 32 + head];
    f32x16 Hacc;
#pragma unroll
    for (int r = 0; r < 16; ++r) Hacc[r] = 0.f;
    __syncthreads();
    for (int e = tid; e < 1024; e += NTHR) *(uint4*)(lds + 98304 + e * 16) = make_uint4(0, 0, 0, 0);
    uint4 st[2][5];
    float dtr0, dtr1;
    uint4 oyf[2], oz[2];
#define SSD_ISSUE(CH) do { \
      _Pragma("unroll") for (int rh_ = 0; rh_ < 2; ++rh_) { \
        const int t_ = scan_token(d, (CH) * 128 + rh_ * 64 + rr); \
        st[rh_][0] = *(const uint4*)(xh + (size_t)t_ * 64 + cc * 8); \
        st[rh_][1] = *(const uint4*)(bg + (size_t)t_ * 128 + cc * 8); \
        st[rh_][2] = *(const uint4*)(bg + (size_t)t_ * 128 + 64 + cc * 8); \
        st[rh_][3] = *(const uint4*)(cgp_ + (size_t)t_ * 128 + cc * 8); \
        st[rh_][4] = *(const uint4*)(cgp_ + (size_t)t_ * 128 + 64 + cc * 8); \
      } \
      dtr0 = bf2f(dtp[(size_t)scan_token(d, (CH) * 128 + lane) * 64 + d * 32 + head]); \
      dtr1 = bf2f(dtp[(size_t)scan_token(d, (CH) * 128 + 64 + lane) * 64 + d * 32 + head]); \
    } while (0)
    SSD_ISSUE(0);
    SEGS_INIT();
    for (int ch = 0; ch <= NCH; ++ch) {
      int zoff = 0;
      asm volatile("" : "+v"(zoff));
      char* L0 = lds + zoff;
      char* LB = L0; char* LC = L0 + 32768; char* LX = L0 + 65536; char* LXw = L0 + 81920; char* LHs = L0 + 98304;
      float* Lacs = (float*)(L0 + 131072); float* Ldt = (float*)(L0 + 131584); float* Lea = (float*)(L0 + 132096);
      char* LY = L0 + 132608;
      __syncthreads();
      SEGS_ADD(0);
      if (ch - 1 >= CTXL / 128) {
#pragma unroll
        for (int i = 0; i < 2; ++i) {
          const int row = orow + i * 64;
          const int t = scan_token(d, (ch - 1) * 128 + row);
          const uint4 yv = *(const uint4*)(LY + row * 128 + ock * 16);
          if (d == 0) {
            *(uint4*)(yftmp + (size_t)(t - CTXL) * 64 + ock * 8) = yv;
          } else {
            float y[8], yf[8], z[8], o[8];
            unpack8(yv, y); unpack8(oyf[i], yf); unpack8(oz[i], z);
#pragma unroll
            for (int j = 0; j < 8; ++j) o[j] = (yf[j] + y[j]) * siluf_(z[j]);
            *(uint4*)(zh + (size_t)t * 64 + ock * 8) = pack8(o);
          }
        }
      }
      if (ch == NCH) break;
      float dt0, dt1, acs0, acs1, alast;
      {
        dt0 = softplusf_(dtr0 + dtb); dt1 = softplusf_(dtr1 + dtb);
        acs0 = dt0 * Aneg; acs1 = dt1 * Aneg;
#pragma unroll
        for (int off = 1; off < 64; off <<= 1) {
          const float y0 = __shfl_up(acs0, off), y1 = __shfl_up(acs1, off);
          if (lane >= off) { acs0 += y0; acs1 += y1; }
        }
        acs1 += __shfl(acs0, 63);
        alast = __shfl(acs1, 63);
        if (wave == 0) {
          Lacs[lane] = acs0; Lacs[64 + lane] = acs1; Ldt[lane] = dt0; Ldt[64 + lane] = dt1;
          Lea[lane] = __expf(acs0); Lea[64 + lane] = __expf(acs1);
        }
      }
#pragma unroll
      for (int rh = 0; rh < 2; ++rh) {
        const int s_ = rh * 64 + rr;
        const float dts = __shfl(rh ? dt1 : dt0, rr);
        const float ws_ = __expf(alast - __shfl(rh ? acs1 : acs0, rr));
        float xv[8], xw[8];
        unpack8(st[rh][0], xv);
#pragma unroll
        for (int j = 0; j < 8; ++j) { xv[j] *= dts; xw[j] = xv[j] * ws_; }
        const int off = s_ * 128 + ((cc ^ swzX(s_)) << 4);
        *(uint4*)(LX + off) = pack8(xv);
        *(uint4*)(LXw + off) = pack8(xw);
        const int sw = swzBC(s_);
        *(uint4*)(LB + s_ * 256 + ((cc ^ sw) << 4)) = st[rh][1];
        *(uint4*)(LB + s_ * 256 + (((8 + cc) ^ sw) << 4)) = st[rh][2];
        *(uint4*)(LC + s_ * 256 + ((cc ^ sw) << 4)) = st[rh][3];
        *(uint4*)(LC + s_ * 256 + (((8 + cc) ^ sw) << 4)) = st[rh][4];
      }
      SEGS_ADD(1);
      __syncthreads();
      SEGS_ADD(2);
      if (ch + 1 < NCH) SSD_ISSUE(ch + 1);
      if (d == 1 && ch >= CTXL / 128) {
#pragma unroll
        for (int i = 0; i < 2; ++i) {
          const int t = scan_token(d, ch * 128 + orow + i * 64);
          oyf[i] = *(const uint4*)(yftmp + (size_t)(t - CTXL) * 64 + ock * 8);
          oz[i] = *(const uint4*)(zh + (size_t)t * 64 + ock * 8);
        }
      }
      const char* LBz = LB; const char* LCz = LC; const char* LXz = LX; const char* LXwz = LXw;
      const char* Hs = LHs;
      char* LMa = L0 + 114688; char* LMb = L0 + 148992;
      if (ch >= CTXL / 128) {
        f32x16 Y;
#pragma unroll
        for (int r = 0; r < 16; ++r) Y[r] = 0.f;
        const int crow = lt * 32 + r31;
        const char* cbase = LCz + crow * 256;
        const int csw = swzBC(crow);
        {
          const int hrow = pt * 32 + r31;
#pragma unroll 2
          for (int kk = 0; kk < 8; ++kk) {
            const bf16x8 cfk = *(const bf16x8*)(cbase + (((kk * 2 + hh) ^ csw) << 4));
            const bf16x8 hb = *(const bf16x8*)(Hs + hrow * 256 + (((kk * 2 + hh) ^ swzBC(hrow)) << 4));
            Y = MFMA32(cfk, hb, Y);
          }
        }
#pragma unroll
        for (int r = 0; r < 16; ++r) Y[r] *= Lea[lt * 32 + ACC_ROW(r, lane)];
        const int lcol = lt * 32 + r31;
        const float acs_l = Lacs[lcol];
        const float ddiag = (d == 1) ? dsk / Ldt[lcol] : 0.f;
        for (int st_ = pt; st_ <= lt; st_ += 2) {
          f32x16 g;
#pragma unroll
          for (int r = 0; r < 16; ++r) g[r] = 0.f;
          const int row = st_ * 32 + r31;
#pragma unroll 4
          for (int kk = 0; kk < 8; ++kk) {
            const bf16x8 a = *(const bf16x8*)(LBz + row * 256 + (((kk * 2 + hh) ^ swzBC(row)) << 4));
            const bf16x8 cfk = *(const bf16x8*)(cbase + (((kk * 2 + hh) ^ csw) << 4));
            g = MFMA32(a, cfk, g);
          }
#pragma unroll
          for (int r = 0; r < 16; ++r) {
            const int srow = st_ * 32 + ACC_ROW(r, lane);
            const float e = __expf(fminf(acs_l - Lacs[srow], 0.f));
            float val = (srow <= lcol) ? g[r] * e : 0.f;
            if (srow == lcol) val += ddiag;
            g[r] = val;
          }
          const int id = lt * (lt + 1) / 2 + st_;
          char* mt = (id < 8) ? (LMa + id * 2048) : (LMb + (id - 8) * 2048);
#pragma unroll
          for (int k2 = 0; k2 < 2; ++k2) {
            uint4 u; u.x = pack_bf2(g[8 * k2], g[8 * k2 + 1]); u.y = pack_bf2(g[8 * k2 + 2], g[8 * k2 + 3]); u.z = pack_bf2(g[8 * k2 + 4], g[8 * k2 + 5]); u.w = pack_bf2(g[8 * k2 + 6], g[8 * k2 + 7]);
            *(uint4*)(mt + (k2 * 64 + lane) * 16) = u;
          }
        }
        __syncthreads();
        for (int st_ = 0; st_ <= lt; ++st_) {
          const int id = lt * (lt + 1) / 2 + st_;
          const char* mt = (id < 8) ? (LMa + id * 2048) : (LMb + (id - 8) * 2048);
#pragma unroll
          for (int k2 = 0; k2 < 2; ++k2) {
            const bf16x8 am = *(const bf16x8*)(mt + (k2 * 64 + lane) * 16);
            const int s0 = st_ * 32 + 16 * k2 + 4 * hh + q4, s1 = s0 + 8;
            const int cx = pt * 4 + grp16 * 2 + (p3 >> 1);
            const s16x4 lo = tr_read(LXz + s0 * 128 + ((cx ^ swzX(s0)) << 4) + 8 * (p3 & 1));
            const s16x4 hi = tr_read(LXz + s1 * 128 + ((cx ^ swzX(s1)) << 4) + 8 * (p3 & 1));
            const bf16x8 bx = __builtin_shufflevector(lo, hi, 0, 1, 2, 3, 4, 5, 6, 7);
            Y = MFMA32(am, bx, Y);
          }
        }
#pragma unroll
        for (int r = 0; r < 16; ++r) {
          const int srow = lt * 32 + ACC_ROW(r, lane);
          *(bf16_t*)(LY + srow * 128 + (pt * 32 + r31) * 2) = f2bf(Y[r]);
        }
      }
      {
        const float ea = __expf(alast);
#pragma unroll
        for (int r = 0; r < 16; ++r) Hacc[r] *= ea;
        const int cb_ = lt * 4 + grp16 * 2 + (p3 >> 1);
        const int cx = pt * 4 + grp16 * 2 + (p3 >> 1);
        const int sb0 = 8 * hh + q4, sb1 = sb0 + 4;
        const char* pa_lo = LBz + sb0 * 256 + ((cb_ ^ swzBC(sb0)) << 4) + 8 * (p3 & 1);
        const char* pa_hi = LBz + sb1 * 256 + ((cb_ ^ swzBC(sb1)) << 4) + 8 * (p3 & 1);
        const char* pb_lo = LXwz + sb0 * 128 + ((cx ^ swzX(sb0)) << 4) + 8 * (p3 & 1);
        const char* pb_hi = LXwz + sb1 * 128 + ((cx ^ swzX(sb1)) << 4) + 8 * (p3 & 1);
#pragma unroll 2
        for (int k = 0; k < 8; ++k) {
          const s16x4 alo = tr_read(pa_lo + k * 4096);
          const s16x4 ahi = tr_read(pa_hi + k * 4096);
          const s16x4 blo = tr_read(pb_lo + k * 2048);
          const s16x4 bhi = tr_read(pb_hi + k * 2048);
          const bf16x8 a = __builtin_shufflevector(alo, ahi, 0, 1, 2, 3, 4, 5, 6, 7);
          const bf16x8 bb = __builtin_shufflevector(blo, bhi, 0, 1, 2, 3, 4, 5, 6, 7);
          Hacc = MFMA32(a, bb, Hacc);
        }
        char* Hn = LHs;
        const int prow = pt * 32 + r31;
#pragma unroll
        for (int g4 = 0; g4 < 4; ++g4) {
          const int n0 = lt * 32 + 8 * g4 + 4 * hh;
          uint2 w; w.x = pack_bf2(Hacc[g4 * 4], Hacc[g4 * 4 + 1]); w.y = pack_bf2(Hacc[g4 * 4 + 2], Hacc[g4 * 4 + 3]);
          *(uint2*)(Hn + prow * 256 + ((((n0 >> 3)) ^ swzBC(prow)) << 4) + (n0 & 7) * 2) = w;
        }
      }
      SEGS_ADD(3);
    }
  }
  SEGS_FLUSH(4);
  __syncthreads();
}

DI void phase_groupnorm(const P& p) {
  const int lane = threadIdx.x & 63, gw = blockIdx.x * 8 + (threadIdx.x >> 6), nw = gridDim.x * 8;
  bf16_t* zh = (bf16_t*)(p.ws + WS_PB + L1_ZH);
  const float* gn = p.in[I_GNORM];
  for (int lr0 = gw * 2; lr0 < NB * SEQ; lr0 += nw * 2) {
    uint4 raw[2][4];
    bf16_t* rp[2];
#pragma unroll
    for (int u = 0; u < 2; ++u) {
      const int lr = lr0 + u, b = lr >> 12, l = lr & 4095;
      rp[u] = zh + ((size_t)(b * 32 + (lane >> 1)) * TPB + CTXL + l) * 64 + (lane & 1) * 32;
#pragma unroll
      for (int i = 0; i < 4; ++i) raw[u][i] = *(const uint4*)(rp[u] + i * 8);
    }
#pragma unroll
    for (int u = 0; u < 2; ++u) {
      float v[32];
#pragma unroll
      for (int i = 0; i < 4; ++i) { float f[8]; unpack8(raw[u][i], f);
#pragma unroll
        for (int j = 0; j < 8; ++j) v[i * 8 + j] = f[j]; }
      float ss = 0.f;
#pragma unroll
      for (int i = 0; i < 32; ++i) ss += v[i] * v[i];
      ss = red16(ss);
      const float rs = rsqrtf(ss * (1.f / 512.f) + 1e-6f);
#pragma unroll
      for (int i = 0; i < 4; ++i) {
        float o[8];
#pragma unroll
        for (int j = 0; j < 8; ++j) o[j] = v[i * 8 + j] * rs * gn[lane * 32 + i * 8 + j];
        *(uint4*)(rp[u] + i * 8) = pack8(o);
      }
    }
  }
}


__global__ void __launch_bounds__(NTHR) fwd_kernel(P p) {
  extern __shared__ __attribute__((aligned(16))) char lds[];
  const int lo = p.ph_lo, hi = p.ph_hi;
  unsigned char* ws = p.ws;
  XcdBarrier bar; bar.bar = (unsigned*)(ws + WS_CTL); bar.x = 0; bar.st = nullptr;
  volatile LAS unsigned* stw = (volatile LAS unsigned*)(lds + LDS_BYTES - 16);
  if (hi - lo > 1) {
    if (threadIdx.x == 0) { stw[0] = 0u; stw[1] = 0u; }
    __syncthreads();
    bar = xcd_barrier_post((unsigned*)(ws + WS_CTL), stw);
  }
#ifndef PHASE_MASK
#define PHASE_MASK 0xFFFFFFFFu
#endif
#define IN(k) (((PHASE_MASK >> (k)) & 1u) && lo <= (k) && (k) < hi)
#define SEAM(k) do { if (IN(k) && IN((k) + 1)) xcd_barrier(bar); } while (0)
#ifdef PROBE_A
  unsigned long long* tsp = (unsigned long long*)(ws + WS_SCAL + 1024);
#define STAMP(k) do { if (blockIdx.x == 0 && threadIdx.x == 0) tsp[k] = __builtin_amdgcn_s_memrealtime(); } while (0)
#else
#define STAMP(k) do {} while (0)
#endif
  const int G = gridDim.x;
  bf16_t* HBp = (bf16_t*)(ws + WS_HB);
  bf16_t* PBp = (bf16_t*)(ws + WS_PB + PB_P);

#ifdef PROBE_A
  if (blockIdx.x == 0 && threadIdx.x == 0) for (int k = 22; k < 64; ++k) tsp[k] = 0ull;
#endif
  STAMP(0); if (IN(0)) { phase_prep(p, lds); } SEAM(0);
  STAMP(1); if (IN(1)) { phase_normmod(p, 0, 0, true, false, HBp); } SEAM(1);
  STAMP(2); if (IN(2)) { pg8::Order S; S.init(R / 256, 3584 / 256, G, (int)blockIdx.x, 0);
    pg8::gemm_phase(lds, pg8::Gemm{HBp, (const bf16_t*)(ws + WS_WIN0T), D, D, 0}, S, pg8::EpiP0{PBp, (const float2*)(ws + WS_ROPE)}); } SEAM(2);
  STAMP(3); if (IN(3)) {
    if (G == 256) {
      const int xg = blockIdx.x & 7, jg = blockIdx.x >> 3;
      for (int r = 0; r < 4; ++r) attn_flash_unit(p, lds, ((r * 8 + xg) << 5) | jg);
      if (jg < 8) attn_flash_unit(p, lds, 1024 + xg * 8 + jg);
    } else {
      for (int u = blockIdx.x; u < 1024 + 64; u += G) attn_flash_unit(p, lds, u);
    }
    phase_ga(p);
  } SEAM(3);
  STAMP(4); if (IN(4)) {
    if (G == 256) {
      const int xg = blockIdx.x & 7, jg = blockIdx.x >> 3;
      rwkv_scan_unit(p, lds, ((xg + 8 * (jg >> 2)) << 2) | (jg & 3));
    } else {
      for (int u = blockIdx.x; u < 256; u += G) rwkv_scan_unit(p, lds, u);
    }
    __syncthreads();
    gemm_store_phase(lds, (const bf16_t*)(ws + WS_PB + PB_GA), 128, (const bf16_t*)(ws + WS_RWT + 262144), 128, R, 512, 128, (bf16_t*)(ws + WS_PB + PB_G), 512, 512);
  } SEAM(4);
  STAMP(5); if (IN(5)) { phase_rwkv_post(p); } SEAM(5);
  STAMP(6); if (IN(6)) { pg8::Order S; S.init(R / 256, 4, G, (int)blockIdx.x, 0);
    pg8::gemm_phase(lds, pg8::Gemm{(const bf16_t*)(ws + WS_PB + PB_O0), (const bf16_t*)(ws + WS_WOUT0T), D, D, 0}, S,
                    pg8::EpiDelta{(bf16_t*)(ws + WS_PB + PB_H2), (const float*)(ws + WS_MODS)}); } SEAM(6);
  STAMP(7); if (IN(7)) { phase_normmod(p, 0, 1, true, false, (bf16_t*)(ws + WS_PB + PB_H2), (const bf16_t*)(ws + WS_PB + PB_H2)); convert_tables(p, 0); } SEAM(7);
  STAMP(8); if (IN(8)) { pg8::Order S; S.init(R / 256, 8, G, (int)blockIdx.x, 0);
    pg8::gemm_phase(lds, pg8::Gemm{(const bf16_t*)(ws + WS_PB + PB_H2), (const bf16_t*)(ws + WS_PQ0T), D, D, 0}, S, pg8::EpiBf16{(bf16_t*)(ws + WS_PB + PB_Q), 2048, 2048}); } SEAM(8);
  STAMP(9); if (IN(9)) { for (int u = blockIdx.x; u < (R / 256) * 8; u += G) peer_topk_unit(p, lds, 0, u); } SEAM(9);
  STAMP(10); if (IN(10)) { phase_peer_gather(p, 0); } SEAM(10);
  STAMP(11);
  STAMP(12); if (IN(12)) { pg8::Order S; S.init(R / 256, 5376 / 256, G, (int)blockIdx.x, 0);
    pg8::gemm_phase(lds, pg8::Gemm{(const bf16_t*)(ws + WS_HNEXT), (const bf16_t*)(ws + WS_WIN1T), D, D, 0}, S, pg8::EpiP1{ws + WS_PB}); } SEAM(12);
  STAMP(13); if (IN(13)) {
    phase_conv(p, lds);
    if (hi - lo > 1) xcd_barrier(bar);
    if (G == 256) {
      const int xg = blockIdx.x & 7, jg = blockIdx.x >> 3;
      const int gidx = xg + 8 * (jg >> 3);
      ssd_chunk_unit(p, lds, (gidx >> 2) * 32 + (gidx & 3) * 8 + (jg & 7));
    } else {
      for (int u = blockIdx.x; u < 256; u += G) ssd_chunk_unit(p, lds, u);
    }
  } SEAM(13);
  STAMP(14); if (IN(14)) { phase_groupnorm(p); } SEAM(14);
  STAMP(15); if (IN(15)) { pg8::Order S; S.init(NB * SEQ / 256, 4, G, (int)blockIdx.x, 1);
    pg8::gemm_phase(lds, pg8::Gemm{(const bf16_t*)(ws + WS_PB + L1_ZH), (const bf16_t*)(ws + WS_WOUT1T), 64, 2048, 1}, S,
                    pg8::EpiDelta{(bf16_t*)(ws + WS_PB + L1_XH), (const float*)(ws + WS_MODS) + 9 * 6144}); } SEAM(15);
  STAMP(16); if (IN(16)) { phase_normmod(p, 1, 1, false, true, (bf16_t*)(ws + WS_PB + PB_H2), (const bf16_t*)(ws + WS_PB + L1_XH)); convert_tables(p, 1); } SEAM(16);
  STAMP(17); if (IN(17)) { pg8::Order S; S.init(NB * SEQ / 256, 8, G, (int)blockIdx.x, 1);
    pg8::gemm_phase(lds, pg8::Gemm{(const bf16_t*)(ws + WS_PB + PB_H2), (const bf16_t*)(ws + WS_PQ1T), D, D, 0}, S, pg8::EpiBf16{(bf16_t*)(ws + WS_PB + PB_Q), 2048, 2048}); } SEAM(17);
  STAMP(18); if (IN(18)) { for (int u = blockIdx.x; u < (NB * SEQ / 256) * 8; u += G) { const int mtl = u >> 3; peer_topk_unit(p, lds, 1, ((((mtl >> 4) * 17 + 1 + (mtl & 15)) << 3) | (u & 7))); } } SEAM(18);
  STAMP(19); if (IN(19)) { phase_peer_gather(p, 1); }
  STAMP(20);
#ifdef PROBE_A
  xcd_barrier(bar);
  if (blockIdx.x == 0 && threadIdx.x == 0) {
    const unsigned long long tend = __builtin_amdgcn_s_memrealtime();
    tsp[21] = tend;
    unsigned long long ta = 0;
    for (int k = 0; k < 21; ++k) if ((PROBE_A >> k) & 1) ta += tsp[k + 1] - tsp[k];
    for (int k = 22; k < 64; ++k) if ((PROBE_A >> k) & 1ull) ta += tsp[k];
    while (__builtin_amdgcn_s_memrealtime() - tend < ta * PROBE_K) __builtin_amdgcn_s_sleep(8);
  }
#endif
}

extern "C" void kernel_launch(void* const* d_in, const int* in_sizes, int n_in, void* d_out, int out_size, void* d_ws, size_t ws_size, hipStream_t stream) {
  static int inited = 0;
  if (!inited) {
    if (n_in != N_IN || ws_size < WS_XC + 128 * MiB) { fprintf(stderr, "kernel_launch: unexpected n_in %d / ws_size %zu\n", n_in, ws_size); inited = -1; return; }
    if (hipFuncSetAttribute((const void*)fwd_kernel, hipFuncAttributeMaxDynamicSharedMemorySize, LDS_BYTES) != hipSuccess) { fprintf(stderr, "kernel_launch: hipFuncSetAttribute failed\n"); inited = -1; return; }
    inited = 1;
  }
  if (inited < 0) return;
  P p{};
  for (int i = 0; i < N_IN; ++i) p.in[i] = (const float*)d_in[i];
  p.out = (float*)d_out; p.ws = (unsigned char*)d_ws;
  (void)hipMemsetAsync((char*)d_ws + WS_CTL, 0, 65536, stream);
#if N_LAUNCH_MODE == 1
  p.ph_lo = 0; p.ph_hi = N_PHASES;
  hipLaunchKernelGGL(fwd_kernel, dim3(256), dim3(NTHR), LDS_BYTES, stream, p);
#else
  for (int ph = 0; ph < N_PHASES; ++ph) {
    p.ph_lo = ph; p.ph_hi = ph + 1;
    hipLaunchKernelGGL(fwd_kernel, dim3(256), dim3(NTHR), LDS_BYTES, stream, p);
  }
#endif
}
```

```cpp
#include <hip/hip_runtime.h>
#include <stdint.h>
#include <stdio.h>

#ifndef N_LAUNCH_MODE
#define N_LAUNCH_MODE 1
#endif

#define DI __device__ __forceinline__
typedef unsigned short bf16_t;
typedef __attribute__((ext_vector_type(8))) short bf16x8;
typedef __attribute__((ext_vector_type(16))) float f32x16;
typedef __attribute__((ext_vector_type(2))) __bf16 bf2_t;

constexpr int D = 1024, NB = 8, SEQ = 4096, CTXL = 256, TPB = SEQ + CTXL, R = NB * TPB;
constexpr int NTHR = 512;
constexpr int LDS_BYTES = 163840;
constexpr int P0LD = 3456;
constexpr int P1LD = 5184;
constexpr int P1NPAD = 5248;

enum { I_X = 0, I_C, I_CTX, I_CCTX,
       I_ADAW0, I_ADAB0, I_N1_0, I_N2_0, I_WIN0, I_DALAM, I_DASUB, I_RWMU, I_RWW0, I_RWW2, I_RWA0, I_RWA2, I_RWG2, I_RWKK, I_RWKA, I_RWRK, I_LNXW, I_LNXB, I_WOUT0, I_PQ0, I_PK0, I_PU0, I_PV0,
       I_ADAW1, I_ADAB1, I_N1_1, I_N2_1, I_WIN1, I_CONVW, I_CONVB, I_DTB, I_ALOG, I_DSKIP, I_GNORM, I_WOUT1, I_PQ1, I_PK1, I_PU1, I_PV1, I_NF, N_IN };

constexpr size_t MiB = 1048576;
constexpr size_t WS_CTL = 0;
constexpr size_t WS_SCAL = 65536;
constexpr size_t WS_MODS = 131072;
constexpr size_t WS_ROPE = 1 * MiB;
constexpr size_t WS_RWT = 2 * MiB;
constexpr size_t WS_WIN0T = 3 * MiB;
constexpr size_t WS_WOUT0T = 10 * MiB;
constexpr size_t WS_PQ0T = 12 * MiB;
constexpr size_t WS_KEYS0 = 16 * MiB;
constexpr size_t WS_KEYS1 = 16 * MiB + 524288;
constexpr size_t WS_WIN1T = 17 * MiB;
constexpr size_t WS_WOUT1T = 28 * MiB;
constexpr size_t WS_PQ1T = 32 * MiB;
constexpr size_t WS_PB = 36 * MiB;
constexpr size_t WS_XC = 381 * MiB;
constexpr size_t WS_HB = 389 * MiB;
constexpr size_t WS_END = 457 * MiB;
constexpr size_t WS_YF = WS_XC;
constexpr size_t PB_P = 0;
constexpr size_t PB_O0 = 230 * MiB;
constexpr size_t PB_G = 298 * MiB;
constexpr size_t PB_GA = 332 * MiB;
constexpr size_t PB_BONUS = 341 * MiB;
constexpr size_t L1_ZH = 0;
constexpr size_t L1_XH = 136 * MiB;
constexpr size_t L1_BG = 272 * MiB;
constexpr size_t L1_CG = 306 * MiB;
constexpr size_t L1_DT = 340 * MiB;
constexpr size_t PB_H2 = 0;
constexpr size_t PB_Q = 68 * MiB;
constexpr size_t PB_IDX = 204 * MiB;
constexpr size_t PB_GATE = 221 * MiB;
constexpr size_t WS_HNEXT = WS_HB + 33 * MiB;
constexpr size_t HB_YF = 0, HB_YB = 34 * MiB;
constexpr size_t HB_U = 0, HB_V = 8 * MiB;
constexpr size_t HB_SU = 32 * MiB, HB_SV = 32 * MiB + 65536;

struct P {
  const float* in[N_IN];
  float* out;
  unsigned char* ws;
  int ph_lo, ph_hi;
};

constexpr int N_PHASES = 21;
#ifndef PROBE_GRP
#define PROBE_GRP 0
#endif
#define SEG_DECL_() unsigned long long seg_last_ = 0ull, seg_acc_[4] = {0ull, 0ull, 0ull, 0ull}
#define SEG_INIT_() do { seg_last_ = __builtin_amdgcn_s_memrealtime(); } while (0)
#define SEG_ADD_(j) do { const unsigned long long t__ = __builtin_amdgcn_s_memrealtime(); seg_acc_[j] += t__ - seg_last_; seg_last_ = t__; } while (0)
#define SEG_FLUSH_(base) do { if (blockIdx.x == 0 && threadIdx.x == 0) { for (int j__ = 0; j__ < 4; ++j__) ((unsigned long long*)(p.ws + WS_SCAL + 1024))[22 + (base) + j__] += seg_acc_[j__]; } } while (0)
#if defined(PROBE_A) && PROBE_GRP == 1
#define SEGR_DECL() SEG_DECL_()
#define SEGR_INIT() SEG_INIT_()
#define SEGR_ADD(j) SEG_ADD_(j)
#define SEGR_FLUSH(b) SEG_FLUSH_(b)
#else
#define SEGR_DECL() do {} while (0)
#define SEGR_INIT() do {} while (0)
#define SEGR_ADD(j) do {} while (0)
#define SEGR_FLUSH(b) do {} while (0)
#endif
#if defined(PROBE_A) && PROBE_GRP == 2
#define SEGS_DECL() SEG_DECL_()
#define SEGS_INIT() SEG_INIT_()
#define SEGS_ADD(j) SEG_ADD_(j)
#define SEGS_FLUSH(b) SEG_FLUSH_(b)
#else
#define SEGS_DECL() do {} while (0)
#define SEGS_INIT() do {} while (0)
#define SEGS_ADD(j) do {} while (0)
#define SEGS_FLUSH(b) do {} while (0)
#endif

DI unsigned pack_bf2(float a, float b) { bf2_t v; v[0] = (__bf16)a; v[1] = (__bf16)b; return __builtin_bit_cast(unsigned, v); }
DI bf16_t f2bf(float a) { return __builtin_bit_cast(unsigned short, (__bf16)a); }
DI float bf2f(bf16_t v) { return __uint_as_float((unsigned)v << 16); }
DI float bflo(unsigned u) { return __uint_as_float(u << 16); }
DI float bfhi(unsigned u) { return __uint_as_float(u & 0xffff0000u); }
template <int CTRL> DI float dpp_f(float x) { return __int_as_float(__builtin_amdgcn_update_dpp(0, __float_as_int(x), CTRL, 0xF, 0xF, true)); }
DI float red4(float x) { x += dpp_f<0xB1>(x); x += dpp_f<0x4E>(x); return x; }
DI float red8(float x) { x += dpp_f<0x141>(x); return red4(x); }
DI float red16(float x) { x += dpp_f<0x140>(x); return red8(x); }
DI float red64(float x) { x = red16(x); x += __shfl_xor(x, 16); x += __shfl_xor(x, 32); return x; }
DI float frcp_(float x) { return __builtin_amdgcn_rcpf(x); }
DI float sigmoidf_(float x) { return frcp_(1.f + __expf(-x)); }
DI float siluf_(float x) { return x * frcp_(1.f + __expf(-x)); }
DI float softplusf_(float x) { return x > 20.f ? x : log1pf(__expf(x)); }
DI float geluf_(float x) { return 0.5f * x * (1.f + erff(x * 0.70710678118654752f)); }
DI void unpack8(const uint4& u, float (&f)[8]) { f[0] = bflo(u.x); f[1] = bfhi(u.x); f[2] = bflo(u.y); f[3] = bfhi(u.y); f[4] = bflo(u.z); f[5] = bfhi(u.z); f[6] = bflo(u.w); f[7] = bfhi(u.w); }
DI uint4 pack8(const float (&f)[8]) { uint4 u; u.x = pack_bf2(f[0], f[1]); u.y = pack_bf2(f[2], f[3]); u.z = pack_bf2(f[4], f[5]); u.w = pack_bf2(f[6], f[7]); return u; }
#define ACC_ROW(reg, lane) (((reg) & 3) + 8 * ((reg) >> 2) + 4 * ((lane) >> 5))
#define MFMA32(a, b, c) __builtin_amdgcn_mfma_f32_32x32x16_bf16((a), (b), (c), 0, 0, 0)

#define XB_TMO      128
#define XB_XCNT(j)  (256  + 64 * (j))
#define XB_XSUB(j)  (1280 + 64 * (j))
#define XB_XGEN(j)  (2304 + 64 * (j))
#define XB_TOP      3328
#define XB_TOPGEN   3392
#define XCD_BAR_WORDS 3456
#define XB_SPIN_CAP (1u << 22)
#define LAS __attribute__((address_space(3)))
DI unsigned xb_ld(unsigned* p) { return __hip_atomic_load(p, __ATOMIC_RELAXED, __HIP_MEMORY_SCOPE_AGENT); }
DI unsigned xb_add(unsigned* p, unsigned v) { return __hip_atomic_fetch_add(p, v, __ATOMIC_RELAXED, __HIP_MEMORY_SCOPE_AGENT); }
DI unsigned xb_xcc_id() { return (unsigned)__builtin_amdgcn_s_getreg((3 << 11) | 20) & 0xFu; }
#define XB_SPIN(cond, bar) do { unsigned _sp = 0; while (cond) { __builtin_amdgcn_s_sleep(1); \
    if ((++_sp & 255u) == 0u) { if (xb_ld(&(bar)[XB_TMO])) break; if (_sp > XB_SPIN_CAP) { atomicAdd(&(bar)[XB_TMO], 1u); break; } } } } while (0)
struct XcdBarrier { unsigned* bar; unsigned x; volatile LAS unsigned* st; };
DI XcdBarrier xcd_barrier_post(unsigned* bar, volatile LAS unsigned* st) {
  XcdBarrier b; b.bar = bar; b.x = xb_xcc_id(); b.st = st;
  if (threadIdx.x == 0) (void)xb_add(&bar[XB_XCNT(b.x)], 1u);
  return b;
}
DI void xcd_barrier_complete(unsigned* bar, unsigned x, unsigned& nloc, unsigned& nx) {
  const unsigned G = gridDim.x * gridDim.y * gridDim.z;
  unsigned sum, cnt, mine, sp = 0u;
  for (;;) {
    sum = 0u; cnt = 0u; mine = 0u;
#pragma unroll
    for (unsigned j = 0; j < 16; ++j) { const unsigned c = xb_ld(&bar[XB_XCNT(j)]); sum += c; cnt += (c > 0u) ? 1u : 0u; mine = (j == x) ? c : mine; }
    if (sum == G) break;
    __builtin_amdgcn_s_sleep(1);
    if ((++sp & 255u) == 0u) { if (xb_ld(&bar[XB_TMO])) break; if (sp > XB_SPIN_CAP) { atomicAdd(&bar[XB_TMO], 1u); break; } }
  }
  nloc = mine > 0u ? mine : 1u; nx = cnt > 0u ? cnt : 1u;
}
DI void xcd_barrier(const XcdBarrier& b) {
  asm volatile("s_waitcnt vmcnt(0)" ::: "memory");
  __syncthreads();
  if (threadIdx.x == 0) {
    unsigned* bar = b.bar;
    __builtin_amdgcn_s_waitcnt(0);
    unsigned nloc = b.st[0], nx = b.st[1];
    if (nloc == 0u) { xcd_barrier_complete(bar, b.x, nloc, nx); b.st[0] = nloc; b.st[1] = nx; }
    const unsigned old = xb_add(&bar[XB_XSUB(b.x)], 1u);
    const unsigned gen = old / nloc;
    if (old + 1u == (gen + 1u) * nloc) {
      __builtin_amdgcn_fence(__ATOMIC_RELEASE, "agent");
      asm volatile("s_waitcnt vmcnt(0)" ::: "memory");
      const unsigned og = xb_add(&bar[XB_TOP], 1u);
      const unsigned tg = og / nx;
      if (og + 1u == (tg + 1u) * nx) xb_add(&bar[XB_TOPGEN], 1u);
      else XB_SPIN(xb_ld(&bar[XB_TOPGEN]) == tg, bar);
      __builtin_amdgcn_fence(__ATOMIC_ACQUIRE, "agent");
      xb_add(&bar[XB_XGEN(b.x)], 1u);
      asm volatile("s_waitcnt vmcnt(0)" ::: "memory");
    } else {
      XB_SPIN(xb_ld(&bar[XB_XGEN(b.x)]) == gen, bar);
      __builtin_amdgcn_fence(__ATOMIC_ACQUIRE, "agent");
      asm volatile("s_waitcnt vmcnt(0)" ::: "memory");
    }
  }
  __syncthreads();
}

DI void gemm_tile(char* lds, const bf16_t* __restrict__ A, int lda, const bf16_t* __restrict__ Bt, int ldb, int K, f32x16 (&acc)[2][2]) {
  const int tid = threadIdx.x, lane = tid & 63, wave = tid >> 6, wm = wave >> 1, wn = wave & 1;
#pragma unroll
  for (int i = 0; i < 2; ++i)
#pragma unroll
    for (int j = 0; j < 2; ++j)
#pragma unroll
      for (int r = 0; r < 16; ++r) acc[i][j][r] = 0.f;
  const int arow0 = tid >> 3, ac = tid & 7;
  const bf16_t* ap = A + (size_t)arow0 * lda + ac * 8;
  const bf16_t* bp = Bt + (size_t)arow0 * ldb + ac * 8;
  const int sw = ((ac ^ (arow0 >> 1)) & 7) << 4;
  const int st_off = arow0 * 128 + sw;
  uint4 ra[4], rb[2];
#pragma unroll
  for (int i = 0; i < 4; ++i) ra[i] = *(const uint4*)(ap + (size_t)i * 64 * lda);
#pragma unroll
  for (int i = 0; i < 2; ++i) rb[i] = *(const uint4*)(bp + (size_t)i * 64 * ldb);
#pragma unroll
  for (int i = 0; i < 4; ++i) *(uint4*)(lds + st_off + i * 8192) = ra[i];
#pragma unroll
  for (int i = 0; i < 2; ++i) *(uint4*)(lds + 65536 + st_off + i * 8192) = rb[i];
  __syncthreads();
  const int nk = K >> 6;
  const int r31 = lane & 31, hh = lane >> 5;
  for (int kt = 0; kt < nk; ++kt) {
    const int cur = kt & 1;
    if (kt + 1 < nk) {
#pragma unroll
      for (int i = 0; i < 4; ++i) ra[i] = *(const uint4*)(ap + (size_t)i * 64 * lda + (kt + 1) * 64);
#pragma unroll
      for (int i = 0; i < 2; ++i) rb[i] = *(const uint4*)(bp + (size_t)i * 64 * ldb + (kt + 1) * 64);
    }
    const char* la = lds + cur * 32768;
    const char* lb = lds + 65536 + cur * 16384;
#pragma unroll
    for (int kk = 0; kk < 4; ++kk) {
      const int c = kk * 2 + hh;
      bf16x8 a[2], b[2];
#pragma unroll
      for (int mi = 0; mi < 2; ++mi) { const int row = wm * 64 + mi * 32 + r31; a[mi] = *(const bf16x8*)(la + row * 128 + (((c ^ (row >> 1)) & 7) << 4)); }
#pragma unroll
      for (int ni = 0; ni < 2; ++ni) { const int row = wn * 64 + ni * 32 + r31; b[ni] = *(const bf16x8*)(lb + row * 128 + (((c ^ (row >> 1)) & 7) << 4)); }
#pragma unroll
      for (int mi = 0; mi < 2; ++mi)
#pragma unroll
        for (int ni = 0; ni < 2; ++ni) acc[mi][ni] = MFMA32(a[mi], b[ni], acc[mi][ni]);
    }
    if (kt + 1 < nk) {
      char* wa = lds + (cur ^ 1) * 32768;
      char* wb = lds + 65536 + (cur ^ 1) * 16384;
#pragma unroll
      for (int i = 0; i < 4; ++i) *(uint4*)(wa + st_off + i * 8192) = ra[i];
#pragma unroll
      for (int i = 0; i < 2; ++i) *(uint4*)(wb + st_off + i * 8192) = rb[i];
    }
    __syncthreads();
  }
}

DI void gemm_store_phase(char* lds, const bf16_t* A, int lda, const bf16_t* Bt, int ldb, int M, int Npad, int K, bf16_t* C, int ldc, int nvalid) {
  const int ntn = Npad / 128, ntm = M / 256;
  const int lane = threadIdx.x & 63, wave = threadIdx.x >> 6, wm = wave >> 1, wn = wave & 1;
  for (int tile = blockIdx.x; tile < ntm * ntn; tile += gridDim.x) {
    const int mt = tile / ntn, nt = tile - mt * ntn;
    f32x16 acc[2][2];
    gemm_tile(lds, A + (size_t)mt * 256 * lda, lda, Bt + (size_t)nt * 128 * ldb, ldb, K, acc);
#pragma unroll
    for (int mi = 0; mi < 2; ++mi)
#pragma unroll
      for (int ni = 0; ni < 2; ++ni) {
        const int col = nt * 128 + wn * 64 + ni * 32 + (lane & 31);
        if (col < nvalid) {
#pragma unroll
          for (int r = 0; r < 16; ++r) {
            const int row = mt * 256 + wm * 64 + mi * 32 + ACC_ROW(r, lane);
            C[(size_t)row * ldc + col] = f2bf(acc[mi][ni][r]);
          }
        }
      }
  }
}

namespace pg8 {
typedef float f32x4 __attribute__((ext_vector_type(4)));
typedef unsigned u32x4 __attribute__((ext_vector_type(4)));
constexpr int BM = 256, BK = 64, HALF = 128, HTB = HALF * BK * 2, STAGE_BYTES = 8 * HTB, NXCD = 8, WGM = 8;
DI int lds_byte(int r, int c) { const int st = (r >> 4) * 2 + (c >> 5), rr = r & 15, cc = c & 31, ob = rr * 64 + cc * 2; return st * 1024 + (ob ^ (((ob >> 9) & 1) << 5)); }
DI void stage_rc(int b, int& R_, int& C_) { const int st = b / 1024, sb = b % 1024, swz = sb ^ (((sb >> 9) & 1) << 5); R_ = (st >> 1) * 16 + swz / 64; C_ = (st & 1) * 32 + (swz % 64) / 2; }
DI int perm32(int rho) { const int n = rho >> 4, i = rho & 15; return 8 * (i >> 2) + 4 * n + (i & 3); }
struct Unit { int pm, pn; };
struct Gemm { const bf16_t* A; const bf16_t* Bt; int lda, K; int headmajor; };
struct Order {
  int nM, nN, nwg, G, c, skipctx;
  DI void init(int nM_, int nN_, int G_, int c_, int skipctx_) { nM = nM_; nN = nN_; nwg = nM * nN; G = G_; c = c_; skipctx = skipctx_; }
  DI bool next(int i, Unit& u) const {
    const long L = (long)i * G + c; if (L >= nwg) return false;
    int wgid = (int)L; { const int q = nwg / NXCD, r = nwg % NXCD, xcd = wgid % NXCD, off = wgid / NXCD; wgid = (xcd < r ? xcd * (q + 1) : r * (q + 1) + (xcd - r) * q) + off; }
    const int nig = WGM * nN, gid = wgid / nig, fm = gid * WGM, gsz = (nM - fm) < WGM ? (nM - fm) : WGM;
    int pm = fm + ((wgid % nig) % gsz); u.pn = (wgid % nig) / gsz;
    if (skipctx) pm = (pm >> 4) * 17 + 1 + (pm & 15);
    u.pm = pm; return true;
  }
};
template <class Epi>
DI void gemm_phase(char* lds_generic, const Gemm g, const Order& S, const Epi& E) {
  LAS unsigned char* lds = (LAS unsigned char*)lds_generic;
  const int tid = threadIdx.x, wid = __builtin_amdgcn_readfirstlane(tid >> 6), lane = tid & 63, wr = wid >> 2, wc = wid & 3, fr = lane & 15, fq = lane >> 4;
  const int K = g.K, nt = K / BK, lda = g.lda;
  unsigned voffA[2], voffB[2];
#pragma unroll
  for (int i = 0; i < 2; ++i) { int R_, C_; stage_rc(tid * 16 + i * 8192, R_, C_); const int Rb = Epi::PERM ? ((R_ & ~31) + perm32(R_ & 31)) : R_;
    voffA[i] = (unsigned)(R_ * lda + C_) * 2u; voffB[i] = (unsigned)(Rb * K + C_) * 2u; }
  const size_t kstep = (size_t)(BK * 2);
  const size_t kstepA = g.headmajor ? (size_t)TPB * 64 * 2 : kstep;
  const size_t hstepA = (size_t)HALF * lda * 2, hstepB = (size_t)HALF * K * 2;
  const size_t tstepB = 2 * hstepB;
#define PG8_ABASE(pm_) ((const char*)g.A + (g.headmajor ? ((size_t)((pm_) / 17) * 32 * TPB + (size_t)((pm_) % 17) * 256) * 128 : (size_t)(pm_) * 2 * hstepA))
  const unsigned ldsw = (unsigned)wid * 1024u;
  const int aoff = lds_byte(wr * 64 + fr, fq * 8), boff = lds_byte(wc * 32 + fr, fq * 8);
#define PG8_SA(b, h) (((b) * 2 + (h)) * HTB)
#define PG8_SB(b, h) ((4 + (b) * 2 + (h)) * HTB)
#define PG8_STAGE(bufoff, gbase, voff) do { _Pragma("unroll") for (int _i = 0; _i < 2; ++_i) \
    __builtin_amdgcn_global_load_lds((const unsigned*)((const char*)(gbase) + (voff)[_i]), (LAS unsigned*)(lds + (bufoff) + ldsw + _i * 8192), 16, 0, 0); } while (0)
#define PG8_LDA(dst, b, h) do { _Pragma("unroll") for (int m = 0; m < 4; ++m) _Pragma("unroll") for (int k = 0; k < 2; ++k) dst[m][k] = *(const LAS bf16x8*)(lds + PG8_SA(b, h) + aoff + m * 2048 + k * 1024); } while (0)
#define PG8_LDB(dst, b, h) do { _Pragma("unroll") for (int n = 0; n < 2; ++n) _Pragma("unroll") for (int k = 0; k < 2; ++k) dst[n][k] = *(const LAS bf16x8*)(lds + PG8_SB(b, h) + boff + n * 2048 + k * 1024); } while (0)
#define PG8_MMA(ai, bj, At, Bt) do { __builtin_amdgcn_s_setprio(1); _Pragma("unroll") for (int m = 0; m < 4; ++m) _Pragma("unroll") for (int n = 0; n < 2; ++n) _Pragma("unroll") for (int k = 0; k < 2; ++k) \
    acc[ai][bj][m][n] = __builtin_amdgcn_mfma_f32_16x16x32_bf16(Bt[n][k], At[m][k], acc[ai][bj][m][n], 0, 0, 0); __builtin_amdgcn_s_setprio(0); } while (0)
#define PG8_WAIT_V(n) asm volatile("s_waitcnt vmcnt(" #n ")" ::: "memory")
#define PG8_WAIT_L(n) asm volatile("s_waitcnt lgkmcnt(" #n ")" ::: "memory")
#define PG8_BAR __builtin_amdgcn_s_barrier()
#define PG8_SCHED __builtin_amdgcn_sched_barrier(0)
  Unit cur, nxt; int ui = 0;
  if (!S.next(0, cur)) return;
  f32x4 acc[2][2][4][2];
#pragma unroll
  for (int a = 0; a < 2; ++a)
#pragma unroll
    for (int b = 0; b < 2; ++b)
#pragma unroll
      for (int m = 0; m < 4; ++m)
#pragma unroll
        for (int n = 0; n < 2; ++n) acc[a][b][m][n] = (f32x4){0.f, 0.f, 0.f, 0.f};
  bf16x8 At[4][2], B0[2][2], B1[2][2];
  const char* cA = PG8_ABASE(cur.pm); const char* cB = (const char*)g.Bt + (size_t)cur.pn * tstepB;
  PG8_STAGE(PG8_SB(0, 0), cB, voffB); PG8_STAGE(PG8_SA(0, 0), cA, voffA); PG8_STAGE(PG8_SB(0, 1), cB + hstepB, voffB); PG8_STAGE(PG8_SA(0, 1), cA + hstepA, voffA);
  if (wr == 1) PG8_BAR;
  PG8_WAIT_V(4); PG8_BAR;
  PG8_STAGE(PG8_SB(1, 0), cB + kstep, voffB); PG8_STAGE(PG8_SA(1, 0), cA + kstepA, voffA); PG8_STAGE(PG8_SB(1, 1), cB + hstepB + kstep, voffB);
  PG8_WAIT_V(6); PG8_BAR;
  for (;;) {
    const bool has_next = S.next(ui + 1, nxt);
    const char* nA = has_next ? PG8_ABASE(nxt.pm) : cA; const char* nB = has_next ? (const char*)g.Bt + (size_t)nxt.pn * tstepB : cB;
    for (int t = 0; t < nt; t += 2) {
      const bool last = (t == nt - 2);
      const char* a1 = cA + (size_t)(t + 1) * kstepA;
      const char* a2 = last ? nA : cA + (size_t)(t + 2) * kstepA; const char* b2 = last ? nB : cB + (size_t)(t + 2) * kstep;
      const char* a3 = a2 + kstepA; const char* b3 = b2 + kstep;
      PG8_LDB(B0, 0, 0); PG8_SCHED; PG8_LDA(At, 0, 0); PG8_STAGE(PG8_SA(1, 1), a1 + hstepA, voffA);
      PG8_WAIT_L(8); PG8_BAR; PG8_WAIT_L(0); PG8_MMA(0, 0, At, B0); PG8_BAR; PG8_SCHED;
      PG8_LDB(B1, 0, 1); PG8_STAGE(PG8_SB(0, 0), b2, voffB);
      PG8_BAR; PG8_WAIT_L(0); PG8_MMA(0, 1, At, B1); PG8_BAR;
      PG8_LDA(At, 0, 1); PG8_STAGE(PG8_SA(0, 0), a2, voffA);
      PG8_BAR; PG8_WAIT_L(0); PG8_MMA(1, 0, At, B0); PG8_BAR; PG8_SCHED;
      PG8_STAGE(PG8_SB(0, 1), b2 + hstepB, voffB);
      PG8_WAIT_V(6); PG8_BAR; PG8_MMA(1, 1, At, B1); PG8_BAR;
      PG8_LDB(B0, 1, 0); PG8_SCHED; PG8_LDA(At, 1, 0); PG8_STAGE(PG8_SA(0, 1), a2 + hstepA, voffA);
      PG8_WAIT_L(8); PG8_BAR; PG8_WAIT_L(0); PG8_MMA(0, 0, At, B0); PG8_BAR; PG8_SCHED;
      PG8_LDB(B1, 1, 1); PG8_STAGE(PG8_SB(1, 0), b3, voffB);
      PG8_BAR; PG8_WAIT_L(0); PG8_MMA(0, 1, At, B1); PG8_BAR;
      PG8_LDA(At, 1, 1); PG8_STAGE(PG8_SA(1, 0), a3, voffA);
      PG8_BAR; PG8_WAIT_L(0); PG8_MMA(1, 0, At, B0); PG8_BAR; PG8_SCHED;
      PG8_STAGE(PG8_SB(1, 1), b3 + hstepB, voffB);
      PG8_WAIT_V(6); PG8_BAR; PG8_MMA(1, 1, At, B1); PG8_BAR;
    }
    E(acc, cur, wr, wc, fr, fq);
    if (!has_next) break;
#pragma unroll
    for (int a = 0; a < 2; ++a)
#pragma unroll
      for (int b = 0; b < 2; ++b)
#pragma unroll
        for (int m = 0; m < 4; ++m)
#pragma unroll
          for (int n = 0; n < 2; ++n) acc[a][b][m][n] = (f32x4){0.f, 0.f, 0.f, 0.f};
    cur = nxt; cA = nA; cB = nB; ++ui;
  }
  PG8_WAIT_V(0);
  if (wr == 0) PG8_BAR;
  PG8_BAR;
#undef PG8_ABASE
#undef PG8_SA
#undef PG8_SB
#undef PG8_STAGE
#undef PG8_LDA
#undef PG8_LDB
#undef PG8_MMA
#undef PG8_WAIT_V
#undef PG8_WAIT_L
#undef PG8_BAR
#undef PG8_SCHED
}

struct EpiBf16 {
  static constexpr bool PERM = true;
  bf16_t* O; int ldc, nvalid;
  DI void operator()(const f32x4 (&acc)[2][2][4][2], const Unit& u, int wr, int wc, int fr, int fq) const {
    const int row0 = u.pm * BM + wr * 64 + fr, col0 = u.pn * BM + wc * 32 + 8 * fq;
#pragma unroll
    for (int ai = 0; ai < 2; ++ai)
#pragma unroll
      for (int m = 0; m < 4; ++m) { bf16_t* rowp = O + (size_t)(row0 + ai * HALF + m * 16) * ldc + col0;
#pragma unroll
        for (int bj = 0; bj < 2; ++bj) if (col0 + bj * HALF < nvalid) {
          const f32x4 v0 = acc[ai][bj][m][0], v1 = acc[ai][bj][m][1];
          u32x4 w; w.x = pack_bf2(v0[0], v0[1]); w.y = pack_bf2(v0[2], v0[3]); w.z = pack_bf2(v1[0], v1[1]); w.w = pack_bf2(v1[2], v1[3]);
          *(u32x4*)(rowp + bj * HALF) = w; } }
  }
};
struct EpiP0 {
  static constexpr bool PERM = true;
  bf16_t* O; const float2* rope;
  DI void operator()(const f32x4 (&acc)[2][2][4][2], const Unit& u, int wr, int wc, int fr, int fq) const {
    const int row0 = u.pm * BM + wr * 64 + fr, col0 = u.pn * BM + wc * 32 + 8 * fq;
    const bool isctx = (u.pm % 17) == 0; const int b = u.pm / 17;
    const bool qk = u.pn < 4;
    const float qs = (u.pn < 2) ? 0.125f * 1.4426950408889634f : 1.f;
    const int a = wc & 1, half = fq >> 1, f0 = 8 * (fq & 1);
#pragma unroll
    for (int ai = 0; ai < 2; ++ai)
#pragma unroll
      for (int m = 0; m < 4; ++m) {
        const int row = row0 + ai * HALF + m * 16;
        bf16_t* rowp = O + (size_t)row * P0LD + col0;
        const int l = row - b * TPB - CTXL;
#pragma unroll
        for (int bj = 0; bj < 2; ++bj) if (col0 + bj * HALF < P0LD) {
          float v[8];
#pragma unroll
          for (int j = 0; j < 4; ++j) { v[j] = acc[ai][bj][m][0][j]; v[4 + j] = acc[ai][bj][m][1][j]; }
          if (qk) {
            float pv[8];
#pragma unroll
            for (int j = 0; j < 8; ++j) pv[j] = __shfl_xor(v[j], 32);
            if (!isctx) {
              const float4* cs4 = (const float4*)(rope + (size_t)l * 32 + a * 16 + f0);
#pragma unroll
              for (int j2 = 0; j2 < 4; ++j2) {
                const float4 cs = cs4[j2];
                v[2 * j2] = half ? (v[2 * j2] * cs.x + pv[2 * j2] * cs.y) : (v[2 * j2] * cs.x - pv[2 * j2] * cs.y);
                v[2 * j2 + 1] = half ? (v[2 * j2 + 1] * cs.z + pv[2 * j2 + 1] * cs.w) : (v[2 * j2 + 1] * cs.z - pv[2 * j2 + 1] * cs.w);
              }
            }
#pragma unroll
            for (int j = 0; j < 8; ++j) v[j] *= qs;
          }
          u32x4 w; w.x = pack_bf2(v[0], v[1]); w.y = pack_bf2(v[2], v[3]); w.z = pack_bf2(v[4], v[5]); w.w = pack_bf2(v[6], v[7]);
          *(u32x4*)(rowp + bj * HALF) = w; } }
  }
};
struct EpiResid {
  static constexpr bool PERM = false;
  const float* x_in; const float* ctx_in; float* out; float* xc; const float* mods; int layer;
  DI void operator()(const f32x4 (&acc)[2][2][4][2], const Unit& u, int wr, int wc, int fr, int fq) const {
    const int row0 = u.pm * BM + wr * 64 + fr, col0 = u.pn * BM + wc * 32 + 4 * fq;
    const bool isctx = (u.pm % 17) == 0; const int b = u.pm / 17;
    const float* gate = mods + (isctx ? 8 : b) * 6144 + 2 * 1024 + col0;
    f32x4 gv[2][2];
#pragma unroll
    for (int bj = 0; bj < 2; ++bj)
#pragma unroll
      for (int n = 0; n < 2; ++n) gv[bj][n] = *(const f32x4*)(gate + bj * HALF + n * 16);
#pragma unroll
    for (int ai = 0; ai < 2; ++ai)
#pragma unroll
      for (int m = 0; m < 4; ++m) {
        const int row = row0 + ai * HALF + m * 16;
        const int t = row - b * TPB;
        const size_t o = isctx ? ((size_t)(b * CTXL + t)) * D + col0 : ((size_t)(b * SEQ + t - CTXL)) * D + col0;
        const float* src = isctx ? ctx_in : ((layer == 0) ? x_in : out);
        float* dst = isctx ? xc : out;
#pragma unroll
        for (int bj = 0; bj < 2; ++bj)
#pragma unroll
          for (int n = 0; n < 2; ++n) {
            const f32x4 xi = *(const f32x4*)(src + o + bj * HALF + n * 16);
            *(f32x4*)(dst + o + bj * HALF + n * 16) = xi + gv[bj][n] * acc[ai][bj][m][n];
          }
      }
  }
};
struct EpiDelta {
  static constexpr bool PERM = true;
  bf16_t* O; const float* mods;
  DI void operator()(const f32x4 (&acc)[2][2][4][2], const Unit& u, int wr, int wc, int fr, int fq) const {
    const int row0 = u.pm * BM + wr * 64 + fr, col0 = u.pn * BM + wc * 32 + 8 * fq;
    const bool isctx = (u.pm % 17) == 0; const int b = u.pm / 17;
    const float* gate = mods + (isctx ? 8 : b) * 6144 + 2 * 1024 + col0;
    f32x4 g0[2], g1[2];
#pragma unroll
    for (int bj = 0; bj < 2; ++bj) { g0[bj] = *(const f32x4*)(gate + bj * HALF); g1[bj] = *(const f32x4*)(gate + bj * HALF + 4); }
#pragma unroll
    for (int ai = 0; ai < 2; ++ai)
#pragma unroll
      for (int m = 0; m < 4; ++m) { bf16_t* rowp = O + (size_t)(row0 + ai * HALF + m * 16) * D + col0;
#pragma unroll
        for (int bj = 0; bj < 2; ++bj) {
          const f32x4 v0 = acc[ai][bj][m][0] * g0[bj], v1 = acc[ai][bj][m][1] * g1[bj];
          u32x4 w; w.x = pack_bf2(v0[0], v0[1]); w.y = pack_bf2(v0[2], v0[3]); w.z = pack_bf2(v1[0], v1[1]); w.w = pack_bf2(v1[2], v1[3]);
          *(u32x4*)(rowp + bj * HALF) = w; } }
  }
};
struct EpiP1 {
  static constexpr bool PERM = true;
  unsigned char* pb;
  DI void operator()(const f32x4 (&acc)[2][2][4][2], const Unit& u, int wr, int wc, int fr, int fq) const {
    unsigned zo = 0;
    asm volatile("" : "+v"(zo));
    const int row0 = u.pm * BM + wr * 64 + fr, col0 = u.pn * BM + wc * 32 + 8 * fq;
    const int b = u.pm / 17;
    const unsigned t0 = (unsigned)(row0 - b * TPB) + zo;
#pragma unroll
    for (int bj = 0; bj < 2; ++bj) {
      const int c = col0 + bj * HALF;
      if (c >= P1LD) continue;
      unsigned off, tstride;
      if (c < 2048) { off = (unsigned)L1_ZH + ((unsigned)(b * 32 + (c >> 6)) * TPB) * 128u + (unsigned)(c & 63) * 2u; tstride = 128u; }
      else if (c < 4096) { const int cc = c - 2048; off = (unsigned)L1_XH + ((unsigned)(b * 32 + (cc >> 6)) * TPB) * 128u + (unsigned)(cc & 63) * 2u; tstride = 128u; }
      else if (c < 4608) { const int cc = c - 4096; off = (unsigned)L1_BG + ((unsigned)(b * 4 + (cc >> 7)) * TPB) * 256u + (unsigned)(cc & 127) * 2u; tstride = 256u; }
      else if (c < 5120) { const int cc = c - 4608; off = (unsigned)L1_CG + ((unsigned)(b * 4 + (cc >> 7)) * TPB) * 256u + (unsigned)(cc & 127) * 2u; tstride = 256u; }
      else { off = (unsigned)L1_DT + (unsigned)b * TPB * 128u + (unsigned)(c - 5120) * 2u; tstride = 128u; }
      off += t0 * tstride;
#pragma unroll
      for (int ai = 0; ai < 2; ++ai)
#pragma unroll
        for (int m = 0; m < 4; ++m) {
          const f32x4 v0 = acc[ai][bj][m][0], v1 = acc[ai][bj][m][1];
          u32x4 w; w.x = pack_bf2(v0[0], v0[1]); w.y = pack_bf2(v0[2], v0[3]); w.z = pack_bf2(v1[0], v1[1]); w.w = pack_bf2(v1[2], v1[3]);
          *(u32x4*)(pb + off + (unsigned)(ai * HALF + m * 16) * tstride) = w;
        }
    }
  }
};
}

DI void transpose_tile(char* lds, const float* __restrict__ src, int K, int N, bf16_t* __restrict__ dst, int tile) {
  float* T = (float*)lds;
  const int ntk = K / 64;
  const int tn = tile / ntk, tk = tile - tn * ntk;
  const int tid = threadIdx.x;
  __syncthreads();
#pragma unroll
  for (int i = 0; i < 2; ++i) {
    const int kk = (tid >> 4) + 32 * i, n4 = (tid & 15) * 4;
    const int n = tn * 64 + n4;
    float4 v = make_float4(0.f, 0.f, 0.f, 0.f);
    if (n < N) v = *(const float4*)(src + (size_t)(tk * 64 + kk) * N + n);
    *(float4*)(T + kk * 68 + n4) = v;
  }
  __syncthreads();
  {
    const int nn = tid & 63, kc = tid >> 6;
    float f[8];
#pragma unroll
    for (int j = 0; j < 8; ++j) f[j] = T[(kc * 8 + j) * 68 + nn];
    *(uint4*)(dst + (size_t)(tn * 64 + nn) * K + tk * 64 + kc * 8) = pack8(f);
  }
}

DI void phase_prep(const P& p, char* lds) {
  const int tid = threadIdx.x;
  unsigned char* ws = p.ws;
  struct TD { int idx; int K, N, Npad; size_t dst; size_t srcoff; };
  int base = 0;
  const int G = gridDim.x;
#define TRANSPOSE_TASK(SRC, KK, NN, NPAD, DST) { const int nt_ = ((NPAD) / 64) * ((KK) / 64); \
    for (int w = blockIdx.x; w < nt_; w += G) transpose_tile(lds, (SRC), (KK), (NN), (bf16_t*)(DST), w); }
  TRANSPOSE_TASK(p.in[I_WIN0], 1024, 3456, 3584, ws + WS_WIN0T)
  TRANSPOSE_TASK(p.in[I_WOUT0], 1024, 1024, 1024, ws + WS_WOUT0T)
  TRANSPOSE_TASK(p.in[I_PQ0], 1024, 2048, 2048, ws + WS_PQ0T)
  TRANSPOSE_TASK(p.in[I_WIN1], 1024, 5184, 5376, ws + WS_WIN1T)
  TRANSPOSE_TASK(p.in[I_WOUT1], 2048, 1024, 1024, ws + WS_WOUT1T)
  TRANSPOSE_TASK(p.in[I_PQ1], 1024, 2048, 2048, ws + WS_PQ1T)
  TRANSPOSE_TASK(p.in[I_RWW2], 64, 512, 512, ws + WS_RWT)
  TRANSPOSE_TASK(p.in[I_RWW2] + 64 * 512, 64, 512, 512, ws + WS_RWT + 65536)
  TRANSPOSE_TASK(p.in[I_RWA2], 64, 512, 512, ws + WS_RWT + 131072)
  TRANSPOSE_TASK(p.in[I_RWA2] + 64 * 512, 64, 512, 512, ws + WS_RWT + 196608)
  TRANSPOSE_TASK(p.in[I_RWG2], 128, 512, 512, ws + WS_RWT + 262144)
  (void)base;
  {
    const int gt = blockIdx.x * NTHR + tid, gs = G * NTHR;
    bf16_t* k0 = (bf16_t*)(ws + WS_KEYS0); bf16_t* k1 = (bf16_t*)(ws + WS_KEYS1);
    for (int i = gt; i < 262144; i += gs) { k0[i] = f2bf(p.in[I_PK0][i]); k1[i] = f2bf(p.in[I_PK1][i]); }
    float2* rope = (float2*)(ws + WS_ROPE);
    for (int i = gt; i < 4096 * 32; i += gs) {
      const int l = i >> 5, a = (i >> 4) & 1, f = i & 15;
      const float inv = powf(10000.f, -(float)f / 16.f);
      const float pos = (float)(a == 0 ? (l >> 6) : (l & 63));
      float s, c; sincosf(pos * inv, &s, &c);
      rope[i] = make_float2(c, s);
    }
    if (gt == 0) {
      const float* lp = p.in[I_DALAM];
      float s01 = 0.f, s23 = 0.f;
      for (int i = 0; i < 64; ++i) { s01 += lp[i] * lp[64 + i]; s23 += lp[128 + i] * lp[192 + i]; }
      ((float*)(ws + WS_SCAL))[0] = expf(s01) - expf(s23) + 0.2f;
    }
  }
  {
    float* sc = (float*)lds;
    float* red = (float*)(lds + 36864);
    __syncthreads();
    for (int e = tid; e < 9 * 1024; e += NTHR) { const int r = e >> 10, k = e & 1023; const float v = (r < 8) ? p.in[I_C][r * 1024 + k] : p.in[I_CCTX][k]; sc[e] = siluf_(v); }
    __syncthreads();
    float* mods = (float*)(ws + WS_MODS);
    for (int w = blockIdx.x; w < 192; w += G) {
      const int l = w / 96, j0 = (w % 96) * 64;
      const float* aw = p.in[l == 0 ? I_ADAW0 : I_ADAW1];
      const float* ab = p.in[l == 0 ? I_ADAB0 : I_ADAB1];
      const int col = tid & 63, kg = tid >> 6;
      float a[9];
#pragma unroll
      for (int r = 0; r < 9; ++r) a[r] = 0.f;
      for (int k = kg * 128; k < kg * 128 + 128; ++k) {
        const float wv = aw[(size_t)k * 6144 + j0 + col];
#pragma unroll
        for (int r = 0; r < 9; ++r) a[r] += sc[r * 1024 + k] * wv;
      }
      __syncthreads();
#pragma unroll
      for (int r = 0; r < 9; ++r) red[(kg * 64 + col) * 9 + r] = a[r];
      __syncthreads();
      for (int e = tid; e < 64 * 9; e += NTHR) {
        const int c2 = e / 9, r = e - c2 * 9;
        float s = ab[j0 + c2];
        for (int g = 0; g < 8; ++g) s += red[(g * 64 + c2) * 9 + r];
        mods[((size_t)l * 9 + r) * 6144 + j0 + c2] = s;
      }
    }
  }
}

DI float wave_max(float x) {
  x = fmaxf(x, dpp_f<0xB1>(x)); x = fmaxf(x, dpp_f<0x4E>(x)); x = fmaxf(x, dpp_f<0x141>(x)); x = fmaxf(x, dpp_f<0x140>(x));
  x = fmaxf(x, __shfl_xor(x, 16)); x = fmaxf(x, __shfl_xor(x, 32)); return x;
}
DI void convert_tables(const P& p, int layer) {
  const int lane = threadIdx.x & 63, gw = blockIdx.x * 8 + (threadIdx.x >> 6), nw = gridDim.x * 8;
  const float* u = p.in[layer == 0 ? I_PU0 : I_PU1];
  const float* v = p.in[layer == 0 ? I_PV0 : I_PV1];
  unsigned char* du = p.ws + WS_HB + HB_U;
  unsigned char* dv = p.ws + WS_HB + HB_V;
  float* su = (float*)(p.ws + WS_HB + HB_SU);
  float* sv = (float*)(p.ws + WS_HB + HB_SV);
  for (int row = gw; row < 32768; row += nw) {
    const bool isv = row >= 16384;
    const int r = row & 16383;
    const float* src = (isv ? v : u) + (size_t)r * D + lane * 16;
    float x[16];
#pragma unroll
    for (int i = 0; i < 4; ++i) { const float4 f = *(const float4*)(src + i * 4); x[i * 4] = f.x; x[i * 4 + 1] = f.y; x[i * 4 + 2] = f.z; x[i * 4 + 3] = f.w; }
    float am = 0.f, ss = 0.f;
#pragma unroll
    for (int i = 0; i < 16; ++i) { am = fmaxf(am, fabsf(x[i])); ss += x[i] * x[i]; }
    am = fmaxf(wave_max(am), 1e-30f);
    ss = red64(ss);
    const float step = fminf(am * (1.f / 7.5f), fmaxf(0.3352f * sqrtf(ss * (1.f / 1024.f)), 1e-30f));
    const float inv = 1.f / step;
    unsigned w[2];
#pragma unroll
    for (int d2 = 0; d2 < 2; ++d2) {
      unsigned pk = 0;
#pragma unroll
      for (int j = 0; j < 8; ++j) {
        int q = (int)rintf(x[d2 * 8 + j] * inv + 7.5f);
        q = q < 0 ? 0 : (q > 15 ? 15 : q);
        pk |= (unsigned)q << (8 * (j >> 1) + 4 * (j & 1));
      }
      w[d2] = pk;
    }
    *(uint2*)((isv ? dv : du) + (size_t)r * 512 + lane * 8) = make_uint2(w[0], w[1]);
    if (lane == 0) (isv ? sv : su)[r] = step;
  }
}

DI void phase_normmod(const P& p, int layer, int which, bool from_inputs, bool lat_only, bf16_t* dst, const bf16_t* delta = nullptr) {
  const int lane = threadIdx.x & 63, gw = blockIdx.x * 8 + (threadIdx.x >> 6), nw = gridDim.x * 8;
  const float* g = p.in[layer == 0 ? (which == 0 ? I_N1_0 : I_N2_0) : (which == 0 ? I_N1_1 : I_N2_1)];
  const float* mods = (const float*)(p.ws + WS_MODS) + (size_t)layer * 9 * 6144;
  const float* xc = (const float*)(p.ws + WS_XC);
  float4 nx[4]; uint4 nd[2];
#define NM_SRC(ROW) ((((ROW) % TPB) < CTXL) ? ((from_inputs ? p.in[I_CTX] : xc) + ((size_t)(((ROW) / TPB) * CTXL + ((ROW) % TPB))) * D) \
                                             : ((from_inputs ? p.in[I_X] : p.out) + ((size_t)(((ROW) / TPB) * SEQ + ((ROW) % TPB) - CTXL)) * D))
#define NM_LOAD(ROW) do { if (!(lat_only && ((ROW) % TPB) < CTXL)) { const float* s_ = NM_SRC(ROW); \
      _Pragma("unroll") for (int i = 0; i < 4; ++i) nx[i] = *(const float4*)(s_ + lane * 16 + i * 4); \
      if (delta) { nd[0] = *(const uint4*)(delta + (size_t)(ROW) * D + lane * 16); nd[1] = *(const uint4*)(delta + (size_t)(ROW) * D + lane * 16 + 8); } } } while (0)
  if (gw < R) NM_LOAD(gw);
  for (int row = gw; row < R; row += nw) {
    const int b = row / TPB, t = row - b * TPB;
    const bool isctx = t < CTXL;
    float v[16]; uint4 dcur0 = nd[0], dcur1 = nd[1];
#pragma unroll
    for (int i = 0; i < 4; ++i) { v[i * 4] = nx[i].x; v[i * 4 + 1] = nx[i].y; v[i * 4 + 2] = nx[i].z; v[i * 4 + 3] = nx[i].w; }
    if (row + nw < R) NM_LOAD(row + nw);
    if (isctx && lat_only) continue;
    const float* mrow = mods + (isctx ? 8 : b) * 6144 + (which == 0 ? 0 : 3 * 1024);
    if (delta) {
      float dl[8];
      unpack8(dcur0, dl);
#pragma unroll
      for (int i = 0; i < 8; ++i) v[i] += dl[i];
      unpack8(dcur1, dl);
#pragma unroll
      for (int i = 0; i < 8; ++i) v[8 + i] += dl[i];
      float* xo = isctx ? ((float*)(p.ws + WS_XC) + ((size_t)(b * CTXL + t)) * D) : (p.out + ((size_t)(b * SEQ + t - CTXL)) * D);
#pragma unroll
      for (int i = 0; i < 4; ++i) *(float4*)(xo + lane * 16 + i * 4) = make_float4(v[i * 4], v[i * 4 + 1], v[i * 4 + 2], v[i * 4 + 3]);
    }
    float ss = 0.f;
#pragma unroll
    for (int i = 0; i < 16; ++i) ss += v[i] * v[i];
    ss = red64(ss);
    const float rs = rsqrtf(ss * (1.f / 1024.f) + 1e-6f);
    float o[16];
#pragma unroll
    for (int i = 0; i < 16; ++i) { const int c = lane * 16 + i; o[i] = v[i] * rs * g[c] * (1.f + mrow[1024 + c]) + mrow[c]; }
    uint4 w0, w1;
    w0.x = pack_bf2(o[0], o[1]); w0.y = pack_bf2(o[2], o[3]); w0.z = pack_bf2(o[4], o[5]); w0.w = pack_bf2(o[6], o[7]);
    w1.x = pack_bf2(o[8], o[9]); w1.y = pack_bf2(o[10], o[11]); w1.z = pack_bf2(o[12], o[13]); w1.w = pack_bf2(o[14], o[15]);
    *(uint4*)(dst + (size_t)row * D + lane * 16) = w0;
    *(uint4*)(dst + (size_t)row * D + lane * 16 + 8) = w1;
  }
#undef NM_SRC
#undef NM_LOAD
}

DI void phase_final_norm(const P& p) {
  const int lane = threadIdx.x & 63, gw = blockIdx.x * 8 + (threadIdx.x >> 6), nw = gridDim.x * 8;
  const float* g = p.in[I_NF];
  for (int row = gw; row < NB * SEQ; row += nw) {
    float* src = p.out + (size_t)row * D;
    float v[16];
#pragma unroll
    for (int i = 0; i < 4; ++i) { const float4 f = *(const float4*)(src + lane * 16 + i * 4); v[i * 4] = f.x; v[i * 4 + 1] = f.y; v[i * 4 + 2] = f.z; v[i * 4 + 3] = f.w; }
    float ss = 0.f;
#pragma unroll
    for (int i = 0; i < 16; ++i) ss += v[i] * v[i];
    ss = red64(ss);
    const float rs = rsqrtf(ss * (1.f / 1024.f) + 1e-6f);
#pragma unroll
    for (int i = 0; i < 4; ++i) {
      const int c = lane * 16 + i * 4;
      float4 f; f.x = v[i * 4] * rs * g[c]; f.y = v[i * 4 + 1] * rs * g[c + 1]; f.z = v[i * 4 + 2] * rs * g[c + 2]; f.w = v[i * 4 + 3] * rs * g[c + 3];
      *(float4*)(src + c) = f;
    }
  }
}

typedef __attribute__((ext_vector_type(4))) short s16x4;
DI s16x4 tr_read(const char* p) { return __builtin_amdgcn_ds_read_tr16_b64_v4i16((__attribute__((address_space(3))) s16x4*)(p)); }

DI void attn_flash_unit(const P& p, char* lds, int unit) {
  const int tid = threadIdx.x, lane = tid & 63, wave = tid >> 6;
  const bool isctx = unit >= 1024;
  int b, h, qb;
  if (!isctx) { b = unit >> 7; h = (unit >> 5) & 3; qb = unit & 31; } else { const int u = unit - 1024; b = u >> 3; h = (u >> 1) & 3; qb = u & 1; }
  const int nkt = isctx ? CTXL / 64 : TPB / 64;
  const bf16_t* p0 = (const bf16_t*)(p.ws + WS_PB + PB_P);
  const float lam = ((const float*)(p.ws + WS_SCAL))[0];
  const int qg = wave >> 1, m = wave & 1;
  const int r31 = lane & 31, hh = lane >> 5;
  const int ql = qb * 128 + qg * 32 + r31;
  const size_t qrow = (size_t)b * TPB + (isctx ? ql : CTXL + ql);
  bf16x8 qf[4];
#pragma unroll
  for (int kk = 0; kk < 4; ++kk) qf[kk] = *(const bf16x8*)(p0 + qrow * P0LD + h * 128 + m * 64 + kk * 16 + 8 * hh);
  const int skey = tid >> 4, scc = tid & 15;
  const bf16_t* kg = p0 + ((size_t)b * TPB + skey) * P0LD + 512 + h * 128 + scc * 8;
  const bf16_t* vg = kg + 512;
  const int koff = (scc >> 3) * 8192 + skey * 128 + ((((scc & 7) ^ (skey >> 1)) & 7) << 4);
  const int voff = 16384 + skey * 320 + scc * 16;
  constexpr int BUFSZ = 36864;
  uint4 rk[2], rv[2];
  __syncthreads();
#pragma unroll
  for (int i = 0; i < 2; ++i) { rk[i] = *(const uint4*)(kg + (size_t)i * 32 * P0LD); rv[i] = *(const uint4*)(vg + (size_t)i * 32 * P0LD); }
#pragma unroll
  for (int i = 0; i < 2; ++i) { *(uint4*)(lds + koff + i * 4096) = rk[i]; *(uint4*)(lds + voff + i * 10240) = rv[i]; }
  __syncthreads();
  f32x16 o[4];
#pragma unroll
  for (int v = 0; v < 4; ++v)
#pragma unroll
    for (int r = 0; r < 16; ++r) o[v][r] = 0.f;
  float mrun = -1e30f, lsum = 0.f;
  const int q4 = (lane & 15) >> 2;
  const int vboff = ((lane >> 4) & 1) * 32 + 8 * (lane & 3);
  for (int kt = 0; kt < nkt; ++kt) {
    const int cur = kt & 1;
    if (kt + 1 < nkt) {
#pragma unroll
      for (int i = 0; i < 2; ++i) { rk[i] = *(const uint4*)(kg + (size_t)((kt + 1) * 64 + i * 32) * P0LD); rv[i] = *(const uint4*)(vg + (size_t)((kt + 1) * 64 + i * 32) * P0LD); }
    }
    const char* kb = lds + cur * BUFSZ + m * 8192;
    const char* vb = lds + cur * BUFSZ + 16384;
    f32x16 s[2];
#pragma unroll
    for (int t = 0; t < 2; ++t)
#pragma unroll
      for (int r = 0; r < 16; ++r) s[t][r] = 0.f;
#pragma unroll
    for (int kk = 0; kk < 4; ++kk)
#pragma unroll
      for (int t = 0; t < 2; ++t) {
        const int row = t * 32 + r31;
        const bf16x8 a = *(const bf16x8*)(kb + row * 128 + ((((kk * 2 + hh) ^ (row >> 1)) & 7) << 4));
        s[t] = MFMA32(a, qf[kk], s[t]);
      }
    float mx = s[0][0];
#pragma unroll
    for (int t = 0; t < 2; ++t)
#pragma unroll
      for (int r = 0; r < 16; ++r) mx = fmaxf(mx, s[t][r]);
    mx = fmaxf(mx, __shfl_xor(mx, 32));
    const float mnew = fmaxf(mrun, mx);
    const float corr = __builtin_amdgcn_exp2f(mrun - mnew);
    mrun = mnew;
    lsum *= corr;
#pragma unroll
    for (int v = 0; v < 4; ++v)
#pragma unroll
      for (int r = 0; r < 16; ++r) o[v][r] *= corr;
#pragma unroll
    for (int t = 0; t < 2; ++t)
#pragma unroll
      for (int r = 0; r < 16; ++r) { const float e = __builtin_amdgcn_exp2f(s[t][r] - mnew); s[t][r] = e; lsum += e; }
#pragma unroll
    for (int t = 0; t < 2; ++t)
#pragma unroll
      for (int st = 0; st < 2; ++st) {
        unsigned pk[4];
#pragma unroll
        for (int j = 0; j < 4; ++j) pk[j] = pack_bf2(s[t][8 * st + 2 * j], s[t][8 * st + 2 * j + 1]);
        bf16x8 bp;
        { typedef __attribute__((ext_vector_type(4))) unsigned u32x4; u32x4 u = {pk[0], pk[1], pk[2], pk[3]}; bp = __builtin_bit_cast(bf16x8, u); }
        const int key0 = t * 32 + 16 * st + 4 * hh + q4;
#pragma unroll
        for (int v = 0; v < 4; ++v) {
          const s16x4 lo = tr_read(vb + key0 * 320 + v * 64 + vboff);
          const s16x4 hi = tr_read(vb + (key0 + 8) * 320 + v * 64 + vboff);
          const bf16x8 av = __builtin_shufflevector(lo, hi, 0, 1, 2, 3, 4, 5, 6, 7);
          o[v] = MFMA32(av, bp, o[v]);
        }
      }
    if (kt + 1 < nkt) {
      char* nb = lds + (cur ^ 1) * BUFSZ;
#pragma unroll
      for (int i = 0; i < 2; ++i) { *(uint4*)(nb + koff + i * 4096) = rk[i]; *(uint4*)(nb + voff + i * 10240) = rv[i]; }
    }
    __syncthreads();
  }
  lsum += __shfl_xor(lsum, 32);
  const float inv = 1.f / lsum;
  float* Ex = (float*)lds;
  if (m == 1) {
#pragma unroll
    for (int v = 0; v < 4; ++v)
#pragma unroll
      for (int r = 0; r < 16; ++r) Ex[(qg * 128 + v * 32 + ACC_ROW(r, lane)) * 32 + r31] = o[v][r] * inv;
  }
  __syncthreads();
  if (m == 0) {
    float ss = 0.f;
#pragma unroll
    for (int v = 0; v < 4; ++v)
#pragma unroll
      for (int r = 0; r < 16; ++r) { const float dv = o[v][r] * inv - lam * Ex[(qg * 128 + v * 32 + ACC_ROW(r, lane)) * 32 + r31]; o[v][r] = dv; ss += dv * dv; }
    ss += __shfl_xor(ss, 32);
    const float rs = rsqrtf(ss * (1.f / 128.f) + 1e-6f) * 0.8f;
    const float* sub = p.in[I_DASUB];
    bf16_t* op = (bf16_t*)(p.ws + WS_PB + PB_O0) + qrow * 1024 + h * 128;
#pragma unroll
    for (int v = 0; v < 4; ++v)
#pragma unroll
      for (int g4 = 0; g4 < 4; ++g4) {
        const int vd = v * 32 + 8 * g4 + 4 * hh;
        uint2 w;
        w.x = pack_bf2(o[v][g4 * 4] * rs * sub[vd], o[v][g4 * 4 + 1] * rs * sub[vd + 1]);
        w.y = pack_bf2(o[v][g4 * 4 + 2] * rs * sub[vd + 2], o[v][g4 * 4 + 3] * rs * sub[vd + 3]);
        *(uint2*)(op + vd) = w;
      }
  }
  __syncthreads();
}

DI void phase_ga(const P& p) {
  const bf16_t* p0 = (const bf16_t*)(p.ws + WS_PB + PB_P);
  bf16_t* ga = (bf16_t*)(p.ws + WS_PB + PB_GA);
  const float* mu = p.in[I_RWMU] + 1792;
  for (int i = blockIdx.x * NTHR + threadIdx.x; i < R * 16; i += gridDim.x * NTHR) {
    const int row = i >> 4, c8 = (i & 15) * 8;
    const int t = row % TPB;
    const bool first = (t == 0) || (t == CTXL), last = (t == CTXL - 1) || (t == TPB - 1);
    const bf16_t* sp = p0 + (size_t)row * P0LD + 1536 + 1792 + c8;
    float u[8], um[8], up[8];
    unpack8(*(const uint4*)sp, u);
    if (!first) unpack8(*(const uint4*)(sp - P0LD), um); else { for (int j = 0; j < 8; ++j) um[j] = 0.f; }
    if (!last) unpack8(*(const uint4*)(sp + P0LD), up); else { for (int j = 0; j < 8; ++j) up[j] = 0.f; }
    float o[8];
#pragma unroll
    for (int j = 0; j < 8; ++j) { const float mix = u[j] + mu[c8 + j] * (0.5f * (um[j] + up[j]) - u[j]); o[j] = sigmoidf_(mix); }
    *(uint4*)(ga + (size_t)row * 128 + c8) = pack8(o);
  }
}

DI int scan_token(int d, int s) { return d == 0 ? s : (s < CTXL ? (CTXL - 1 - s) : (TPB + CTXL - 1 - s)); }

typedef __attribute__((ext_vector_type(4))) float f32x4_t;
DI void rwkv_scan_unit(const P& p, char* lds, int unit) {
  int tid_ = threadIdx.x;
  asm volatile("" : "+v"(tid_));
  const int tid = tid_, lane = tid & 63, wave = __builtin_amdgcn_readfirstlane(tid >> 6);
  const int half = unit & 1, d = (unit >> 1) & 1, h = (unit >> 2) & 7, b = unit >> 5;
  constexpr int T = 32, NCHK = TPB / T, BUFB = 45056;
  const bf16_t* p0 = (const bf16_t*)(p.ws + WS_PB + PB_P);
  __syncthreads();
  {
    const bf16_t* w2t = (const bf16_t*)(p.ws + WS_RWT + (size_t)d * 65536) + h * 64 * 64;
    const bf16_t* a2t = (const bf16_t*)(p.ws + WS_RWT + 131072 + (size_t)d * 65536) + h * 64 * 64;
    *(uint4*)(lds + 139264 + tid * 16) = *(const uint4*)(w2t + tid * 8);
    *(uint4*)(lds + 147456 + tid * 16) = *(const uint4*)(a2t + tid * 8);
    float* LC = (float*)(lds + 155648);
    for (int e = tid; e < 640; e += NTHR) {
      const int g = e >> 6, cidx = e & 63;
      float v;
      if (g == 0) v = p.in[I_RWW0][d * 512 + h * 64 + cidx];
      else if (g == 1) v = p.in[I_RWA0][d * 512 + h * 64 + cidx];
      else if (g == 2) v = p.in[I_RWKK][h * 64 + cidx];
      else if (g == 3) v = p.in[I_RWKA][h * 64 + cidx];
      else if (g == 4) v = p.in[I_RWRK][h * 64 + cidx];
      else if (g < 8) v = p.in[I_RWMU][(g - 5) * 512 + h * 64 + cidx];
      else v = p.in[I_RWMU][(g == 8 ? 1536 : 1664) + d * 64 + cidx];
      LC[e] = v;
    }
  }
  __syncthreads();
  if (wave < 4) {
    const int rp = tid >> 4, c16 = tid & 15, c4 = c16 * 4;
    typedef float f32x2 __attribute__((ext_vector_type(2)));
    f32x2 S0a = {0.f, 0.f}, S0b = {0.f, 0.f}, S1a = {0.f, 0.f}, S1b = {0.f, 0.f};
    bf16_t* yout = (bf16_t*)(p.ws + WS_HB + (d == 0 ? HB_YF : HB_YB)) + h * 64 + half * 32 + wave * 8 + (lane & 7);
    SEGR_DECL();
    __syncthreads();
    SEGR_INIT();
    for (int c = 0; c < NCHK; ++c) {
      int zo = 0;
      asm volatile("" : "+v"(zo));
      const char* B0 = lds + (c & 1) * BUFB + zo;
      float* Lyp = (float*)(lds + 122880 + zo);
      const float* La = (const float*)B0 + c4; const float* Lb = (const float*)(B0 + 8192) + c4; const float* Lk = (const float*)(B0 + 16384) + c4;
      const float* Lw = (const float*)(B0 + 24576) + c4; const float* Lr = (const float*)(B0 + 32768) + c4; const float* Lv = (const float*)(B0 + 40960) + rp * 2;
#define RW_LD(s_, A_, B_, K_, W_, R_, V_) const float4 A_ = *(const float4*)(La + (s_) * 64), B_ = *(const float4*)(Lb + (s_) * 64), K_ = *(const float4*)(Lk + (s_) * 64), \
          W_ = *(const float4*)(Lw + (s_) * 64), R_ = *(const float4*)(Lr + (s_) * 64); const float2 V_ = *(const float2*)(Lv + (s_) * 32)
      float4 a4, b4, k4, w4, r4, a4n, b4n, k4n, w4n, r4n; float2 v2, v2n;
      { RW_LD(0, xa, xb, xk, xw, xr, xv); a4 = xa; b4 = xb; k4 = xk; w4 = xw; r4 = xr; v2 = xv; }
      { RW_LD(1, xa, xb, xk, xw, xr, xv); a4n = xa; b4n = xb; k4n = xk; w4n = xw; r4n = xr; v2n = xv; }
#pragma unroll 1
      for (int g8 = 0; g8 < 4; ++g8) {
#pragma unroll
        for (int si = 0; si < 8; ++si) {
          const int s2 = (g8 * 8 + si + 2) & 31;
          RW_LD(s2, a4f, b4f, k4f, w4f, r4f, v2f);
          const f32x2 a01 = {a4.x, a4.y}, a23 = {a4.z, a4.w}, b01 = {b4.x, b4.y}, b23 = {b4.z, b4.w}, k01 = {k4.x, k4.y}, k23 = {k4.z, k4.w};
          const f32x2 w01 = {w4.x, w4.y}, w23 = {w4.z, w4.w}, r01 = {r4.x, r4.y}, r23 = {r4.z, r4.w};
          const f32x2 t0 = S0a * a01 + S0b * a23, t1 = S1a * a01 + S1b * a23;
          float sa0 = t0.x + t0.y, sa1 = t1.x + t1.y;
          const f32x2 vv0 = {v2.x, v2.x}, vv1 = {v2.y, v2.y};
          const f32x2 u0a = S0a * w01 + vv0 * k01, u0b = S0b * w23 + vv0 * k23, u1a = S1a * w01 + vv1 * k01, u1b = S1b * w23 + vv1 * k23;
          sa0 = red16(sa0); sa1 = red16(sa1);
          const f32x2 s0 = {sa0, sa0}, s1 = {sa1, sa1};
          S0a = s0 * b01 + u0a; S0b = s0 * b23 + u0b; S1a = s1 * b01 + u1a; S1b = s1 * b23 + u1b;
          const f32x2 y0 = S0a * r01 + S0b * r23, y1 = S1a * r01 + S1b * r23;
          Lyp[(si * 32 + rp * 2) * 16 + c16] = y0.x + y0.y;
          Lyp[(si * 32 + rp * 2 + 1) * 16 + c16] = y1.x + y1.y;
          a4 = a4n; b4 = b4n; k4 = k4n; w4 = w4n; r4 = r4n; v2 = v2n;
          a4n = a4f; b4n = b4f; k4n = k4f; w4n = w4f; r4n = r4f; v2n = v2f;
        }
        __builtin_amdgcn_wave_barrier();
        asm volatile("s_waitcnt lgkmcnt(0)" ::: "memory");
        {
          const int sj = lane >> 3, ri = lane & 7;
          const float4* pp = (const float4*)(Lyp + (sj * 32 + wave * 8 + ri) * 16);
          const float4 q0 = pp[0], q1 = pp[1], q2 = pp[2], q3 = pp[3];
          const float ysum = ((q0.x + q0.y) + (q0.z + q0.w)) + ((q1.x + q1.y) + (q1.z + q1.w)) + ((q2.x + q2.y) + (q2.z + q2.w)) + ((q3.x + q3.y) + (q3.z + q3.w));
          const int t = scan_token(d, c * T + g8 * 8 + sj);
          yout[((size_t)b * TPB + t) * 512] = f2bf(ysum);
        }
        asm volatile("s_waitcnt lgkmcnt(0)" ::: "memory");
        __builtin_amdgcn_wave_barrier();
      }
      SEGR_ADD(0);
      __syncthreads();
      SEGR_ADD(1);
    }
    SEGR_FLUSH(0);
  } else {
    const int pw = wave - 4;
    const int tok = lane >> 3, cg8 = (lane & 7) * 8;
    const int colsb[5] = {h * 64 + cg8, 512 + h * 64 + cg8, 1024 + h * 64 + cg8, 1536 + d * 64 + cg8, 1664 + d * 64 + cg8};
    const int n16 = lane & 15, q16 = lane >> 4;
    float* bonus = (float*)(p.ws + WS_PB + PB_BONUS) + (size_t)d * R * 8;
    uint4 raw[5][3];
    float fm = 1.f, fp_ = 1.f;
#define RW_ISSUE(CH) do { \
      const int t_ = scan_token(d, (CH) * T + pw * 8 + tok); \
      const bool first_ = (t_ == 0) || (t_ == CTXL), last_ = (t_ == CTXL - 1) || (t_ == TPB - 1); \
      fm = first_ ? 0.f : 1.f; fp_ = last_ ? 0.f : 1.f; \
      const bf16_t* rowp_ = p0 + ((size_t)b * TPB + t_) * P0LD + 1536; \
      const bf16_t* rowm_ = first_ ? rowp_ : rowp_ - P0LD; \
      const bf16_t* rowq_ = last_ ? rowp_ : rowp_ + P0LD; \
      _Pragma("unroll") for (int g_ = 0; g_ < 5; ++g_) { raw[g_][0] = *(const uint4*)(rowm_ + colsb[g_]); raw[g_][1] = *(const uint4*)(rowp_ + colsb[g_]); raw[g_][2] = *(const uint4*)(rowq_ + colsb[g_]); } \
    } while (0)
    RW_ISSUE(0);
    SEGR_DECL();
    SEGR_INIT();
    for (int c = 0; c < NCHK; ++c) {
      int zo = 0;
      asm volatile("" : "+v"(zo));
      char* PS = lds + 90112 + pw * 8192 + zo;
      float* Pk = (float*)PS; bf16_t* PA = (bf16_t*)(PS + 2048); bf16_t* PBa = (bf16_t*)(PS + 4096); float* Pinv = (float*)(PS + 6144);
      const float* LCc = (const float*)(lds + 155648 + zo);
      char* B0 = lds + (c & 1) * BUFB + zo;
      float* La = (float*)B0; float* Lb = (float*)(B0 + 8192); float* Lk = (float*)(B0 + 16384);
      float* Lw = (float*)(B0 + 24576); float* Lr = (float*)(B0 + 32768); float* Lv = (float*)(B0 + 40960);
      const int sl = pw * 8 + tok;
      {
#define RW_MIX(G, OUT) do { float u_[8], um_[8], up_[8]; unpack8(raw[G][1], u_); unpack8(raw[G][0], um_); unpack8(raw[G][2], up_); \
          const float4 m0_ = *(const float4*)(LCc + (5 + G) * 64 + cg8), m1_ = *(const float4*)(LCc + (5 + G) * 64 + cg8 + 4); \
          const float mm_[8] = {m0_.x, m0_.y, m0_.z, m0_.w, m1_.x, m1_.y, m1_.z, m1_.w}; \
          _Pragma("unroll") for (int j = 0; j < 8; ++j) OUT[j] = u_[j] + mm_[j] * (0.5f * (fm * um_[j] + fp_ * up_[j]) - u_[j]); } while (0)
        float mx[8];
        RW_MIX(0, mx);
        *(float4*)(Lr + sl * 64 + cg8) = make_float4(mx[0], mx[1], mx[2], mx[3]);
        *(float4*)(Lr + sl * 64 + cg8 + 4) = make_float4(mx[4], mx[5], mx[6], mx[7]);
        RW_MIX(2, mx);
        if ((cg8 >> 5) == half) {
          *(float4*)(Lv + sl * 32 + (cg8 & 31)) = make_float4(mx[0], mx[1], mx[2], mx[3]);
          *(float4*)(Lv + sl * 32 + (cg8 & 31) + 4) = make_float4(mx[4], mx[5], mx[6], mx[7]);
        }
        RW_MIX(3, mx);
        {
          float tw[8];
#pragma unroll
          for (int j = 0; j < 8; ++j) tw[j] = 1.f - 2.f * frcp_(1.f + __expf(2.f * mx[j]));
          *(uint4*)(PA + tok * 64 + cg8) = pack8(tw);
        }
        RW_MIX(4, mx);
        *(uint4*)(PBa + tok * 64 + cg8) = pack8(mx);
        RW_MIX(1, mx);
        *(float4*)(Pk + tok * 64 + cg8) = make_float4(mx[0], mx[1], mx[2], mx[3]);
        *(float4*)(Pk + tok * 64 + cg8 + 4) = make_float4(mx[4], mx[5], mx[6], mx[7]);
        float nrm = 0.f;
        {
          const float4 q0 = *(const float4*)(LCc + 2 * 64 + cg8), q1 = *(const float4*)(LCc + 2 * 64 + cg8 + 4);
          const float kk8[8] = {q0.x, q0.y, q0.z, q0.w, q1.x, q1.y, q1.z, q1.w};
#pragma unroll
          for (int j = 0; j < 8; ++j) { const float kq = mx[j] * kk8[j]; nrm += kq * kq; }
        }
        nrm = red8(nrm);
        if ((lane & 7) == 0) Pinv[tok] = __builtin_amdgcn_rsqf(fmaxf(nrm, 1e-24f));
        if (c + 1 < NCHK) RW_ISSUE(c + 1);
#undef RW_MIX
      }
      __builtin_amdgcn_wave_barrier();
      asm volatile("s_waitcnt lgkmcnt(0)" ::: "memory");
      SEGR_ADD(2);
      {
        float bon[2] = {0.f, 0.f};
        const int hq = lane >> 5, qq = (lane >> 4) & 1;
#pragma unroll
        for (int gsel = 0; gsel < 2; ++gsel) {
          const bf16_t* Asrc = (gsel == 0 ? PA : PBa) + n16 * 64 + q16 * 8;
          const bf16_t* Wsrc = (const bf16_t*)(lds + (gsel == 0 ? 139264 : 147456) + zo) + n16 * 64 + q16 * 8;
#pragma unroll
          for (int nt = 0; nt < 4; ++nt) {
            f32x4_t acc = {0.f, 0.f, 0.f, 0.f};
#pragma unroll
            for (int ks = 0; ks < 2; ++ks) {
              const bf16x8 af = *(const bf16x8*)(Asrc + ks * 32);
              const bf16x8 bf = *(const bf16x8*)(Wsrc + nt * 16 * 64 + ks * 32);
              acc = __builtin_amdgcn_mfma_f32_16x16x32_bf16(af, bf, acc, 0, 0, 0);
            }
            float xv[2];
            xv[0] = __uint_as_float(__builtin_amdgcn_permlane32_swap(__float_as_uint(acc[0]), __float_as_uint(acc[2]), false, false)[0]);
            xv[1] = __uint_as_float(__builtin_amdgcn_permlane32_swap(__float_as_uint(acc[1]), __float_as_uint(acc[3]), false, false)[0]);
            const int col = nt * 16 + n16;
            const float bias = LCc[gsel * 64 + col];
            const float kkc_ = LCc[2 * 64 + col], kac_ = LCc[3 * 64 + col], rkc_ = LCc[4 * 64 + col];
#pragma unroll
            for (int r = 0; r < 2; ++r) {
              const int tk = qq * 4 + hq * 2 + r, so = (pw * 8 + tk) * 64 + col;
              if (gsel == 0) { Lw[so] = __expf(-0.6065306597126334f * sigmoidf_(xv[r] + bias)); }
              else {
                const float as = sigmoidf_(xv[r] + bias);
                const float k = Pk[tk * 64 + col];
                const float kkv = k * kkc_ * Pinv[tk];
                La[so] = -kkv; Lb[so] = kkv * as;
                const float kd = k * (1.f + (as - 1.f) * kac_);
                Lk[so] = kd;
                bon[r] += Lr[so] * kd * rkc_;
              }
            }
          }
        }
#pragma unroll
        for (int r = 0; r < 2; ++r) bon[r] = red16(bon[r]);
        if (half == 0 && n16 == 0) {
#pragma unroll
          for (int r = 0; r < 2; ++r) {
            const int t = scan_token(d, c * T + pw * 8 + qq * 4 + hq * 2 + r);
            bonus[((size_t)b * TPB + t) * 8 + h] = bon[r];
          }
        }
      }
      SEGR_ADD(3);
      __syncthreads();
      SEGR_ADD(1);
    }
#if defined(PROBE_A) && PROBE_GRP == 1
    if (blockIdx.x == 0 && threadIdx.x == 256) { for (int j__ = 1; j__ < 4; ++j__) ((unsigned long long*)(p.ws + WS_SCAL + 1024))[22 + 4 + j__] += seg_acc_[j__]; }
#endif
    __syncthreads();
#undef RW_ISSUE
  }
}

DI void phase_rwkv_post(const P& p) {
  const bf16_t* p0 = (const bf16_t*)(p.ws + WS_PB + PB_P);
  const bf16_t* yf = (const bf16_t*)(p.ws + WS_HB + HB_YF);
  const bf16_t* yb = (const bf16_t*)(p.ws + WS_HB + HB_YB);
  const bf16_t* G = (const bf16_t*)(p.ws + WS_PB + PB_G);
  const float* bonus = (const float*)(p.ws + WS_PB + PB_BONUS);
  bf16_t* o0 = (bf16_t*)(p.ws + WS_PB + PB_O0);
  const float* mu = p.in[I_RWMU] + 1024;
  const int sub = threadIdx.x & 7;
  for (int it = (blockIdx.x * NTHR + threadIdx.x) >> 3; it < R * 8; it += (gridDim.x * NTHR) >> 3) {
    const int row = it >> 3, h = it & 7;
    const int t = row % TPB;
    const bool first = (t == 0) || (t == CTXL), last = (t == CTXL - 1) || (t == TPB - 1);
    const int cc = h * 64 + sub * 8;
    float y[8], a[8], bb[8];
    unpack8(*(const uint4*)(yf + (size_t)row * 512 + cc), a);
    unpack8(*(const uint4*)(yb + (size_t)row * 512 + cc), bb);
    float mean = 0.f;
#pragma unroll
    for (int j = 0; j < 8; ++j) { y[j] = a[j] + bb[j]; mean += y[j]; }
    mean = red8(mean) * (1.f / 64.f);
    float var = 0.f;
#pragma unroll
    for (int j = 0; j < 8; ++j) { const float dlt = y[j] - mean; var += dlt * dlt; }
    var = red8(var) * (1.f / 64.f);
    const float rs = rsqrtf(var + 64e-5f);
    const float bn = bonus[(size_t)row * 8 + h] + bonus[(size_t)R * 8 + (size_t)row * 8 + h];
    const bf16_t* vp = p0 + (size_t)row * P0LD + 1536 + 1024 + cc;
    float u[8], um[8], up[8], g[8], o[8];
    unpack8(*(const uint4*)vp, u);
    unpack8(*(const uint4*)(first ? vp : vp - P0LD), um);
    unpack8(*(const uint4*)(last ? vp : vp + P0LD), up);
    unpack8(*(const uint4*)(G + (size_t)row * 512 + cc), g);
    const float fm = first ? 0.f : 1.f, fp_ = last ? 0.f : 1.f;
#pragma unroll
    for (int j = 0; j < 8; ++j) {
      const float v = u[j] + mu[cc + j] * (0.5f * (fm * um[j] + fp_ * up[j]) - u[j]);
      const float yn = (y[j] - mean) * rs * p.in[I_LNXW][cc + j] + p.in[I_LNXB][cc + j];
      o[j] = (yn + bn * v) * g[j];
    }
    *(uint4*)(o0 + (size_t)row * 1024 + 512 + cc) = pack8(o);
  }
}

DI unsigned f2ord(float f) { const unsigned u = __float_as_uint(f); return u ^ ((u >> 31) ? 0xFFFFFFFFu : 0x80000000u); }
DI float ord2f(unsigned u) { u ^= ((u >> 31) ? 0x80000000u : 0xFFFFFFFFu); return __uint_as_float(u); }

DI void bitonic_sort16_desc(unsigned (&v)[16]) {
#pragma unroll
  for (int k = 2; k <= 16; k <<= 1)
#pragma unroll
    for (int j = k >> 1; j > 0; j >>= 1)
#pragma unroll
      for (int i = 0; i < 16; ++i) {
        const int l = i ^ j;
        if (l > i) { const unsigned hi = max(v[i], v[l]), lo = min(v[i], v[l]); const bool desc = ((i & k) == 0); v[i] = desc ? hi : lo; v[l] = desc ? lo : hi; }
      }
}
DI void merge_top16_desc(unsigned (&a)[16], const unsigned (&b)[16]) {
#pragma unroll
  for (int i = 0; i < 16; ++i) a[i] = max(a[i], b[15 - i]);
#pragma unroll
  for (int j = 8; j > 0; j >>= 1)
#pragma unroll
    for (int i = 0; i < 16; ++i) { const int l = i ^ j; if (l > i) { const unsigned hi = max(a[i], a[l]), lo = min(a[i], a[l]); a[i] = hi; a[l] = lo; } }
}
struct CandPairs { int ia[25], ja[25], ib[25], jb[25]; };
constexpr CandPairs make_pairs() {
  CandPairs c{};
  int n = 0;
  for (int i = 0; i < 16; ++i) for (int j = 0; j < 16; ++j) if ((i + 1) * (j + 1) <= 16) {
    if ((n & 1) == 0) { c.ia[n >> 1] = i; c.ja[n >> 1] = j; } else { c.ib[n >> 1] = i; c.jb[n >> 1] = j; }
    ++n;
  }
  return c;
}
constexpr CandPairs CP = make_pairs();

DI void peer_topk_unit(const P& p, char* lds, int layer, int unit) {
  const int tid = threadIdx.x, lane = tid & 63, wave = tid >> 6;
  const int mt = unit >> 3, h = unit & 7;
  const bf16_t* q = (const bf16_t*)(p.ws + WS_PB + PB_Q);
  const bf16_t* keys = (const bf16_t*)(p.ws + (layer == 0 ? WS_KEYS0 : WS_KEYS1)) + (size_t)h * 2 * 128 * 128;
  int* idxo = (int*)(p.ws + WS_PB + PB_IDX);
  float* gateo = (float*)(p.ws + WS_PB + PB_GATE);
  __syncthreads();
  for (int e = tid; e < 2 * 128 * 16; e += NTHR) {
    const int pp = e >> 11, row = (e >> 4) & 127, c = e & 15;
    *(uint4*)(lds + pp * 32768 + row * 256 + ((c ^ (row & 15)) << 4)) = *(const uint4*)(keys + (size_t)pp * 16384 + row * 128 + c * 8);
  }
  __syncthreads();
  const int r31 = lane & 31, hh = lane >> 5;
  const size_t trow = (size_t)mt * 256 + wave * 32 + r31;
  unsigned vk[2][16];
#pragma unroll
  for (int pp = 0; pp < 2; ++pp) {
    f32x16 acc[4];
#pragma unroll
    for (int m = 0; m < 4; ++m)
#pragma unroll
      for (int r = 0; r < 16; ++r) acc[m][r] = 0.f;
    const bf16_t* qp = q + trow * 2048 + (h * 2 + pp) * 128;
#pragma unroll
    for (int kk = 0; kk < 8; ++kk) {
      const bf16x8 bq = *(const bf16x8*)(qp + kk * 16 + 8 * hh);
      const int c = kk * 2 + hh;
#pragma unroll
      for (int m = 0; m < 4; ++m) {
        const int row = m * 32 + r31;
        const bf16x8 ak = *(const bf16x8*)(lds + pp * 32768 + row * 256 + ((c ^ (row & 15)) << 4));
        acc[m] = MFMA32(ak, bq, acc[m]);
      }
    }
    unsigned v[16];
#pragma unroll
    for (int m = 0; m < 4; ++m) {
      unsigned kx[16];
#pragma unroll
      for (int r = 0; r < 16; ++r) kx[r] = (f2ord(acc[m][r]) & ~127u) | (unsigned)(127 - (m * 32 + ACC_ROW(r, lane)));
      bitonic_sort16_desc(kx);
      if (m == 0) {
#pragma unroll
        for (int i = 0; i < 16; ++i) v[i] = kx[i];
      } else merge_top16_desc(v, kx);
    }
    unsigned c16[16];
#pragma unroll
    for (int i = 0; i < 16; ++i) c16[i] = (unsigned)__shfl_xor((int)v[i], 32);
    merge_top16_desc(v, c16);
#pragma unroll
    for (int i = 0; i < 16; ++i) vk[pp][i] = v[i];
  }
  float val1[16], val2[16]; int id1[16], id2[16];
#pragma unroll
  for (int i = 0; i < 16; ++i) {
    val1[i] = ord2f(vk[0][i] & ~127u); id1[i] = 127 - (int)(vk[0][i] & 127u);
    val2[i] = ord2f(vk[1][i] & ~127u); id2[i] = 127 - (int)(vk[1][i] & 127u);
  }
  unsigned tk[16];
#pragma unroll
  for (int t = 0; t < 16; ++t) {
    const float va = val1[CP.ia[t]] + val2[CP.ja[t]], vb = val1[CP.ib[t]] + val2[CP.jb[t]];
    const int pa = id1[CP.ia[t]] * 128 + id2[CP.ja[t]], pb = id1[CP.ib[t]] * 128 + id2[CP.jb[t]];
    tk[t] = (f2ord(hh ? vb : va) & ~0x3FFFu) | (unsigned)(hh ? pb : pa);
  }
  bitonic_sort16_desc(tk);
#pragma unroll
  for (int t = 16; t < 25; ++t) {
    const float va = val1[CP.ia[t]] + val2[CP.ja[t]], vb = val1[CP.ib[t]] + val2[CP.jb[t]];
    const int pa = id1[CP.ia[t]] * 128 + id2[CP.ja[t]], pb = id1[CP.ib[t]] * 128 + id2[CP.jb[t]];
    unsigned x = (f2ord(hh ? vb : va) & ~0x3FFFu) | (unsigned)(hh ? pb : pa);
#pragma unroll
    for (int i = 0; i < 16; ++i) { const unsigned hi = max(tk[i], x); x = min(tk[i], x); tk[i] = hi; }
  }
  float cv[16]; int cp[16];
  float mx = -3.0e38f;
#pragma unroll
  for (int i = 0; i < 16; ++i) {
    const unsigned ok = (unsigned)__shfl_xor((int)tk[15 - i], 32);
    const unsigned kk_ = max(tk[i], ok);
    cv[i] = ord2f(kk_ & ~0x3FFFu); cp[i] = (int)(kk_ & 0x3FFFu);
    mx = fmaxf(mx, cv[i]);
  }
  float sum = 0.f;
#pragma unroll
  for (int i = 0; i < 16; ++i) { cv[i] = __expf(cv[i] - mx); sum += cv[i]; }
  const float inv = 1.f / sum;
  if (hh == 0) {
    int* ip = idxo + trow * 128 + h * 16;
    float* gp = gateo + trow * 128 + h * 16;
#pragma unroll
    for (int i = 0; i < 4; ++i) {
      *(int4*)(ip + i * 4) = make_int4(cp[i * 4], cp[i * 4 + 1], cp[i * 4 + 2], cp[i * 4 + 3]);
      *(float4*)(gp + i * 4) = make_float4(cv[i * 4] * inv, cv[i * 4 + 1] * inv, cv[i * 4 + 2] * inv, cv[i * 4 + 3] * inv);
    }
  }
}

DI int wave_sum_i(int x) {
  x += __builtin_amdgcn_update_dpp(0, x, 0xB1, 0xF, 0xF, true);
  x += __builtin_amdgcn_update_dpp(0, x, 0x4E, 0xF, 0xF, true);
  x += __builtin_amdgcn_update_dpp(0, x, 0x141, 0xF, 0xF, true);
  x += __builtin_amdgcn_update_dpp(0, x, 0x140, 0xF, 0xF, true);
  return __builtin_amdgcn_readlane(x, 0) + __builtin_amdgcn_readlane(x, 16) + __builtin_amdgcn_readlane(x, 32) + __builtin_amdgcn_readlane(x, 48);
}
DI int reduce8_transposed(const int (&v)[8], int lane) {
  int x[4], y[2];
#pragma unroll
  for (int j = 0; j < 4; ++j) { const auto r = __builtin_amdgcn_permlane32_swap((unsigned)v[j], (unsigned)v[4 + j], false, false); x[j] = (int)(r[0] + r[1]); }
#pragma unroll
  for (int j = 0; j < 2; ++j) { const auto r = __builtin_amdgcn_permlane16_swap((unsigned)x[j], (unsigned)x[2 + j], false, false); y[j] = (int)(r[0] + r[1]); }
  const bool b3 = (lane >> 3) & 1;
  const int keep = b3 ? y[1] : y[0], send = b3 ? y[0] : y[1];
  int z = keep + __builtin_amdgcn_update_dpp(0, send, 0x128, 0xF, 0xF, true);
  z += __builtin_amdgcn_update_dpp(0, z, 0xB1, 0xF, 0xF, true);
  z += __builtin_amdgcn_update_dpp(0, z, 0x4E, 0xF, 0xF, true);
  z += __builtin_amdgcn_update_dpp(0, z, 0x141, 0xF, 0xF, true);
  return z;
}
DI float gelu_fast(float v) {
  const float av = fabsf(v), t = __builtin_amdgcn_rcpf(av * 0.2316418882f + 1.0f);
  float q = t * 0.5307027145f + (-0.7265760135f); q = q * t + 0.7107068705f; q = q * t + (-0.142248368f); q = q * t + 0.127414796f; q = q * t;
  const float e = __builtin_amdgcn_exp2f((v * v) * (-0.72134752044f));
  const float m = v * (q * e);
  return v < 0.f ? m : v - m;
}
typedef float f32x2g __attribute__((ext_vector_type(2)));
DI int reduce4_half(const int (&v)[4], int lane) {
  int y[2];
#pragma unroll
  for (int j = 0; j < 2; ++j) { const auto r = __builtin_amdgcn_permlane16_swap((unsigned)v[j], (unsigned)v[2 + j], false, false); y[j] = (int)(r[0] + r[1]); }
  const bool b3 = (lane >> 3) & 1;
  const int keep = b3 ? y[1] : y[0], send = b3 ? y[0] : y[1];
  int z = keep + __builtin_amdgcn_update_dpp(0, send, 0x128, 0xF, 0xF, true);
  z += __builtin_amdgcn_update_dpp(0, z, 0xB1, 0xF, 0xF, true);
  z += __builtin_amdgcn_update_dpp(0, z, 0x4E, 0xF, 0xF, true);
  z += __builtin_amdgcn_update_dpp(0, z, 0x141, 0xF, 0xF, true);
  return z;
}
#ifndef PG_VREP
#define PG_VREP 1
#endif
DI void phase_peer_gather(const P& p, int layer) {
  const int lane = threadIdx.x & 63, gw = blockIdx.x * 8 + (threadIdx.x >> 6), nw = gridDim.x * 8;
  const bf16_t* h2 = (const bf16_t*)(p.ws + WS_PB + PB_H2);
  const int* idx = (const int*)(p.ws + WS_PB + PB_IDX);
  const float* gate = (const float*)(p.ws + WS_PB + PB_GATE);
  const unsigned char* U = p.ws + WS_HB + HB_U;
  const unsigned char* V = p.ws + WS_HB + HB_V;
  const float* su = (const float*)(p.ws + WS_HB + HB_SU);
  const float* sv = (const float*)(p.ws + WS_HB + HB_SV);
  const float* mods = (const float*)(p.ws + WS_MODS) + (size_t)layer * 9 * 6144;
  float* xc = (float*)(p.ws + WS_XC);
  const int hs = lane & 31, up = lane >> 5, k4 = (lane >> 3) & 3;
  for (int row = gw; row < R; row += nw) {
    const int b = row / TPB, t = row - b * TPB;
    const bool isctx = t < CTXL;
    if (isctx && layer == 1) continue;
    int hE[4], hO[4]; float sh, hoff;
    {
      float hv[32], f[8];
#pragma unroll
      for (int i = 0; i < 4; ++i) { unpack8(*(const uint4*)(h2 + (size_t)row * D + hs * 32 + i * 8), f);
#pragma unroll
        for (int j = 0; j < 8; ++j) hv[i * 8 + j] = f[j]; }
      float am = 0.f;
#pragma unroll
      for (int j = 0; j < 32; ++j) am = fmaxf(am, fabsf(hv[j]));
      am = fmaxf(wave_max(am), 1e-30f);
      const float inv = 127.f / am;
      sh = am * (1.f / 127.f);
      int hsum = 0;
#pragma unroll
      for (int d4 = 0; d4 < 4; ++d4) {
        unsigned pe = 0, po = 0;
#pragma unroll
        for (int j = 0; j < 4; ++j) {
          const int qe = (int)rintf(hv[d4 * 8 + 2 * j] * inv), qo = (int)rintf(hv[d4 * 8 + 2 * j + 1] * inv);
          hsum += qe + qo;
          pe |= ((unsigned)qe & 0xffu) << (8 * j); po |= ((unsigned)qo & 0xffu) << (8 * j);
        }
        hE[d4] = (int)pe; hO[d4] = (int)po;
      }
      hoff = 7.5f * 0.5f * (float)wave_sum_i(hsum);
    }
    f32x2g accp[16];
#pragma unroll
    for (int j = 0; j < 16; ++j) accp[j] = f32x2g{0.f, 0.f};
    float corr = 0.f;
    const int my_i0 = idx[(size_t)row * 128 + lane], my_i1 = idx[(size_t)row * 128 + 64 + lane];
    const float my_g0 = gate[(size_t)row * 128 + lane], my_g1 = gate[(size_t)row * 128 + 64 + lane];
#define PG_LOAD(E0, UR, VR, SC) do { _Pragma("unroll") for (int k = 0; k < 4; ++k) { const int e_ = (E0) + 2 * k; \
        const int ea_ = ((E0) < 64) ? __builtin_amdgcn_readlane(my_i0, e_ & 63) : __builtin_amdgcn_readlane(my_i1, e_ & 63); \
        const int eb_ = ((E0) < 64) ? __builtin_amdgcn_readlane(my_i0, (e_ + 1) & 63) : __builtin_amdgcn_readlane(my_i1, (e_ + 1) & 63); \
        const size_t ro_ = (size_t)(up ? eb_ : ea_) * 512 + hs * 16; \
        UR[k] = *(const uint4*)(U + ro_); VR[k] = *(const uint4*)(V + ro_); } \
      { const int es_ = (E0) + 2 * k4 + up; const int ei_ = __shfl(((E0) < 64) ? my_i0 : my_i1, es_ & 63); SC[0] = su[ei_]; SC[1] = sv[ei_]; } } while (0)
#define PG_COMPUTE(E0, UR, VR, SC) do { \
      const int es_ = (E0) + 2 * k4 + up; \
      const float ggA = __shfl(((E0) < 64) ? my_g0 : my_g1, es_ & 63); \
      const float suA = SC[0], svA = SC[1]; \
      int dA[4]; \
      _Pragma("unroll") for (int k = 0; k < 4; ++k) { \
        const unsigned uu[4] = {UR[k].x, UR[k].y, UR[k].z, UR[k].w}; int d = 0; \
        _Pragma("unroll") for (int d4 = 0; d4 < 4; ++d4) { \
          d = __builtin_amdgcn_sdot4(hE[d4], (int)(uu[d4] & 0x0F0F0F0Fu), d, false); \
          d = __builtin_amdgcn_sdot4(hO[d4], (int)((uu[d4] >> 4) & 0x0F0F0F0Fu), d, false); } \
        dA[k] = d; } \
      const int tA = reduce4_half(dA, lane); \
      const float wA = ggA * gelu_fast(((float)tA - hoff) * (sh * suA)) * svA; \
      _Pragma("unroll") for (int k = 0; k < 4; ++k) { \
        const float w0_ = __shfl(wA, (lane & 32) + 8 * k); \
        corr += w0_; \
        const unsigned vv[4] = {VR[k].x, VR[k].y, VR[k].z, VR[k].w}; \
        _Pragma("unroll") for (int rep_ = 0; rep_ < PG_VREP; ++rep_) { const f32x2g w2 = {w0_, w0_}; \
        _Pragma("unroll") for (int d4 = 0; d4 < 4; ++d4) { \
          const int lo = (int)(vv[d4] & 0x0F0F0F0Fu), hi = (int)((vv[d4] >> 4) & 0x0F0F0F0Fu); \
          accp[d4 * 4 + 0] += w2 * __builtin_amdgcn_cvt_pk_f32_fp8(lo, false); accp[d4 * 4 + 1] += w2 * __builtin_amdgcn_cvt_pk_f32_fp8(hi, false); \
          accp[d4 * 4 + 2] += w2 * __builtin_amdgcn_cvt_pk_f32_fp8(lo, true); accp[d4 * 4 + 3] += w2 * __builtin_amdgcn_cvt_pk_f32_fp8(hi, true); } } } } while (0)
    {
      uint4 urA[4], vrA[4], urB[4], vrB[4];
      float scA[2], scB[2];
      PG_LOAD(0, urA, vrA, scA);
#pragma unroll 1
      for (int e0 = 0; e0 < 128; e0 += 16) {
        PG_LOAD(e0 + 8, urB, vrB, scB);
        PG_COMPUTE(e0, urA, vrA, scA);
        if (e0 + 16 < 128) PG_LOAD(e0 + 16, urA, vrA, scA);
        PG_COMPUTE(e0 + 8, urB, vrB, scB);
      }
    }
#undef PG_LOAD
#undef PG_COMPUTE
    const float c75 = 7.5f * (corr + __shfl_xor(corr, 32));
    const float inv_unit = 1.f / __builtin_amdgcn_cvt_pk_f32_fp8(1, false)[0];
    float acc[32];
#pragma unroll
    for (int d4 = 0; d4 < 4; ++d4) {
      acc[d4 * 8 + 0] = accp[d4 * 4 + 0][0]; acc[d4 * 8 + 2] = accp[d4 * 4 + 0][1]; acc[d4 * 8 + 1] = accp[d4 * 4 + 1][0]; acc[d4 * 8 + 3] = accp[d4 * 4 + 1][1];
      acc[d4 * 8 + 4] = accp[d4 * 4 + 2][0]; acc[d4 * 8 + 6] = accp[d4 * 4 + 2][1]; acc[d4 * 8 + 5] = accp[d4 * 4 + 3][0]; acc[d4 * 8 + 7] = accp[d4 * 4 + 3][1];
    }
    float o16[16];
#pragma unroll
    for (int i = 0; i < 16; ++i) {
      const float mine = up ? acc[16 + i] : acc[i], give = up ? acc[i] : acc[16 + i];
      o16[i] = (mine + __shfl_xor(give, 32)) * inv_unit - c75;
    }
    const int col0 = hs * 32 + up * 16;
    const float* g5 = mods + (isctx ? 8 : b) * 6144 + 5 * 1024 + col0;
    float* xp = isctx ? (xc + ((size_t)(b * CTXL + t)) * D + col0) : (p.out + ((size_t)(b * SEQ + t - CTXL)) * D + col0);
    float xn[16];
    float ssq = 0.f;
#pragma unroll
    for (int i = 0; i < 4; ++i) {
      const float4 x = *(const float4*)(xp + i * 4);
      xn[i * 4] = x.x + g5[i * 4] * o16[i * 4]; xn[i * 4 + 1] = x.y + g5[i * 4 + 1] * o16[i * 4 + 1];
      xn[i * 4 + 2] = x.z + g5[i * 4 + 2] * o16[i * 4 + 2]; xn[i * 4 + 3] = x.w + g5[i * 4 + 3] * o16[i * 4 + 3];
#pragma unroll
      for (int j = 0; j < 4; ++j) ssq += xn[i * 4 + j] * xn[i * 4 + j];
    }
    ssq = red64(ssq);
    const float rs = rsqrtf(ssq * (1.f / 1024.f) + 1e-6f);
    if (layer == 1) {
      const float* gf = p.in[I_NF] + col0;
#pragma unroll
      for (int i = 0; i < 4; ++i)
        *(float4*)(xp + i * 4) = make_float4(xn[i * 4] * rs * gf[i * 4], xn[i * 4 + 1] * rs * gf[i * 4 + 1], xn[i * 4 + 2] * rs * gf[i * 4 + 2], xn[i * 4 + 3] * rs * gf[i * 4 + 3]);
    } else {
#pragma unroll
      for (int i = 0; i < 4; ++i) *(float4*)(xp + i * 4) = make_float4(xn[i * 4], xn[i * 4 + 1], xn[i * 4 + 2], xn[i * 4 + 3]);
      const float* gn1 = p.in[I_N1_1] + col0;
      const float* m1 = mods + 9 * 6144 + (isctx ? 8 : b) * 6144 + col0;
      float hh_[16];
#pragma unroll
      for (int i = 0; i < 16; ++i) hh_[i] = xn[i] * rs * gn1[i] * (1.f + m1[1024 + i]) + m1[i];
      bf16_t* hp = (bf16_t*)(p.ws + WS_HNEXT) + (size_t)row * D + col0;
      uint4 w0, w1;
      w0.x = pack_bf2(hh_[0], hh_[1]); w0.y = pack_bf2(hh_[2], hh_[3]); w0.z = pack_bf2(hh_[4], hh_[5]); w0.w = pack_bf2(hh_[6], hh_[7]);
      w1.x = pack_bf2(hh_[8], hh_[9]); w1.y = pack_bf2(hh_[10], hh_[11]); w1.z = pack_bf2(hh_[12], hh_[13]); w1.w = pack_bf2(hh_[14], hh_[15]);
      *(uint4*)hp = w0; *(uint4*)(hp + 8) = w1;
    }
  }
}

template <int CH>
DI void conv_stream(const P& p, char* lds, bf16_t* base, int pitch  , int chan0  ) {
  const int tid = threadIdx.x;
  constexpr int NT = NTHR / CH;
  constexpr int RPT = TPB / NT;
  const int ck = tid % CH, tl = tid / CH;
  const int t0 = tl * RPT;
  bf16_t* colp = base + ck * 8;
  uint4* halo = (uint4*)lds;
  float w0[8], w1[8], w2[8], bb[8];
#pragma unroll
  for (int j = 0; j < 8; ++j) { const int c = chan0 + ck * 8 + j; w0[j] = p.in[I_CONVW][c]; w1[j] = p.in[I_CONVW][3072 + c]; w2[j] = p.in[I_CONVW][6144 + c]; bb[j] = p.in[I_CONVB][c]; }
  __syncthreads();
  uint4 cur = *(const uint4*)(colp + (size_t)t0 * pitch);
  halo[(tl * 2 + 0) * CH + ck] = cur;
  halo[(tl * 2 + 1) * CH + ck] = *(const uint4*)(colp + (size_t)(t0 + RPT - 1) * pitch);
  __syncthreads();
  uint4 prev = halo[((tl > 0 ? tl - 1 : 0) * 2 + 1) * CH + ck];
  const uint4 nxt_halo = halo[((tl < NT - 1 ? tl + 1 : NT - 1) * 2 + 0) * CH + ck];
  __syncthreads();
  constexpr int UB = (RPT % 4 == 0) ? 4 : 2;
  for (int rb = 0; rb < RPT; rb += UB) {
    uint4 nx[UB];
#pragma unroll
    for (int i = 0; i < UB; ++i) { const int r = rb + i + 1; uint4 v_ = nxt_halo; if (r < RPT) v_ = *(const uint4*)(colp + (size_t)(t0 + r) * pitch); nx[i] = v_; }
#pragma unroll
    for (int i = 0; i < UB; ++i) {
      const int t = t0 + rb + i;
      const bool first = (t == 0) || (t == CTXL), last = (t == CTXL - 1) || (t == TPB - 1);
      float u[8], um[8], up[8], o[8];
      unpack8(cur, u); unpack8(prev, um); unpack8(nx[i], up);
      const float fm = first ? 0.f : 1.f, fp_ = last ? 0.f : 1.f;
#pragma unroll
      for (int j = 0; j < 8; ++j) o[j] = siluf_(w0[j] * (fm * um[j]) + w1[j] * u[j] + w2[j] * (fp_ * up[j]) + bb[j]);
      *(uint4*)(colp + (size_t)t * pitch) = pack8(o);
      prev = cur; cur = nx[i];
    }
  }
}
DI void phase_conv(const P& p, char* lds) {
  unsigned char* pb = p.ws + WS_PB;
  for (int w = blockIdx.x; w < 256; w += gridDim.x) {
    conv_stream<8>(p, lds, (bf16_t*)(pb + L1_XH) + (size_t)w * TPB * 64, 64, (w & 31) * 64);
    const int q = w & 3, sg = (w >> 2) & 31, isC = w >> 7;
    conv_stream<4>(p, lds, (bf16_t*)(pb + (isC ? L1_CG : L1_BG)) + (size_t)sg * TPB * 128 + q * 32, 128, (isC ? 2560 : 2048) + (sg & 3) * 128 + q * 32);
  }
}

DI int swzBC(int row) { return ((row & 3) << 2) | ((row >> 2) & 3); }
DI int swzX(int row) { return ((row >> 1) & 1) << 2; }

DI void ssd_chunk_unit(const P& p, char* lds, int unit) {
  const int tid = threadIdx.x, lane = tid & 63, wave = tid >> 6;
  const int b = unit >> 5, head = unit & 31, grp = head >> 3;
  bf16_t* zh = (bf16_t*)(p.ws + WS_PB + L1_ZH) + (size_t)(b * 32 + head) * TPB * 64;
  const bf16_t* xh = (const bf16_t*)(p.ws + WS_PB + L1_XH) + (size_t)(b * 32 + head) * TPB * 64;
  const bf16_t* bg = (const bf16_t*)(p.ws + WS_PB + L1_BG) + (size_t)(b * 4 + grp) * TPB * 128;
  const bf16_t* cgp_ = (const bf16_t*)(p.ws + WS_PB + L1_CG) + (size_t)(b * 4 + grp) * TPB * 128;
  const bf16_t* dtp = (const bf16_t*)(p.ws + WS_PB + L1_DT) + (size_t)b * TPB * 64;
  bf16_t* yftmp = (bf16_t*)(p.ws + WS_YF) + (size_t)(b * 32 + head) * SEQ * 64;
  const float dsk = p.in[I_DSKIP][head];
  const int r31 = lane & 31, hh = lane >> 5, q4 = (lane & 15) >> 2, grp16 = (lane >> 4) & 1, p3 = lane & 3;
  const int lt = wave >> 1, pt = wave & 1;
  const int cc = tid & 7, rr = tid >> 3;
  const int orow = tid >> 3, ock = tid & 7;
  constexpr int NCH = TPB / 128;
  SEGS_DECL();
  for (int d = 0; d < 2; ++d) {
    const float Aneg = -__expf(p.in[I_ALOG][d * 32 + head]);
    const float dtb = p.in[I_DTB][d * 32 + head];
    f32x16 Hacc;
#pragma unroll
    for (int r = 0; r < 16; ++r) Hacc[r] = 0.f;
    __syncthreads();
    for (int e = tid; e < 1024; e += NTHR) *(uint4*)(lds + 98304 + e * 16) = make_uint4(0, 0, 0, 0);
    uint4 st[2][5];
    float dtr0, dtr1;
    uint4 oyf[2], oz[2];
#define SSD_ISSUE(CH) do { \
      _Pragma("unroll") for (int rh_ = 0; rh_ < 2; ++rh_) { \
        const int t_ = scan_token(d, (CH) * 128 + rh_ * 64 + rr); \
        st[rh_][0] = *(const uint4*)(xh + (size_t)t_ * 64 + cc * 8); \
        st[rh_][1] = *(const uint4*)(bg + (size_t)t_ * 128 + cc * 8); \
        st[rh_][2] = *(const uint4*)(bg + (size_t)t_ * 128 + 64 + cc * 8); \
        st[rh_][3] = *(const uint4*)(cgp_ + (size_t)t_ * 128 + cc * 8); \
        st[rh_][4] = *(const uint4*)(cgp_ + (size_t)t_ * 128 + 64 + cc * 8); \
      } \
      dtr0 = bf2f(dtp[(size_t)scan_token(d, (CH) * 128 + lane) * 64 + d * 32 + head]); \
      dtr1 = bf2f(dtp[(size_t)scan_token(d, (CH) * 128 + 64 + lane) * 64 + d * 32 + head]); \
    } while (0)
    SSD_ISSUE(0);
    SEGS_INIT();
    for (int ch = 0; ch <= NCH; ++ch) {
      int zoff = 0;
      asm volatile("" : "+v"(zoff));
      char* L0 = lds + zoff;
      char* LB = L0; char* LC = L0 + 32768; char* LX = L0 + 65536; char* LXw = L0 + 81920; char* LHs = L0 + 98304;
      float* Lacs = (float*)(L0 + 131072); float* Ldt = (float*)(L0 + 131584); float* Lea = (float*)(L0 + 132096);
      char* LY = L0 + 132608;
      __syncthreads();
      SEGS_ADD(0);
      if (ch - 1 >= CTXL / 128) {
#pragma unroll
        for (int i = 0; i < 2; ++i) {
          const int row = orow + i * 64;
          const int t = scan_token(d, (ch - 1) * 128 + row);
          const uint4 yv = *(const uint4*)(LY + row * 128 + ock * 16);
          if (d == 0) {
            *(uint4*)(yftmp + (size_t)(t - CTXL) * 64 + ock * 8) = yv;
          } else {
            float y[8], yf[8], z[8], o[8];
            unpack8(yv, y); unpack8(oyf[i], yf); unpack8(oz[i], z);
#pragma unroll
            for (int j = 0; j < 8; ++j) o[j] = (yf[j] + y[j]) * siluf_(z[j]);
            *(uint4*)(zh + (size_t)t * 64 + ock * 8) = pack8(o);
          }
        }
      }
      if (ch == NCH) break;
      float dt0, dt1, acs0, acs1, alast;
      {
        dt0 = softplusf_(dtr0 + dtb); dt1 = softplusf_(dtr1 + dtb);
        acs0 = dt0 * Aneg; acs1 = dt1 * Aneg;
#pragma unroll
        for (int off = 1; off < 64; off <<= 1) {
          const float y0 = __shfl_up(acs0, off), y1 = __shfl_up(acs1, off);
          if (lane >= off) { acs0 += y0; acs1 += y1; }
        }
        acs1 += __shfl(acs0, 63);
        alast = __shfl(acs1, 63);
        if (wave == 0) {
          Lacs[lane] = acs0; Lacs[64 + lane] = acs1; Ldt[lane] = dt0; Ldt[64 + lane] = dt1;
          Lea[lane] = __expf(acs0); Lea[64 + lane] = __expf(acs1);
        }
      }
#pragma unroll
      for (int rh = 0; rh < 2; ++rh) {
        const int s_ = rh * 64 + rr;
        const float dts = __shfl(rh ? dt1 : dt0, rr);
        const float ws_ = __expf(alast - __shfl(rh ? acs1 : acs0, rr));
        float xv[8], xw[8];
        unpack8(st[rh][0], xv);
#pragma unroll
        for (int j = 0; j < 8; ++j) { xv[j] *= dts; xw[j] = xv[j] * ws_; }
        const int off = s_ * 128 + ((cc ^ swzX(s_)) << 4);
        *(uint4*)(LX + off) = pack8(xv);
        *(uint4*)(LXw + off) = pack8(xw);
        const int sw = swzBC(s_);
        *(uint4*)(LB + s_ * 256 + ((cc ^ sw) << 4)) = st[rh][1];
        *(uint4*)(LB + s_ * 256 + (((8 + cc) ^ sw) << 4)) = st[rh][2];
        *(uint4*)(LC + s_ * 256 + ((cc ^ sw) << 4)) = st[rh][3];
        *(uint4*)(LC + s_ * 256 + (((8 + cc) ^ sw) << 4)) = st[rh][4];
      }
      SEGS_ADD(1);
      __syncthreads();
      SEGS_ADD(2);
      if (ch + 1 < NCH) SSD_ISSUE(ch + 1);
      if (d == 1 && ch >= CTXL / 128) {
#pragma unroll
        for (int i = 0; i < 2; ++i) {
          const int t = scan_token(d, ch * 128 + orow + i * 64);
          oyf[i] = *(const uint4*)(yftmp + (size_t)(t - CTXL) * 64 + ock * 8);
          oz[i] = *(const uint4*)(zh + (size_t)t * 64 + ock * 8);
        }
      }
      const char* LBz = LB; const char* LCz = LC; const char* LXz = LX; const char* LXwz = LXw;
      const char* Hs = LHs;
      char* LMa = L0 + 114688; char* LMb = L0 + 148992;
      if (ch >= CTXL / 128) {
        f32x16 Y;
#pragma unroll
        for (int r = 0; r < 16; ++r) Y[r] = 0.f;
        const int crow = lt * 32 + r31;
        const char* cbase = LCz + crow * 256;
        const int csw = swzBC(crow);
        {
          const int hrow = pt * 32 + r31;
#pragma unroll 2
          for (int kk = 0; kk < 8; ++kk) {
            const bf16x8 cfk = *(const bf16x8*)(cbase + (((kk * 2 + hh) ^ csw) << 4));
            const bf16x8 hb = *(const bf16x8*)(Hs + hrow * 256 + (((kk * 2 + hh) ^ swzBC(hrow)) << 4));
            Y = MFMA32(cfk, hb, Y);
          }
        }
#pragma unroll
        for (int r = 0; r < 16; ++r) Y[r] *= Lea[lt * 32 + ACC_ROW(r, lane)];
        const int lcol = lt * 32 + r31;
        const float acs_l = Lacs[lcol];
        const float ddiag = (d == 1) ? dsk / Ldt[lcol] : 0.f;
        for (int st_ = pt; st_ <= lt; st_ += 2) {
          f32x16 g;
#pragma unroll
          for (int r = 0; r < 16; ++r) g[r] = 0.f;
          const int row = st_ * 32 + r31;
#pragma unroll 4
          for (int kk = 0; kk < 8; ++kk) {
            const bf16x8 a = *(const bf16x8*)(LBz + row * 256 + (((kk * 2 + hh) ^ swzBC(row)) << 4));
            const bf16x8 cfk = *(const bf16x8*)(cbase + (((kk * 2 + hh) ^ csw) << 4));
            g = MFMA32(a, cfk, g);
          }
#pragma unroll
          for (int r = 0; r < 16; ++r) {
            const int srow = st_ * 32 + ACC_ROW(r, lane);
            const float e = __expf(fminf(acs_l - Lacs[srow], 0.f));
            float val = (srow <= lcol) ? g[r] * e : 0.f;
            if (srow == lcol) val += ddiag;
            g[r] = val;
          }
          const int id = lt * (lt + 1) / 2 + st_;
          char* mt = (id < 8) ? (LMa + id * 2048) : (LMb + (id - 8) * 2048);
#pragma unroll
          for (int k2 = 0; k2 < 2; ++k2) {
            uint4 u; u.x = pack_bf2(g[8 * k2], g[8 * k2 + 1]); u.y = pack_bf2(g[8 * k2 + 2], g[8 * k2 + 3]); u.z = pack_bf2(g[8 * k2 + 4], g[8 * k2 + 5]); u.w = pack_bf2(g[8 * k2 + 6], g[8 * k2 + 7]);
            *(uint4*)(mt + (k2 * 64 + lane) * 16) = u;
          }
        }
        __syncthreads();
        for (int st_ = 0; st_ <= lt; ++st_) {
          const int id = lt * (lt + 1) / 2 + st_;
          const char* mt = (id < 8) ? (LMa + id * 2048) : (LMb + (id - 8) * 2048);
#pragma unroll
          for (int k2 = 0; k2 < 2; ++k2) {
            const bf16x8 am = *(const bf16x8*)(mt + (k2 * 64 + lane) * 16);
            const int s0 = st_ * 32 + 16 * k2 + 4 * hh + q4, s1 = s0 + 8;
            const int cx = pt * 4 + grp16 * 2 + (p3 >> 1);
            const s16x4 lo = tr_read(LXz + s0 * 128 + ((cx ^ swzX(s0)) << 4) + 8 * (p3 & 1));
            const s16x4 hi = tr_read(LXz + s1 * 128 + ((cx ^ swzX(s1)) << 4) + 8 * (p3 & 1));
            const bf16x8 bx = __builtin_shufflevector(lo, hi, 0, 1, 2, 3, 4, 5, 6, 7);
            Y = MFMA32(am, bx, Y);
          }
        }
#pragma unroll
        for (int r = 0; r < 16; ++r) {
          const int srow = lt * 32 + ACC_ROW(r, lane);
          *(bf16_t*)(LY + srow * 128 + (pt * 32 + r31) * 2) = f2bf(Y[r]);
        }
      }
      {
        const float ea = __expf(alast);
#pragma unroll
        for (int r = 0; r < 16; ++r) Hacc[r] *= ea;
        const int cb_ = lt * 4 + grp16 * 2 + (p3 >> 1);
        const int cx = pt * 4 + grp16 * 2 + (p3 >> 1);
        const int sb0 = 8 * hh + q4, sb1 = sb0 + 4;
        const char* pa_lo = LBz + sb0 * 256 + ((cb_ ^ swzBC(sb0)) << 4) + 8 * (p3 & 1);
        const char* pa_hi = LBz + sb1 * 256 + ((cb_ ^ swzBC(sb1)) << 4) + 8 * (p3 & 1);
        const char* pb_lo = LXwz + sb0 * 128 + ((cx ^ swzX(sb0)) << 4) + 8 * (p3 & 1);
        const char* pb_hi = LXwz + sb1 * 128 + ((cx ^ swzX(sb1)) << 4) + 8 * (p3 & 1);
#pragma unroll 2
        for (int k = 0; k < 8; ++k) {
          const s16x4 alo = tr_read(pa_lo + k * 4096);
          const s16x4 ahi = tr_read(pa_hi + k * 4096);
          const s16x4 blo = tr_read(pb_lo + k * 2048);
          const s16x4 bhi = tr_read(pb_hi + k * 2048);
          const bf16x8 a = __builtin_shufflevector(alo, ahi, 0, 1, 2, 3, 4, 5, 6, 7);
          const bf16x8 bb = __builtin_shufflevector(blo, bhi, 0, 1, 2, 3, 4, 5, 6, 7);
          Hacc = MFMA32(a, bb, Hacc);
        }
        char* Hn = LHs;
        const int prow = pt * 32 + r31;
#pragma unroll
        for (int g4 = 0; g4 < 4; ++g4) {
          const int n0 = lt * 32 + 8 * g4 + 4 * hh;
          uint2 w; w.x = pack_bf2(Hacc[g4 * 4], Hacc[g4 * 4 + 1]); w.y = pack_bf2(Hacc[g4 * 4 + 2], Hacc[g4 * 4 + 3]);
          *(uint2*)(Hn + prow * 256 + ((((n0 >> 3)) ^ swzBC(prow)) << 4) + (n0 & 7) * 2) = w;
        }
      }
      SEGS_ADD(3);
    }
  }
  SEGS_FLUSH(4);
  __syncthreads();
}

DI void phase_groupnorm(const P& p) {
  const int lane = threadIdx.x & 63, gw = blockIdx.x * 8 + (threadIdx.x >> 6), nw = gridDim.x * 8;
  bf16_t* zh = (bf16_t*)(p.ws + WS_PB + L1_ZH);
  const float* gn = p.in[I_GNORM];
  for (int lr0 = gw * 2; lr0 < NB * SEQ; lr0 += nw * 2) {
    uint4 raw[2][4];
    bf16_t* rp[2];
#pragma unroll
    for (int u = 0; u < 2; ++u) {
      const int lr = lr0 + u, b = lr >> 12, l = lr & 4095;
      rp[u] = zh + ((size_t)(b * 32 + (lane >> 1)) * TPB + CTXL + l) * 64 + (lane & 1) * 32;
#pragma unroll
      for (int i = 0; i < 4; ++i) raw[u][i] = *(const uint4*)(rp[u] + i * 8);
    }
#pragma unroll
    for (int u = 0; u < 2; ++u) {
      float v[32];
#pragma unroll
      for (int i = 0; i < 4; ++i) { float f[8]; unpack8(raw[u][i], f);
#pragma unroll
        for (int j = 0; j < 8; ++j) v[i * 8 + j] = f[j]; }
      float ss = 0.f;
#pragma unroll
      for (int i = 0; i < 32; ++i) ss += v[i] * v[i];
      ss = red16(ss);
      const float rs = rsqrtf(ss * (1.f / 512.f) + 1e-6f);
#pragma unroll
      for (int i = 0; i < 4; ++i) {
        float o[8];
#pragma unroll
        for (int j = 0; j < 8; ++j) o[j] = v[i * 8 + j] * rs * gn[lane * 32 + i * 8 + j];
        *(uint4*)(rp[u] + i * 8) = pack8(o);
      }
    }
  }
}


__global__ void __launch_bounds__(NTHR) fwd_kernel(P p) {
  extern __shared__ __attribute__((aligned(16))) char lds[];
  const int lo = p.ph_lo, hi = p.ph_hi;
  unsigned char* ws = p.ws;
  XcdBarrier bar; bar.bar = (unsigned*)(ws + WS_CTL); bar.x = 0; bar.st = nullptr;
  volatile LAS unsigned* stw = (volatile LAS unsigned*)(lds + LDS_BYTES - 16);
  if (hi - lo > 1) {
    if (threadIdx.x == 0) { stw[0] = 0u; stw[1] = 0u; }
    __syncthreads();
    bar = xcd_barrier_post((unsigned*)(ws + WS_CTL), stw);
  }
#ifndef PHASE_MASK
#define PHASE_MASK 0xFFFFFFFFu
#endif
#define IN(k) (((PHASE_MASK >> (k)) & 1u) && lo <= (k) && (k) < hi)
#define SEAM(k) do { if (IN(k) && IN((k) + 1)) xcd_barrier(bar); } while (0)
#ifdef PROBE_A
  unsigned long long* tsp = (unsigned long long*)(ws + WS_SCAL + 1024);
#define STAMP(k) do { if (blockIdx.x == 0 && threadIdx.x == 0) tsp[k] = __builtin_amdgcn_s_memrealtime(); } while (0)
#else
#define STAMP(k) do {} while (0)
#endif
  const int G = gridDim.x;
  bf16_t* HBp = (bf16_t*)(ws + WS_HB);
  bf16_t* PBp = (bf16_t*)(ws + WS_PB + PB_P);

#ifdef PROBE_A
  if (blockIdx.x == 0 && threadIdx.x == 0) for (int k = 22; k < 64; ++k) tsp[k] = 0ull;
#endif
  STAMP(0); if (IN(0)) { phase_prep(p, lds); } SEAM(0);
  STAMP(1); if (IN(1)) { phase_normmod(p, 0, 0, true, false, HBp); } SEAM(1);
  STAMP(2); if (IN(2)) { pg8::Order S; S.init(R / 256, 3584 / 256, G, (int)blockIdx.x, 0);
    pg8::gemm_phase(lds, pg8::Gemm{HBp, (const bf16_t*)(ws + WS_WIN0T), D, D, 0}, S, pg8::EpiP0{PBp, (const float2*)(ws + WS_ROPE)}); } SEAM(2);
  STAMP(3); if (IN(3)) {
    if (G == 256) {
      const int xg = blockIdx.x & 7, jg = blockIdx.x >> 3;
      for (int r = 0; r < 4; ++r) attn_flash_unit(p, lds, ((r * 8 + xg) << 5) | jg);
      if (jg < 8) attn_flash_unit(p, lds, 1024 + xg * 8 + jg);
    } else {
      for (int u = blockIdx.x; u < 1024 + 64; u += G) attn_flash_unit(p, lds, u);
    }
    phase_ga(p);
  } SEAM(3);
  STAMP(4); if (IN(4)) {
    if (G == 256) {
      const int xg = blockIdx.x & 7, jg = blockIdx.x >> 3;
      rwkv_scan_unit(p, lds, ((xg + 8 * (jg >> 2)) << 2) | (jg & 3));
    } else {
      for (int u = blockIdx.x; u < 256; u += G) rwkv_scan_unit(p, lds, u);
    }
    __syncthreads();
    gemm_store_phase(lds, (const bf16_t*)(ws + WS_PB + PB_GA), 128, (const bf16_t*)(ws + WS_RWT + 262144), 128, R, 512, 128, (bf16_t*)(ws + WS_PB + PB_G), 512, 512);
  } SEAM(4);
  STAMP(5); if (IN(5)) { phase_rwkv_post(p); } SEAM(5);
  STAMP(6); if (IN(6)) { pg8::Order S; S.init(R / 256, 4, G, (int)blockIdx.x, 0);
    pg8::gemm_phase(lds, pg8::Gemm{(const bf16_t*)(ws + WS_PB + PB_O0), (const bf16_t*)(ws + WS_WOUT0T), D, D, 0}, S,
                    pg8::EpiDelta{(bf16_t*)(ws + WS_PB + PB_H2), (const float*)(ws + WS_MODS)}); } SEAM(6);
  STAMP(7); if (IN(7)) { phase_normmod(p, 0, 1, true, false, (bf16_t*)(ws + WS_PB + PB_H2), (const bf16_t*)(ws + WS_PB + PB_H2)); convert_tables(p, 0); } SEAM(7);
  STAMP(8); if (IN(8)) { pg8::Order S; S.init(R / 256, 8, G, (int)blockIdx.x, 0);
    pg8::gemm_phase(lds, pg8::Gemm{(const bf16_t*)(ws + WS_PB + PB_H2), (const bf16_t*)(ws + WS_PQ0T), D, D, 0}, S, pg8::EpiBf16{(bf16_t*)(ws + WS_PB + PB_Q), 2048, 2048}); } SEAM(8);
  STAMP(9); if (IN(9)) { for (int u = blockIdx.x; u < (R / 256) * 8; u += G) peer_topk_unit(p, lds, 0, u); } SEAM(9);
  STAMP(10); if (IN(10)) { phase_peer_gather(p, 0); } SEAM(10);
  STAMP(11);
  STAMP(12); if (IN(12)) { pg8::Order S; S.init(R / 256, 5376 / 256, G, (int)blockIdx.x, 0);
    pg8::gemm_phase(lds, pg8::Gemm{(const bf16_t*)(ws + WS_HNEXT), (const bf16_t*)(ws + WS_WIN1T), D, D, 0}, S, pg8::EpiP1{ws + WS_PB}); } SEAM(12);
  STAMP(13); if (IN(13)) {
    phase_conv(p, lds);
    if (hi - lo > 1) xcd_barrier(bar);
    if (G == 256) {
      const int xg = blockIdx.x & 7, jg = blockIdx.x >> 3;
      const int gidx = xg + 8 * (jg >> 3);
      ssd_chunk_unit(p, lds, (gidx >> 2) * 32 + (gidx & 3) * 8 + (jg & 7));
    } else {
      for (int u = blockIdx.x; u < 256; u += G) ssd_chunk_unit(p, lds, u);
    }
  } SEAM(13);
  STAMP(14); if (IN(14)) { phase_groupnorm(p); } SEAM(14);
  STAMP(15); if (IN(15)) { pg8::Order S; S.init(NB * SEQ / 256, 4, G, (int)blockIdx.x, 1);
    pg8::gemm_phase(lds, pg8::Gemm{(const bf16_t*)(ws + WS_PB + L1_ZH), (const bf16_t*)(ws + WS_WOUT1T), 64, 2048, 1}, S,
                    pg8::EpiDelta{(bf16_t*)(ws + WS_PB + L1_XH), (const float*)(ws + WS_MODS) + 9 * 6144}); } SEAM(15);
  STAMP(16); if (IN(16)) { phase_normmod(p, 1, 1, false, true, (bf16_t*)(ws + WS_PB + PB_H2), (const bf16_t*)(ws + WS_PB + L1_XH)); convert_tables(p, 1); } SEAM(16);
  STAMP(17); if (IN(17)) { pg8::Order S; S.init(NB * SEQ / 256, 8, G, (int)blockIdx.x, 1);
    pg8::gemm_phase(lds, pg8::Gemm{(const bf16_t*)(ws + WS_PB + PB_H2), (const bf16_t*)(ws + WS_PQ1T), D, D, 0}, S, pg8::EpiBf16{(bf16_t*)(ws + WS_PB + PB_Q), 2048, 2048}); } SEAM(17);
  STAMP(18); if (IN(18)) { for (int u = blockIdx.x; u < (NB * SEQ / 256) * 8; u += G) { const int mtl = u >> 3; peer_topk_unit(p, lds, 1, ((((mtl >> 4) * 17 + 1 + (mtl & 15)) << 3) | (u & 7))); } } SEAM(18);
  STAMP(19); if (IN(19)) { phase_peer_gather(p, 1); }
  STAMP(20);
#ifdef PROBE_A
  xcd_barrier(bar);
  if (blockIdx.x == 0 && threadIdx.x == 0) {
    const unsigned long long tend = __builtin_amdgcn_s_memrealtime();
    tsp[21] = tend;
    unsigned long long ta = 0;
    for (int k = 0; k < 21; ++k) if ((PROBE_A >> k) & 1) ta += tsp[k + 1] - tsp[k];
    for (int k = 22; k < 64; ++k) if ((PROBE_A >> k) & 1ull) ta += tsp[k];
    while (__builtin_amdgcn_s_memrealtime() - tend < ta * PROBE_K) __builtin_amdgcn_s_sleep(8);
  }
#endif
}

extern "C" void kernel_launch(void* const* d_in, const int* in_sizes, int n_in, void* d_out, int out_size, void* d_ws, size_t ws_size, hipStream_t stream) {
  static int inited = 0;
  if (!inited) {
    if (n_in != N_IN || ws_size < WS_XC + 128 * MiB) { fprintf(stderr, "kernel_launch: unexpected n_in %d / ws_size %zu\n", n_in, ws_size); inited = -1; return; }
    if (hipFuncSetAttribute((const void*)fwd_kernel, hipFuncAttributeMaxDynamicSharedMemorySize, LDS_BYTES) != hipSuccess) { fprintf(stderr, "kernel_launch: hipFuncSetAttribute failed\n"); inited = -1; return; }
    inited = 1;
  }
  if (inited < 0) return;
  P p{};
  for (int i = 0; i < N_IN; ++i) p.in[i] = (const float*)d_in[i];
  p.out = (float*)d_out; p.ws = (unsigned char*)d_ws;
  (void)hipMemsetAsync((char*)d_ws + WS_CTL, 0, 65536, stream);
#if N_LAUNCH_MODE == 1
  p.ph_lo = 0; p.ph_hi = N_PHASES;
  hipLaunchKernelGGL(fwd_kernel, dim3(256), dim3(NTHR), LDS_BYTES, stream, p);
#else
  for (int ph = 0; ph < N_PHASES; ++ph) {
    p.ph_lo = ph; p.ph_hi = ph + 1;
    hipLaunchKernelGGL(fwd_kernel, dim3(256), dim3(NTHR), LDS_BYTES, stream, p);
  }
#endif
}
```

```cpp
#include <hip/hip_runtime.h>
#include <stdint.h>
#include <stdio.h>

#ifndef N_LAUNCH_MODE
#define N_LAUNCH_MODE 1
#endif

#define DI __device__ __forceinline__
#define WAVE_ID __builtin_amdgcn_readfirstlane((int)(threadIdx.x >> 6))
typedef unsigned short bf16_t;
typedef __attribute__((ext_vector_type(8))) short bf16x8;
typedef __attribute__((ext_vector_type(16))) float f32x16;
typedef __attribute__((ext_vector_type(2))) __bf16 bf2_t;

constexpr int D = 1024, NB = 8, SEQ = 4096, CTXL = 256, TPB = SEQ + CTXL, R = NB * TPB;
constexpr int NTHR = 512;
constexpr int LDS_BYTES = 163840;
constexpr int P0LD = 3456;
constexpr int P1LD = 5184;
constexpr int P1NPAD = 5248;

enum { I_X = 0, I_C, I_CTX, I_CCTX,
       I_ADAW0, I_ADAB0, I_N1_0, I_N2_0, I_WIN0, I_DALAM, I_DASUB, I_RWMU, I_RWW0, I_RWW2, I_RWA0, I_RWA2, I_RWG2, I_RWKK, I_RWKA, I_RWRK, I_LNXW, I_LNXB, I_WOUT0, I_PQ0, I_PK0, I_PU0, I_PV0,
       I_ADAW1, I_ADAB1, I_N1_1, I_N2_1, I_WIN1, I_CONVW, I_CONVB, I_DTB, I_ALOG, I_DSKIP, I_GNORM, I_WOUT1, I_PQ1, I_PK1, I_PU1, I_PV1, I_NF, N_IN };

constexpr size_t MiB = 1048576;
constexpr size_t WS_CTL = 0;
constexpr size_t WS_SCAL = 65536;
constexpr size_t WS_MODS = 131072;
constexpr size_t WS_ROPE = 1 * MiB;
constexpr size_t WS_RWT = 2 * MiB;
constexpr size_t WS_WIN0T = 3 * MiB;
constexpr size_t WS_WOUT0T = 10 * MiB;
constexpr size_t WS_PQ0T = 12 * MiB;
constexpr size_t WS_KEYS0 = 16 * MiB;
constexpr size_t WS_KEYS1 = 16 * MiB + 524288;
constexpr size_t WS_WIN1T = 17 * MiB;
constexpr size_t WS_WOUT1T = 28 * MiB;
constexpr size_t WS_PQ1T = 32 * MiB;
constexpr size_t WS_PB = 36 * MiB;
constexpr size_t WS_XC = 381 * MiB;
constexpr size_t WS_HB = 389 * MiB;
constexpr size_t WS_END = 457 * MiB;
constexpr size_t WS_YF = WS_XC;
constexpr size_t PB_P = 0;
constexpr size_t PB_O0 = 230 * MiB;
constexpr size_t PB_G = 298 * MiB;
constexpr size_t PB_GA = 332 * MiB;
constexpr size_t PB_BONUS = 341 * MiB;
constexpr size_t L1_ZH = 0;
constexpr size_t L1_XH = 136 * MiB;
constexpr size_t L1_BG = 272 * MiB;
constexpr size_t L1_CG = 306 * MiB;
constexpr size_t L1_DT = 340 * MiB;
constexpr size_t PB_H2 = 0;
constexpr size_t PB_Q = 68 * MiB;
constexpr size_t PB_IDX = 204 * MiB;
constexpr size_t PB_GATE = 221 * MiB;
constexpr size_t PB_HQ = 238 * MiB;
constexpr size_t PB_HS = 272 * MiB;
constexpr size_t WS_HNEXT = WS_HB + 33 * MiB;
constexpr size_t HB_YF = 0, HB_YB = 34 * MiB;
constexpr size_t HB_U = 0, HB_V = 8 * MiB;
constexpr size_t HB_SU = 32 * MiB, HB_SV = 32 * MiB + 65536;

struct P {
  const float* in[N_IN];
  float* out;
  unsigned char* ws;
  int ph_lo, ph_hi;
};

constexpr int N_PHASES = 21;
#ifndef PROBE_GRP
#define PROBE_GRP 0
#endif
#define SEG_DECL_() unsigned long long seg_last_ = 0ull, seg_acc_[4] = {0ull, 0ull, 0ull, 0ull}
#define SEG_INIT_() do { seg_last_ = __builtin_amdgcn_s_memrealtime(); } while (0)
#define SEG_ADD_(j) do { const unsigned long long t__ = __builtin_amdgcn_s_memrealtime(); seg_acc_[j] += t__ - seg_last_; seg_last_ = t__; } while (0)
#define SEG_FLUSH_(base) do { if (blockIdx.x == 0 && threadIdx.x == 0) { for (int j__ = 0; j__ < 4; ++j__) ((unsigned long long*)(p.ws + WS_SCAL + 1024))[22 + (base) + j__] += seg_acc_[j__]; } } while (0)
#if defined(PROBE_A) && PROBE_GRP == 1
#define SEGR_DECL() SEG_DECL_()
#define SEGR_INIT() SEG_INIT_()
#define SEGR_ADD(j) SEG_ADD_(j)
#define SEGR_FLUSH(b) SEG_FLUSH_(b)
#else
#define SEGR_DECL() do {} while (0)
#define SEGR_INIT() do {} while (0)
#define SEGR_ADD(j) do {} while (0)
#define SEGR_FLUSH(b) do {} while (0)
#endif
#if defined(PROBE_A) && PROBE_GRP == 2
#define SEGS_DECL() SEG_DECL_()
#define SEGS_INIT() SEG_INIT_()
#define SEGS_ADD(j) SEG_ADD_(j)
#define SEGS_FLUSH(b) SEG_FLUSH_(b)
#else
#define SEGS_DECL() do {} while (0)
#define SEGS_INIT() do {} while (0)
#define SEGS_ADD(j) do {} while (0)
#define SEGS_FLUSH(b) do {} while (0)
#endif

DI unsigned pack_bf2(float a, float b) { bf2_t v; v[0] = (__bf16)a; v[1] = (__bf16)b; return __builtin_bit_cast(unsigned, v); }
DI bf16_t f2bf(float a) { return __builtin_bit_cast(unsigned short, (__bf16)a); }
DI float bf2f(bf16_t v) { return __uint_as_float((unsigned)v << 16); }
DI float bflo(unsigned u) { return __uint_as_float(u << 16); }
DI float bfhi(unsigned u) { return __uint_as_float(u & 0xffff0000u); }
template <int CTRL> DI float dpp_f(float x) { return __int_as_float(__builtin_amdgcn_update_dpp(0, __float_as_int(x), CTRL, 0xF, 0xF, true)); }
DI float red4(float x) { x += dpp_f<0xB1>(x); x += dpp_f<0x4E>(x); return x; }
DI float red8(float x) { x += dpp_f<0x141>(x); return red4(x); }
DI float red16(float x) { x += dpp_f<0x140>(x); return red8(x); }
DI float red64(float x) { x = red16(x); x += __shfl_xor(x, 16); x += __shfl_xor(x, 32); return x; }
DI float frcp_(float x) { return __builtin_amdgcn_rcpf(x); }
DI float sigmoidf_(float x) { return frcp_(1.f + __expf(-x)); }
DI float siluf_(float x) { return x * frcp_(1.f + __expf(-x)); }
DI float softplusf_(float x) { return x > 20.f ? x : log1pf(__expf(x)); }
DI float geluf_(float x) { return 0.5f * x * (1.f + erff(x * 0.70710678118654752f)); }
DI void unpack8(const uint4& u, float (&f)[8]) { f[0] = bflo(u.x); f[1] = bfhi(u.x); f[2] = bflo(u.y); f[3] = bfhi(u.y); f[4] = bflo(u.z); f[5] = bfhi(u.z); f[6] = bflo(u.w); f[7] = bfhi(u.w); }
DI uint4 pack8(const float (&f)[8]) { uint4 u; u.x = pack_bf2(f[0], f[1]); u.y = pack_bf2(f[2], f[3]); u.z = pack_bf2(f[4], f[5]); u.w = pack_bf2(f[6], f[7]); return u; }
#define ACC_ROW(reg, lane) (((reg) & 3) + 8 * ((reg) >> 2) + 4 * ((lane) >> 5))
#define MFMA32(a, b, c) __builtin_amdgcn_mfma_f32_32x32x16_bf16((a), (b), (c), 0, 0, 0)

#define XB_TMO      128
#define XB_XCNT(j)  (256  + 64 * (j))
#define XB_XSUB(j)  (1280 + 64 * (j))
#define XB_XGEN(j)  (2304 + 64 * (j))
#define XB_TOP      3328
#define XB_TOPGEN   3392
#define XCD_BAR_WORDS 3456
#define XB_SPIN_CAP (1u << 22)
#define LAS __attribute__((address_space(3)))
DI unsigned xb_ld(unsigned* p) { return __hip_atomic_load(p, __ATOMIC_RELAXED, __HIP_MEMORY_SCOPE_AGENT); }
DI unsigned xb_add(unsigned* p, unsigned v) { return __hip_atomic_fetch_add(p, v, __ATOMIC_RELAXED, __HIP_MEMORY_SCOPE_AGENT); }
DI unsigned xb_xcc_id() { return (unsigned)__builtin_amdgcn_s_getreg((3 << 11) | 20) & 0xFu; }
#define XB_SPIN(cond, bar) do { unsigned _sp = 0; while (cond) { __builtin_amdgcn_s_sleep(1); \
    if ((++_sp & 255u) == 0u) { if (xb_ld(&(bar)[XB_TMO])) break; if (_sp > XB_SPIN_CAP) { atomicAdd(&(bar)[XB_TMO], 1u); break; } } } } while (0)
struct XcdBarrier { unsigned* bar; unsigned x; volatile LAS unsigned* st; };
DI XcdBarrier xcd_barrier_post(unsigned* bar, volatile LAS unsigned* st) {
  XcdBarrier b; b.bar = bar; b.x = xb_xcc_id(); b.st = st;
  if (threadIdx.x == 0) (void)xb_add(&bar[XB_XCNT(b.x)], 1u);
  return b;
}
DI void xcd_barrier_complete(unsigned* bar, unsigned x, unsigned& nloc, unsigned& nx) {
  const unsigned G = gridDim.x * gridDim.y * gridDim.z;
  unsigned sum, cnt, mine, sp = 0u;
  for (;;) {
    sum = 0u; cnt = 0u; mine = 0u;
#pragma unroll
    for (unsigned j = 0; j < 16; ++j) { const unsigned c = xb_ld(&bar[XB_XCNT(j)]); sum += c; cnt += (c > 0u) ? 1u : 0u; mine = (j == x) ? c : mine; }
    if (sum == G) break;
    __builtin_amdgcn_s_sleep(1);
    if ((++sp & 255u) == 0u) { if (xb_ld(&bar[XB_TMO])) break; if (sp > XB_SPIN_CAP) { atomicAdd(&bar[XB_TMO], 1u); break; } }
  }
  nloc = mine > 0u ? mine : 1u; nx = cnt > 0u ? cnt : 1u;
}
DI void xcd_barrier(const XcdBarrier& b) {
  asm volatile("s_waitcnt vmcnt(0)" ::: "memory");
  __syncthreads();
  if (threadIdx.x == 0) {
    unsigned* bar = b.bar;
    __builtin_amdgcn_s_waitcnt(0);
    unsigned nloc = b.st[0], nx = b.st[1];
    if (nloc == 0u) { xcd_barrier_complete(bar, b.x, nloc, nx); b.st[0] = nloc; b.st[1] = nx; }
    const unsigned old = xb_add(&bar[XB_XSUB(b.x)], 1u);
    const unsigned gen = old / nloc;
    if (old + 1u == (gen + 1u) * nloc) {
      __builtin_amdgcn_fence(__ATOMIC_RELEASE, "agent");
      asm volatile("s_waitcnt vmcnt(0)" ::: "memory");
      const unsigned og = xb_add(&bar[XB_TOP], 1u);
      const unsigned tg = og / nx;
      if (og + 1u == (tg + 1u) * nx) xb_add(&bar[XB_TOPGEN], 1u);
      else XB_SPIN(xb_ld(&bar[XB_TOPGEN]) == tg, bar);
      __builtin_amdgcn_fence(__ATOMIC_ACQUIRE, "agent");
      xb_add(&bar[XB_XGEN(b.x)], 1u);
      asm volatile("s_waitcnt vmcnt(0)" ::: "memory");
    } else {
      XB_SPIN(xb_ld(&bar[XB_XGEN(b.x)]) == gen, bar);
      __builtin_amdgcn_fence(__ATOMIC_ACQUIRE, "agent");
      asm volatile("s_waitcnt vmcnt(0)" ::: "memory");
    }
  }
  __syncthreads();
}

DI void gemm_tile(char* lds, const bf16_t* __restrict__ A, int lda, const bf16_t* __restrict__ Bt, int ldb, int K, f32x16 (&acc)[2][2]) {
  const int tid = threadIdx.x, lane = tid & 63, wave = tid >> 6, wm = wave >> 1, wn = wave & 1;
#pragma unroll
  for (int i = 0; i < 2; ++i)
#pragma unroll
    for (int j = 0; j < 2; ++j)
#pragma unroll
      for (int r = 0; r < 16; ++r) acc[i][j][r] = 0.f;
  const int arow0 = tid >> 3, ac = tid & 7;
  const bf16_t* ap = A + (size_t)arow0 * lda + ac * 8;
  const bf16_t* bp = Bt + (size_t)arow0 * ldb + ac * 8;
  const int sw = ((ac ^ (arow0 >> 1)) & 7) << 4;
  const int st_off = arow0 * 128 + sw;
  uint4 ra[4], rb[2];
#pragma unroll
  for (int i = 0; i < 4; ++i) ra[i] = *(const uint4*)(ap + (size_t)i * 64 * lda);
#pragma unroll
  for (int i = 0; i < 2; ++i) rb[i] = *(const uint4*)(bp + (size_t)i * 64 * ldb);
#pragma unroll
  for (int i = 0; i < 4; ++i) *(uint4*)(lds + st_off + i * 8192) = ra[i];
#pragma unroll
  for (int i = 0; i < 2; ++i) *(uint4*)(lds + 65536 + st_off + i * 8192) = rb[i];
  __syncthreads();
  const int nk = K >> 6;
  const int r31 = lane & 31, hh = lane >> 5;
  for (int kt = 0; kt < nk; ++kt) {
    const int cur = kt & 1;
    if (kt + 1 < nk) {
#pragma unroll
      for (int i = 0; i < 4; ++i) ra[i] = *(const uint4*)(ap + (size_t)i * 64 * lda + (kt + 1) * 64);
#pragma unroll
      for (int i = 0; i < 2; ++i) rb[i] = *(const uint4*)(bp + (size_t)i * 64 * ldb + (kt + 1) * 64);
    }
    const char* la = lds + cur * 32768;
    const char* lb = lds + 65536 + cur * 16384;
#pragma unroll
    for (int kk = 0; kk < 4; ++kk) {
      const int c = kk * 2 + hh;
      bf16x8 a[2], b[2];
#pragma unroll
      for (int mi = 0; mi < 2; ++mi) { const int row = wm * 64 + mi * 32 + r31; a[mi] = *(const bf16x8*)(la + row * 128 + (((c ^ (row >> 1)) & 7) << 4)); }
#pragma unroll
      for (int ni = 0; ni < 2; ++ni) { const int row = wn * 64 + ni * 32 + r31; b[ni] = *(const bf16x8*)(lb + row * 128 + (((c ^ (row >> 1)) & 7) << 4)); }
#pragma unroll
      for (int mi = 0; mi < 2; ++mi)
#pragma unroll
        for (int ni = 0; ni < 2; ++ni) acc[mi][ni] = MFMA32(a[mi], b[ni], acc[mi][ni]);
    }
    if (kt + 1 < nk) {
      char* wa = lds + (cur ^ 1) * 32768;
      char* wb = lds + 65536 + (cur ^ 1) * 16384;
#pragma unroll
      for (int i = 0; i < 4; ++i) *(uint4*)(wa + st_off + i * 8192) = ra[i];
#pragma unroll
      for (int i = 0; i < 2; ++i) *(uint4*)(wb + st_off + i * 8192) = rb[i];
    }
    __syncthreads();
  }
}

DI void gemm_store_phase(char* lds, const bf16_t* A, int lda, const bf16_t* Bt, int ldb, int M, int Npad, int K, bf16_t* C, int ldc, int nvalid) {
  const int ntn = Npad / 128, ntm = M / 256;
  const int lane = threadIdx.x & 63, wave = threadIdx.x >> 6, wm = wave >> 1, wn = wave & 1;
  for (int tile = blockIdx.x; tile < ntm * ntn; tile += gridDim.x) {
    const int mt = tile / ntn, nt = tile - mt * ntn;
    f32x16 acc[2][2];
    gemm_tile(lds, A + (size_t)mt * 256 * lda, lda, Bt + (size_t)nt * 128 * ldb, ldb, K, acc);
#pragma unroll
    for (int mi = 0; mi < 2; ++mi)
#pragma unroll
      for (int ni = 0; ni < 2; ++ni) {
        const int col = nt * 128 + wn * 64 + ni * 32 + (lane & 31);
        if (col < nvalid) {
#pragma unroll
          for (int r = 0; r < 16; ++r) {
            const int row = mt * 256 + wm * 64 + mi * 32 + ACC_ROW(r, lane);
            C[(size_t)row * ldc + col] = f2bf(acc[mi][ni][r]);
          }
        }
      }
  }
}

namespace pg8 {
typedef float f32x4 __attribute__((ext_vector_type(4)));
typedef unsigned u32x4 __attribute__((ext_vector_type(4)));
constexpr int BM = 256, BK = 64, HALF = 128, HTB = HALF * BK * 2, STAGE_BYTES = 8 * HTB, NXCD = 8, WGM = 8;
DI int lds_byte(int r, int c) { const int st = (r >> 4) * 2 + (c >> 5), rr = r & 15, cc = c & 31, ob = rr * 64 + cc * 2; return st * 1024 + (ob ^ (((ob >> 9) & 1) << 5)); }
DI void stage_rc(int b, int& R_, int& C_) { const int st = b / 1024, sb = b % 1024, swz = sb ^ (((sb >> 9) & 1) << 5); R_ = (st >> 1) * 16 + swz / 64; C_ = (st & 1) * 32 + (swz % 64) / 2; }
DI int perm32(int rho) { const int n = rho >> 4, i = rho & 15; return 8 * (i >> 2) + 4 * n + (i & 3); }
struct Unit { int pm, pn; };
struct Gemm { const bf16_t* A; const bf16_t* Bt; int lda, K; int headmajor; };
struct Order {
  int nM, nN, nwg, G, c, skipctx, nmain, zs;
  DI void init(int nM_, int nN_, int G_, int c_, int skipctx_) { nM = nM_; nN = nN_; nmain = nM * nN; nwg = nmain; zs = 0; G = G_; c = c_; skipctx = skipctx_; }
  DI void init_zskip(int nMlat, int nN_, int G_, int c_, int nz) { nM = nMlat; nN = nN_; nmain = nM * nN; zs = nz; nwg = nmain + (nMlat / 16) * (nN_ - nz); G = G_; c = c_; skipctx = 1; }
  DI bool next(int i, Unit& u) const {
    const long L = (long)i * G + c; if (L >= nwg) return false;
    if (L >= nmain) { const int t = (int)L - nmain, per = nN - zs; u.pm = (t / per) * 17; u.pn = zs + t % per; return true; }
    int wgid = (int)L; { const int q = nmain / NXCD, r = nmain % NXCD, xcd = wgid % NXCD, off = wgid / NXCD; wgid = (xcd < r ? xcd * (q + 1) : r * (q + 1) + (xcd - r) * q) + off; }
    const int nig = WGM * nN, gid = wgid / nig, fm = gid * WGM, gsz = (nM - fm) < WGM ? (nM - fm) : WGM;
    int pm = fm + ((wgid % nig) % gsz); u.pn = (wgid % nig) / gsz;
    if (skipctx) pm = (pm >> 4) * 17 + 1 + (pm & 15);
    u.pm = pm; return true;
  }
};
template <class Epi>
DI void gemm_phase(char* lds_generic, const Gemm g, const Order& S, const Epi& E) {
  LAS unsigned char* lds = (LAS unsigned char*)lds_generic;
  const int tid = threadIdx.x, wid = __builtin_amdgcn_readfirstlane(tid >> 6), lane = tid & 63, wr = wid >> 2, wc = wid & 3, fr = lane & 15, fq = lane >> 4;
  const int K = g.K, nt = K / BK, lda = g.lda;
  unsigned voffA[2], voffB[2];
#pragma unroll
  for (int i = 0; i < 2; ++i) { int R_, C_; stage_rc(tid * 16 + i * 8192, R_, C_); const int Rb = Epi::PERM ? ((R_ & ~31) + perm32(R_ & 31)) : R_;
    voffA[i] = (unsigned)(R_ * lda + C_) * 2u; voffB[i] = (unsigned)(Rb * K + C_) * 2u; }
  const size_t kstep = (size_t)(BK * 2);
  const size_t kstepA = g.headmajor ? (size_t)TPB * 64 * 2 : kstep;
  const size_t hstepA = (size_t)HALF * lda * 2, hstepB = (size_t)HALF * K * 2;
  const size_t tstepB = 2 * hstepB;
#define PG8_ABASE(pm_) ((const char*)g.A + (g.headmajor ? ((size_t)((pm_) / 17) * 32 * TPB + (size_t)((pm_) % 17) * 256) * 128 : (size_t)(pm_) * 2 * hstepA))
  const unsigned ldsw = (unsigned)wid * 1024u;
  const int aoff = lds_byte(wr * 64 + fr, fq * 8), boff = lds_byte(wc * 32 + fr, fq * 8);
#define PG8_SA(b, h) (((b) * 2 + (h)) * HTB)
#define PG8_SB(b, h) ((4 + (b) * 2 + (h)) * HTB)
#define PG8_STAGE(bufoff, gbase, voff) do { _Pragma("unroll") for (int _i = 0; _i < 2; ++_i) \
    __builtin_amdgcn_global_load_lds((const unsigned*)((const char*)(gbase) + (voff)[_i]), (LAS unsigned*)(lds + (bufoff) + ldsw + _i * 8192), 16, 0, 0); } while (0)
#define PG8_LDA(dst, b, h) do { _Pragma("unroll") for (int m = 0; m < 4; ++m) _Pragma("unroll") for (int k = 0; k < 2; ++k) dst[m][k] = *(const LAS bf16x8*)(lds + PG8_SA(b, h) + aoff + m * 2048 + k * 1024); } while (0)
#define PG8_LDB(dst, b, h) do { _Pragma("unroll") for (int n = 0; n < 2; ++n) _Pragma("unroll") for (int k = 0; k < 2; ++k) dst[n][k] = *(const LAS bf16x8*)(lds + PG8_SB(b, h) + boff + n * 2048 + k * 1024); } while (0)
#define PG8_MMA(ai, bj, At, Bt) do { __builtin_amdgcn_s_setprio(1); _Pragma("unroll") for (int m = 0; m < 4; ++m) _Pragma("unroll") for (int n = 0; n < 2; ++n) _Pragma("unroll") for (int k = 0; k < 2; ++k) \
    acc[ai][bj][m][n] = __builtin_amdgcn_mfma_f32_16x16x32_bf16(Bt[n][k], At[m][k], acc[ai][bj][m][n], 0, 0, 0); __builtin_amdgcn_s_setprio(0); } while (0)
#define PG8_WAIT_V(n) asm volatile("s_waitcnt vmcnt(" #n ")" ::: "memory")
#define PG8_WAIT_L(n) asm volatile("s_waitcnt lgkmcnt(" #n ")" ::: "memory")
#define PG8_BAR __builtin_amdgcn_s_barrier()
#define PG8_SCHED __builtin_amdgcn_sched_barrier(0)
  Unit cur, nxt; int ui = 0;
  if (!S.next(0, cur)) return;
  f32x4 acc[2][2][4][2];
#pragma unroll
  for (int a = 0; a < 2; ++a)
#pragma unroll
    for (int b = 0; b < 2; ++b)
#pragma unroll
      for (int m = 0; m < 4; ++m)
#pragma unroll
        for (int n = 0; n < 2; ++n) acc[a][b][m][n] = (f32x4){0.f, 0.f, 0.f, 0.f};
  bf16x8 At[4][2], B0[2][2], B1[2][2];
  const char* cA = PG8_ABASE(cur.pm); const char* cB = (const char*)g.Bt + (size_t)cur.pn * tstepB;
  PG8_STAGE(PG8_SB(0, 0), cB, voffB); PG8_STAGE(PG8_SA(0, 0), cA, voffA); PG8_STAGE(PG8_SB(0, 1), cB + hstepB, voffB); PG8_STAGE(PG8_SA(0, 1), cA + hstepA, voffA);
  if (wr == 1) PG8_BAR;
  PG8_WAIT_V(4); PG8_BAR;
  PG8_STAGE(PG8_SB(1, 0), cB + kstep, voffB); PG8_STAGE(PG8_SA(1, 0), cA + kstepA, voffA); PG8_STAGE(PG8_SB(1, 1), cB + hstepB + kstep, voffB);
  PG8_WAIT_V(6); PG8_BAR;
  for (;;) {
    const bool has_next = S.next(ui + 1, nxt);
    const char* nA = has_next ? PG8_ABASE(nxt.pm) : cA; const char* nB = has_next ? (const char*)g.Bt + (size_t)nxt.pn * tstepB : cB;
    for (int t = 0; t < nt; t += 2) {
      const bool last = (t == nt - 2);
      const char* a1 = cA + (size_t)(t + 1) * kstepA;
      const char* a2 = last ? nA : cA + (size_t)(t + 2) * kstepA; const char* b2 = last ? nB : cB + (size_t)(t + 2) * kstep;
      const char* a3 = a2 + kstepA; const char* b3 = b2 + kstep;
      PG8_LDB(B0, 0, 0); PG8_SCHED; PG8_LDA(At, 0, 0); PG8_STAGE(PG8_SA(1, 1), a1 + hstepA, voffA);
      PG8_WAIT_L(8); PG8_BAR; PG8_WAIT_L(0); PG8_MMA(0, 0, At, B0); PG8_BAR; PG8_SCHED;
      PG8_LDB(B1, 0, 1); PG8_STAGE(PG8_SB(0, 0), b2, voffB);
      PG8_BAR; PG8_WAIT_L(0); PG8_MMA(0, 1, At, B1); PG8_BAR;
      PG8_LDA(At, 0, 1); PG8_STAGE(PG8_SA(0, 0), a2, voffA);
      PG8_BAR; PG8_WAIT_L(0); PG8_MMA(1, 0, At, B0); PG8_BAR; PG8_SCHED;
      PG8_STAGE(PG8_SB(0, 1), b2 + hstepB, voffB);
      PG8_WAIT_V(6); PG8_BAR; PG8_MMA(1, 1, At, B1); PG8_BAR;
      PG8_LDB(B0, 1, 0); PG8_SCHED; PG8_LDA(At, 1, 0); PG8_STAGE(PG8_SA(0, 1), a2 + hstepA, voffA);
      PG8_WAIT_L(8); PG8_BAR; PG8_WAIT_L(0); PG8_MMA(0, 0, At, B0); PG8_BAR; PG8_SCHED;
      PG8_LDB(B1, 1, 1); PG8_STAGE(PG8_SB(1, 0), b3, voffB);
      PG8_BAR; PG8_WAIT_L(0); PG8_MMA(0, 1, At, B1); PG8_BAR;
      PG8_LDA(At, 1, 1); PG8_STAGE(PG8_SA(1, 0), a3, voffA);
      PG8_BAR; PG8_WAIT_L(0); PG8_MMA(1, 0, At, B0); PG8_BAR; PG8_SCHED;
      PG8_STAGE(PG8_SB(1, 1), b3 + hstepB, voffB);
      PG8_WAIT_V(6); PG8_BAR; PG8_MMA(1, 1, At, B1); PG8_BAR;
    }
    E(acc, cur, wr, wc, fr, fq);
    if (!has_next) break;
#pragma unroll
    for (int a = 0; a < 2; ++a)
#pragma unroll
      for (int b = 0; b < 2; ++b)
#pragma unroll
        for (int m = 0; m < 4; ++m)
#pragma unroll
          for (int n = 0; n < 2; ++n) acc[a][b][m][n] = (f32x4){0.f, 0.f, 0.f, 0.f};
    cur = nxt; cA = nA; cB = nB; ++ui;
  }
  PG8_WAIT_V(0);
  if (wr == 0) PG8_BAR;
  PG8_BAR;
#undef PG8_ABASE
#undef PG8_SA
#undef PG8_SB
#undef PG8_STAGE
#undef PG8_LDA
#undef PG8_LDB
#undef PG8_MMA
#undef PG8_WAIT_V
#undef PG8_WAIT_L
#undef PG8_BAR
#undef PG8_SCHED
}

struct EpiBf16 {
  static constexpr bool PERM = true;
  bf16_t* O; int ldc, nvalid;
  DI void operator()(const f32x4 (&acc)[2][2][4][2], const Unit& u, int wr, int wc, int fr, int fq) const {
    const int row0 = u.pm * BM + wr * 64 + fr, col0 = u.pn * BM + wc * 32 + 8 * fq;
#pragma unroll
    for (int ai = 0; ai < 2; ++ai)
#pragma unroll
      for (int m = 0; m < 4; ++m) { bf16_t* rowp = O + (size_t)(row0 + ai * HALF + m * 16) * ldc + col0;
#pragma unroll
        for (int bj = 0; bj < 2; ++bj) if (col0 + bj * HALF < nvalid) {
          const f32x4 v0 = acc[ai][bj][m][0], v1 = acc[ai][bj][m][1];
          u32x4 w; w.x = pack_bf2(v0[0], v0[1]); w.y = pack_bf2(v0[2], v0[3]); w.z = pack_bf2(v1[0], v1[1]); w.w = pack_bf2(v1[2], v1[3]);
          *(u32x4*)(rowp + bj * HALF) = w; } }
  }
};
struct EpiP0 {
  static constexpr bool PERM = true;
  bf16_t* O; const float2* rope;
  DI void operator()(const f32x4 (&acc)[2][2][4][2], const Unit& u, int wr, int wc, int fr, int fq) const {
    const int row0 = u.pm * BM + wr * 64 + fr, col0 = u.pn * BM + wc * 32 + 8 * fq;
    const bool isctx = (u.pm % 17) == 0; const int b = u.pm / 17;
    const bool qk = u.pn < 4;
    const float qs = (u.pn < 2) ? 0.125f * 1.4426950408889634f : 1.f;
    const int a = wc & 1, half = fq >> 1, f0 = 8 * (fq & 1);
#pragma unroll
    for (int ai = 0; ai < 2; ++ai)
#pragma unroll
      for (int m = 0; m < 4; ++m) {
        const int row = row0 + ai * HALF + m * 16;
        bf16_t* rowp = O + (size_t)row * P0LD + col0;
        const int l = row - b * TPB - CTXL;
#pragma unroll
        for (int bj = 0; bj < 2; ++bj) if (col0 + bj * HALF < P0LD) {
          float v[8];
#pragma unroll
          for (int j = 0; j < 4; ++j) { v[j] = acc[ai][bj][m][0][j]; v[4 + j] = acc[ai][bj][m][1][j]; }
          if (qk) {
            float pv[8];
#pragma unroll
            for (int j = 0; j < 8; ++j) pv[j] = __shfl_xor(v[j], 32);
            if (!isctx) {
              const float4* cs4 = (const float4*)(rope + (size_t)l * 32 + a * 16 + f0);
#pragma unroll
              for (int j2 = 0; j2 < 4; ++j2) {
                const float4 cs = cs4[j2];
                v[2 * j2] = half ? (v[2 * j2] * cs.x + pv[2 * j2] * cs.y) : (v[2 * j2] * cs.x - pv[2 * j2] * cs.y);
                v[2 * j2 + 1] = half ? (v[2 * j2 + 1] * cs.z + pv[2 * j2 + 1] * cs.w) : (v[2 * j2 + 1] * cs.z - pv[2 * j2 + 1] * cs.w);
              }
            }
#pragma unroll
            for (int j = 0; j < 8; ++j) v[j] *= qs;
          }
          u32x4 w; w.x = pack_bf2(v[0], v[1]); w.y = pack_bf2(v[2], v[3]); w.z = pack_bf2(v[4], v[5]); w.w = pack_bf2(v[6], v[7]);
          *(u32x4*)(rowp + bj * HALF) = w; } }
  }
};
struct EpiResid {
  static constexpr bool PERM = false;
  const float* x_in; const float* ctx_in; float* out; float* xc; const float* mods; int layer;
  DI void operator()(const f32x4 (&acc)[2][2][4][2], const Unit& u, int wr, int wc, int fr, int fq) const {
    const int row0 = u.pm * BM + wr * 64 + fr, col0 = u.pn * BM + wc * 32 + 4 * fq;
    const bool isctx = (u.pm % 17) == 0; const int b = u.pm / 17;
    const float* gate = mods + (isctx ? 8 : b) * 6144 + 2 * 1024 + col0;
    f32x4 gv[2][2];
#pragma unroll
    for (int bj = 0; bj < 2; ++bj)
#pragma unroll
      for (int n = 0; n < 2; ++n) gv[bj][n] = *(const f32x4*)(gate + bj * HALF + n * 16);
#pragma unroll
    for (int ai = 0; ai < 2; ++ai)
#pragma unroll
      for (int m = 0; m < 4; ++m) {
        const int row = row0 + ai * HALF + m * 16;
        const int t = row - b * TPB;
        const size_t o = isctx ? ((size_t)(b * CTXL + t)) * D + col0 : ((size_t)(b * SEQ + t - CTXL)) * D + col0;
        const float* src = isctx ? ctx_in : ((layer == 0) ? x_in : out);
        float* dst = isctx ? xc : out;
#pragma unroll
        for (int bj = 0; bj < 2; ++bj)
#pragma unroll
          for (int n = 0; n < 2; ++n) {
            const f32x4 xi = *(const f32x4*)(src + o + bj * HALF + n * 16);
            *(f32x4*)(dst + o + bj * HALF + n * 16) = xi + gv[bj][n] * acc[ai][bj][m][n];
          }
      }
  }
};
struct EpiDelta {
  static constexpr bool PERM = true;
  bf16_t* O; const float* mods;
  DI void operator()(const f32x4 (&acc)[2][2][4][2], const Unit& u, int wr, int wc, int fr, int fq) const {
    const int row0 = u.pm * BM + wr * 64 + fr, col0 = u.pn * BM + wc * 32 + 8 * fq;
    const bool isctx = (u.pm % 17) == 0; const int b = u.pm / 17;
    const float* gate = mods + (isctx ? 8 : b) * 6144 + 2 * 1024 + col0;
    f32x4 g0[2], g1[2];
#pragma unroll
    for (int bj = 0; bj < 2; ++bj) { g0[bj] = *(const f32x4*)(gate + bj * HALF); g1[bj] = *(const f32x4*)(gate + bj * HALF + 4); }
#pragma unroll
    for (int ai = 0; ai < 2; ++ai)
#pragma unroll
      for (int m = 0; m < 4; ++m) { bf16_t* rowp = O + (size_t)(row0 + ai * HALF + m * 16) * D + col0;
#pragma unroll
        for (int bj = 0; bj < 2; ++bj) {
          const f32x4 v0 = acc[ai][bj][m][0] * g0[bj], v1 = acc[ai][bj][m][1] * g1[bj];
          u32x4 w; w.x = pack_bf2(v0[0], v0[1]); w.y = pack_bf2(v0[2], v0[3]); w.z = pack_bf2(v1[0], v1[1]); w.w = pack_bf2(v1[2], v1[3]);
          *(u32x4*)(rowp + bj * HALF) = w; } }
  }
};
struct EpiP1 {
  static constexpr bool PERM = true;
  unsigned char* pb;
  DI void operator()(const f32x4 (&acc)[2][2][4][2], const Unit& u, int wr, int wc, int fr, int fq) const {
    unsigned zo = 0;
    asm volatile("" : "+v"(zo));
    const int row0 = u.pm * BM + wr * 64 + fr, col0 = u.pn * BM + wc * 32 + 8 * fq;
    const int b = u.pm / 17;
    const unsigned t0 = (unsigned)(row0 - b * TPB) + zo;
#pragma unroll
    for (int bj = 0; bj < 2; ++bj) {
      const int c = col0 + bj * HALF;
      if (c >= P1LD) continue;
      unsigned off, tstride;
      if (c < 2048) { off = (unsigned)L1_ZH + ((unsigned)(b * 32 + (c >> 6)) * TPB) * 128u + (unsigned)(c & 63) * 2u; tstride = 128u; }
      else if (c < 4096) { const int cc = c - 2048; off = (unsigned)L1_XH + ((unsigned)(b * 32 + (cc >> 6)) * TPB) * 128u + (unsigned)(cc & 63) * 2u; tstride = 128u; }
      else if (c < 4608) { const int cc = c - 4096; off = (unsigned)L1_BG + ((unsigned)(b * 4 + (cc >> 7)) * TPB) * 256u + (unsigned)(cc & 127) * 2u; tstride = 256u; }
      else if (c < 5120) { const int cc = c - 4608; off = (unsigned)L1_CG + ((unsigned)(b * 4 + (cc >> 7)) * TPB) * 256u + (unsigned)(cc & 127) * 2u; tstride = 256u; }
      else { off = (unsigned)L1_DT + (unsigned)b * TPB * 128u + (unsigned)(c - 5120) * 2u; tstride = 128u; }
      off += t0 * tstride;
#pragma unroll
      for (int ai = 0; ai < 2; ++ai)
#pragma unroll
        for (int m = 0; m < 4; ++m) {
          const f32x4 v0 = acc[ai][bj][m][0], v1 = acc[ai][bj][m][1];
          u32x4 w; w.x = pack_bf2(v0[0], v0[1]); w.y = pack_bf2(v0[2], v0[3]); w.z = pack_bf2(v1[0], v1[1]); w.w = pack_bf2(v1[2], v1[3]);
          *(u32x4*)(pb + off + (unsigned)(ai * HALF + m * 16) * tstride) = w;
        }
    }
  }
};
}

DI void transpose_tile(char* lds, const float* __restrict__ src, int K, int N, bf16_t* __restrict__ dst, int tile) {
  float* T = (float*)lds;
  const int ntk = K / 64;
  const int tn = tile / ntk, tk = tile - tn * ntk;
  const int tid = threadIdx.x;
  __syncthreads();
#pragma unroll
  for (int i = 0; i < 2; ++i) {
    const int kk = (tid >> 4) + 32 * i, n4 = (tid & 15) * 4;
    const int n = tn * 64 + n4;
    float4 v = make_float4(0.f, 0.f, 0.f, 0.f);
    if (n < N) v = *(const float4*)(src + (size_t)(tk * 64 + kk) * N + n);
    *(float4*)(T + kk * 68 + n4) = v;
  }
  __syncthreads();
  {
    const int nn = tid & 63, kc = tid >> 6;
    float f[8];
#pragma unroll
    for (int j = 0; j < 8; ++j) f[j] = T[(kc * 8 + j) * 68 + nn];
    *(uint4*)(dst + (size_t)(tn * 64 + nn) * K + tk * 64 + kc * 8) = pack8(f);
  }
}

DI void phase_prep(const P& p, char* lds) {
  const int tid = threadIdx.x;
  unsigned char* ws = p.ws;
  struct TD { int idx; int K, N, Npad; size_t dst; size_t srcoff; };
  int base = 0;
  const int G = gridDim.x;
#define TP_DESC(g_) \
    if (g_ < 896) { src = p.in[I_WIN0]; KK = 1024; NN = 3456; dst = (bf16_t*)(ws + WS_WIN0T); w = g_; } \
    else if (g_ < 1152) { src = p.in[I_WOUT0]; KK = 1024; NN = 1024; dst = (bf16_t*)(ws + WS_WOUT0T); w = g_ - 896; } \
    else if (g_ < 1664) { src = p.in[I_PQ0]; KK = 1024; NN = 2048; dst = (bf16_t*)(ws + WS_PQ0T); w = g_ - 1152; } \
    else if (g_ < 3008) { src = p.in[I_WIN1]; KK = 1024; NN = 5184; dst = (bf16_t*)(ws + WS_WIN1T); w = g_ - 1664; } \
    else if (g_ < 3520) { src = p.in[I_WOUT1]; KK = 2048; NN = 1024; dst = (bf16_t*)(ws + WS_WOUT1T); w = g_ - 3008; } \
    else if (g_ < 4032) { src = p.in[I_PQ1]; KK = 1024; NN = 2048; dst = (bf16_t*)(ws + WS_PQ1T); w = g_ - 3520; } \
    else if (g_ < 4040) { src = p.in[I_RWW2]; KK = 64; NN = 512; dst = (bf16_t*)(ws + WS_RWT); w = g_ - 4032; } \
    else if (g_ < 4048) { src = p.in[I_RWW2] + 64 * 512; KK = 64; NN = 512; dst = (bf16_t*)(ws + WS_RWT + 65536); w = g_ - 4040; } \
    else if (g_ < 4056) { src = p.in[I_RWA2]; KK = 64; NN = 512; dst = (bf16_t*)(ws + WS_RWT + 131072); w = g_ - 4048; } \
    else if (g_ < 4064) { src = p.in[I_RWA2] + 64 * 512; KK = 64; NN = 512; dst = (bf16_t*)(ws + WS_RWT + 196608); w = g_ - 4056; } \
    else { src = p.in[I_RWG2]; KK = 128; NN = 512; dst = (bf16_t*)(ws + WS_RWT + 262144); w = g_ - 4064; }
#define TP_LOAD(g_, V0, V1) do { const float* src; int KK, NN; bf16_t* dst; int w; TP_DESC(g_) (void)dst; \
      const int ntk_ = KK / 64, tn_ = w / ntk_, tk_ = w - tn_ * ntk_, n_ = tn_ * 64 + (tid & 15) * 4; \
      V0 = make_float4(0.f, 0.f, 0.f, 0.f); V1 = V0; \
      if (n_ < NN) { V0 = *(const float4*)(src + (size_t)(tk_ * 64 + (tid >> 4)) * NN + n_); V1 = *(const float4*)(src + (size_t)(tk_ * 64 + (tid >> 4) + 32) * NN + n_); } } while (0)
  {
    float4 c0, c1, n0, n1;
    int g = blockIdx.x;
    if (g < 4080) TP_LOAD(g, c0, c1);
    __syncthreads();
    for (int it = 0; g < 4080; g += G, ++it) {
      float* T = (float*)lds + (it & 1) * (64 * 68);
      const int gn = (g + G < 4080) ? g + G : 4079;
      TP_LOAD(gn, n0, n1);
      const float* src; int KK, NN; bf16_t* dst; int w; TP_DESC(g) (void)src; (void)NN;
      const int ntk = KK / 64, tn = w / ntk, tk = w - tn * ntk;
      *(float4*)(T + (tid >> 4) * 68 + (tid & 15) * 4) = c0;
      *(float4*)(T + ((tid >> 4) + 32) * 68 + (tid & 15) * 4) = c1;
      __syncthreads();
      {
        const int nn = tid & 63, kc = tid >> 6;
        float f[8];
#pragma unroll
        for (int j = 0; j < 8; ++j) f[j] = T[(kc * 8 + j) * 68 + nn];
        *(uint4*)(dst + (size_t)(tn * 64 + nn) * KK + tk * 64 + kc * 8) = pack8(f);
      }
      c0 = n0; c1 = n1;
    }
  }
#undef TP_DESC
#undef TP_LOAD
  (void)base;
  {
    const int gt = blockIdx.x * NTHR + tid, gs = G * NTHR;
    bf16_t* k0 = (bf16_t*)(ws + WS_KEYS0); bf16_t* k1 = (bf16_t*)(ws + WS_KEYS1);
    for (int i = gt; i < 262144; i += gs) { k0[i] = f2bf(p.in[I_PK0][i]); k1[i] = f2bf(p.in[I_PK1][i]); }
    float2* rope = (float2*)(ws + WS_ROPE);
    for (int i = gt; i < 4096 * 32; i += gs) {
      const int l = i >> 5, a = (i >> 4) & 1, f = i & 15;
      const float inv = powf(10000.f, -(float)f / 16.f);
      const float pos = (float)(a == 0 ? (l >> 6) : (l & 63));
      float s, c; sincosf(pos * inv, &s, &c);
      rope[i] = make_float2(c, s);
    }
    if (gt == 0) {
      const float* lp = p.in[I_DALAM];
      float s01 = 0.f, s23 = 0.f;
      for (int i = 0; i < 64; ++i) { s01 += lp[i] * lp[64 + i]; s23 += lp[128 + i] * lp[192 + i]; }
      ((float*)(ws + WS_SCAL))[0] = expf(s01) - expf(s23) + 0.2f;
    }
  }
  {
    float* sc = (float*)lds;
    float* red = (float*)(lds + 36864);
    __syncthreads();
    for (int e = tid; e < 9 * 1024; e += NTHR) { const int r = e >> 10, k = e & 1023; const float v = (r < 8) ? p.in[I_C][r * 1024 + k] : p.in[I_CCTX][k]; sc[e] = siluf_(v); }
    __syncthreads();
    float* mods = (float*)(ws + WS_MODS);
    for (int w = blockIdx.x; w < 192; w += G) {
      const int l = w / 96, j0 = (w % 96) * 64;
      const float* aw = p.in[l == 0 ? I_ADAW0 : I_ADAW1];
      const float* ab = p.in[l == 0 ? I_ADAB0 : I_ADAB1];
      const int lane = tid & 63, kg = tid >> 6, ks = lane >> 4, c4 = (lane & 15) * 4;
      float a[9][4];
#pragma unroll
      for (int r = 0; r < 9; ++r) { a[r][0] = 0.f; a[r][1] = 0.f; a[r][2] = 0.f; a[r][3] = 0.f; }
#pragma unroll 1
      for (int it = 0; it < 32; it += 8) {
        float4 wv[8];
#pragma unroll
        for (int u = 0; u < 8; ++u) wv[u] = *(const float4*)(aw + (size_t)(kg * 128 + (it + u) * 4 + ks) * 6144 + j0 + c4);
#pragma unroll
        for (int u = 0; u < 8; ++u) {
          const int k = kg * 128 + (it + u) * 4 + ks;
#pragma unroll
          for (int r = 0; r < 9; ++r) { const float sv = sc[r * 1024 + k]; a[r][0] += sv * wv[u].x; a[r][1] += sv * wv[u].y; a[r][2] += sv * wv[u].z; a[r][3] += sv * wv[u].w; }
        }
      }
      __syncthreads();
#pragma unroll
      for (int r = 0; r < 9; ++r)
#pragma unroll
        for (int c = 0; c < 4; ++c) red[((kg * 4 + ks) * 64 + c4 + c) * 9 + r] = a[r][c];
      __syncthreads();
      for (int e = tid; e < 64 * 9; e += NTHR) {
        const int c2 = e / 9, r = e - c2 * 9;
        float s = ab[j0 + c2];
        for (int g = 0; g < 32; ++g) s += red[(g * 64 + c2) * 9 + r];
        mods[((size_t)l * 9 + r) * 6144 + j0 + c2] = s;
      }
    }
  }
}

DI int wave_sum_i(int x) {
  x += __builtin_amdgcn_update_dpp(0, x, 0xB1, 0xF, 0xF, true);
  x += __builtin_amdgcn_update_dpp(0, x, 0x4E, 0xF, 0xF, true);
  x += __builtin_amdgcn_update_dpp(0, x, 0x141, 0xF, 0xF, true);
  x += __builtin_amdgcn_update_dpp(0, x, 0x140, 0xF, 0xF, true);
  return __builtin_amdgcn_readlane(x, 0) + __builtin_amdgcn_readlane(x, 16) + __builtin_amdgcn_readlane(x, 32) + __builtin_amdgcn_readlane(x, 48);
}
DI float wave_max(float x) {
  x = fmaxf(x, dpp_f<0xB1>(x)); x = fmaxf(x, dpp_f<0x4E>(x)); x = fmaxf(x, dpp_f<0x141>(x)); x = fmaxf(x, dpp_f<0x140>(x));
  x = fmaxf(x, __shfl_xor(x, 16)); x = fmaxf(x, __shfl_xor(x, 32)); return x;
}
DI void ct_row(const P& p, const float4 (&c)[4], int row, unsigned char* du, unsigned char* dv, float4* sc4, int lane) {
    const bool isv = row >= 16384;
    const int r = row & 16383;
    float x[16];
#pragma unroll
    for (int i = 0; i < 4; ++i) { x[i * 4] = c[i].x; x[i * 4 + 1] = c[i].y; x[i * 4 + 2] = c[i].z; x[i * 4 + 3] = c[i].w; }
    asm volatile("" : "+v"(x[0]), "+v"(x[1]), "+v"(x[2]), "+v"(x[3]), "+v"(x[4]), "+v"(x[5]), "+v"(x[6]), "+v"(x[7]),
                      "+v"(x[8]), "+v"(x[9]), "+v"(x[10]), "+v"(x[11]), "+v"(x[12]), "+v"(x[13]), "+v"(x[14]), "+v"(x[15]));
    float am = 0.f, ss = 0.f;
#pragma unroll
    for (int i = 0; i < 16; ++i) { am = fmaxf(am, fabsf(x[i])); ss += x[i] * x[i]; }
    am = fmaxf(wave_max(am), 1e-30f);
    ss = red64(ss);
    const float step = fminf(am * (1.f / 7.5f), fmaxf(0.3352f * sqrtf(ss * (1.f / 1024.f)), 1e-30f));
    const float inv = 1.f / step;
    unsigned w[2];
    int qs = 0;
#pragma unroll
    for (int d2 = 0; d2 < 2; ++d2) {
      unsigned pk = 0;
#pragma unroll
      for (int j = 0; j < 8; ++j) {
        int q = (int)rintf(x[d2 * 8 + j] * inv + 7.5f);
        q = q < 0 ? 0 : (q > 15 ? 15 : q);
        qs += q;
        pk |= (unsigned)q << (8 * (j >> 1) + 4 * (j & 1));
      }
      w[d2] = pk;
    }
    *(uint2*)((isv ? dv : du) + (size_t)r * 512 + lane * 8) = make_uint2(w[0], w[1]);
    qs = wave_sum_i(qs);
    if (lane == 0) { if (isv) sc4[r].y = step; else { sc4[r].x = step; sc4[r].z = 128.f * (float)qs; } }
}
DI void convert_tables(const P& p, int layer) {
  const int lane = threadIdx.x & 63, gw = blockIdx.x * 8 + WAVE_ID, nw = gridDim.x * 8;
  const float* u = p.in[layer == 0 ? I_PU0 : I_PU1];
  const float* v = p.in[layer == 0 ? I_PV0 : I_PV1];
  unsigned char* du = p.ws + WS_HB + HB_U;
  unsigned char* dv = p.ws + WS_HB + HB_V;
  float4* sc4 = (float4*)(p.ws + WS_HB + HB_SU);
#define CT_LD(C, ROW) do { __builtin_amdgcn_sched_barrier(0); const float* s_ = (((ROW) >= 16384) ? v : u) + (size_t)((ROW) & 16383) * D + lane * 16; \
    _Pragma("unroll") for (int i = 0; i < 4; ++i) C[i] = *(const float4*)(s_ + i * 4); __builtin_amdgcn_sched_barrier(0); } while (0)
  if (nw == 2048) {
    float4 ca[4], cb[4], cc[4];
    CT_LD(ca, gw); CT_LD(cb, gw + 2048);
#pragma unroll 1
    for (int j = 0; j < 12; j += 3) {
      CT_LD(cc, gw + 2048 * (j + 2)); ct_row(p, ca, gw + 2048 * j, du, dv, sc4, lane);
      CT_LD(ca, gw + 2048 * (j + 3)); ct_row(p, cb, gw + 2048 * (j + 1), du, dv, sc4, lane);
      CT_LD(cb, gw + 2048 * (j + 4)); ct_row(p, cc, gw + 2048 * (j + 2), du, dv, sc4, lane);
    }
    CT_LD(cc, gw + 2048 * 14); ct_row(p, ca, gw + 2048 * 12, du, dv, sc4, lane);
    CT_LD(ca, gw + 2048 * 15); ct_row(p, cb, gw + 2048 * 13, du, dv, sc4, lane);
    ct_row(p, cc, gw + 2048 * 14, du, dv, sc4, lane);
    ct_row(p, ca, gw + 2048 * 15, du, dv, sc4, lane);
  } else {
    for (int row = gw; row < 32768; row += nw) { float4 c[4]; CT_LD(c, row); ct_row(p, c, row, du, dv, sc4, lane); }
  }
#undef CT_LD
}

DI void nm_load(float4 (&nx)[4], uint4 (&nd)[2], const float* s, const bf16_t* dl, int lane, bool xf32) {
  if (xf32) {
#pragma unroll
    for (int i = 0; i < 4; ++i) nx[i] = *(const float4*)(s + lane * 16 + i * 4);
  } else {
    const uint4 r0 = *(const uint4*)((const char*)s + lane * 32), r1 = *(const uint4*)((const char*)s + lane * 32 + 16);
    nx[0] = make_float4(__uint_as_float(r0.x), __uint_as_float(r0.y), __uint_as_float(r0.z), __uint_as_float(r0.w));
    nx[1] = make_float4(__uint_as_float(r1.x), __uint_as_float(r1.y), __uint_as_float(r1.z), __uint_as_float(r1.w));
  }
  if (dl) { nd[0] = *(const uint4*)(dl + lane * 16); nd[1] = *(const uint4*)(dl + lane * 16 + 8); }
}
typedef float f32x2n __attribute__((ext_vector_type(2)));
DI void nm_row(const P& p, const float4 (&nx)[4], const uint4 (&nd)[2], bool has_delta, bool xf32, float* xo, const float (&gv)[16], const float (&sc)[16], const float (&sf)[16], bf16_t* drow, size_t crow, int lane) {
  float v[16];
  if (xf32) {
#pragma unroll
    for (int i = 0; i < 4; ++i) { v[i * 4] = nx[i].x; v[i * 4 + 1] = nx[i].y; v[i * 4 + 2] = nx[i].z; v[i * 4 + 3] = nx[i].w; }
  } else {
    const unsigned rw[8] = {__float_as_uint(nx[0].x), __float_as_uint(nx[0].y), __float_as_uint(nx[0].z), __float_as_uint(nx[0].w),
                            __float_as_uint(nx[1].x), __float_as_uint(nx[1].y), __float_as_uint(nx[1].z), __float_as_uint(nx[1].w)};
#pragma unroll
    for (int j = 0; j < 8; ++j) { v[2 * j] = bflo(rw[j]); v[2 * j + 1] = bfhi(rw[j]); }
  }
  asm volatile("" : "+v"(v[0]), "+v"(v[1]), "+v"(v[2]), "+v"(v[3]), "+v"(v[4]), "+v"(v[5]), "+v"(v[6]), "+v"(v[7]),
                    "+v"(v[8]), "+v"(v[9]), "+v"(v[10]), "+v"(v[11]), "+v"(v[12]), "+v"(v[13]), "+v"(v[14]), "+v"(v[15]));
  if (has_delta) {
    float dl[8];
    unpack8(nd[0], dl);
#pragma unroll
    for (int i = 0; i < 8; ++i) v[i] += dl[i];
    unpack8(nd[1], dl);
#pragma unroll
    for (int i = 0; i < 8; ++i) v[8 + i] += dl[i];
    {
      float f8[8];
#pragma unroll
      for (int i = 0; i < 8; ++i) f8[i] = v[i];
      *(uint4*)((char*)xo + lane * 32) = pack8(f8);
#pragma unroll
      for (int i = 0; i < 8; ++i) f8[i] = v[8 + i];
      *(uint4*)((char*)xo + lane * 32 + 16) = pack8(f8);
    }
  }
  f32x2n ss2 = {0.f, 0.f};
#pragma unroll
  for (int i = 0; i < 8; ++i) { const f32x2n t = {v[2 * i], v[2 * i + 1]}; ss2 += t * t; }
  float ss = red64(ss2[0] + ss2[1]);
  const float rs = rsqrtf(ss * (1.f / 1024.f) + 1e-6f);
  float o[16];
#pragma unroll
  for (int i = 0; i < 16; ++i) o[i] = v[i] * rs * gv[i] * sc[i] + sf[i];
  uint4 w0, w1;
  w0.x = pack_bf2(o[0], o[1]); w0.y = pack_bf2(o[2], o[3]); w0.z = pack_bf2(o[4], o[5]); w0.w = pack_bf2(o[6], o[7]);
  w1.x = pack_bf2(o[8], o[9]); w1.y = pack_bf2(o[10], o[11]); w1.z = pack_bf2(o[12], o[13]); w1.w = pack_bf2(o[14], o[15]);
  *(uint4*)(drow + lane * 16) = w0;
  *(uint4*)(drow + lane * 16 + 8) = w1;
  if (has_delta) {
    const unsigned ww[8] = {w0.x, w0.y, w0.z, w0.w, w1.x, w1.y, w1.z, w1.w};
    float ob[16];
#pragma unroll
    for (int j = 0; j < 8; ++j) { ob[2 * j] = bflo(ww[j]); ob[2 * j + 1] = bfhi(ww[j]); }
    float am = 0.f;
#pragma unroll
    for (int j = 0; j < 16; ++j) am = fmaxf(am, fabsf(ob[j]));
    am = fmaxf(wave_max(am), 1e-30f);
    const float inv = 127.f / am;
    int hsum = 0;
    unsigned pa[2] = {0u, 0u}, pq[2] = {0u, 0u};
#pragma unroll
    for (int j = 0; j < 16; ++j) {
      const int q = (int)rintf(ob[j] * inv);
      hsum += q;
      const unsigned hp = (unsigned)(q + 128);
      pa[j >> 3] |= (hp >> 4) << (4 * (j & 7)); pq[j >> 3] |= (hp & 15u) << (4 * (j & 7));
    }
    hsum = wave_sum_i(hsum);
    unsigned char* hq = p.ws + WS_PB + PB_HQ + crow * 1024 + (lane >> 1) * 32 + (lane & 1) * 8;
    *(uint2*)hq = make_uint2(pa[0], pa[1]);
    *(uint2*)(hq + 16) = make_uint2(pq[0], pq[1]);
    if (lane == 0) ((float2*)(p.ws + WS_PB + PB_HS))[crow] = make_float2(am * (1.f / 127.f), 7.5f * (float)hsum);
  }
}
DI void phase_normmod_generic(const P& p, int layer, int which, bool from_inputs, bool lat_only, bf16_t* dst, const bf16_t* delta);
DI void phase_normmod(const P& p, int layer, int which, bool from_inputs, bool lat_only, bf16_t* dst, const bf16_t* delta = nullptr) {
  const int lane = threadIdx.x & 63, gw = blockIdx.x * 8 + WAVE_ID, nw = gridDim.x * 8;
  if (nw != 2048) { phase_normmod_generic(p, layer, which, from_inputs, lat_only, dst, delta); return; }
  const float* g = p.in[layer == 0 ? (which == 0 ? I_N1_0 : I_N2_0) : (which == 0 ? I_N1_1 : I_N2_1)];
  const float* mods = (const float*)(p.ws + WS_MODS) + (size_t)layer * 9 * 6144 + (which == 0 ? 0 : 3 * 1024);
  const bool hd = delta != nullptr;
  float gv[16], sc[16], sf[16];
  const int b = gw >> 8, tl0 = gw & 255;
#pragma unroll
  for (int i = 0; i < 4; ++i) {
    const float4 a = *(const float4*)(g + lane * 16 + i * 4), c1 = *(const float4*)(mods + b * 6144 + 1024 + lane * 16 + i * 4), c0 = *(const float4*)(mods + b * 6144 + lane * 16 + i * 4);
    gv[i * 4] = a.x; gv[i * 4 + 1] = a.y; gv[i * 4 + 2] = a.z; gv[i * 4 + 3] = a.w;
    sc[i * 4] = 1.f + c1.x; sc[i * 4 + 1] = 1.f + c1.y; sc[i * 4 + 2] = 1.f + c1.z; sc[i * 4 + 3] = 1.f + c1.w;
    sf[i * 4] = c0.x; sf[i * 4 + 1] = c0.y; sf[i * 4 + 2] = c0.z; sf[i * 4 + 3] = c0.w;
  }
  {
    const float* srow = (from_inputs ? p.in[I_X] : p.out) + ((size_t)(b * SEQ + tl0)) * D;
    float* xrow = p.out + ((size_t)(b * SEQ + tl0)) * D;
    const size_t crow = (size_t)b * TPB + CTXL + tl0;
    const bf16_t* drow = hd ? delta + crow * D : nullptr;
    bf16_t* orow = dst + crow * D;
    float4 xa[4], xb[4], xq[4]; uint4 da[2], db[2], dq[2];
#define NM_LD(X, DD, J) do { __builtin_amdgcn_sched_barrier(0); nm_load(X, DD, srow + (size_t)(J) * (256 * D), hd ? drow + (size_t)(J) * (256 * D) : nullptr, lane, from_inputs); __builtin_amdgcn_sched_barrier(0); } while (0)
#define NM_DO(X, DD, J) nm_row(p, X, DD, hd, from_inputs, xrow + (size_t)(J) * (256 * D), gv, sc, sf, orow + (size_t)(J) * (256 * D), crow + (size_t)(J) * 256, lane)
    NM_LD(xa, da, 0); NM_LD(xb, db, 1);
#pragma unroll 1
    for (int j = 0; j < 12; j += 3) {
      NM_LD(xq, dq, j + 2); NM_DO(xa, da, j);
      NM_LD(xa, da, j + 3); NM_DO(xb, db, j + 1);
      NM_LD(xb, db, j + 4); NM_DO(xq, dq, j + 2);
    }
    NM_LD(xq, dq, 14); NM_DO(xa, da, 12);
    NM_LD(xa, da, 15); NM_DO(xb, db, 13);
    NM_DO(xq, dq, 14);
    NM_DO(xa, da, 15);
#undef NM_LD
#undef NM_DO
  }
  if (!lat_only) {
    const int t2 = gw & 255;
#pragma unroll
    for (int i = 0; i < 4; ++i) {
      const float4 c1 = *(const float4*)(mods + 8 * 6144 + 1024 + lane * 16 + i * 4), c0 = *(const float4*)(mods + 8 * 6144 + lane * 16 + i * 4);
      sc[i * 4] = 1.f + c1.x; sc[i * 4 + 1] = 1.f + c1.y; sc[i * 4 + 2] = 1.f + c1.z; sc[i * 4 + 3] = 1.f + c1.w;
      sf[i * 4] = c0.x; sf[i * 4 + 1] = c0.y; sf[i * 4 + 2] = c0.z; sf[i * 4 + 3] = c0.w;
    }
    const size_t xoff = ((size_t)(b * CTXL + t2)) * D, crow = (size_t)b * TPB + t2;
    float4 xa[4]; uint4 da[2];
    nm_load(xa, da, (from_inputs ? p.in[I_CTX] : (const float*)(p.ws + WS_XC)) + xoff, hd ? delta + crow * D : nullptr, lane, from_inputs);
    nm_row(p, xa, da, hd, from_inputs, (float*)(p.ws + WS_XC) + xoff, gv, sc, sf, dst + crow * D, crow, lane);
  }
}
DI void phase_normmod_generic(const P& p, int layer, int which, bool from_inputs, bool lat_only, bf16_t* dst, const bf16_t* delta) {
  const int lane = threadIdx.x & 63, gw = blockIdx.x * 8 + WAVE_ID, nw = gridDim.x * 8;
  const float* g = p.in[layer == 0 ? (which == 0 ? I_N1_0 : I_N2_0) : (which == 0 ? I_N1_1 : I_N2_1)];
  const float* mods = (const float*)(p.ws + WS_MODS) + (size_t)layer * 9 * 6144;
  const float* xc = (const float*)(p.ws + WS_XC);
  float4 nx[4]; uint4 nd[2], nb[2];
#define NM_SRC(ROW) ((((ROW) % TPB) < CTXL) ? ((from_inputs ? p.in[I_CTX] : xc) + ((size_t)(((ROW) / TPB) * CTXL + ((ROW) % TPB))) * D) \
                                             : ((from_inputs ? p.in[I_X] : p.out) + ((size_t)(((ROW) / TPB) * SEQ + ((ROW) % TPB) - CTXL)) * D))
#define NM_LOAD(ROW) do { if (!(lat_only && ((ROW) % TPB) < CTXL)) { const float* s_ = NM_SRC(ROW); \
      if (from_inputs) { _Pragma("unroll") for (int i = 0; i < 4; ++i) nx[i] = *(const float4*)(s_ + lane * 16 + i * 4); } \
      else { nb[0] = *(const uint4*)((const char*)s_ + lane * 32); nb[1] = *(const uint4*)((const char*)s_ + lane * 32 + 16); } \
      if (delta) { nd[0] = *(const uint4*)(delta + (size_t)(ROW) * D + lane * 16); nd[1] = *(const uint4*)(delta + (size_t)(ROW) * D + lane * 16 + 8); } } } while (0)
  if (gw < R) NM_LOAD(gw);
  for (int row = gw; row < R; row += nw) {
    const int b = row / TPB, t = row - b * TPB;
    const bool isctx = t < CTXL;
    float v[16]; uint4 dcur0 = nd[0], dcur1 = nd[1];
    if (from_inputs) {
#pragma unroll
      for (int i = 0; i < 4; ++i) { v[i * 4] = nx[i].x; v[i * 4 + 1] = nx[i].y; v[i * 4 + 2] = nx[i].z; v[i * 4 + 3] = nx[i].w; }
    } else {
      float f8[8];
      unpack8(nb[0], f8);
#pragma unroll
      for (int i = 0; i < 8; ++i) v[i] = f8[i];
      unpack8(nb[1], f8);
#pragma unroll
      for (int i = 0; i < 8; ++i) v[8 + i] = f8[i];
    }
    if (row + nw < R) NM_LOAD(row + nw);
    if (isctx && lat_only) continue;
    const float* mrow = mods + (isctx ? 8 : b) * 6144 + (which == 0 ? 0 : 3 * 1024);
    if (delta) {
      float dl[8];
      unpack8(dcur0, dl);
#pragma unroll
      for (int i = 0; i < 8; ++i) v[i] += dl[i];
      unpack8(dcur1, dl);
#pragma unroll
      for (int i = 0; i < 8; ++i) v[8 + i] += dl[i];
      float* xo = isctx ? ((float*)(p.ws + WS_XC) + ((size_t)(b * CTXL + t)) * D) : (p.out + ((size_t)(b * SEQ + t - CTXL)) * D);
      {
        float f8[8];
#pragma unroll
        for (int i = 0; i < 8; ++i) f8[i] = v[i];
        *(uint4*)((char*)xo + lane * 32) = pack8(f8);
#pragma unroll
        for (int i = 0; i < 8; ++i) f8[i] = v[8 + i];
        *(uint4*)((char*)xo + lane * 32 + 16) = pack8(f8);
      }
    }
    float ss = 0.f;
#pragma unroll
    for (int i = 0; i < 16; ++i) ss += v[i] * v[i];
    ss = red64(ss);
    const float rs = rsqrtf(ss * (1.f / 1024.f) + 1e-6f);
    float o[16];
#pragma unroll
    for (int i = 0; i < 16; ++i) { const int c = lane * 16 + i; o[i] = v[i] * rs * g[c] * (1.f + mrow[1024 + c]) + mrow[c]; }
    uint4 w0, w1;
    w0.x = pack_bf2(o[0], o[1]); w0.y = pack_bf2(o[2], o[3]); w0.z = pack_bf2(o[4], o[5]); w0.w = pack_bf2(o[6], o[7]);
    w1.x = pack_bf2(o[8], o[9]); w1.y = pack_bf2(o[10], o[11]); w1.z = pack_bf2(o[12], o[13]); w1.w = pack_bf2(o[14], o[15]);
    *(uint4*)(dst + (size_t)row * D + lane * 16) = w0;
    *(uint4*)(dst + (size_t)row * D + lane * 16 + 8) = w1;
    if (delta) {
      const unsigned ww[8] = {w0.x, w0.y, w0.z, w0.w, w1.x, w1.y, w1.z, w1.w};
      float ob[16];
#pragma unroll
      for (int j = 0; j < 8; ++j) { ob[2 * j] = bflo(ww[j]); ob[2 * j + 1] = bfhi(ww[j]); }
      float am = 0.f;
#pragma unroll
      for (int j = 0; j < 16; ++j) am = fmaxf(am, fabsf(ob[j]));
      am = fmaxf(wave_max(am), 1e-30f);
      const float inv = 127.f / am;
      int hsum = 0;
      unsigned pa[2] = {0u, 0u}, pq[2] = {0u, 0u};
#pragma unroll
      for (int j = 0; j < 16; ++j) {
        const int q = (int)rintf(ob[j] * inv);
        hsum += q;
        const unsigned hp = (unsigned)(q + 128);
        pa[j >> 3] |= (hp >> 4) << (4 * (j & 7)); pq[j >> 3] |= (hp & 15u) << (4 * (j & 7));
      }
      hsum = wave_sum_i(hsum);
      unsigned char* hq = p.ws + WS_PB + PB_HQ + (size_t)row * 1024 + (lane >> 1) * 32 + (lane & 1) * 8;
      *(uint2*)hq = make_uint2(pa[0], pa[1]);
      *(uint2*)(hq + 16) = make_uint2(pq[0], pq[1]);
      if (lane == 0) ((float2*)(p.ws + WS_PB + PB_HS))[row] = make_float2(am * (1.f / 127.f), 7.5f * (float)hsum);
    }
  }
#undef NM_SRC
#undef NM_LOAD
}

DI void phase_final_norm(const P& p) {
  const int lane = threadIdx.x & 63, gw = blockIdx.x * 8 + WAVE_ID, nw = gridDim.x * 8;
  const float* g = p.in[I_NF];
  for (int row = gw; row < NB * SEQ; row += nw) {
    float* src = p.out + (size_t)row * D;
    float v[16];
#pragma unroll
    for (int i = 0; i < 4; ++i) { const float4 f = *(const float4*)(src + lane * 16 + i * 4); v[i * 4] = f.x; v[i * 4 + 1] = f.y; v[i * 4 + 2] = f.z; v[i * 4 + 3] = f.w; }
    float ss = 0.f;
#pragma unroll
    for (int i = 0; i < 16; ++i) ss += v[i] * v[i];
    ss = red64(ss);
    const float rs = rsqrtf(ss * (1.f / 1024.f) + 1e-6f);
#pragma unroll
    for (int i = 0; i < 4; ++i) {
      const int c = lane * 16 + i * 4;
      float4 f; f.x = v[i * 4] * rs * g[c]; f.y = v[i * 4 + 1] * rs * g[c + 1]; f.z = v[i * 4 + 2] * rs * g[c + 2]; f.w = v[i * 4 + 3] * rs * g[c + 3];
      *(float4*)(src + c) = f;
    }
  }
}

typedef __attribute__((ext_vector_type(4))) short s16x4;
DI s16x4 tr_read(const char* p) { return __builtin_amdgcn_ds_read_tr16_b64_v4i16((__attribute__((address_space(3))) s16x4*)(p)); }

DI void attn_flash_unit(const P& p, char* lds, int unit) {
  const int tid = threadIdx.x, lane = tid & 63, wave = tid >> 6;
  const bool isctx = unit >= 1024;
  int b, h, qb;
  if (!isctx) { b = unit >> 7; h = (unit >> 5) & 3; qb = unit & 31; } else { const int u = unit - 1024; b = u >> 3; h = (u >> 1) & 3; qb = u & 1; }
  const int nkt = isctx ? CTXL / 64 : TPB / 64;
  const bf16_t* p0 = (const bf16_t*)(p.ws + WS_PB + PB_P);
  const float lam = ((const float*)(p.ws + WS_SCAL))[0];
  const int qg = wave >> 1, m = wave & 1;
  const int r31 = lane & 31, hh = lane >> 5;
  const int ql = qb * 128 + qg * 32 + r31;
  const size_t qrow = (size_t)b * TPB + (isctx ? ql : CTXL + ql);
  bf16x8 qf[4];
#pragma unroll
  for (int kk = 0; kk < 4; ++kk) qf[kk] = *(const bf16x8*)(p0 + qrow * P0LD + h * 128 + m * 64 + kk * 16 + 8 * hh);
  const int skey = tid >> 4, scc = tid & 15;
  const bf16_t* kg = p0 + ((size_t)b * TPB + skey) * P0LD + 512 + h * 128 + scc * 8;
  const bf16_t* vg = kg + 512;
  const int koff = (scc >> 3) * 8192 + skey * 128 + ((((scc & 7) ^ (skey >> 1)) & 7) << 4);
  const int voff = 16384 + skey * 320 + scc * 16;
  constexpr int BUFSZ = 36864;
  uint4 rk[2], rv[2];
  __syncthreads();
#pragma unroll
  for (int i = 0; i < 2; ++i) { rk[i] = *(const uint4*)(kg + (size_t)i * 32 * P0LD); rv[i] = *(const uint4*)(vg + (size_t)i * 32 * P0LD); }
#pragma unroll
  for (int i = 0; i < 2; ++i) { *(uint4*)(lds + koff + i * 4096) = rk[i]; *(uint4*)(lds + voff + i * 10240) = rv[i]; }
  __syncthreads();
  f32x16 o[4];
#pragma unroll
  for (int v = 0; v < 4; ++v)
#pragma unroll
    for (int r = 0; r < 16; ++r) o[v][r] = 0.f;
  float mrun = -1e30f, lsum = 0.f;
  const int q4 = (lane & 15) >> 2;
  const int vboff = ((lane >> 4) & 1) * 32 + 8 * (lane & 3);
  for (int kt = 0; kt < nkt; ++kt) {
    const int cur = kt & 1;
    if (kt + 1 < nkt) {
#pragma unroll
      for (int i = 0; i < 2; ++i) { rk[i] = *(const uint4*)(kg + (size_t)((kt + 1) * 64 + i * 32) * P0LD); rv[i] = *(const uint4*)(vg + (size_t)((kt + 1) * 64 + i * 32) * P0LD); }
    }
    const char* kb = lds + cur * BUFSZ + m * 8192;
    const char* vb = lds + cur * BUFSZ + 16384;
    f32x16 s[2];
#pragma unroll
    for (int t = 0; t < 2; ++t)
#pragma unroll
      for (int r = 0; r < 16; ++r) s[t][r] = 0.f;
#pragma unroll
    for (int kk = 0; kk < 4; ++kk)
#pragma unroll
      for (int t = 0; t < 2; ++t) {
        const int row = t * 32 + r31;
        const bf16x8 a = *(const bf16x8*)(kb + row * 128 + ((((kk * 2 + hh) ^ (row >> 1)) & 7) << 4));
        s[t] = MFMA32(a, qf[kk], s[t]);
      }
    float mx = s[0][0];
#pragma unroll
    for (int t = 0; t < 2; ++t)
#pragma unroll
      for (int r = 0; r < 16; ++r) mx = fmaxf(mx, s[t][r]);
    mx = fmaxf(mx, __shfl_xor(mx, 32));
    const float mnew = fmaxf(mrun, mx);
    const float corr = __builtin_amdgcn_exp2f(mrun - mnew);
    mrun = mnew;
    lsum *= corr;
#pragma unroll
    for (int v = 0; v < 4; ++v)
#pragma unroll
      for (int r = 0; r < 16; ++r) o[v][r] *= corr;
#pragma unroll
    for (int t = 0; t < 2; ++t)
#pragma unroll
      for (int r = 0; r < 16; ++r) { const float e = __builtin_amdgcn_exp2f(s[t][r] - mnew); s[t][r] = e; lsum += e; }
#pragma unroll
    for (int t = 0; t < 2; ++t)
#pragma unroll
      for (int st = 0; st < 2; ++st) {
        unsigned pk[4];
#pragma unroll
        for (int j = 0; j < 4; ++j) pk[j] = pack_bf2(s[t][8 * st + 2 * j], s[t][8 * st + 2 * j + 1]);
        bf16x8 bp;
        { typedef __attribute__((ext_vector_type(4))) unsigned u32x4; u32x4 u = {pk[0], pk[1], pk[2], pk[3]}; bp = __builtin_bit_cast(bf16x8, u); }
        const int key0 = t * 32 + 16 * st + 4 * hh + q4;
#pragma unroll
        for (int v = 0; v < 4; ++v) {
          const s16x4 lo = tr_read(vb + key0 * 320 + v * 64 + vboff);
          const s16x4 hi = tr_read(vb + (key0 + 8) * 320 + v * 64 + vboff);
          const bf16x8 av = __builtin_shufflevector(lo, hi, 0, 1, 2, 3, 4, 5, 6, 7);
          o[v] = MFMA32(av, bp, o[v]);
        }
      }
    if (kt + 1 < nkt) {
      char* nb = lds + (cur ^ 1) * BUFSZ;
#pragma unroll
      for (int i = 0; i < 2; ++i) { *(uint4*)(nb + koff + i * 4096) = rk[i]; *(uint4*)(nb + voff + i * 10240) = rv[i]; }
    }
    __syncthreads();
  }
  lsum += __shfl_xor(lsum, 32);
  const float inv = 1.f / lsum;
  float* Ex = (float*)lds;
  if (m == 1) {
#pragma unroll
    for (int v = 0; v < 4; ++v)
#pragma unroll
      for (int r = 0; r < 16; ++r) Ex[(qg * 128 + v * 32 + ACC_ROW(r, lane)) * 32 + r31] = o[v][r] * inv;
  }
  __syncthreads();
  if (m == 0) {
    float ss = 0.f;
#pragma unroll
    for (int v = 0; v < 4; ++v)
#pragma unroll
      for (int r = 0; r < 16; ++r) { const float dv = o[v][r] * inv - lam * Ex[(qg * 128 + v * 32 + ACC_ROW(r, lane)) * 32 + r31]; o[v][r] = dv; ss += dv * dv; }
    ss += __shfl_xor(ss, 32);
    const float rs = rsqrtf(ss * (1.f / 128.f) + 1e-6f) * 0.8f;
    const float* sub = p.in[I_DASUB];
    bf16_t* op = (bf16_t*)(p.ws + WS_PB + PB_O0) + qrow * 1024 + h * 128;
#pragma unroll
    for (int v = 0; v < 4; ++v)
#pragma unroll
      for (int g4 = 0; g4 < 4; ++g4) {
        const int vd = v * 32 + 8 * g4 + 4 * hh;
        uint2 w;
        w.x = pack_bf2(o[v][g4 * 4] * rs * sub[vd], o[v][g4 * 4 + 1] * rs * sub[vd + 1]);
        w.y = pack_bf2(o[v][g4 * 4 + 2] * rs * sub[vd + 2], o[v][g4 * 4 + 3] * rs * sub[vd + 3]);
        *(uint2*)(op + vd) = w;
      }
  }
  __syncthreads();
}

DI void phase_ga(const P& p) {
  const bf16_t* p0 = (const bf16_t*)(p.ws + WS_PB + PB_P);
  bf16_t* ga = (bf16_t*)(p.ws + WS_PB + PB_GA);
  const float* mu = p.in[I_RWMU] + 1792;
  for (int i = blockIdx.x * NTHR + threadIdx.x; i < R * 16; i += gridDim.x * NTHR) {
    const int row = i >> 4, c8 = (i & 15) * 8;
    const int t = row % TPB;
    const bool first = (t == 0) || (t == CTXL), last = (t == CTXL - 1) || (t == TPB - 1);
    const bf16_t* sp = p0 + (size_t)row * P0LD + 1536 + 1792 + c8;
    float u[8], um[8], up[8];
    unpack8(*(const uint4*)sp, u);
    if (!first) unpack8(*(const uint4*)(sp - P0LD), um); else { for (int j = 0; j < 8; ++j) um[j] = 0.f; }
    if (!last) unpack8(*(const uint4*)(sp + P0LD), up); else { for (int j = 0; j < 8; ++j) up[j] = 0.f; }
    float o[8];
#pragma unroll
    for (int j = 0; j < 8; ++j) { const float mix = u[j] + mu[c8 + j] * (0.5f * (um[j] + up[j]) - u[j]); o[j] = sigmoidf_(mix); }
    *(uint4*)(ga + (size_t)row * 128 + c8) = pack8(o);
  }
}

DI int scan_token(int d, int s) { return d == 0 ? s : (s < CTXL ? (CTXL - 1 - s) : (TPB + CTXL - 1 - s)); }

typedef __attribute__((ext_vector_type(4))) float f32x4_t;
DI void rwkv_scan_unit(const P& p, char* lds, int unit) {
  int tid_ = threadIdx.x;
  asm volatile("" : "+v"(tid_));
  const int tid = tid_, lane = tid & 63, wave = __builtin_amdgcn_readfirstlane(tid >> 6);
  const int half = unit & 1, d = (unit >> 1) & 1, h = (unit >> 2) & 7, b = unit >> 5;
  constexpr int T = 32, NCHK = TPB / T, BUFB = 45056;
  const bf16_t* p0 = (const bf16_t*)(p.ws + WS_PB + PB_P);
  __syncthreads();
  {
    const bf16_t* w2t = (const bf16_t*)(p.ws + WS_RWT + (size_t)d * 65536) + h * 64 * 64;
    const bf16_t* a2t = (const bf16_t*)(p.ws + WS_RWT + 131072 + (size_t)d * 65536) + h * 64 * 64;
    *(uint4*)(lds + 139264 + tid * 16) = *(const uint4*)(w2t + tid * 8);
    *(uint4*)(lds + 147456 + tid * 16) = *(const uint4*)(a2t + tid * 8);
    float* LC = (float*)(lds + 155648);
    for (int e = tid; e < 640; e += NTHR) {
      const int g = e >> 6, cidx = e & 63;
      float v;
      if (g == 0) v = p.in[I_RWW0][d * 512 + h * 64 + cidx];
      else if (g == 1) v = p.in[I_RWA0][d * 512 + h * 64 + cidx];
      else if (g == 2) v = p.in[I_RWKK][h * 64 + cidx];
      else if (g == 3) v = p.in[I_RWKA][h * 64 + cidx];
      else if (g == 4) v = p.in[I_RWRK][h * 64 + cidx];
      else if (g < 8) v = p.in[I_RWMU][(g - 5) * 512 + h * 64 + cidx];
      else v = p.in[I_RWMU][(g == 8 ? 1536 : 1664) + d * 64 + cidx];
      LC[e] = v;
    }
  }
  __syncthreads();
  if (wave < 4) {
    const int rp = tid >> 4, c16 = tid & 15, c4 = c16 * 4;
    typedef float f32x2 __attribute__((ext_vector_type(2)));
    f32x2 S0a = {0.f, 0.f}, S0b = {0.f, 0.f}, S1a = {0.f, 0.f}, S1b = {0.f, 0.f};
    bf16_t* yout = (bf16_t*)(p.ws + WS_HB + (d == 0 ? HB_YF : HB_YB)) + h * 64 + half * 32 + wave * 8 + (lane & 7);
    SEGR_DECL();
    __syncthreads();
    SEGR_INIT();
    for (int c = 0; c < NCHK; ++c) {
      int zo = 0;
      asm volatile("" : "+v"(zo));
      const char* B0 = lds + (c & 1) * BUFB + zo;
      float* Lyp = (float*)(lds + 122880 + zo);
      const float* La = (const float*)B0 + c4; const float* Lb = (const float*)(B0 + 8192) + c4; const float* Lk = (const float*)(B0 + 16384) + c4;
      const float* Lw = (const float*)(B0 + 24576) + c4; const float* Lr = (const float*)(B0 + 32768) + c4; const float* Lv = (const float*)(B0 + 40960) + rp * 2;
#define RW_LD(s_, A_, B_, K_, W_, R_, V_) const float4 A_ = *(const float4*)(La + (s_) * 64), B_ = *(const float4*)(Lb + (s_) * 64), K_ = *(const float4*)(Lk + (s_) * 64), \
          W_ = *(const float4*)(Lw + (s_) * 64), R_ = *(const float4*)(Lr + (s_) * 64); const float2 V_ = *(const float2*)(Lv + (s_) * 32)
      float4 a4, b4, k4, w4, r4, a4n, b4n, k4n, w4n, r4n; float2 v2, v2n;
      { RW_LD(0, xa, xb, xk, xw, xr, xv); a4 = xa; b4 = xb; k4 = xk; w4 = xw; r4 = xr; v2 = xv; }
      { RW_LD(1, xa, xb, xk, xw, xr, xv); a4n = xa; b4n = xb; k4n = xk; w4n = xw; r4n = xr; v2n = xv; }
#pragma unroll 1
      for (int g8 = 0; g8 < 4; ++g8) {
#pragma unroll
        for (int si = 0; si < 8; ++si) {
          const int s2 = (g8 * 8 + si + 2) & 31;
          RW_LD(s2, a4f, b4f, k4f, w4f, r4f, v2f);
          const f32x2 a01 = {a4.x, a4.y}, a23 = {a4.z, a4.w}, b01 = {b4.x, b4.y}, b23 = {b4.z, b4.w}, k01 = {k4.x, k4.y}, k23 = {k4.z, k4.w};
          const f32x2 w01 = {w4.x, w4.y}, w23 = {w4.z, w4.w}, r01 = {r4.x, r4.y}, r23 = {r4.z, r4.w};
          const f32x2 t0 = S0a * a01 + S0b * a23, t1 = S1a * a01 + S1b * a23;
          float sa0 = t0.x + t0.y, sa1 = t1.x + t1.y;
          const f32x2 vv0 = {v2.x, v2.x}, vv1 = {v2.y, v2.y};
          const f32x2 u0a = S0a * w01 + vv0 * k01, u0b = S0b * w23 + vv0 * k23, u1a = S1a * w01 + vv1 * k01, u1b = S1b * w23 + vv1 * k23;
          sa0 = red16(sa0); sa1 = red16(sa1);
          const f32x2 s0 = {sa0, sa0}, s1 = {sa1, sa1};
          S0a = s0 * b01 + u0a; S0b = s0 * b23 + u0b; S1a = s1 * b01 + u1a; S1b = s1 * b23 + u1b;
          const f32x2 y0 = S0a * r01 + S0b * r23, y1 = S1a * r01 + S1b * r23;
          Lyp[(si * 32 + rp * 2) * 16 + c16] = y0.x + y0.y;
          Lyp[(si * 32 + rp * 2 + 1) * 16 + c16] = y1.x + y1.y;
          a4 = a4n; b4 = b4n; k4 = k4n; w4 = w4n; r4 = r4n; v2 = v2n;
          a4n = a4f; b4n = b4f; k4n = k4f; w4n = w4f; r4n = r4f; v2n = v2f;
        }
        __builtin_amdgcn_wave_barrier();
        asm volatile("s_waitcnt lgkmcnt(0)" ::: "memory");
        {
          const int sj = lane >> 3, ri = lane & 7;
          const float4* pp = (const float4*)(Lyp + (sj * 32 + wave * 8 + ri) * 16);
          const float4 q0 = pp[0], q1 = pp[1], q2 = pp[2], q3 = pp[3];
          const float ysum = ((q0.x + q0.y) + (q0.z + q0.w)) + ((q1.x + q1.y) + (q1.z + q1.w)) + ((q2.x + q2.y) + (q2.z + q2.w)) + ((q3.x + q3.y) + (q3.z + q3.w));
          const int t = scan_token(d, c * T + g8 * 8 + sj);
          yout[((size_t)b * TPB + t) * 512] = f2bf(ysum);
        }
        asm volatile("s_waitcnt lgkmcnt(0)" ::: "memory");
        __builtin_amdgcn_wave_barrier();
      }
      SEGR_ADD(0);
      __syncthreads();
      SEGR_ADD(1);
    }
    SEGR_FLUSH(0);
  } else {
    const int pw = wave - 4;
    const int tok = lane >> 3, cg8 = (lane & 7) * 8;
    const int colsb[5] = {h * 64 + cg8, 512 + h * 64 + cg8, 1024 + h * 64 + cg8, 1536 + d * 64 + cg8, 1664 + d * 64 + cg8};
    const int n16 = lane & 15, q16 = lane >> 4;
    float* bonus = (float*)(p.ws + WS_PB + PB_BONUS) + (size_t)d * R * 8;
    uint4 raw[5][3];
    float fm = 1.f, fp_ = 1.f;
#define RW_ISSUE(CH) do { \
      const int t_ = scan_token(d, (CH) * T + pw * 8 + tok); \
      const bool first_ = (t_ == 0) || (t_ == CTXL), last_ = (t_ == CTXL - 1) || (t_ == TPB - 1); \
      fm = first_ ? 0.f : 1.f; fp_ = last_ ? 0.f : 1.f; \
      const bf16_t* rowp_ = p0 + ((size_t)b * TPB + t_) * P0LD + 1536; \
      const bf16_t* rowm_ = first_ ? rowp_ : rowp_ - P0LD; \
      const bf16_t* rowq_ = last_ ? rowp_ : rowp_ + P0LD; \
      _Pragma("unroll") for (int g_ = 0; g_ < 5; ++g_) { raw[g_][0] = *(const uint4*)(rowm_ + colsb[g_]); raw[g_][1] = *(const uint4*)(rowp_ + colsb[g_]); raw[g_][2] = *(const uint4*)(rowq_ + colsb[g_]); } \
    } while (0)
    RW_ISSUE(0);
    SEGR_DECL();
    SEGR_INIT();
    for (int c = 0; c < NCHK; ++c) {
      int zo = 0;
      asm volatile("" : "+v"(zo));
      char* PS = lds + 90112 + pw * 8192 + zo;
      float* Pk = (float*)PS; bf16_t* PA = (bf16_t*)(PS + 2048); bf16_t* PBa = (bf16_t*)(PS + 4096); float* Pinv = (float*)(PS + 6144);
      const float* LCc = (const float*)(lds + 155648 + zo);
      char* B0 = lds + (c & 1) * BUFB + zo;
      float* La = (float*)B0; float* Lb = (float*)(B0 + 8192); float* Lk = (float*)(B0 + 16384);
      float* Lw = (float*)(B0 + 24576); float* Lr = (float*)(B0 + 32768); float* Lv = (float*)(B0 + 40960);
      const int sl = pw * 8 + tok;
      {
#define RW_MIX(G, OUT) do { float u_[8], um_[8], up_[8]; unpack8(raw[G][1], u_); unpack8(raw[G][0], um_); unpack8(raw[G][2], up_); \
          const float4 m0_ = *(const float4*)(LCc + (5 + G) * 64 + cg8), m1_ = *(const float4*)(LCc + (5 + G) * 64 + cg8 + 4); \
          const float mm_[8] = {m0_.x, m0_.y, m0_.z, m0_.w, m1_.x, m1_.y, m1_.z, m1_.w}; \
          _Pragma("unroll") for (int j = 0; j < 8; ++j) OUT[j] = u_[j] + mm_[j] * (0.5f * (fm * um_[j] + fp_ * up_[j]) - u_[j]); } while (0)
        float mx[8];
        RW_MIX(0, mx);
        *(float4*)(Lr + sl * 64 + cg8) = make_float4(mx[0], mx[1], mx[2], mx[3]);
        *(float4*)(Lr + sl * 64 + cg8 + 4) = make_float4(mx[4], mx[5], mx[6], mx[7]);
        RW_MIX(2, mx);
        if ((cg8 >> 5) == half) {
          *(float4*)(Lv + sl * 32 + (cg8 & 31)) = make_float4(mx[0], mx[1], mx[2], mx[3]);
          *(float4*)(Lv + sl * 32 + (cg8 & 31) + 4) = make_float4(mx[4], mx[5], mx[6], mx[7]);
        }
        RW_MIX(3, mx);
        {
          float tw[8];
#pragma unroll
          for (int j = 0; j < 8; ++j) tw[j] = 1.f - 2.f * frcp_(1.f + __expf(2.f * mx[j]));
          *(uint4*)(PA + tok * 64 + cg8) = pack8(tw);
        }
        RW_MIX(4, mx);
        *(uint4*)(PBa + tok * 64 + cg8) = pack8(mx);
        RW_MIX(1, mx);
        *(float4*)(Pk + tok * 64 + cg8) = make_float4(mx[0], mx[1], mx[2], mx[3]);
        *(float4*)(Pk + tok * 64 + cg8 + 4) = make_float4(mx[4], mx[5], mx[6], mx[7]);
        float nrm = 0.f;
        {
          const float4 q0 = *(const float4*)(LCc + 2 * 64 + cg8), q1 = *(const float4*)(LCc + 2 * 64 + cg8 + 4);
          const float kk8[8] = {q0.x, q0.y, q0.z, q0.w, q1.x, q1.y, q1.z, q1.w};
#pragma unroll
          for (int j = 0; j < 8; ++j) { const float kq = mx[j] * kk8[j]; nrm += kq * kq; }
        }
        nrm = red8(nrm);
        if ((lane & 7) == 0) Pinv[tok] = __builtin_amdgcn_rsqf(fmaxf(nrm, 1e-24f));
        if (c + 1 < NCHK) RW_ISSUE(c + 1);
#undef RW_MIX
      }
      __builtin_amdgcn_wave_barrier();
      asm volatile("s_waitcnt lgkmcnt(0)" ::: "memory");
      SEGR_ADD(2);
      {
        float bon[2] = {0.f, 0.f};
        const int hq = lane >> 5, qq = (lane >> 4) & 1;
#pragma unroll
        for (int gsel = 0; gsel < 2; ++gsel) {
          const bf16_t* Asrc = (gsel == 0 ? PA : PBa) + n16 * 64 + q16 * 8;
          const bf16_t* Wsrc = (const bf16_t*)(lds + (gsel == 0 ? 139264 : 147456) + zo) + n16 * 64 + q16 * 8;
#pragma unroll
          for (int nt = 0; nt < 4; ++nt) {
            f32x4_t acc = {0.f, 0.f, 0.f, 0.f};
#pragma unroll
            for (int ks = 0; ks < 2; ++ks) {
              const bf16x8 af = *(const bf16x8*)(Asrc + ks * 32);
              const bf16x8 bf = *(const bf16x8*)(Wsrc + nt * 16 * 64 + ks * 32);
              acc = __builtin_amdgcn_mfma_f32_16x16x32_bf16(af, bf, acc, 0, 0, 0);
            }
            float xv[2];
            xv[0] = __uint_as_float(__builtin_amdgcn_permlane32_swap(__float_as_uint(acc[0]), __float_as_uint(acc[2]), false, false)[0]);
            xv[1] = __uint_as_float(__builtin_amdgcn_permlane32_swap(__float_as_uint(acc[1]), __float_as_uint(acc[3]), false, false)[0]);
            const int col = nt * 16 + n16;
            const float bias = LCc[gsel * 64 + col];
            const float kkc_ = LCc[2 * 64 + col], kac_ = LCc[3 * 64 + col], rkc_ = LCc[4 * 64 + col];
#pragma unroll
            for (int r = 0; r < 2; ++r) {
              const int tk = qq * 4 + hq * 2 + r, so = (pw * 8 + tk) * 64 + col;
              if (gsel == 0) { Lw[so] = __expf(-0.6065306597126334f * sigmoidf_(xv[r] + bias)); }
              else {
                const float as = sigmoidf_(xv[r] + bias);
                const float k = Pk[tk * 64 + col];
                const float kkv = k * kkc_ * Pinv[tk];
                La[so] = -kkv; Lb[so] = kkv * as;
                const float kd = k * (1.f + (as - 1.f) * kac_);
                Lk[so] = kd;
                bon[r] += Lr[so] * kd * rkc_;
              }
            }
          }
        }
#pragma unroll
        for (int r = 0; r < 2; ++r) bon[r] = red16(bon[r]);
        if (half == 0 && n16 == 0) {
#pragma unroll
          for (int r = 0; r < 2; ++r) {
            const int t = scan_token(d, c * T + pw * 8 + qq * 4 + hq * 2 + r);
            bonus[((size_t)b * TPB + t) * 8 + h] = bon[r];
          }
        }
      }
      SEGR_ADD(3);
      __syncthreads();
      SEGR_ADD(1);
    }
#if defined(PROBE_A) && PROBE_GRP == 1
    if (blockIdx.x == 0 && threadIdx.x == 256) { for (int j__ = 1; j__ < 4; ++j__) ((unsigned long long*)(p.ws + WS_SCAL + 1024))[22 + 4 + j__] += seg_acc_[j__]; }
#endif
    __syncthreads();
#undef RW_ISSUE
  }
}

DI void phase_rwkv_post(const P& p) {
  const bf16_t* p0 = (const bf16_t*)(p.ws + WS_PB + PB_P);
  const bf16_t* yf = (const bf16_t*)(p.ws + WS_HB + HB_YF);
  const bf16_t* yb = (const bf16_t*)(p.ws + WS_HB + HB_YB);
  const bf16_t* G = (const bf16_t*)(p.ws + WS_PB + PB_G);
  const float* bonus = (const float*)(p.ws + WS_PB + PB_BONUS);
  bf16_t* o0 = (bf16_t*)(p.ws + WS_PB + PB_O0);
  const float* mu = p.in[I_RWMU] + 1024;
  const int sub = threadIdx.x & 7;
  for (int it = (blockIdx.x * NTHR + threadIdx.x) >> 3; it < R * 8; it += (gridDim.x * NTHR) >> 3) {
    const int row = it >> 3, h = it & 7;
    const int t = row % TPB;
    const bool first = (t == 0) || (t == CTXL), last = (t == CTXL - 1) || (t == TPB - 1);
    const int cc = h * 64 + sub * 8;
    float y[8], a[8], bb[8];
    unpack8(*(const uint4*)(yf + (size_t)row * 512 + cc), a);
    unpack8(*(const uint4*)(yb + (size_t)row * 512 + cc), bb);
    float mean = 0.f;
#pragma unroll
    for (int j = 0; j < 8; ++j) { y[j] = a[j] + bb[j]; mean += y[j]; }
    mean = red8(mean) * (1.f / 64.f);
    float var = 0.f;
#pragma unroll
    for (int j = 0; j < 8; ++j) { const float dlt = y[j] - mean; var += dlt * dlt; }
    var = red8(var) * (1.f / 64.f);
    const float rs = rsqrtf(var + 64e-5f);
    const float bn = bonus[(size_t)row * 8 + h] + bonus[(size_t)R * 8 + (size_t)row * 8 + h];
    const bf16_t* vp = p0 + (size_t)row * P0LD + 1536 + 1024 + cc;
    float u[8], um[8], up[8], g[8], o[8];
    unpack8(*(const uint4*)vp, u);
    unpack8(*(const uint4*)(first ? vp : vp - P0LD), um);
    unpack8(*(const uint4*)(last ? vp : vp + P0LD), up);
    unpack8(*(const uint4*)(G + (size_t)row * 512 + cc), g);
    const float fm = first ? 0.f : 1.f, fp_ = last ? 0.f : 1.f;
#pragma unroll
    for (int j = 0; j < 8; ++j) {
      const float v = u[j] + mu[cc + j] * (0.5f * (fm * um[j] + fp_ * up[j]) - u[j]);
      const float yn = (y[j] - mean) * rs * p.in[I_LNXW][cc + j] + p.in[I_LNXB][cc + j];
      o[j] = (yn + bn * v) * g[j];
    }
    *(uint4*)(o0 + (size_t)row * 1024 + 512 + cc) = pack8(o);
  }
}

DI unsigned f2ord(float f) { const unsigned u = __float_as_uint(f); return u ^ ((u >> 31) ? 0xFFFFFFFFu : 0x80000000u); }
DI float ord2f(unsigned u) { u ^= ((u >> 31) ? 0x80000000u : 0xFFFFFFFFu); return __uint_as_float(u); }

DI void bitonic_sort16_desc(unsigned (&v)[16]) {
#pragma unroll
  for (int k = 2; k <= 16; k <<= 1)
#pragma unroll
    for (int j = k >> 1; j > 0; j >>= 1)
#pragma unroll
      for (int i = 0; i < 16; ++i) {
        const int l = i ^ j;
        if (l > i) { const unsigned hi = max(v[i], v[l]), lo = min(v[i], v[l]); const bool desc = ((i & k) == 0); v[i] = desc ? hi : lo; v[l] = desc ? lo : hi; }
      }
}
DI void merge_top16_desc(unsigned (&a)[16], const unsigned (&b)[16]) {
#pragma unroll
  for (int i = 0; i < 16; ++i) a[i] = max(a[i], b[15 - i]);
#pragma unroll
  for (int j = 8; j > 0; j >>= 1)
#pragma unroll
    for (int i = 0; i < 16; ++i) { const int l = i ^ j; if (l > i) { const unsigned hi = max(a[i], a[l]), lo = min(a[i], a[l]); a[i] = hi; a[l] = lo; } }
}
struct CandPairs { int ia[25], ja[25], ib[25], jb[25]; };
constexpr CandPairs make_pairs() {
  CandPairs c{};
  int n = 0;
  for (int i = 0; i < 16; ++i) for (int j = 0; j < 16; ++j) if ((i + 1) * (j + 1) <= 16) {
    if ((n & 1) == 0) { c.ia[n >> 1] = i; c.ja[n >> 1] = j; } else { c.ib[n >> 1] = i; c.jb[n >> 1] = j; }
    ++n;
  }
  return c;
}
constexpr CandPairs CP = make_pairs();

DI void peer_topk_unit(const P& p, char* lds, int layer, int unit, bool stage_keys) {
  const int tid = threadIdx.x, lane = tid & 63, wave = tid >> 6;
  const int mt = unit >> 3, h = unit & 7;
  const bf16_t* q = (const bf16_t*)(p.ws + WS_PB + PB_Q);
  const bf16_t* keys = (const bf16_t*)(p.ws + (layer == 0 ? WS_KEYS0 : WS_KEYS1)) + (size_t)h * 2 * 128 * 128;
  int* idxo = (int*)(p.ws + WS_PB + PB_IDX);
  float* gateo = (float*)(p.ws + WS_PB + PB_GATE);
  if (stage_keys) {
    __syncthreads();
    for (int e = tid; e < 2 * 128 * 16; e += NTHR) {
      const int pp = e >> 11, row = (e >> 4) & 127, c = e & 15;
      *(uint4*)(lds + pp * 32768 + row * 256 + ((c ^ (row & 15)) << 4)) = *(const uint4*)(keys + (size_t)pp * 16384 + row * 128 + c * 8);
    }
    __syncthreads();
  }
  const int r31 = lane & 31, hh = lane >> 5;
  const size_t trow = (size_t)mt * 256 + wave * 32 + r31;
  unsigned vk[2][16];
#pragma unroll
  for (int pp = 0; pp < 2; ++pp) {
    f32x16 acc[4];
#pragma unroll
    for (int m = 0; m < 4; ++m)
#pragma unroll
      for (int r = 0; r < 16; ++r) acc[m][r] = 0.f;
    const bf16_t* qp = q + trow * 2048 + (h * 2 + pp) * 128;
#pragma unroll
    for (int kk = 0; kk < 8; ++kk) {
      const bf16x8 bq = *(const bf16x8*)(qp + kk * 16 + 8 * hh);
      const int c = kk * 2 + hh;
#pragma unroll
      for (int m = 0; m < 4; ++m) {
        const int row = m * 32 + r31;
        const bf16x8 ak = *(const bf16x8*)(lds + pp * 32768 + row * 256 + ((c ^ (row & 15)) << 4));
        acc[m] = MFMA32(ak, bq, acc[m]);
      }
    }
    unsigned v[16];
#pragma unroll
    for (int m = 0; m < 4; ++m) {
      unsigned kx[16];
#pragma unroll
      for (int r = 0; r < 16; ++r) kx[r] = (f2ord(acc[m][r]) & ~127u) | (unsigned)(127 - (m * 32 + ACC_ROW(r, lane)));
      bitonic_sort16_desc(kx);
      if (m == 0) {
#pragma unroll
        for (int i = 0; i < 16; ++i) v[i] = kx[i];
      } else merge_top16_desc(v, kx);
    }
    unsigned c16[16];
#pragma unroll
    for (int i = 0; i < 16; ++i) c16[i] = (unsigned)__shfl_xor((int)v[i], 32);
    merge_top16_desc(v, c16);
#pragma unroll
    for (int i = 0; i < 16; ++i) vk[pp][i] = v[i];
  }
  float val1[16], val2[16]; int id1[16], id2[16];
#pragma unroll
  for (int i = 0; i < 16; ++i) {
    val1[i] = ord2f(vk[0][i] & ~127u); id1[i] = 127 - (int)(vk[0][i] & 127u);
    val2[i] = ord2f(vk[1][i] & ~127u); id2[i] = 127 - (int)(vk[1][i] & 127u);
  }
  unsigned tk[16];
#pragma unroll
  for (int t = 0; t < 16; ++t) {
    const float va = val1[CP.ia[t]] + val2[CP.ja[t]], vb = val1[CP.ib[t]] + val2[CP.jb[t]];
    const int pa = id1[CP.ia[t]] * 128 + id2[CP.ja[t]], pb = id1[CP.ib[t]] * 128 + id2[CP.jb[t]];
    tk[t] = (f2ord(hh ? vb : va) & ~0x3FFFu) | (unsigned)(hh ? pb : pa);
  }
  bitonic_sort16_desc(tk);
#pragma unroll
  for (int t = 16; t < 25; ++t) {
    const float va = val1[CP.ia[t]] + val2[CP.ja[t]], vb = val1[CP.ib[t]] + val2[CP.jb[t]];
    const int pa = id1[CP.ia[t]] * 128 + id2[CP.ja[t]], pb = id1[CP.ib[t]] * 128 + id2[CP.jb[t]];
    unsigned x = (f2ord(hh ? vb : va) & ~0x3FFFu) | (unsigned)(hh ? pb : pa);
#pragma unroll
    for (int i = 0; i < 16; ++i) { const unsigned hi = max(tk[i], x); x = min(tk[i], x); tk[i] = hi; }
  }
  float cv[16]; int cp[16];
  float mx = -3.0e38f;
#pragma unroll
  for (int i = 0; i < 16; ++i) {
    const unsigned ok = (unsigned)__shfl_xor((int)tk[15 - i], 32);
    const unsigned kk_ = max(tk[i], ok);
    cv[i] = ord2f(kk_ & ~0x3FFFu); cp[i] = (int)(kk_ & 0x3FFFu);
    mx = fmaxf(mx, cv[i]);
  }
  float sum = 0.f;
#pragma unroll
  for (int i = 0; i < 16; ++i) { cv[i] = __expf(cv[i] - mx); sum += cv[i]; }
  const float inv = 1.f / sum;
  if (hh == 0) {
    int* ip = idxo + trow * 128 + h * 16;
    float* gp = gateo + trow * 128 + h * 16;
#pragma unroll
    for (int i = 0; i < 4; ++i) {
      *(int4*)(ip + i * 4) = make_int4(cp[i * 4], cp[i * 4 + 1], cp[i * 4 + 2], cp[i * 4 + 3]);
      *(float4*)(gp + i * 4) = make_float4(cv[i * 4] * inv, cv[i * 4 + 1] * inv, cv[i * 4 + 2] * inv, cv[i * 4 + 3] * inv);
    }
  }
}

DI int reduce8_transposed(const int (&v)[8], int lane) {
  int x[4], y[2];
#pragma unroll
  for (int j = 0; j < 4; ++j) { const auto r = __builtin_amdgcn_permlane32_swap((unsigned)v[j], (unsigned)v[4 + j], false, false); x[j] = (int)(r[0] + r[1]); }
#pragma unroll
  for (int j = 0; j < 2; ++j) { const auto r = __builtin_amdgcn_permlane16_swap((unsigned)x[j], (unsigned)x[2 + j], false, false); y[j] = (int)(r[0] + r[1]); }
  const bool b3 = (lane >> 3) & 1;
  const int keep = b3 ? y[1] : y[0], send = b3 ? y[0] : y[1];
  int z = keep + __builtin_amdgcn_update_dpp(0, send, 0x128, 0xF, 0xF, true);
  z += __builtin_amdgcn_update_dpp(0, z, 0xB1, 0xF, 0xF, true);
  z += __builtin_amdgcn_update_dpp(0, z, 0x4E, 0xF, 0xF, true);
  z += __builtin_amdgcn_update_dpp(0, z, 0x141, 0xF, 0xF, true);
  return z;
}
DI float gelu_fast(float v) {
  const float av = fabsf(v), t = __builtin_amdgcn_rcpf(av * 0.2316418882f + 1.0f);
  float q = t * 0.5307027145f + (-0.7265760135f); q = q * t + 0.7107068705f; q = q * t + (-0.142248368f); q = q * t + 0.127414796f; q = q * t;
  const float e = __builtin_amdgcn_exp2f((v * v) * (-0.72134752044f));
  const float m = v * (q * e);
  return v < 0.f ? m : v - m;
}
typedef float f32x2g __attribute__((ext_vector_type(2)));
DI int reduce4_half(const int (&v)[4], int lane) {
  int y[2];
#pragma unroll
  for (int j = 0; j < 2; ++j) { const auto r = __builtin_amdgcn_permlane16_swap((unsigned)v[j], (unsigned)v[2 + j], false, false); y[j] = (int)(r[0] + r[1]); }
  const bool b3 = (lane >> 3) & 1;
  const int keep = b3 ? y[1] : y[0], send = b3 ? y[0] : y[1];
  int z = keep + __builtin_amdgcn_update_dpp(0, send, 0x128, 0xF, 0xF, true);
  z += __builtin_amdgcn_update_dpp(0, z, 0xB1, 0xF, 0xF, true);
  z += __builtin_amdgcn_update_dpp(0, z, 0x4E, 0xF, 0xF, true);
  z += __builtin_amdgcn_update_dpp(0, z, 0x141, 0xF, 0xF, true);
  return z;
}
#ifndef PG_VREP
#define PG_VREP 1
#endif
DI void phase_peer_gather(const P& p, int layer) {
  const int lane = threadIdx.x & 63, gw = blockIdx.x * 8 + WAVE_ID, nw = gridDim.x * 8;
  const unsigned char* hq = p.ws + WS_PB + PB_HQ;
  const float2* hsc = (const float2*)(p.ws + WS_PB + PB_HS);
  const int* idx = (const int*)(p.ws + WS_PB + PB_IDX);
  const float* gate = (const float*)(p.ws + WS_PB + PB_GATE);
  const unsigned char* U = p.ws + WS_HB + HB_U;
  const unsigned char* V = p.ws + WS_HB + HB_V;
  const float4* sc4 = (const float4*)(p.ws + WS_HB + HB_SU);
  const float* mods = (const float*)(p.ws + WS_MODS) + (size_t)layer * 9 * 6144;
  float* xc = (float*)(p.ws + WS_XC);
  const int hs = lane & 31, up = lane >> 5, k4 = (lane >> 3) & 3;
  const int ntok = (layer == 1) ? NB * SEQ : R;
  auto tok_row = [&](int i) { return (layer == 1) ? ((i >> 12) * TPB + CTXL + (i & 4095)) : i; };
  uint4 nh0, nh1; float2 nhs; int n_i0, n_i1; float n_g0, n_g1;
#define PG_TOKLOAD(ROW) do { const uint4* hp_ = (const uint4*)(hq + (size_t)(ROW) * 1024 + hs * 32); nh0 = hp_[0]; nh1 = hp_[1]; nhs = hsc[ROW]; \
    n_i0 = idx[(size_t)(ROW) * 128 + lane]; n_i1 = idx[(size_t)(ROW) * 128 + 64 + lane]; n_g0 = gate[(size_t)(ROW) * 128 + lane]; n_g1 = gate[(size_t)(ROW) * 128 + 64 + lane]; } while (0)
  if (gw < ntok) PG_TOKLOAD(tok_row(gw));
  for (int ti = gw; ti < ntok; ti += nw) {
    const int row = tok_row(ti);
    const int b = row / TPB, t = row - b * TPB;
    const bool isctx = t < CTXL;
    const unsigned hA[4] = {nh0.x, nh0.y, nh0.z, nh0.w}, hB[4] = {nh1.x, nh1.y, nh1.z, nh1.w};
    const float sh = nhs.x, hoff = nhs.y;
    const int my_i0 = n_i0, my_i1 = n_i1;
    const float my_g0 = n_g0, my_g1 = n_g1;
    f32x2g accp[16];
#pragma unroll
    for (int j = 0; j < 16; ++j) accp[j] = f32x2g{0.f, 0.f};
    float corr = 0.f;
    if (ti + nw < ntok) PG_TOKLOAD(tok_row(ti + nw));
#define PG_LOADU(E0, UR, RO, SC) do { const int isrc_ = ((E0) < 64) ? my_i0 : my_i1; \
      _Pragma("unroll") for (int k = 0; k < 4; ++k) { const int e_ = ((E0) + 2 * k) & 63; \
        const int ea_ = __builtin_amdgcn_readlane(isrc_, e_), eb_ = __builtin_amdgcn_readlane(isrc_, e_ + 1); \
        RO[k] = (unsigned)(up ? eb_ : ea_) * 512u + (unsigned)(hs * 16); \
        UR[k] = *(const uint4*)(U + RO[k]); } \
      { const int ei_ = __shfl(isrc_, ((E0) + 2 * k4 + up) & 63); const float4 s4_ = sc4[ei_]; SC[0] = s4_.x; SC[1] = s4_.y; SC[2] = s4_.z; } } while (0)
#define PG_LOADV(VR, RO) do { _Pragma("unroll") for (int k = 0; k < 4; ++k) VR[k] = *(const uint4*)(V + RO[k]); } while (0)
#define PG_COMPU(E0, UR, SC, WOUT) do { \
      const float ggA = __shfl(((E0) < 64) ? my_g0 : my_g1, ((E0) + 2 * k4 + up) & 63); \
      int dA[4]; \
      _Pragma("unroll") for (int k = 0; k < 4; ++k) { \
        const unsigned uu[4] = {UR[k].x, UR[k].y, UR[k].z, UR[k].w}; unsigned d1 = 0, d0 = 0; \
        _Pragma("unroll") for (int d4 = 0; d4 < 4; ++d4) {        \
          d1 = __builtin_amdgcn_udot8(hA[d4], uu[d4], d1, false); \
          d0 = __builtin_amdgcn_udot8(hB[d4], uu[d4], d0, false); } \
        dA[k] = (int)(d1 * 16u + d0); } \
      const int tA = reduce4_half(dA, lane);                     \
      WOUT = ggA * gelu_fast(((float)tA - hoff - SC[2]) * (sh * SC[0])) * SC[1]; } while (0)
#define PG_COMPV(VR, WIN) do { \
      _Pragma("unroll") for (int k = 0; k < 4; ++k) { \
        const float w0_ = __shfl(WIN, (lane & 32) + 8 * k); \
        corr += w0_; \
        const f32x2g w2 = {w0_ * (1.f / PG_VREP), w0_ * (1.f / PG_VREP)}; \
        unsigned vv[4] = {VR[k].x, VR[k].y, VR[k].z, VR[k].w}; \
        _Pragma("unroll") for (int rep_ = 0; rep_ < PG_VREP; ++rep_) { if (PG_VREP > 1) asm volatile("" : "+v"(vv[0]), "+v"(vv[1]), "+v"(vv[2]), "+v"(vv[3])); \
        _Pragma("unroll") for (int d4 = 0; d4 < 4; ++d4) { \
          const int lo = (int)(vv[d4] & 0x0F0F0F0Fu), hi = (int)((vv[d4] >> 4) & 0x0F0F0F0Fu); \
          accp[d4 * 4 + 0] += w2 * __builtin_amdgcn_cvt_pk_f32_fp8(lo, false); accp[d4 * 4 + 1] += w2 * __builtin_amdgcn_cvt_pk_f32_fp8(hi, false); \
          accp[d4 * 4 + 2] += w2 * __builtin_amdgcn_cvt_pk_f32_fp8(lo, true); accp[d4 * 4 + 3] += w2 * __builtin_amdgcn_cvt_pk_f32_fp8(hi, true); } } } } while (0)
    {
      uint4 urA[4], vrA[4], urB[4], vrB[4];
      unsigned roA[4], roB[4];
      float scA[3], scB[3], wA, wB;
      PG_LOADU(0, urA, roA, scA); PG_LOADV(vrA, roA);
      PG_LOADU(8, urB, roB, scB); PG_LOADV(vrB, roB);
#define PG_ITER(E0, MORE) do { \
        PG_COMPU((E0), urA, scA, wA); \
        if (MORE) PG_LOADU((E0) + 16, urA, roA, scA); \
        PG_COMPV(vrA, wA); \
        if (MORE) PG_LOADV(vrA, roA); \
        PG_COMPU((E0) + 8, urB, scB, wB); \
        if (MORE) PG_LOADU((E0) + 24, urB, roB, scB); \
        PG_COMPV(vrB, wB); \
        if (MORE) PG_LOADV(vrB, roB); } while (0)
#pragma unroll 1
      for (int e0 = 0; e0 < 112; e0 += 16) PG_ITER(e0, true);
      PG_ITER(112, false);
#undef PG_ITER
    }
#undef PG_LOADU
#undef PG_LOADV
#undef PG_COMPU
#undef PG_COMPV
    const float c75 = 7.5f * (corr + __shfl_xor(corr, 32));
    const float inv_unit = 1.f / __builtin_amdgcn_cvt_pk_f32_fp8(1, false)[0];
    float acc[32];
#pragma unroll
    for (int d4 = 0; d4 < 4; ++d4) {
      acc[d4 * 8 + 0] = accp[d4 * 4 + 0][0]; acc[d4 * 8 + 2] = accp[d4 * 4 + 0][1]; acc[d4 * 8 + 1] = accp[d4 * 4 + 1][0]; acc[d4 * 8 + 3] = accp[d4 * 4 + 1][1];
      acc[d4 * 8 + 4] = accp[d4 * 4 + 2][0]; acc[d4 * 8 + 6] = accp[d4 * 4 + 2][1]; acc[d4 * 8 + 5] = accp[d4 * 4 + 3][0]; acc[d4 * 8 + 7] = accp[d4 * 4 + 3][1];
    }
    float o16[16];
#pragma unroll
    for (int i = 0; i < 16; ++i) {
      const float mine = up ? acc[16 + i] : acc[i], give = up ? acc[i] : acc[16 + i];
      o16[i] = (mine + __shfl_xor(give, 32)) * inv_unit - c75;
    }
    const int col0 = hs * 32 + up * 16;
    const float* g5 = mods + (isctx ? 8 : b) * 6144 + 5 * 1024 + col0;
    char* xs = (char*)(isctx ? (xc + ((size_t)(b * CTXL + t)) * D) : (p.out + ((size_t)(b * SEQ + t - CTXL)) * D));
    float* xp = (float*)xs + col0;
    float xn[16];
    float ssq = 0.f;
    {
      float xv[16], f8[8];
      unpack8(*(const uint4*)(xs + col0 * 2), f8);
#pragma unroll
      for (int i = 0; i < 8; ++i) xv[i] = f8[i];
      unpack8(*(const uint4*)(xs + col0 * 2 + 16), f8);
#pragma unroll
      for (int i = 0; i < 8; ++i) xv[8 + i] = f8[i];
#pragma unroll
      for (int i = 0; i < 16; ++i) { xn[i] = xv[i] + g5[i] * o16[i]; ssq += xn[i] * xn[i]; }
    }
    ssq = red64(ssq);
    const float rs = rsqrtf(ssq * (1.f / 1024.f) + 1e-6f);
    if (layer == 1) {
      const float* gf = p.in[I_NF] + col0;
#pragma unroll
      for (int i = 0; i < 4; ++i)
        *(float4*)(xp + i * 4) = make_float4(xn[i * 4] * rs * gf[i * 4], xn[i * 4 + 1] * rs * gf[i * 4 + 1], xn[i * 4 + 2] * rs * gf[i * 4 + 2], xn[i * 4 + 3] * rs * gf[i * 4 + 3]);
    } else {
      if (!isctx) {
        float f8[8];
#pragma unroll
        for (int i = 0; i < 8; ++i) f8[i] = xn[i];
        *(uint4*)(xs + col0 * 2) = pack8(f8);
#pragma unroll
        for (int i = 0; i < 8; ++i) f8[i] = xn[8 + i];
        *(uint4*)(xs + col0 * 2 + 16) = pack8(f8);
      }
      const float* gn1 = p.in[I_N1_1] + col0;
      const float* m1 = mods + 9 * 6144 + (isctx ? 8 : b) * 6144 + col0;
      float hh_[16];
#pragma unroll
      for (int i = 0; i < 16; ++i) hh_[i] = xn[i] * rs * gn1[i] * (1.f + m1[1024 + i]) + m1[i];
      bf16_t* hp = (bf16_t*)(p.ws + WS_HNEXT) + (size_t)row * D + col0;
      uint4 w0, w1;
      w0.x = pack_bf2(hh_[0], hh_[1]); w0.y = pack_bf2(hh_[2], hh_[3]); w0.z = pack_bf2(hh_[4], hh_[5]); w0.w = pack_bf2(hh_[6], hh_[7]);
      w1.x = pack_bf2(hh_[8], hh_[9]); w1.y = pack_bf2(hh_[10], hh_[11]); w1.z = pack_bf2(hh_[12], hh_[13]); w1.w = pack_bf2(hh_[14], hh_[15]);
      *(uint4*)hp = w0; *(uint4*)(hp + 8) = w1;
    }
  }
}

template <int CH>
DI void conv_stream(const P& p, char* lds, bf16_t* base, int pitch  , int chan0  ) {
  const int tid = threadIdx.x;
  constexpr int NT = NTHR / CH;
  constexpr int RPT = TPB / NT;
  const int ck = tid % CH, tl = tid / CH;
  const int t0 = tl * RPT;
  bf16_t* colp = base + ck * 8;
  uint4* halo = (uint4*)lds;
  float w0[8], w1[8], w2[8], bb[8];
#pragma unroll
  for (int j = 0; j < 8; ++j) { const int c = chan0 + ck * 8 + j; w0[j] = p.in[I_CONVW][c]; w1[j] = p.in[I_CONVW][3072 + c]; w2[j] = p.in[I_CONVW][6144 + c]; bb[j] = p.in[I_CONVB][c]; }
  __syncthreads();
  uint4 cur = *(const uint4*)(colp + (size_t)t0 * pitch);
  halo[(tl * 2 + 0) * CH + ck] = cur;
  halo[(tl * 2 + 1) * CH + ck] = *(const uint4*)(colp + (size_t)(t0 + RPT - 1) * pitch);
  __syncthreads();
  uint4 prev = halo[((tl > 0 ? tl - 1 : 0) * 2 + 1) * CH + ck];
  const uint4 nxt_halo = halo[((tl < NT - 1 ? tl + 1 : NT - 1) * 2 + 0) * CH + ck];
  __syncthreads();
  constexpr int UB = (RPT % 4 == 0) ? 4 : 2;
  for (int rb = 0; rb < RPT; rb += UB) {
    uint4 nx[UB];
#pragma unroll
    for (int i = 0; i < UB; ++i) { const int r = rb + i + 1; uint4 v_ = nxt_halo; if (r < RPT) v_ = *(const uint4*)(colp + (size_t)(t0 + r) * pitch); nx[i] = v_; }
#pragma unroll
    for (int i = 0; i < UB; ++i) {
      const int t = t0 + rb + i;
      const bool first = (t == 0) || (t == CTXL), last = (t == CTXL - 1) || (t == TPB - 1);
      float u[8], um[8], up[8], o[8];
      unpack8(cur, u); unpack8(prev, um); unpack8(nx[i], up);
      const float fm = first ? 0.f : 1.f, fp_ = last ? 0.f : 1.f;
#pragma unroll
      for (int j = 0; j < 8; ++j) o[j] = siluf_(w0[j] * (fm * um[j]) + w1[j] * u[j] + w2[j] * (fp_ * up[j]) + bb[j]);
      *(uint4*)(colp + (size_t)t * pitch) = pack8(o);
      prev = cur; cur = nx[i];
    }
  }
}
DI void phase_conv(const P& p, char* lds) {
  unsigned char* pb = p.ws + WS_PB;
  for (int w = blockIdx.x; w < 256; w += gridDim.x) {
    conv_stream<8>(p, lds, (bf16_t*)(pb + L1_XH) + (size_t)w * TPB * 64, 64, (w & 31) * 64);
    const int q = w & 3, sg = (w >> 2) & 31, isC = w >> 7;
    conv_stream<4>(p, lds, (bf16_t*)(pb + (isC ? L1_CG : L1_BG)) + (size_t)sg * TPB * 128 + q * 32, 128, (isC ? 2560 : 2048) + (sg & 3) * 128 + q * 32);
  }
}

DI int swzBC(int row) { return ((row & 3) << 2) | ((row >> 2) & 3); }
DI int swzX(int row) { return ((row >> 1) & 1) << 2; }

DI void ssd_chunk_unit(const P& p, char* lds, int unit) {
  const int tid = threadIdx.x, lane = tid & 63, wave = tid >> 6;
  const int b = unit >> 5, head = unit & 31, grp = head >> 3;
  bf16_t* zh = (bf16_t*)(p.ws + WS_PB + L1_ZH) + (size_t)(b * 32 + head) * TPB * 64;
  const bf16_t* xh = (const bf16_t*)(p.ws + WS_PB + L1_XH) + (size_t)(b * 32 + head) * TPB * 64;
  const bf16_t* bg = (const bf16_t*)(p.ws + WS_PB + L1_BG) + (size_t)(b * 4 + grp) * TPB * 128;
  const bf16_t* cgp_ = (const bf16_t*)(p.ws + WS_PB + L1_CG) + (size_t)(b * 4 + grp) * TPB * 128;
  const bf16_t* dtp = (const bf16_t*)(p.ws + WS_PB + L1_DT) + (size_t)b * TPB * 64;
  bf16_t* yftmp = (bf16_t*)(p.ws + WS_YF) + (size_t)(b * 32 + head) * SEQ * 64;
  const float dsk = p.in[I_DSKIP][head];
  const int r31 = lane & 31, hh = lane >> 5, q4 = (lane & 15) >> 2, grp16 = (lane >> 4) & 1, p3 = lane & 3;
  const int lt = wave >> 1, pt = wave & 1;
  const int cc = tid & 7, rr = tid >> 3;
  const int orow = tid >> 3, ock = tid & 7;
  constexpr int NCH = TPB / 128;
  SEGS_DECL();
  for (int d = 0; d < 2; ++d) {
    const float Aneg = -__expf(p.in[I_ALOG][d * 32 + head]);
    const float dtb = p.in[I_DTB][d * 32 + head];
    f32x16 Hacc;
#pragma unroll
    for (int r = 0; r < 16; ++r) Hacc[r] = 0.f;
    __syncthreads();
    for (int e = tid; e < 1024; e += NTHR) *(uint4*)(lds + 98304 + e * 16) = make_uint4(0, 0, 0, 0);
    uint4 st[2][5];
    bf16_t dtr0, dtr1;
    uint4 oyf[2], oz[2];
#define SSD_ISSUE(CH) do { \
      _Pragma("unroll") for (int rh_ = 0; rh_ < 2; ++rh_) { \
        const int t_ = scan_token(d, (CH) * 128 + rh_ * 64 + rr); \
        st[rh_][0] = *(const uint4*)(xh + (size_t)t_ * 64 + cc * 8); \
        st[rh_][1] = *(const uint4*)(bg + (size_t)t_ * 128 + cc * 8); \
        st[rh_][2] = *(const uint4*)(bg + (size_t)t_ * 128 + 64 + cc * 8); \
        st[rh_][3] = *(const uint4*)(cgp_ + (size_t)t_ * 128 + cc * 8); \
        st[rh_][4] = *(const uint4*)(cgp_ + (size_t)t_ * 128 + 64 + cc * 8); \
      } \
      dtr0 = dtp[(size_t)scan_token(d, (CH) * 128 + lane) * 64 + d * 32 + head];        \
      dtr1 = dtp[(size_t)scan_token(d, (CH) * 128 + 64 + lane) * 64 + d * 32 + head];   \
    } while (0)
#define SSD_OUTPUT(CHP) do { char* LY = lds + zoffo + 132608; \
      if ((CHP) >= CTXL / 128) { \
        const int t0_ = scan_token(d, (CHP) * 128 + orow), t1_ = scan_token(d, (CHP) * 128 + orow + 64); \
        uint4 yv0 = *(const uint4*)(LY + orow * 128 + ock * 16), yv1 = *(const uint4*)(LY + (orow + 64) * 128 + ock * 16); \
        if (d == 0) { \
          *(uint4*)(yftmp + (size_t)(t0_ - CTXL) * 64 + ock * 8) = yv0; \
          *(uint4*)(yftmp + (size_t)(t1_ - CTXL) * 64 + ock * 8) = yv1; \
        } else { \
          float y[8], yf[8], z[8], o[8]; \
          unpack8(yv0, y); unpack8(oyf[0], yf); unpack8(oz[0], z); \
_Pragma("unroll") \
          for (int j = 0; j < 8; ++j) o[j] = (yf[j] + y[j]) * siluf_(z[j]); \
          yv0 = pack8(o); \
          unpack8(yv1, y); unpack8(oyf[1], yf); unpack8(oz[1], z); \
_Pragma("unroll") \
          for (int j = 0; j < 8; ++j) o[j] = (yf[j] + y[j]) * siluf_(z[j]); \
          yv1 = pack8(o); \
          *(uint4*)(zh + (size_t)t0_ * 64 + ock * 8) = yv0; \
          *(uint4*)(zh + (size_t)t1_ * 64 + ock * 8) = yv1; \
        } \
      } } while (0)
    SSD_ISSUE(0);
    SEGS_INIT();
    for (int ch = 0; ch < NCH; ++ch) {
      int zoff = 0;
      asm volatile("" : "+v"(zoff));
      char* L0 = lds + zoff;
      char* LB = L0; char* LC = L0 + 32768; char* LX = L0 + 65536; char* LXw = L0 + 81920; char* LHs = L0 + 98304;
      float* Lacs = (float*)(L0 + 131072); float* Ldt = (float*)(L0 + 131584); float* Lea = (float*)(L0 + 132096);
      char* LY = L0 + 132608;
      __syncthreads();
      SEGS_ADD(0);
      float dt0, dt1, acs0, acs1, alast;
      {
        dt0 = softplusf_(bf2f(dtr0) + dtb); dt1 = softplusf_(bf2f(dtr1) + dtb);
        acs0 = dt0 * Aneg; acs1 = dt1 * Aneg;
        acs0 += dpp_f<0x111>(acs0); acs1 += dpp_f<0x111>(acs1);
        acs0 += dpp_f<0x112>(acs0); acs1 += dpp_f<0x112>(acs1);
        acs0 += dpp_f<0x114>(acs0); acs1 += dpp_f<0x114>(acs1);
        acs0 += dpp_f<0x118>(acs0); acs1 += dpp_f<0x118>(acs1);
        {
          const float a0 = __int_as_float(__builtin_amdgcn_readlane(__float_as_int(acs0), 15)), a1 = __int_as_float(__builtin_amdgcn_readlane(__float_as_int(acs0), 31)),
                      a2 = __int_as_float(__builtin_amdgcn_readlane(__float_as_int(acs0), 47));
          const float b0 = __int_as_float(__builtin_amdgcn_readlane(__float_as_int(acs1), 15)), b1 = __int_as_float(__builtin_amdgcn_readlane(__float_as_int(acs1), 31)),
                      b2 = __int_as_float(__builtin_amdgcn_readlane(__float_as_int(acs1), 47));
          const int rw = lane >> 4;
          acs0 += (rw >= 1 ? a0 : 0.f) + (rw >= 2 ? a1 : 0.f) + (rw >= 3 ? a2 : 0.f);
          acs1 += (rw >= 1 ? b0 : 0.f) + (rw >= 2 ? b1 : 0.f) + (rw >= 3 ? b2 : 0.f);
        }
        acs1 += __int_as_float(__builtin_amdgcn_readlane(__float_as_int(acs0), 63));
        alast = __int_as_float(__builtin_amdgcn_readlane(__float_as_int(acs1), 63));
        if (wave == 0) {
          Lacs[lane] = acs0; Lacs[64 + lane] = acs1; Ldt[lane] = dt0; Ldt[64 + lane] = dt1;
          Lea[lane] = __expf(acs0); Lea[64 + lane] = __expf(acs1);
        }
      }
#pragma unroll
      for (int rh = 0; rh < 2; ++rh) {
        const int s_ = rh * 64 + rr;
        const float dts = __shfl(rh ? dt1 : dt0, rr);
        const float ws_ = __expf(alast - __shfl(rh ? acs1 : acs0, rr));
        float xv[8], xw[8];
        unpack8(st[rh][0], xv);
#pragma unroll
        for (int j = 0; j < 8; ++j) { xv[j] *= dts; xw[j] = xv[j] * ws_; }
        const int off = s_ * 128 + ((cc ^ swzX(s_)) << 4);
        *(uint4*)(LX + off) = pack8(xv);
        *(uint4*)(LXw + off) = pack8(xw);
        const int sw = swzBC(s_);
        *(uint4*)(LB + s_ * 256 + ((cc ^ sw) << 4)) = st[rh][1];
        *(uint4*)(LB + s_ * 256 + (((8 + cc) ^ sw) << 4)) = st[rh][2];
        *(uint4*)(LC + s_ * 256 + ((cc ^ sw) << 4)) = st[rh][3];
        *(uint4*)(LC + s_ * 256 + (((8 + cc) ^ sw) << 4)) = st[rh][4];
      }
      __builtin_amdgcn_sched_barrier(0);
      { int zoffo = zoff; SSD_OUTPUT(ch - 1); }
      __builtin_amdgcn_sched_barrier(0);
      SEGS_ADD(1);
      __syncthreads();
      SEGS_ADD(2);
      if (ch + 1 < NCH) SSD_ISSUE(ch + 1);
      const char* LBz = LB; const char* LCz = LC; const char* LXz = LX; const char* LXwz = LXw;
      const char* Hs = LHs;
      char* LMa = L0 + 114688; char* LMb = L0 + 148992;
      if (ch >= CTXL / 128) {
        f32x16 Y;
#pragma unroll
        for (int r = 0; r < 16; ++r) Y[r] = 0.f;
        const int crow = lt * 32 + r31;
        const char* cbase = LCz + crow * 256;
        const int csw = swzBC(crow);
        {
          const int hrow = pt * 32 + r31;
#pragma unroll 2
          for (int kk = 0; kk < 8; ++kk) {
            const bf16x8 cfk = *(const bf16x8*)(cbase + (((kk * 2 + hh) ^ csw) << 4));
            const bf16x8 hb = *(const bf16x8*)(Hs + hrow * 256 + (((kk * 2 + hh) ^ swzBC(hrow)) << 4));
            Y = MFMA32(cfk, hb, Y);
          }
        }
#pragma unroll
        for (int r = 0; r < 16; ++r) Y[r] *= Lea[lt * 32 + ACC_ROW(r, lane)];
        const int lcol = lt * 32 + r31;
        const float acs_l = Lacs[lcol];
        const float ddiag = (d == 1) ? dsk / Ldt[lcol] : 0.f;
        for (int st_ = pt; st_ <= lt; st_ += 2) {
          f32x16 g;
#pragma unroll
          for (int r = 0; r < 16; ++r) g[r] = 0.f;
          const int row = st_ * 32 + r31;
#pragma unroll 4
          for (int kk = 0; kk < 8; ++kk) {
            const bf16x8 a = *(const bf16x8*)(LBz + row * 256 + (((kk * 2 + hh) ^ swzBC(row)) << 4));
            const bf16x8 cfk = *(const bf16x8*)(cbase + (((kk * 2 + hh) ^ csw) << 4));
            g = MFMA32(a, cfk, g);
          }
#pragma unroll
          for (int r = 0; r < 16; ++r) {
            const int srow = st_ * 32 + ACC_ROW(r, lane);
            const float e = __expf(fminf(acs_l - Lacs[srow], 0.f));
            float val = (srow <= lcol) ? g[r] * e : 0.f;
            if (srow == lcol) val += ddiag;
            g[r] = val;
          }
          const int id = lt * (lt + 1) / 2 + st_;
          char* mt = (id < 8) ? (LMa + id * 2048) : (LMb + (id - 8) * 2048);
#pragma unroll
          for (int k2 = 0; k2 < 2; ++k2) {
            uint4 u; u.x = pack_bf2(g[8 * k2], g[8 * k2 + 1]); u.y = pack_bf2(g[8 * k2 + 2], g[8 * k2 + 3]); u.z = pack_bf2(g[8 * k2 + 4], g[8 * k2 + 5]); u.w = pack_bf2(g[8 * k2 + 6], g[8 * k2 + 7]);
            *(uint4*)(mt + (k2 * 64 + lane) * 16) = u;
          }
        }
        __syncthreads();
        if (d == 1) {
#pragma unroll
          for (int i = 0; i < 2; ++i) {
            const int t = scan_token(d, ch * 128 + orow + i * 64);
            oyf[i] = *(const uint4*)(yftmp + (size_t)(t - CTXL) * 64 + ock * 8);
            oz[i] = *(const uint4*)(zh + (size_t)t * 64 + ock * 8);
          }
        }
        for (int st_ = 0; st_ <= lt; ++st_) {
          const int id = lt * (lt + 1) / 2 + st_;
          const char* mt = (id < 8) ? (LMa + id * 2048) : (LMb + (id - 8) * 2048);
#pragma unroll
          for (int k2 = 0; k2 < 2; ++k2) {
            const bf16x8 am = *(const bf16x8*)(mt + (k2 * 64 + lane) * 16);
            const int s0 = st_ * 32 + 16 * k2 + 4 * hh + q4, s1 = s0 + 8;
            const int cx = pt * 4 + grp16 * 2 + (p3 >> 1);
            const s16x4 lo = tr_read(LXz + s0 * 128 + ((cx ^ swzX(s0)) << 4) + 8 * (p3 & 1));
            const s16x4 hi = tr_read(LXz + s1 * 128 + ((cx ^ swzX(s1)) << 4) + 8 * (p3 & 1));
            const bf16x8 bx = __builtin_shufflevector(lo, hi, 0, 1, 2, 3, 4, 5, 6, 7);
            Y = MFMA32(am, bx, Y);
          }
        }
#pragma unroll
        for (int r = 0; r < 16; ++r) {
          const int srow = lt * 32 + ACC_ROW(r, lane);
          *(bf16_t*)(LY + srow * 128 + (pt * 32 + r31) * 2) = f2bf(Y[r]);
        }
      }
      {
        const float ea = __expf(alast);
#pragma unroll
        for (int r = 0; r < 16; ++r) Hacc[r] *= ea;
        const int cb_ = lt * 4 + grp16 * 2 + (p3 >> 1);
        const int cx = pt * 4 + grp16 * 2 + (p3 >> 1);
        const int sb0 = 8 * hh + q4, sb1 = sb0 + 4;
        const char* pa_lo = LBz + sb0 * 256 + ((cb_ ^ swzBC(sb0)) << 4) + 8 * (p3 & 1);
        const char* pa_hi = LBz + sb1 * 256 + ((cb_ ^ swzBC(sb1)) << 4) + 8 * (p3 & 1);
        const char* pb_lo = LXwz + sb0 * 128 + ((cx ^ swzX(sb0)) << 4) + 8 * (p3 & 1);
        const char* pb_hi = LXwz + sb1 * 128 + ((cx ^ swzX(sb1)) << 4) + 8 * (p3 & 1);
#pragma unroll 2
        for (int k = 0; k < 8; ++k) {
          const s16x4 alo = tr_read(pa_lo + k * 4096);
          const s16x4 ahi = tr_read(pa_hi + k * 4096);
          const s16x4 blo = tr_read(pb_lo + k * 2048);
          const s16x4 bhi = tr_read(pb_hi + k * 2048);
          const bf16x8 a = __builtin_shufflevector(alo, ahi, 0, 1, 2, 3, 4, 5, 6, 7);
          const bf16x8 bb = __builtin_shufflevector(blo, bhi, 0, 1, 2, 3, 4, 5, 6, 7);
          Hacc = MFMA32(a, bb, Hacc);
        }
        char* Hn = LHs;
        const int prow = pt * 32 + r31;
#pragma unroll
        for (int g4 = 0; g4 < 4; ++g4) {
          const int n0 = lt * 32 + 8 * g4 + 4 * hh;
          uint2 w; w.x = pack_bf2(Hacc[g4 * 4], Hacc[g4 * 4 + 1]); w.y = pack_bf2(Hacc[g4 * 4 + 2], Hacc[g4 * 4 + 3]);
          *(uint2*)(Hn + prow * 256 + ((((n0 >> 3)) ^ swzBC(prow)) << 4) + (n0 & 7) * 2) = w;
        }
      }
      SEGS_ADD(3);
    }
    __syncthreads();
    { int zoffo = 0; asm volatile("" : "+v"(zoffo)); SSD_OUTPUT(NCH - 1); }
  }
#undef SSD_OUTPUT
  SEGS_FLUSH(4);
  __syncthreads();
}

DI void gn_load(uint4 (&raw)[2][4], bf16_t* (&rp)[2], bf16_t* zh, int lr0, int lane) {
#pragma unroll
  for (int u = 0; u < 2; ++u) {
    const int lr = lr0 + u, b = lr >> 12, l = lr & 4095;
    rp[u] = zh + ((size_t)(b * 32 + (lane >> 1)) * TPB + CTXL + l) * 64 + (lane & 1) * 32;
#pragma unroll
    for (int i = 0; i < 4; ++i) raw[u][i] = *(const uint4*)(rp[u] + i * 8);
  }
}
DI void gn_proc(uint4 (&raw)[2][4], bf16_t* (&rp)[2], const float (&gnv)[32]) {
#pragma unroll
  for (int u = 0; u < 2; ++u) {
    asm volatile("" : "+v"(raw[u][0].x), "+v"(raw[u][0].y), "+v"(raw[u][0].z), "+v"(raw[u][0].w), "+v"(raw[u][1].x), "+v"(raw[u][1].y), "+v"(raw[u][1].z), "+v"(raw[u][1].w),
                      "+v"(raw[u][2].x), "+v"(raw[u][2].y), "+v"(raw[u][2].z), "+v"(raw[u][2].w), "+v"(raw[u][3].x), "+v"(raw[u][3].y), "+v"(raw[u][3].z), "+v"(raw[u][3].w));
    float v[32];
#pragma unroll
    for (int i = 0; i < 4; ++i) { float f[8]; unpack8(raw[u][i], f);
#pragma unroll
      for (int j = 0; j < 8; ++j) v[i * 8 + j] = f[j]; }
    float ss = 0.f;
#pragma unroll
    for (int i = 0; i < 32; ++i) ss += v[i] * v[i];
    ss = red16(ss);
    const float rs = rsqrtf(ss * (1.f / 512.f) + 1e-6f);
#pragma unroll
    for (int i = 0; i < 4; ++i) {
      float o[8];
#pragma unroll
      for (int j = 0; j < 8; ++j) o[j] = v[i * 8 + j] * rs * gnv[i * 8 + j];
      *(uint4*)(rp[u] + i * 8) = pack8(o);
    }
  }
}
DI void phase_groupnorm(const P& p) {
  const int lane = threadIdx.x & 63, gw = blockIdx.x * 8 + WAVE_ID, nw = gridDim.x * 8;
  bf16_t* zh = (bf16_t*)(p.ws + WS_PB + L1_ZH);
  const float* gn = p.in[I_GNORM];
  float gnv[32];
#pragma unroll
  for (int i = 0; i < 8; ++i) { const float4 g4 = *(const float4*)(gn + lane * 32 + i * 4); gnv[i * 4] = g4.x; gnv[i * 4 + 1] = g4.y; gnv[i * 4 + 2] = g4.z; gnv[i * 4 + 3] = g4.w; }
  if (nw == 2048) {
    uint4 ra[2][4], rb[2][4]; bf16_t* pa[2]; bf16_t* pb[2];
    const int st = nw * 2;
#define GN_LD(R_, P_, I_) do { __builtin_amdgcn_sched_barrier(0); gn_load(R_, P_, zh, gw * 2 + (I_) * st, lane); __builtin_amdgcn_sched_barrier(0); } while (0)
    GN_LD(ra, pa, 0);
#pragma unroll 1
    for (int i = 0; i < 6; i += 2) {
      GN_LD(rb, pb, i + 1); gn_proc(ra, pa, gnv);
      GN_LD(ra, pa, i + 2); gn_proc(rb, pb, gnv);
    }
    GN_LD(rb, pb, 7); gn_proc(ra, pa, gnv);
    gn_proc(rb, pb, gnv);
#undef GN_LD
  } else {
    for (int lr0 = gw * 2; lr0 < NB * SEQ; lr0 += nw * 2) {
      uint4 raw[2][4]; bf16_t* rp[2];
      gn_load(raw, rp, zh, lr0, lane);
      gn_proc(raw, rp, gnv);
    }
  }
}


__global__ void __launch_bounds__(NTHR) fwd_kernel(P p) {
  extern __shared__ __attribute__((aligned(16))) char lds[];
  const int lo = p.ph_lo, hi = p.ph_hi;
  unsigned char* ws = p.ws;
  XcdBarrier bar; bar.bar = (unsigned*)(ws + WS_CTL); bar.x = 0; bar.st = nullptr;
  volatile LAS unsigned* stw = (volatile LAS unsigned*)(lds + LDS_BYTES - 16);
  if (hi - lo > 1) {
    if (threadIdx.x == 0) { stw[0] = 0u; stw[1] = 0u; }
    __syncthreads();
    bar = xcd_barrier_post((unsigned*)(ws + WS_CTL), stw);
  }
#ifndef PHASE_MASK
#define PHASE_MASK 0xFFFFFFFFu
#endif
#define IN(k) (((PHASE_MASK >> (k)) & 1u) && lo <= (k) && (k) < hi)
#define SEAM(k) do { if (IN(k) && IN((k) + 1)) xcd_barrier(bar); } while (0)
#ifdef PROBE_A
  unsigned long long* tsp = (unsigned long long*)(ws + WS_SCAL + 1024);
#define STAMP(k) do { if (blockIdx.x == 0 && threadIdx.x == 0) tsp[k] = __builtin_amdgcn_s_memrealtime(); } while (0)
#else
#define STAMP(k) do {} while (0)
#endif
  const int G = gridDim.x;
  bf16_t* HBp = (bf16_t*)(ws + WS_HB);
  bf16_t* PBp = (bf16_t*)(ws + WS_PB + PB_P);

#ifdef PROBE_A
  if (blockIdx.x == 0 && threadIdx.x == 0) for (int k = 22; k < 64; ++k) tsp[k] = 0ull;
#endif
  STAMP(0); if (IN(0)) { phase_prep(p, lds); } SEAM(0);
  STAMP(1); if (IN(1)) { phase_normmod(p, 0, 0, true, false, HBp); } SEAM(1);
  STAMP(2); if (IN(2)) { pg8::Order S; S.init(R / 256, 3584 / 256, G, (int)blockIdx.x, 0);
    pg8::gemm_phase(lds, pg8::Gemm{HBp, (const bf16_t*)(ws + WS_WIN0T), D, D, 0}, S, pg8::EpiP0{PBp, (const float2*)(ws + WS_ROPE)}); } SEAM(2);
  STAMP(3); if (IN(3)) {
    if (G == 256) {
      const int xg = blockIdx.x & 7, jg = blockIdx.x >> 3;
      for (int r = 0; r < 4; ++r) attn_flash_unit(p, lds, ((r * 8 + xg) << 5) | jg);
      if (jg < 8) attn_flash_unit(p, lds, 1024 + xg * 8 + jg);
    } else {
      for (int u = blockIdx.x; u < 1024 + 64; u += G) attn_flash_unit(p, lds, u);
    }
    phase_ga(p);
  } SEAM(3);
  STAMP(4); if (IN(4)) {
    if (G == 256) {
      const int xg = blockIdx.x & 7, jg = blockIdx.x >> 3;
      rwkv_scan_unit(p, lds, ((xg + 8 * (jg >> 2)) << 2) | (jg & 3));
    } else {
      for (int u = blockIdx.x; u < 256; u += G) rwkv_scan_unit(p, lds, u);
    }
    __syncthreads();
    gemm_store_phase(lds, (const bf16_t*)(ws + WS_PB + PB_GA), 128, (const bf16_t*)(ws + WS_RWT + 262144), 128, R, 512, 128, (bf16_t*)(ws + WS_PB + PB_G), 512, 512);
  } SEAM(4);
  STAMP(5); if (IN(5)) { phase_rwkv_post(p); } SEAM(5);
  STAMP(6); if (IN(6)) { pg8::Order S; S.init(R / 256, 4, G, (int)blockIdx.x, 0);
    pg8::gemm_phase(lds, pg8::Gemm{(const bf16_t*)(ws + WS_PB + PB_O0), (const bf16_t*)(ws + WS_WOUT0T), D, D, 0}, S,
                    pg8::EpiDelta{(bf16_t*)(ws + WS_PB + PB_H2), (const float*)(ws + WS_MODS)}); } SEAM(6);
  STAMP(7); if (IN(7)) { phase_normmod(p, 0, 1, true, false, (bf16_t*)(ws + WS_PB + PB_H2), (const bf16_t*)(ws + WS_PB + PB_H2)); convert_tables(p, 0); } SEAM(7);
  STAMP(8); if (IN(8)) { pg8::Order S; S.init(R / 256, 8, G, (int)blockIdx.x, 0);
    pg8::gemm_phase(lds, pg8::Gemm{(const bf16_t*)(ws + WS_PB + PB_H2), (const bf16_t*)(ws + WS_PQ0T), D, D, 0}, S, pg8::EpiBf16{(bf16_t*)(ws + WS_PB + PB_Q), 2048, 2048}); } SEAM(8);
  STAMP(9); if (IN(9)) { int ph_ = -1; for (int u = blockIdx.x; u < (R / 256) * 8; u += G) { peer_topk_unit(p, lds, 0, u, (u & 7) != ph_); ph_ = u & 7; } } SEAM(9);
  STAMP(10); if (IN(10)) { phase_peer_gather(p, 0); } SEAM(10);
  STAMP(11);
  STAMP(12); if (IN(12)) { pg8::Order S; S.init_zskip(NB * SEQ / 256, 5376 / 256, G, (int)blockIdx.x, 8);
    pg8::gemm_phase(lds, pg8::Gemm{(const bf16_t*)(ws + WS_HNEXT), (const bf16_t*)(ws + WS_WIN1T), D, D, 0}, S, pg8::EpiP1{ws + WS_PB}); } SEAM(12);
  STAMP(13); if (IN(13)) {
    phase_conv(p, lds);
    if (hi - lo > 1) xcd_barrier(bar);
    if (G == 256) {
      const int xg = blockIdx.x & 7, jg = blockIdx.x >> 3;
      const int gidx = xg + 8 * (jg >> 3);
      ssd_chunk_unit(p, lds, (gidx >> 2) * 32 + (gidx & 3) * 8 + (jg & 7));
    } else {
      for (int u = blockIdx.x; u < 256; u += G) ssd_chunk_unit(p, lds, u);
    }
  } SEAM(13);
  STAMP(14); if (IN(14)) { phase_groupnorm(p); } SEAM(14);
  STAMP(15); if (IN(15)) { pg8::Order S; S.init(NB * SEQ / 256, 4, G, (int)blockIdx.x, 1);
    pg8::gemm_phase(lds, pg8::Gemm{(const bf16_t*)(ws + WS_PB + L1_ZH), (const bf16_t*)(ws + WS_WOUT1T), 64, 2048, 1}, S,
                    pg8::EpiDelta{(bf16_t*)(ws + WS_PB + L1_XH), (const float*)(ws + WS_MODS) + 9 * 6144}); } SEAM(15);
  STAMP(16); if (IN(16)) { phase_normmod(p, 1, 1, false, true, (bf16_t*)(ws + WS_PB + PB_H2), (const bf16_t*)(ws + WS_PB + L1_XH)); convert_tables(p, 1); } SEAM(16);
  STAMP(17); if (IN(17)) { pg8::Order S; S.init(NB * SEQ / 256, 8, G, (int)blockIdx.x, 1);
    pg8::gemm_phase(lds, pg8::Gemm{(const bf16_t*)(ws + WS_PB + PB_H2), (const bf16_t*)(ws + WS_PQ1T), D, D, 0}, S, pg8::EpiBf16{(bf16_t*)(ws + WS_PB + PB_Q), 2048, 2048}); } SEAM(17);
  STAMP(18); if (IN(18)) { int ph_ = -1; for (int u = blockIdx.x; u < (NB * SEQ / 256) * 8; u += G) { const int mtl = u >> 3; peer_topk_unit(p, lds, 1, ((((mtl >> 4) * 17 + 1 + (mtl & 15)) << 3) | (u & 7)), (u & 7) != ph_); ph_ = u & 7; } } SEAM(18);
  STAMP(19); if (IN(19)) { phase_peer_gather(p, 1); }
  STAMP(20);
#ifdef PROBE_A
  xcd_barrier(bar);
  if (blockIdx.x == 0 && threadIdx.x == 0) {
    const unsigned long long tend = __builtin_amdgcn_s_memrealtime();
    tsp[21] = tend;
    unsigned long long ta = 0;
    for (int k = 0; k < 21; ++k) if ((PROBE_A >> k) & 1) ta += tsp[k + 1] - tsp[k];
    for (int k = 22; k < 64; ++k) if ((PROBE_A >> k) & 1ull) ta += tsp[k];
    while (__builtin_amdgcn_s_memrealtime() - tend < ta * PROBE_K) __builtin_amdgcn_s_sleep(8);
  }
#endif
}

extern "C" void kernel_launch(void* const* d_in, const int* in_sizes, int n_in, void* d_out, int out_size, void* d_ws, size_t ws_size, hipStream_t stream) {
  static int inited = 0;
  if (!inited) {
    if (n_in != N_IN || ws_size < WS_XC + 128 * MiB) { fprintf(stderr, "kernel_launch: unexpected n_in %d / ws_size %zu\n", n_in, ws_size); inited = -1; return; }
    if (hipFuncSetAttribute((const void*)fwd_kernel, hipFuncAttributeMaxDynamicSharedMemorySize, LDS_BYTES) != hipSuccess) { fprintf(stderr, "kernel_launch: hipFuncSetAttribute failed\n"); inited = -1; return; }
    inited = 1;
  }
  if (inited < 0) return;
  P p{};
  for (int i = 0; i < N_IN; ++i) p.in[i] = (const float*)d_in[i];
  p.out = (float*)d_out; p.ws = (unsigned char*)d_ws;
  (void)hipMemsetAsync((char*)d_ws + WS_CTL, 0, 65536, stream);
#if N_LAUNCH_MODE == 1
  p.ph_lo = 0; p.ph_hi = N_PHASES;
  hipLaunchKernelGGL(fwd_kernel, dim3(256), dim3(NTHR), LDS_BYTES, stream, p);
#else
  for (int ph = 0; ph < N_PHASES; ++ph) {
    p.ph_lo = ph; p.ph_hi = ph + 1;
    hipLaunchKernelGGL(fwd_kernel, dim3(256), dim3(NTHR), LDS_BYTES, stream, p);
  }
#endif
}
```
